# Optimizing an MI355X kernel written in HIP

```python
import math
import jax
import jax.numpy as jnp
from jax import lax
import numpy as np

D_MODEL = 1024
BATCH = 2
SEQ = 8192
DEPTH = 2

N_META = 16
CHUNK = 128
PAD = CHUNK - N_META
EPS = 1e-6

S5_WIDTH = D_MODEL // 4
S5_GROUP = 16
S5_NGROUPS = S5_WIDTH // S5_GROUP
S5_STATE = 64
S5_STEP_MIN = 1e-3
S5_STEP_MAX = 1e-1

HG_HEADS = 4
HG_DK = 64
HG_DV = 64
HG_KEY_WIDTH = HG_HEADS * HG_DK
HG_WIDTH = HG_HEADS * HG_DV
CONV_K = 4

RET_HEADS = 8
RET_DK = 32
RET_DV = 64
RET_KEY_WIDTH = RET_HEADS * RET_DK
RET_WIDTH = RET_HEADS * RET_DV
ROPE_BASE = 10000.0

D_MIX = S5_WIDTH + HG_WIDTH + RET_WIDTH
IN_SPLITS = (S5_WIDTH, HG_KEY_WIDTH, HG_KEY_WIDTH, HG_WIDTH, HG_WIDTH,
             RET_KEY_WIDTH, RET_KEY_WIDTH, RET_WIDTH, RET_WIDTH)
IN_COLS = S5_WIDTH + 2 * HG_KEY_WIDTH + 2 * HG_WIDTH + 2 * RET_KEY_WIDTH + 2 * RET_WIDTH

D_FF = 2816
N_EXPERTS = 8
TOP_K = 2
D_FF_EXPERT = 3584
N_DENSE = (DEPTH + 1) // 2
N_MOE = DEPTH // 2

kernel_name = 'hybrid_s5_hgrn2_retention_moe'


def rmsnorm(x, g):
    xf = x.astype(jnp.float32)
    y = xf * lax.rsqrt(jnp.mean(xf * xf, axis=-1, keepdims=True) + EPS)
    return (y * g.astype(jnp.float32)).astype(x.dtype)


def head_rmsnorm(o):
    return o * lax.rsqrt(jnp.mean(o * o, axis=-1, keepdims=True) + EPS)


def head_groupnorm(o):
    c = o - jnp.mean(o, axis=-1, keepdims=True)
    return c * lax.rsqrt(jnp.mean(c * c, axis=-1, keepdims=True) + EPS)


def causal_dwconv(x, w):
    xp = jnp.pad(x, ((0, 0), (CONV_K - 1, 0), (0, 0)))
    return lax.conv_general_dilated(
        xp, w[:, None, :].astype(x.dtype), window_strides=(1,), padding='VALID',
        dimension_numbers=('NWC', 'WIO', 'NWC'), feature_group_count=x.shape[-1])


def rotary(t, pos):
    half = t.shape[-1] // 2
    inv_freq = ROPE_BASE ** (-jnp.arange(half, dtype=jnp.float32) / half)
    ang = pos[:, None] * inv_freq[None, :]
    cos = jnp.cos(ang)[None, :, None, :]
    sin = jnp.sin(ang)[None, :, None, :]
    t1, t2 = t[..., :half], t[..., half:]
    return jnp.concatenate([t1 * cos - t2 * sin, t1 * sin + t2 * cos], axis=-1)


def to_chunks(t):
    b, l, h, d = t.shape
    return t.reshape(b, l // CHUNK, CHUNK, h, d).transpose(1, 0, 3, 2, 4)


def from_chunks(t):
    n, b, h, c, d = t.shape
    return t.transpose(1, 0, 3, 2, 4).reshape(b, n * c, h, d)


def _ssm_combine(a, b):
    a_decay, a_state = a
    b_decay, b_state = b
    return b_decay * a_decay, b_decay * a_state + b_state


def s5_mixer(u, lam_re, lam_im, b_re, b_im, c_re, c_im, d_skip, log_step, w_glu):
    f32 = jnp.float32
    bsz, seq_len, _ = u.shape
    uf = u.astype(f32).reshape(bsz, seq_len, S5_NGROUPS, S5_GROUP)
    lam = lax.complex(lam_re.astype(f32), lam_im.astype(f32))
    step = jnp.exp(log_step.astype(f32))[:, None]
    lam_bar = jnp.exp(lam * step)
    b_mat = lax.complex(b_re.astype(f32), b_im.astype(f32))
    c_mat = lax.complex(c_re.astype(f32), c_im.astype(f32))
    b_bar = ((lam_bar - 1.0) / lam)[..., None] * b_mat
    bu = jnp.einsum('gph,blgh->blgp', b_bar, uf.astype(jnp.complex64))
    decay = jnp.broadcast_to(lam_bar, bu.shape)
    _, states = lax.associative_scan(_ssm_combine, (decay, bu), axis=1)
    y = jnp.einsum('ghp,blgp->blgh', c_mat, states).real + d_skip.astype(f32) * uf
    y = jax.nn.gelu(y.reshape(bsz, seq_len, S5_WIDTH))
    return y * jax.nn.sigmoid(y @ w_glu.astype(f32))


def hgrn2_chunked(q, k, log_f, v):
    bsz, _, h, dk = q.shape
    dv = v.shape[-1]
    causal = jnp.tril(jnp.ones((CHUNK, CHUNK), dtype=bool))

    def step(state, blk):
        qb, kb, gb, vb = blk
        g_cum = jnp.cumsum(gb, axis=2)
        o_inter = jnp.einsum('bhik,bhkv->bhiv', qb * jnp.exp(g_cum), state)
        rel = jnp.where(causal[None, None, :, :, None],
                        g_cum[:, :, :, None, :] - g_cum[:, :, None, :, :], -jnp.inf)
        scores = jnp.einsum('bhik,bhjk,bhijk->bhij', qb, kb, jnp.exp(rel))
        o_intra = jnp.einsum('bhij,bhjv->bhiv', scores, vb)
        g_last = g_cum[:, :, -1:, :]
        new_state = (jnp.exp(g_last[:, :, 0, :])[..., None] * state
                     + jnp.einsum('bhjk,bhjv->bhkv', kb * jnp.exp(g_last - g_cum), vb))
        return new_state, o_inter + o_intra

    s0 = jnp.zeros((bsz, h, dk, dv), jnp.float32)
    _, out = lax.scan(step, s0, (to_chunks(q), to_chunks(k), to_chunks(log_f), to_chunks(v)))
    return from_chunks(out)


def hgrn2_mixer(hq, hf, hi, gate, lb, out_g):
    f32 = jnp.float32
    bsz, seq_len, _ = hq.shape
    q = jax.nn.silu(hq.astype(f32)).reshape(bsz, seq_len, HG_HEADS, HG_DK)
    z = hf.astype(f32).reshape(bsz, seq_len, HG_HEADS, HG_DK)
    lbh = lb.reshape(HG_HEADS, HG_DK)
    log_f = jnp.logaddexp(jnp.log(lbh), jnp.log1p(-lbh) + jax.nn.log_sigmoid(z))
    k = -jnp.expm1(log_f)
    v = hi.astype(f32).reshape(bsz, seq_len, HG_HEADS, HG_DV)
    o = head_rmsnorm(hgrn2_chunked(q, k, log_f, v)).reshape(bsz, seq_len, HG_WIDTH)
    return o * out_g.astype(f32) * jax.nn.silu(gate.astype(f32))


def retention_chunked(q, k, v, log_gamma):
    bsz, _, h, dk = q.shape
    dv = v.shape[-1]
    n = jnp.arange(CHUNK, dtype=jnp.float32)
    lg = log_gamma[:, None]
    causal = jnp.tril(jnp.ones((CHUNK, CHUNK), dtype=bool))
    intra = jnp.exp(jnp.where(causal[None], (n[:, None] - n[None, :])[None] * lg[:, :, None], -jnp.inf))
    inter = jnp.exp((n[None, :] + 1.0) * lg)[None, :, :, None]
    to_state = jnp.exp((CHUNK - 1.0 - n[None, :]) * lg)[None, :, :, None]
    carry_decay = jnp.exp(CHUNK * lg)[None, :, :, None]

    def step(state, blk):
        qb, kb, vb = blk
        scores = jnp.einsum('bhik,bhjk->bhij', qb, kb) * intra[None]
        o = (jnp.einsum('bhij,bhjv->bhiv', scores, vb)
             + jnp.einsum('bhik,bhkv->bhiv', qb, state) * inter)
        new_state = carry_decay * state + jnp.einsum('bhjk,bhjv->bhkv', kb * to_state, vb)
        return new_state, o

    s0 = jnp.zeros((bsz, h, dk, dv), jnp.float32)
    _, out = lax.scan(step, s0, (to_chunks(q), to_chunks(k), to_chunks(v)))
    return from_chunks(out)


def retention_mixer(rq, rk, rv, gate, pos, log_gamma, out_g):
    f32 = jnp.float32
    bsz, seq_len, _ = rq.shape
    q = rotary(rq.astype(f32).reshape(bsz, seq_len, RET_HEADS, RET_DK), pos) * (RET_DK ** -0.5)
    k = rotary(rk.astype(f32).reshape(bsz, seq_len, RET_HEADS, RET_DK), pos)
    v = rv.astype(f32).reshape(bsz, seq_len, RET_HEADS, RET_DV)
    o = head_groupnorm(retention_chunked(q, k, v, log_gamma)).reshape(bsz, seq_len, RET_WIDTH)
    return o * out_g.astype(f32) * jax.nn.silu(gate.astype(f32))


def swiglu(h, w1, w3, w2):
    a = jnp.einsum('bld,df->blf', h, w1)
    b = jnp.einsum('bld,df->blf', h, w3)
    return jnp.einsum('blf,fd->bld', jax.nn.silu(a) * b, w2)


def moe_swiglu(h, router, w1, w3, w2):
    logits = jnp.einsum('bld,de->ble', h, router).astype(jnp.float32)
    top_vals, top_idx = lax.top_k(logits, TOP_K)
    gates = jax.nn.softmax(top_vals, axis=-1)
    dense_gate = jnp.sum(jax.nn.one_hot(top_idx, N_EXPERTS, dtype=jnp.float32) * gates[..., None], axis=-2)
    out = jnp.zeros_like(h)
    for e in range(N_EXPERTS):
        out = out + dense_gate[..., e:e + 1].astype(h.dtype) * swiglu(h, w1[e], w3[e], w2[e])
    return out


def setup_inputs(seed: int = 0) -> dict:
    key = jax.random.key(seed)
    keys = iter(jax.random.split(key, 40))

    def nrm(shape, scale):
        return scale * jax.random.normal(next(keys), shape, jnp.float32)

    def gain(shape):
        return 1.0 + nrm(shape, 0.02)

    n_idx = jnp.arange(S5_STATE, dtype=jnp.float32)
    return {
        'x': nrm((BATCH, SEQ, D_MODEL), 1.0),
        'meta_tokens': nrm((N_META, D_MODEL), 1.0),
        'norm_mix_g': gain((DEPTH, D_MODEL)),
        'w_in': nrm((DEPTH, D_MODEL, IN_COLS), D_MODEL ** -0.5),
        's5_lam_re': -0.5 + nrm((DEPTH, S5_NGROUPS, S5_STATE), 0.01),
        's5_lam_im': math.pi * n_idx + nrm((DEPTH, S5_NGROUPS, S5_STATE), 0.01),
        's5_b_re': nrm((DEPTH, S5_NGROUPS, S5_STATE, S5_GROUP), (2 * S5_GROUP) ** -0.5),
        's5_b_im': nrm((DEPTH, S5_NGROUPS, S5_STATE, S5_GROUP), (2 * S5_GROUP) ** -0.5),
        's5_c_re': nrm((DEPTH, S5_NGROUPS, S5_GROUP, S5_STATE), (2 * S5_STATE) ** -0.5),
        's5_c_im': nrm((DEPTH, S5_NGROUPS, S5_GROUP, S5_STATE), (2 * S5_STATE) ** -0.5),
        's5_d': nrm((DEPTH, S5_NGROUPS, S5_GROUP), 1.0),
        's5_log_step': jax.random.uniform(next(keys), (DEPTH, S5_NGROUPS), jnp.float32,
                                          math.log(S5_STEP_MIN), math.log(S5_STEP_MAX)),
        's5_w_glu': nrm((DEPTH, S5_WIDTH, S5_WIDTH), S5_WIDTH ** -0.5),
        's5_out_g': gain((DEPTH, S5_WIDTH)),
        'hg_conv_w': nrm((DEPTH, CONV_K, 2 * HG_KEY_WIDTH + HG_WIDTH), CONV_K ** -0.5),
        'hg_lb_param': nrm((DEPTH, HG_KEY_WIDTH), 1.0),
        'hg_out_g': gain((DEPTH, HG_WIDTH)),
        'ret_out_g': gain((DEPTH, RET_WIDTH)),
        'w_out': nrm((DEPTH, D_MIX, D_MODEL), D_MIX ** -0.5),
        'norm_ffn_g': gain((DEPTH, D_MODEL)),
        'ffn_w1': nrm((N_DENSE, D_MODEL, D_FF), D_MODEL ** -0.5),
        'ffn_w3': nrm((N_DENSE, D_MODEL, D_FF), D_MODEL ** -0.5),
        'ffn_w2': nrm((N_DENSE, D_FF, D_MODEL), D_FF ** -0.5),
        'moe_router': nrm((N_MOE, D_MODEL, N_EXPERTS), D_MODEL ** -0.5),
        'moe_w1': nrm((N_MOE, N_EXPERTS, D_MODEL, D_FF_EXPERT), D_MODEL ** -0.5),
        'moe_w3': nrm((N_MOE, N_EXPERTS, D_MODEL, D_FF_EXPERT), D_MODEL ** -0.5),
        'moe_w2': nrm((N_MOE, N_EXPERTS, D_FF_EXPERT, D_MODEL), D_FF_EXPERT ** -0.5),
        'final_norm_g': gain((D_MODEL,)),
    }


def reference(x, meta_tokens, norm_mix_g, w_in, s5_lam_re, s5_lam_im, s5_b_re, s5_b_im,
              s5_c_re, s5_c_im, s5_d, s5_log_step, s5_w_glu, s5_out_g, hg_conv_w,
              hg_lb_param, hg_out_g, ret_out_g, w_out, norm_ffn_g, ffn_w1, ffn_w3, ffn_w2,
              moe_router, moe_w1, moe_w3, moe_w2, final_norm_g):
    f32 = jnp.float32
    dt = x.dtype
    bsz, seq_len, d = x.shape
    total = seq_len + CHUNK
    meta = jnp.broadcast_to(meta_tokens.astype(dt)[None], (bsz, N_META, d))
    h = jnp.concatenate([jnp.zeros((bsz, PAD, d), dt), meta, x], axis=1)
    mask = (jnp.arange(total) >= PAD).astype(dt)[None, :, None]
    pos = (jnp.arange(total) - PAD).astype(f32)

    lb_all = jnp.cumsum(jax.nn.softmax(hg_lb_param.astype(f32), axis=0), axis=0)
    lb_all = lb_all - lb_all[0]
    log_gamma = jnp.log1p(-jnp.power(2.0, -5.0 - jnp.arange(RET_HEADS, dtype=f32)))

    split_idx = [int(i) for i in np.cumsum(IN_SPLITS)[:-1]]
    hg_idx = [HG_KEY_WIDTH, 2 * HG_KEY_WIDTH]

    for l in range(DEPTH):
        hn = rmsnorm(h, norm_mix_g[l])
        proj = jnp.einsum('bld,dc->blc', hn, w_in[l]) * mask
        u, hq, hf, hi, hgate, rq, rk, rv, rgate = jnp.split(proj, split_idx, axis=-1)

        y_a = rmsnorm(s5_mixer(u, s5_lam_re[l], s5_lam_im[l], s5_b_re[l], s5_b_im[l],
                               s5_c_re[l], s5_c_im[l], s5_d[l], s5_log_step[l], s5_w_glu[l]),
                      s5_out_g[l])
        hqfi = causal_dwconv(jnp.concatenate([hq, hf, hi], axis=-1), hg_conv_w[l])
        cq, cf, ci = jnp.split(hqfi, hg_idx, axis=-1)
        y_b = hgrn2_mixer(cq, cf, ci, hgate, lb_all[l], hg_out_g[l])
        y_c = retention_mixer(rq, rk, rv, rgate, pos, log_gamma, ret_out_g[l])

        mixed = jnp.concatenate([y_a, y_b, y_c], axis=-1).astype(dt)
        h = h + jnp.einsum('blc,cd->bld', mixed, w_out[l])

        hn = rmsnorm(h, norm_ffn_g[l])
        if l % 2 == 0:
            ffn = swiglu(hn, ffn_w1[l // 2], ffn_w3[l // 2], ffn_w2[l // 2])
        else:
            ffn = moe_swiglu(hn, moe_router[l // 2], moe_w1[l // 2], moe_w3[l // 2], moe_w2[l // 2])
        h = h + ffn

    h = rmsnorm(h, final_norm_g)
    return h[:, CHUNK:, :]
```

```cpp
#include <hip/hip_runtime.h>
#include <cstdio>
#include <cstdint>
#include <cmath>
namespace pg8 {
#define PG8_LAS __attribute__((address_space(3)))
typedef unsigned short bf16_t;
typedef short bf16x8 __attribute__((ext_vector_type(8)));
typedef float f32x4 __attribute__((ext_vector_type(4)));
typedef unsigned u32x4 __attribute__((ext_vector_type(4)));
constexpr int BM = 256, BK = 64, HALF = 128, HTB = HALF * BK * 2  , STAGE_BYTES = 8 * HTB, NXCD = 8, WGM = 8;

__host__ __device__ __forceinline__ int lds_byte(int r, int c) { const int st = (r >> 4) * 2 + (c >> 5), rr = r & 15, cc = c & 31, ob = rr * 64 + cc * 2; return st * 1024 + (ob ^ (((ob >> 9) & 1) << 5)); }
__host__ __device__ __forceinline__ void stage_rc(int b, int& R, int& C) { const int st = b / 1024, sb = b % 1024, swz = sb ^ (((sb >> 9) & 1) << 5); R = (st >> 1) * 16 + swz / 64; C = (st & 1) * 32 + (swz % 64) / 2; }
__host__ __device__ __forceinline__ int perm32(int rho) { const int n = rho >> 4, i = rho & 15; return 8 * (i >> 2) + 4 * n + (i & 3); }

struct Unit { int pm, pn; };
struct Gemm { const bf16_t* A; const bf16_t* Bt; int M, N, K; };

struct StaticOrder {
    int nM, nN, nwg, G, c;
    __host__ __device__ void init(int M, int N, int G_, int c_) { nM = M / BM; nN = N / BM; nwg = nM * nN; G = G_; c = c_; }
    __host__ __device__ bool next(int i, Unit& u) const {
        const long L = (long)i * G + c; if (L >= nwg) return false;
        int wgid = (int)L; { const int q = nwg / NXCD, r = nwg % NXCD, xcd = wgid % NXCD, off = wgid / NXCD; wgid = (xcd < r ? xcd * (q + 1) : r * (q + 1) + (xcd - r) * q) + off; }
        const int nig = WGM * nN, gid = wgid / nig, fm = gid * WGM, gsz = (nM - fm) < WGM ? (nM - fm) : WGM;
        u.pm = fm + ((wgid % nig) % gsz); u.pn = (wgid % nig) / gsz; return true;
    }
    __device__ __forceinline__ void a_ready(const Unit&) const {}
    __device__ __forceinline__ void done(const Unit&) const {}
};

__device__ __forceinline__ unsigned cvt_pk_bf16(float lo, float hi) { unsigned r; asm volatile("v_cvt_pk_bf16_f32 %0, %1, %2" : "=v"(r) : "v"(lo), "v"(hi)); return r; }
typedef float f32x2 __attribute__((ext_vector_type(2)));
constexpr float RMS_EPS = 1e-6f;
__device__ __forceinline__ float fast_silu(float a) { return a * __builtin_amdgcn_rcpf(1.0f + __expf(-a)); }
__device__ __forceinline__ float row_rstd(const float* ss, int row) { const f32x4* p = (const f32x4*)(ss + (size_t)row * 16); const f32x4 a = p[0], b = p[1], c = p[2], d = p[3];
    const float t = (((a[0] + a[1]) + (a[2] + a[3])) + ((b[0] + b[1]) + (b[2] + b[3]))) + (((c[0] + c[1]) + (c[2] + c[3])) + ((d[0] + d[1]) + (d[2] + d[3])));
    return __builtin_amdgcn_rsqf(t * (1.0f / 1024.0f) + RMS_EPS); }
struct EpiProj {
    static constexpr bool PERM = true, AFTER_DRAIN = false;
    bf16_t* O; int ldc; const float* ss;
    __device__ __forceinline__ void operator()(const f32x4 (&acc)[2][2][4][2], const Unit& u, int wr, int wc, int fr, int fq) const {
        const int row0 = u.pm * BM + wr * 64 + fr, col0 = u.pn * BM + wc * 32 + 8 * fq;
#pragma unroll
        for (int ai = 0; ai < 2; ++ai)
#pragma unroll
            for (int m = 0; m < 4; ++m) { const int row = row0 + ai * HALF + m * 16; const float sc = row_rstd(ss, row);
                bf16_t* rowp = O + (size_t)row * ldc + col0;
#pragma unroll
                for (int bj = 0; bj < 2; ++bj) { const f32x4 v0 = acc[ai][bj][m][0] * sc, v1 = acc[ai][bj][m][1] * sc;
                    u32x4 w; w.x = cvt_pk_bf16(v0[0], v0[1]); w.y = cvt_pk_bf16(v0[2], v0[3]); w.z = cvt_pk_bf16(v1[0], v1[1]); w.w = cvt_pk_bf16(v1[2], v1[3]);
                    *(u32x4*)(rowp + bj * HALF) = w; } }
    }
};
struct EpiSwiglu {
    static constexpr bool PERM = true, AFTER_DRAIN = false;
    bf16_t* O; int ldc; const float* ss;
    __device__ __forceinline__ void operator()(const f32x4 (&acc)[2][2][4][2], const Unit& u, int wr, int wc, int fr, int fq) const {
        const int row0 = u.pm * BM + wr * 64 + fr, col0 = u.pn * HALF + wc * 32 + 8 * fq;
#pragma unroll
        for (int ai = 0; ai < 2; ++ai)
#pragma unroll
            for (int m = 0; m < 4; ++m) { const int row = row0 + ai * HALF + m * 16; const float sc = row_rstd(ss, row);
                const f32x4 a0 = acc[ai][0][m][0] * sc, a1 = acc[ai][0][m][1] * sc, b0 = acc[ai][1][m][0] * sc, b1 = acc[ai][1][m][1] * sc;
                u32x4 w; w.x = cvt_pk_bf16(fast_silu(a0[0]) * b0[0], fast_silu(a0[1]) * b0[1]); w.y = cvt_pk_bf16(fast_silu(a0[2]) * b0[2], fast_silu(a0[3]) * b0[3]);
                w.z = cvt_pk_bf16(fast_silu(a1[0]) * b1[0], fast_silu(a1[1]) * b1[1]); w.w = cvt_pk_bf16(fast_silu(a1[2]) * b1[2], fast_silu(a1[3]) * b1[3]);
                *(u32x4*)(O + (size_t)row * ldc + col0) = w; }
    }
};
struct EpiResid {
    static constexpr bool PERM = false, AFTER_DRAIN = false;
    float* H; bf16_t* HB; float* ssout; const float* gate; int gstride; int write_hb;
    __device__ __forceinline__ void operator()(const f32x4 (&acc)[2][2][4][2], const Unit& u, int wr, int wc, int fr, int fq) const {
        const int row0 = u.pm * BM + wr * 64 + fr, col0 = u.pn * BM + wc * 32 + 4 * fq;
#pragma unroll
        for (int ai = 0; ai < 2; ++ai)
#pragma unroll
            for (int m = 0; m < 4; ++m) { const int row = row0 + ai * HALF + m * 16; const float g = gate ? gate[(size_t)row * gstride] : 1.0f;
                float* hp = H + (size_t)row * 1024 + col0; float s = 0.f;
#pragma unroll
                for (int bj = 0; bj < 2; ++bj)
#pragma unroll
                    for (int n = 0; n < 2; ++n) { float* p = hp + bj * HALF + n * 16; const f32x4 o = *(const f32x4*)p + acc[ai][bj][m][n] * g; *(f32x4*)p = o;
                        s += (o[0] * o[0] + o[1] * o[1]) + (o[2] * o[2] + o[3] * o[3]);
                        if (write_hb) { unsigned long long w = (unsigned long long)cvt_pk_bf16(o[0], o[1]) | ((unsigned long long)cvt_pk_bf16(o[2], o[3]) << 32);
                            *(unsigned long long*)(HB + (size_t)row * 1024 + col0 + bj * HALF + n * 16) = w; } }
                if (write_hb) { s += __shfl_xor(s, 16); s += __shfl_xor(s, 32); if (fq == 0) ssout[(size_t)row * 16 + u.pn * 4 + wc] = s; } }
    }
};

template <class Epi, class Sched, bool ALIGN_EPI = false, bool SP2 = false>
__device__ __forceinline__ void gemm_phase(PG8_LAS unsigned char* lds, const Gemm g, const Sched& S, const Epi& E) {
    int tid_ = threadIdx.x; asm volatile("" : "+v"(tid_));
    const int tid = tid_, wid = __builtin_amdgcn_readfirstlane(tid >> 6), lane = tid & 63, wr = wid >> 2, wc = wid & 3, fr = lane & 15, fq = lane >> 4;
    const int K = g.K, nt = K / BK;
    unsigned voffA[2], voffB[2];
#pragma unroll
    for (int i = 0; i < 2; ++i) { int R, C; stage_rc(tid * 16 + i * 8192, R, C); const int Rb = Epi::PERM ? ((R & ~31) + perm32(R & 31)) : R;
        voffA[i] = (unsigned)(R * K + C) * 2u; voffB[i] = (unsigned)(Rb * K + C) * 2u; }
    const size_t kstep = (size_t)(BK * 2);
    const size_t hstep = (size_t)HALF * K * 2;
    const size_t tstep = 2 * hstep;
    const unsigned ldsw = (unsigned)wid * 1024u;
    const int aoff = lds_byte(wr * 64 + fr, fq * 8), boff = lds_byte(wc * 32 + fr, fq * 8);
#define PG8_SA(b, h) (((b) * 2 + (h)) * HTB)
#define PG8_SB(b, h) ((4 + (b) * 2 + (h)) * HTB)
#define PG8_STAGE(bufoff, gbase, voff) do { _Pragma("unroll") for (int _i = 0; _i < 2; ++_i) \
        __builtin_amdgcn_global_load_lds((const unsigned*)((const char*)(gbase) + (voff)[_i]), (PG8_LAS unsigned*)(lds + (bufoff) + ldsw + _i * 8192), 16, 0, 0); } while (0)
#define PG8_LDA(dst, b, h) do { _Pragma("unroll") for (int m = 0; m < 4; ++m) _Pragma("unroll") for (int k = 0; k < 2; ++k) dst[m][k] = *(const PG8_LAS bf16x8*)(lds + PG8_SA(b, h) + aoff + m * 2048 + k * 1024); } while (0)
#define PG8_LDB(dst, b, h) do { _Pragma("unroll") for (int n = 0; n < 2; ++n) _Pragma("unroll") for (int k = 0; k < 2; ++k) dst[n][k] = *(const PG8_LAS bf16x8*)(lds + PG8_SB(b, h) + boff + n * 2048 + k * 1024); } while (0)
#define PG8_MMA(ai, bj, At, Bt) do { __builtin_amdgcn_s_setprio(1); _Pragma("unroll") for (int m = 0; m < 4; ++m) _Pragma("unroll") for (int n = 0; n < 2; ++n) _Pragma("unroll") for (int k = 0; k < 2; ++k) \
        acc[ai][bj][m][n] = __builtin_amdgcn_mfma_f32_16x16x32_bf16(Bt[n][k], At[m][k], acc[ai][bj][m][n], 0, 0, 0); __builtin_amdgcn_s_setprio(0); } while (0)
#define PG8_WAIT_V(n) asm volatile("s_waitcnt vmcnt(" #n ")" ::: "memory")
#define PG8_WAIT_L(n) asm volatile("s_waitcnt lgkmcnt(" #n ")" ::: "memory")
#define PG8_BAR __builtin_amdgcn_s_barrier()
#define PG8_SCHED __builtin_amdgcn_sched_barrier(0)
    Unit cur, nxt; int ui = 0;
    if (!S.next(0, cur)) return;
    f32x4 acc[2][2][4][2];
#pragma unroll
    for (int a = 0; a < 2; ++a)
#pragma unroll
        for (int b = 0; b < 2; ++b)
#pragma unroll
            for (int m = 0; m < 4; ++m)
#pragma unroll
                for (int n = 0; n < 2; ++n) acc[a][b][m][n] = (f32x4){0.f, 0.f, 0.f, 0.f};
    bf16x8 At[4][2], B0[2][2], B1[2][2];
    const char* cA = (const char*)g.A + (size_t)cur.pm * tstep; const char* cB = (const char*)g.Bt + (size_t)cur.pn * tstep;
    S.a_ready(cur);
    if constexpr (SP2) {
        PG8_STAGE(PG8_SB(0, 0), cB, voffB); PG8_STAGE(PG8_SB(0, 1), cB + hstep, voffB); PG8_STAGE(PG8_SA(0, 0), cA, voffA); PG8_STAGE(PG8_SA(0, 1), cA + hstep, voffA);
        if (wr == 1) PG8_BAR;
        PG8_WAIT_V(2); PG8_BAR;
        PG8_STAGE(PG8_SB(1, 0), cB + kstep, voffB); PG8_STAGE(PG8_SA(1, 0), cA + kstep, voffA); PG8_STAGE(PG8_SB(1, 1), cB + hstep + kstep, voffB);
        PG8_WAIT_V(6); PG8_BAR;
    } else {
        PG8_STAGE(PG8_SB(0, 0), cB, voffB); PG8_STAGE(PG8_SA(0, 0), cA, voffA); PG8_STAGE(PG8_SB(0, 1), cB + hstep, voffB); PG8_STAGE(PG8_SA(0, 1), cA + hstep, voffA);
        if (wr == 1) PG8_BAR;
        PG8_WAIT_V(4); PG8_BAR;
        PG8_STAGE(PG8_SB(1, 0), cB + kstep, voffB); PG8_STAGE(PG8_SA(1, 0), cA + kstep, voffA); PG8_STAGE(PG8_SB(1, 1), cB + hstep + kstep, voffB);
        PG8_WAIT_V(6); PG8_BAR;
    }
    for (;;) {
        const bool has_next = S.next(ui + 1, nxt);
        const char* nA = has_next ? (const char*)g.A + (size_t)nxt.pm * tstep : cA; const char* nB = has_next ? (const char*)g.Bt + (size_t)nxt.pn * tstep : cB;
        for (int t = 0; t < nt; t += 2) {
            const bool last = (t == nt - 2);
            const char* a1 = cA + (size_t)(t + 1) * kstep;
            const char* a2 = last ? nA : cA + (size_t)(t + 2) * kstep; const char* b2 = last ? nB : cB + (size_t)(t + 2) * kstep;
            const char* a3 = a2 + kstep; const char* b3 = b2 + kstep;
            if (last && has_next) S.a_ready(nxt);
            if constexpr (SP2) {
            PG8_LDB(B0, 0, 0); PG8_LDB(B1, 0, 1); PG8_SCHED; PG8_LDA(At, 0, 0); PG8_STAGE(PG8_SA(1, 1), a1 + hstep, voffA);
            PG8_WAIT_V(8); PG8_WAIT_L(0); PG8_BAR; PG8_MMA(0, 0, At, B0); PG8_MMA(0, 1, At, B1); PG8_BAR; PG8_SCHED;
            PG8_LDA(At, 0, 1); PG8_STAGE(PG8_SB(0, 0), b2, voffB); PG8_STAGE(PG8_SB(0, 1), b2 + hstep, voffB); PG8_STAGE(PG8_SA(0, 0), a2, voffA);
            PG8_WAIT_V(8); PG8_WAIT_L(0); PG8_BAR; PG8_MMA(1, 0, At, B0); PG8_MMA(1, 1, At, B1); PG8_BAR; PG8_SCHED;
            PG8_LDB(B0, 1, 0); PG8_LDB(B1, 1, 1); PG8_SCHED; PG8_LDA(At, 1, 0); PG8_STAGE(PG8_SA(0, 1), a2 + hstep, voffA);
            PG8_WAIT_V(8); PG8_WAIT_L(0); PG8_BAR; PG8_MMA(0, 0, At, B0); PG8_MMA(0, 1, At, B1); PG8_BAR; PG8_SCHED;
            PG8_LDA(At, 1, 1); PG8_STAGE(PG8_SB(1, 0), b3, voffB); PG8_STAGE(PG8_SB(1, 1), b3 + hstep, voffB); PG8_STAGE(PG8_SA(1, 0), a3, voffA);
            PG8_WAIT_V(8); PG8_WAIT_L(0); PG8_BAR; PG8_MMA(1, 0, At, B0); PG8_MMA(1, 1, At, B1); PG8_BAR; PG8_SCHED;
            } else {
            PG8_LDB(B0, 0, 0); PG8_SCHED; PG8_LDA(At, 0, 0); PG8_STAGE(PG8_SA(1, 1), a1 + hstep, voffA);
            PG8_WAIT_L(8); PG8_BAR; PG8_WAIT_L(0); PG8_MMA(0, 0, At, B0); PG8_BAR; PG8_SCHED;
            PG8_LDB(B1, 0, 1); PG8_STAGE(PG8_SB(0, 0), b2, voffB);
            PG8_BAR; PG8_WAIT_L(0); PG8_MMA(0, 1, At, B1); PG8_BAR;
            PG8_LDA(At, 0, 1); PG8_STAGE(PG8_SA(0, 0), a2, voffA);
            PG8_BAR; PG8_WAIT_L(0); PG8_MMA(1, 0, At, B0); PG8_BAR; PG8_SCHED;
            PG8_STAGE(PG8_SB(0, 1), b2 + hstep, voffB);
            PG8_WAIT_V(6); PG8_BAR; PG8_MMA(1, 1, At, B1); PG8_BAR;
            PG8_LDB(B0, 1, 0); PG8_SCHED; PG8_LDA(At, 1, 0); PG8_STAGE(PG8_SA(0, 1), a2 + hstep, voffA);
            PG8_WAIT_L(8); PG8_BAR; PG8_WAIT_L(0); PG8_MMA(0, 0, At, B0); PG8_BAR; PG8_SCHED;
            PG8_LDB(B1, 1, 1); PG8_STAGE(PG8_SB(1, 0), b3, voffB);
            PG8_BAR; PG8_WAIT_L(0); PG8_MMA(0, 1, At, B1); PG8_BAR;
            PG8_LDA(At, 1, 1); PG8_STAGE(PG8_SA(1, 0), a3, voffA);
            PG8_BAR; PG8_WAIT_L(0); PG8_MMA(1, 0, At, B0); PG8_BAR; PG8_SCHED;
            PG8_STAGE(PG8_SB(1, 1), b3 + hstep, voffB);
            PG8_WAIT_V(6); PG8_BAR; PG8_MMA(1, 1, At, B1); PG8_BAR;
            }
        }
        if constexpr (ALIGN_EPI) { if (wr == 0) PG8_BAR; }
        if constexpr (!Epi::AFTER_DRAIN) { E(acc, cur, wr, wc, fr, fq); S.done(cur); }
        if (!has_next) break;
#pragma unroll
        for (int a = 0; a < 2; ++a)
#pragma unroll
            for (int b = 0; b < 2; ++b)
#pragma unroll
                for (int m = 0; m < 4; ++m)
#pragma unroll
                    for (int n = 0; n < 2; ++n) acc[a][b][m][n] = (f32x4){0.f, 0.f, 0.f, 0.f};
        cur = nxt; cA = nA; cB = nB; ++ui;
        if constexpr (ALIGN_EPI) { if (wr == 1) PG8_BAR; }
    }
    PG8_WAIT_V(0);
    if constexpr (!ALIGN_EPI) { if (wr == 0) PG8_BAR; }
    PG8_BAR;
    if constexpr (Epi::AFTER_DRAIN) { E.fused(acc, cur, wr, wc, fr, fq, lds, wid, lane); S.done(cur); }
#undef PG8_SA
#undef PG8_SB
#undef PG8_STAGE
#undef PG8_LDA
#undef PG8_LDB
#undef PG8_MMA
#undef PG8_WAIT_V
#undef PG8_WAIT_L
#undef PG8_BAR
#undef PG8_SCHED
}
}
#define GAS __attribute__((address_space(1)))
#define LAS __attribute__((address_space(3)))
typedef unsigned short bf16;
typedef unsigned v4u __attribute__((ext_vector_type(4)));
typedef float f32x4 __attribute__((ext_vector_type(4)));
typedef short bf16x8 __attribute__((ext_vector_type(8)));
typedef GAS unsigned gu32;
typedef GAS unsigned long long gu64;
#define RLX_AGENT __ATOMIC_RELAXED, __HIP_MEMORY_SCOPE_AGENT
#define LDS_WAIT() asm volatile("s_waitcnt lgkmcnt(0)" ::: "memory")
#define VM_WAIT() asm volatile("s_waitcnt vmcnt(0)" ::: "memory")
__device__ __forceinline__ unsigned long long rt() { return __builtin_amdgcn_s_memrealtime(); }
__device__ __forceinline__ unsigned f2bf(float f) { unsigned u = __builtin_bit_cast(unsigned, f); return (u + 0x7fffu + ((u >> 16) & 1u)) >> 16; }
__device__ __forceinline__ unsigned pk2(float lo, float hi) { return f2bf(lo) | (f2bf(hi) << 16); }

#define XB_TMO      128
#define XB_XCNT(j)  (256  + 64 * (j))
#define XB_XSUB(j)  (1280 + 64 * (j))
#define XB_XGEN(j)  (2304 + 64 * (j))
#define XB_TOP      3328
#define XB_TOPGEN   3392
#define XCD_BAR_WORDS 3456
#define XB_SPIN_CAP (1u << 18)

__device__ __forceinline__ unsigned xb_ld(unsigned* p)              { return __hip_atomic_load(p, __ATOMIC_RELAXED, __HIP_MEMORY_SCOPE_AGENT); }
__device__ __forceinline__ unsigned xb_add(unsigned* p, unsigned v) { return __hip_atomic_fetch_add(p, v, __ATOMIC_RELAXED, __HIP_MEMORY_SCOPE_AGENT); }
__device__ __forceinline__ unsigned xb_xcc_id() { return (unsigned)__builtin_amdgcn_s_getreg((3 << 11) | 20) & 0xFu; }
#define XB_SPIN(cond, bar) do { unsigned _sp = 0; while (cond) { __builtin_amdgcn_s_sleep(1); \
    if ((++_sp & 255u) == 0u) { if (xb_ld(&(bar)[XB_TMO])) break; if (_sp > XB_SPIN_CAP) { atomicAdd(&(bar)[XB_TMO], 1u); break; } } } } while (0)

struct XcdBarrier {
    unsigned* bar; unsigned x;
    volatile LAS unsigned* st;
};

__device__ __forceinline__ XcdBarrier xcd_barrier_post(unsigned* bar, volatile LAS unsigned* st) {
    XcdBarrier b; b.bar = bar; b.x = xb_xcc_id(); b.st = st;
    if (threadIdx.x == 0) (void)xb_add(&bar[XB_XCNT(b.x)], 1u);
    return b;
}
__device__ __forceinline__ void xcd_barrier_complete(unsigned* bar, unsigned x, unsigned& nloc, unsigned& nx) {
    const unsigned G = gridDim.x * gridDim.y * gridDim.z;
    unsigned sum, cnt, mine, sp = 0u;
    for (;;) {
        sum = 0u; cnt = 0u; mine = 0u;
#pragma unroll
        for (unsigned j = 0; j < 16; ++j) { const unsigned c = xb_ld(&bar[XB_XCNT(j)]); sum += c; cnt += (c > 0u) ? 1u : 0u; mine = (j == x) ? c : mine; }
        if (sum == G) break;
        __builtin_amdgcn_s_sleep(1);
        if ((++sp & 255u) == 0u) { if (xb_ld(&bar[XB_TMO])) break; if (sp > XB_SPIN_CAP) { atomicAdd(&bar[XB_TMO], 1u); break; } }
    }
    nloc = mine > 0u ? mine : 1u; nx = cnt > 0u ? cnt : 1u;
}

__device__ __forceinline__ void xcd_barrier(const XcdBarrier& b) {
    asm volatile("s_waitcnt vmcnt(0)" ::: "memory");
    __syncthreads();
    if (threadIdx.x == 0) {
        unsigned* bar = b.bar;
        __builtin_amdgcn_s_waitcnt(0);
        unsigned nloc = b.st[0], nx = b.st[1];
        if (nloc == 0u) { xcd_barrier_complete(bar, b.x, nloc, nx); b.st[0] = nloc; b.st[1] = nx; }
        const unsigned old = xb_add(&bar[XB_XSUB(b.x)], 1u);
        const unsigned gen = old / nloc;
        if (old + 1u == (gen + 1u) * nloc) {
            __builtin_amdgcn_fence(__ATOMIC_RELEASE, "agent");
            asm volatile("s_waitcnt vmcnt(0)" ::: "memory");
            const unsigned og = xb_add(&bar[XB_TOP], 1u);
            const unsigned tg = og / nx;
            if (og + 1u == (tg + 1u) * nx) xb_add(&bar[XB_TOPGEN], 1u);
            else XB_SPIN(xb_ld(&bar[XB_TOPGEN]) == tg, bar);
            __builtin_amdgcn_fence(__ATOMIC_ACQUIRE, "agent");
            xb_add(&bar[XB_XGEN(b.x)], 1u);
            asm volatile("s_waitcnt vmcnt(0)" ::: "memory");
        } else {
            XB_SPIN(xb_ld(&bar[XB_XGEN(b.x)]) == gen, bar);
            __builtin_amdgcn_fence(__ATOMIC_ACQUIRE, "agent");
            asm volatile("s_waitcnt vmcnt(0)" ::: "memory");
        }
    }
    __syncthreads();
}
constexpr int NWAVES = 8, NT = 512;
constexpr int BATCH = 2, SEQ = 8192, D = 1024, TB = 8320, M = BATCH * TB, PADR = 112;
constexpr int NIN = 2816, DFF = 2816, NEXP = 8, DFE = 3584;
constexpr int C_U = 0, C_HQ = 256, C_HF = 512, C_HI = 768, C_HG = 1024, C_RQ = 1280, C_RK = 1536, C_RV = 1792, C_RG = 2304;
constexpr float EPS = 1e-6f;
#ifndef MK_PER_PHASE
#define MK_PER_PHASE 0
#endif
constexpr int NPH = 50;
__host__ __device__ inline bool phase_exists(int k) {
    if (k == 0 || k == NPH - 1) return true;
    const int l = (k - 1) / 24, r = (k - 1) % 24;
    if (r <= 3) return true;
    if (r == 4) return l == 1;
    const int e = (r - 5) / 2; return e < (l == 0 ? 1 : NEXP);
}
constexpr size_t MiB = 1u << 20;
constexpr size_t WS_CTL = 0, CTL_ZERO_BYTES = 1 * MiB;
constexpr int CW_TMO = 0, CW_CODE = 1, CW_BAR = 4096;
constexpr size_t WS_LB = 1 * MiB, WS_BB = 1 * MiB + 65536, WS_ROT = 1 * MiB + 524288, WS_LBT = 3 * MiB, WS_GT = 3 * MiB + 65536;
constexpr size_t WS_WIN = 4 * MiB, WS_WOUT = 15 * MiB, WS_WF13 = 19 * MiB, WS_WF2 = 30 * MiB, WS_WM13 = 36 * MiB, WS_WM2 = 148 * MiB;
constexpr size_t WS_H = 204 * MiB, WS_HB = 269 * MiB, WS_PROJ = 302 * MiB, WS_MIXED = 392 * MiB, WS_ACT = 302 * MiB, WS_YS5 = 425 * MiB, WS_SSP = 442 * MiB, WS_END = 448 * MiB;
static_assert(WS_PROJ + (size_t)M * NIN * 2 <= WS_MIXED && WS_MIXED + (size_t)M * D * 2 <= WS_YS5 && WS_ACT + (size_t)M * DFE * 2 <= WS_YS5 && WS_YS5 + (size_t)M * 256 * 4 <= WS_SSP && WS_SSP + (size_t)5 * M * 16 * 4 <= WS_END, "ws map");
static_assert(WS_H + (size_t)M * D * 4 <= WS_HB && WS_HB + (size_t)M * D * 2 <= WS_PROJ && WS_WM2 + (size_t)NEXP * D * DFE * 2 <= WS_H && WS_WM13 + (size_t)NEXP * 2 * DFE * D * 2 <= WS_WM2, "ws map 2");
constexpr int RING_OFF = 0, RING_BYTES = 131072, LDSCTL_OFF = RING_BYTES, MISC_OFF = LDSCTL_OFF + 320, LDS_BYTES = 147456;

struct Frame { LAS unsigned char* lds; volatile LAS unsigned* MISC; gu32* ctl; unsigned char* ws; const float* const* in; };
struct Loc { int tid, lane, wave, bx, vcu, G; };
__device__ __forceinline__ Loc make_loc() { Loc L; int t = threadIdx.x; asm volatile("" : "+v"(t)); int b = blockIdx.x; asm volatile("" : "+s"(b)); L.tid = t; L.lane = t & 63; L.wave = __builtin_amdgcn_readfirstlane(t >> 6);
    L.bx = b; L.G = gridDim.x; L.vcu = (L.G % 8 == 0) ? (b % 8) * (L.G / 8) + b / 8 : b; return L; }
__device__ __forceinline__ float bf2f(bf16 x) { return __uint_as_float((unsigned)x << 16); }
__device__ __forceinline__ bf16 f2bf_(float f) { return (bf16)f2bf(f); }
__device__ __forceinline__ float wave_sum(float v) {
#pragma unroll
    for (int o = 1; o < 64; o <<= 1) v += __shfl_xor(v, o);
    return v;
}
__device__ __forceinline__ float silu_f(float a) { return a / (1.0f + __expf(-a)); }
__device__ __forceinline__ float sigmoid_f(float a) { return 1.0f / (1.0f + __expf(-a)); }

__device__ __forceinline__ void tr_item(const float* W, int K, int N, bf16* WT, int mode, const float* g, LAS float* scr, int item, int lane) {
    const int nblk = N / 32, kb = item / nblk, nb = item % nblk, k0 = 64 * kb, n0 = 32 * nb;
#pragma unroll 8
    for (int i = 0; i < 32; ++i) { const int kk = 2 * i + (lane >> 5); float w = W[(size_t)(k0 + kk) * N + n0 + (lane & 31)]; if (g) w *= g[k0 + kk]; scr[kk * 33 + (lane & 31)] = w; }
    LDS_WAIT(); asm volatile("" ::: "memory");
    const int c = lane & 7;
#pragma unroll
    for (int j = 0; j < 4; ++j) { const int n = (lane >> 3) + 8 * j; const LAS float* s = scr + (8 * c) * 33 + n;
        v4u o; o.x = pk2(s[0 * 33], s[1 * 33]); o.y = pk2(s[2 * 33], s[3 * 33]); o.z = pk2(s[4 * 33], s[5 * 33]); o.w = pk2(s[6 * 33], s[7 * 33]);
        const int nn = n0 + n, drow = mode == 0 ? nn : ((nn >> 7) * 256 + (nn & 127) + (mode == 2 ? 128 : 0));
        *(GAS v4u*)(WT + (size_t)drow * K + k0 + 8 * c) = o; }
    LDS_WAIT(); asm volatile("" ::: "memory");
}
__device__ __forceinline__ void p0_prologue(Frame& F) {
    const Loc L = make_loc();
    LAS float* scr = (LAS float*)(F.lds + RING_OFF + L.wave * 16384);
    const int gw = L.vcu * NWAVES + L.wave, NGW = L.G * NWAVES;
    unsigned char* ws = F.ws; const float* const* in = F.in;
    constexpr int I_IN = 16 * 88, I_OUT = 16 * 32, I_F = 16 * 88, I_F2 = 44 * 32, I_M = 16 * 112, I_M2 = 56 * 32;
    constexpr int NITEMS = 2 * I_IN + 2 * I_OUT + 2 * I_F + I_F2 + 16 * I_M + 8 * I_M2;
    for (int it = gw; it < NITEMS; it += NGW) {
        int r = it;
        if (r < 2 * I_IN) { const int l = r / I_IN; tr_item(in[3] + (size_t)l * D * NIN, D, NIN, (bf16*)(ws + WS_WIN) + (size_t)l * NIN * D, 0, in[2] + l * D, scr, r % I_IN, L.lane); continue; } r -= 2 * I_IN;
        if (r < 2 * I_OUT) { const int l = r / I_OUT; tr_item(in[18] + (size_t)l * D * D, D, D, (bf16*)(ws + WS_WOUT) + (size_t)l * D * D, 0, nullptr, scr, r % I_OUT, L.lane); continue; } r -= 2 * I_OUT;
        if (r < I_F) { tr_item(in[20], D, DFF, (bf16*)(ws + WS_WF13), 1, in[19], scr, r, L.lane); continue; } r -= I_F;
        if (r < I_F) { tr_item(in[21], D, DFF, (bf16*)(ws + WS_WF13), 2, in[19], scr, r, L.lane); continue; } r -= I_F;
        if (r < I_F2) { tr_item(in[22], DFF, D, (bf16*)(ws + WS_WF2), 0, nullptr, scr, r, L.lane); continue; } r -= I_F2;
        if (r < 8 * I_M) { const int e = r / I_M; tr_item(in[24] + (size_t)e * D * DFE, D, DFE, (bf16*)(ws + WS_WM13) + (size_t)e * 2 * DFE * D, 1, in[19] + D, scr, r % I_M, L.lane); continue; } r -= 8 * I_M;
        if (r < 8 * I_M) { const int e = r / I_M; tr_item(in[25] + (size_t)e * D * DFE, D, DFE, (bf16*)(ws + WS_WM13) + (size_t)e * 2 * DFE * D, 2, in[19] + D, scr, r % I_M, L.lane); continue; } r -= 8 * I_M;
        { const int e = r / I_M2; tr_item(in[26] + (size_t)e * DFE * D, DFE, D, (bf16*)(ws + WS_WM2) + (size_t)e * D * DFE, 0, nullptr, scr, r % I_M2, L.lane); }
    }
    float* H = (float*)(ws + WS_H); bf16* HB = (bf16*)(ws + WS_HB); float* SS0 = (float*)(ws + WS_SSP);
    for (int m = gw; m < M; m += NGW) {
        const int b = m / TB, t = m % TB;
        const float* src = t < PADR ? nullptr : (t < 128 ? in[1] + (size_t)(t - PADR) * D : in[0] + ((size_t)b * SEQ + (t - 128)) * D);
        f32x4 v[4]; float s = 0.f;
#pragma unroll
        for (int j = 0; j < 4; ++j) { v[j] = src ? ((const GAS f32x4*)src)[L.lane + 64 * j] : (f32x4){0.f, 0.f, 0.f, 0.f}; s += (v[j].x * v[j].x + v[j].y * v[j].y) + (v[j].z * v[j].z + v[j].w * v[j].w); }
        s = wave_sum(s);
#pragma unroll
        for (int j = 0; j < 4; ++j) { ((GAS f32x4*)(H + (size_t)m * D))[L.lane + 64 * j] = v[j];
            ((GAS unsigned long long*)(HB + (size_t)m * D))[L.lane + 64 * j] = (unsigned long long)pk2(v[j].x, v[j].y) | ((unsigned long long)pk2(v[j].z, v[j].w) << 32); }
        if (L.lane < 16) SS0[(size_t)m * 16 + L.lane] = L.lane == 0 ? s : 0.0f;
    }
    const int gt = L.vcu * NT + L.tid, NGT = L.G * NT;
    float* LB = (float*)(ws + WS_LB); float* BB = (float*)(ws + WS_BB); float* ROT = (float*)(ws + WS_ROT); float* LBT = (float*)(ws + WS_LBT);
    for (int i = gt; i < 2048; i += NGT) {
        const int lg = i >> 6; const float step = expf(in[11][lg]); const float lre = in[4][i], lim = in[5][i];
        const float mag = expf(lre * step); float sn, cs; sincosf(lim * step, &sn, &cs); const float br = mag * cs, bi = mag * sn;
        const float den = 1.0f / (lre * lre + lim * lim), cr = ((br - 1.0f) * lre + bi * lim) * den, ci = (bi * lre - (br - 1.0f) * lim) * den;
        LB[2 * i] = br; LB[2 * i + 1] = bi;
        for (int h = 0; h < 16; ++h) { const float b_r = in[6][i * 16 + h], b_i = in[7][i * 16 + h]; BB[(i * 16 + h) * 2] = cr * b_r - ci * b_i; BB[(i * 16 + h) * 2 + 1] = cr * b_i + ci * b_r; }
    }
    for (int i = gt; i < TB * 16; i += NGT) { const int t = i >> 4, f = i & 15; const float pos = (float)(t - PADR), inv = powf(10000.0f, -(float)f / 16.0f); float sn, cs; sincosf(pos * inv, &sn, &cs); ROT[2 * i] = cs; ROT[2 * i + 1] = sn; }
    for (int i = gt; i < 512; i += NGT) { const int l = i >> 8, c = i & 255; float lb = 0.f; if (l == 1) { const float a0 = in[15][c], a1 = in[15][256 + c], mx = fmaxf(a0, a1), e0 = expf(a0 - mx), e1 = expf(a1 - mx); lb = e1 / (e0 + e1); } LBT[i] = lb; }
}

__device__ __forceinline__ void gold_hgrn(Frame& F, int l, int b, int h) {
    const Loc L = make_loc();
    LAS float* qs = (LAS float*)F.lds; LAS float* fs = qs + 1024; LAS float* ks = fs + 1024; LAS float* vs = ks + 1024; LAS float* po = vs + 1024;
    const bf16* P = (const bf16*)(F.ws + WS_PROJ) + (size_t)b * TB * NIN; bf16* MX = (bf16*)(F.ws + WS_MIXED) + (size_t)b * TB * D;
    const float* cw = F.in[14] + l * 4 * 768; const float* lbt = (const float*)(F.ws + WS_LBT) + l * 256; const float* og = F.in[16] + l * 256 + h * 64;
    const int tid = L.tid, kg = tid >> 6, v = tid & 63;
    float S[8];
#pragma unroll
    for (int i = 0; i < 8; ++i) S[i] = 0.f;
    for (int t0 = 0; t0 < TB; t0 += 16) {
        for (int it = tid; it < 1024; it += NT) {
            const int tt = it >> 6, c = it & 63, t = t0 + tt, ch = h * 64 + c; float cq = 0.f, cf = 0.f, ci = 0.f;
#pragma unroll
            for (int j = 0; j < 4; ++j) { const int ts = t - 3 + j; if (ts >= 0) { const bf16* pr = P + (size_t)ts * NIN;
                cq += cw[j * 768 + ch] * bf2f(pr[C_HQ + ch]); cf += cw[j * 768 + 256 + ch] * bf2f(pr[C_HF + ch]); ci += cw[j * 768 + 512 + ch] * bf2f(pr[C_HI + ch]); } }
            const float lb = lbt[ch], f = lb + (1.0f - lb) * sigmoid_f(cf);
            qs[it] = silu_f(cq); fs[it] = f; ks[it] = 1.0f - f; vs[it] = ci;
        }
        __syncthreads();
        for (int tt = 0; tt < 16; ++tt) { float part = 0.f; const float vv = vs[tt * 64 + v];
#pragma unroll
            for (int i = 0; i < 8; ++i) { const int k = kg * 8 + i; S[i] = fs[tt * 64 + k] * S[i] + ks[tt * 64 + k] * vv; part += qs[tt * 64 + k] * S[i]; }
            po[(tt * 8 + kg) * 64 + v] = part; }
        __syncthreads();
        { const int tt = tid >> 5, vq = tid & 31; float o0 = 0.f, o1 = 0.f;
#pragma unroll
          for (int g = 0; g < 8; ++g) { o0 += po[(tt * 8 + g) * 64 + vq]; o1 += po[(tt * 8 + g) * 64 + vq + 32]; }
          float s = o0 * o0 + o1 * o1;
#pragma unroll
          for (int o = 1; o < 32; o <<= 1) s += __shfl_xor(s, o);
          const float r = rsqrtf(s * (1.0f / 64.0f) + EPS); const int t = t0 + tt; const bf16* pr = P + (size_t)t * NIN + C_HG + h * 64;
          bf16* mo = MX + (size_t)t * D + 256 + h * 64;
          mo[vq] = f2bf_(o0 * r * og[vq] * silu_f(bf2f(pr[vq]))); mo[vq + 32] = f2bf_(o1 * r * og[vq + 32] * silu_f(bf2f(pr[vq + 32]))); }
        __syncthreads();
    }
}
__device__ __forceinline__ void gold_ret(Frame& F, int l, int b, int h) {
    const Loc L = make_loc();
    LAS float* qs = (LAS float*)F.lds; LAS float* ks = qs + 512; LAS float* vs = ks + 512; LAS float* po = vs + 1024;
    const bf16* P = (const bf16*)(F.ws + WS_PROJ) + (size_t)b * TB * NIN; bf16* MX = (bf16*)(F.ws + WS_MIXED) + (size_t)b * TB * D;
    const float* ROT = (const float*)(F.ws + WS_ROT); const float* og = F.in[17] + l * 512 + h * 64;
    const int tid = L.tid, kg = tid >> 6, v = tid & 63; const float gamma = 1.0f - exp2f(-5.0f - (float)h), scale = 0.17677669529663687f;
    float S[4];
#pragma unroll
    for (int i = 0; i < 4; ++i) S[i] = 0.f;
    for (int t0 = 0; t0 < TB; t0 += 16) {
        if (tid < 256) { const int tt = tid >> 4, i = tid & 15, t = t0 + tt; const bf16* pr = P + (size_t)t * NIN; const float c = ROT[(t * 16 + i) * 2], s = ROT[(t * 16 + i) * 2 + 1];
            const float q1 = bf2f(pr[C_RQ + h * 32 + i]), q2 = bf2f(pr[C_RQ + h * 32 + 16 + i]), k1 = bf2f(pr[C_RK + h * 32 + i]), k2 = bf2f(pr[C_RK + h * 32 + 16 + i]);
            qs[tt * 32 + i] = (q1 * c - q2 * s) * scale; qs[tt * 32 + 16 + i] = (q1 * s + q2 * c) * scale; ks[tt * 32 + i] = k1 * c - k2 * s; ks[tt * 32 + 16 + i] = k1 * s + k2 * c; }
        for (int it = tid; it < 1024; it += NT) { const int tt = it >> 6, c = it & 63; vs[it] = bf2f(P[(size_t)(t0 + tt) * NIN + C_RV + h * 64 + c]); }
        __syncthreads();
        for (int tt = 0; tt < 16; ++tt) { float part = 0.f; const float vv = vs[tt * 64 + v];
#pragma unroll
            for (int i = 0; i < 4; ++i) { const int k = kg * 4 + i; S[i] = gamma * S[i] + ks[tt * 32 + k] * vv; part += qs[tt * 32 + k] * S[i]; }
            po[(tt * 8 + kg) * 64 + v] = part; }
        __syncthreads();
        { const int tt = tid >> 5, vq = tid & 31; float o0 = 0.f, o1 = 0.f;
#pragma unroll
          for (int g = 0; g < 8; ++g) { o0 += po[(tt * 8 + g) * 64 + vq]; o1 += po[(tt * 8 + g) * 64 + vq + 32]; }
          float s = o0 + o1;
#pragma unroll
          for (int o = 1; o < 32; o <<= 1) s += __shfl_xor(s, o);
          const float mean = s * (1.0f / 64.0f), c0 = o0 - mean, c1 = o1 - mean; float q = c0 * c0 + c1 * c1;
#pragma unroll
          for (int o = 1; o < 32; o <<= 1) q += __shfl_xor(q, o);
          const float r = rsqrtf(q * (1.0f / 64.0f) + EPS); const int t = t0 + tt; const bf16* pr = P + (size_t)t * NIN + C_RG + h * 64;
          bf16* mo = MX + (size_t)t * D + 512 + h * 64;
          mo[vq] = f2bf_(c0 * r * og[vq] * silu_f(bf2f(pr[vq]))); mo[vq + 32] = f2bf_(c1 * r * og[vq + 32] * silu_f(bf2f(pr[vq + 32]))); }
        __syncthreads();
    }
}
__device__ __forceinline__ void gold_s5(Frame& F, int l, int b, int g) {
    const Loc L = make_loc();
    LAS float* us = (LAS float*)F.lds; LAS float* xs = us + 512; LAS float* Cs = xs + 4096;
    const bf16* P = (const bf16*)(F.ws + WS_PROJ) + (size_t)b * TB * NIN; float* Y = (float*)(F.ws + WS_YS5) + (size_t)b * TB * 256;
    const int tid = L.tid, lg = l * 16 + g;
    for (int it = tid; it < 1024; it += NT) { const int h = it >> 6, p = it & 63; Cs[(p * 16 + h) * 2] = F.in[8][(lg * 16 + h) * 64 + p]; Cs[(p * 16 + h) * 2 + 1] = F.in[9][(lg * 16 + h) * 64 + p]; }
    float Bre[16], Bim[16], lr = 0.f, li = 0.f, xr = 0.f, xi = 0.f;
    { const int p = tid & 63; const float* BB = (const float*)(F.ws + WS_BB) + (size_t)(lg * 64 + p) * 32; const float* LB = (const float*)(F.ws + WS_LB) + (lg * 64 + p) * 2;
#pragma unroll
      for (int h = 0; h < 16; ++h) { Bre[h] = BB[2 * h]; Bim[h] = BB[2 * h + 1]; }
      lr = LB[0]; li = LB[1]; }
    const float dsk = F.in[10][lg * 16 + (tid & 15)];
    for (int t0 = 0; t0 < TB; t0 += 32) {
        { const int tt = tid >> 4, h = tid & 15; us[tid] = bf2f(P[(size_t)(t0 + tt) * NIN + C_U + g * 16 + h]); }
        __syncthreads();
        if (tid < 64) { const int p = tid;
            for (int tt = 0; tt < 32; ++tt) { float bur = 0.f, bui = 0.f;
#pragma unroll
                for (int h = 0; h < 16; ++h) { const float u = us[tt * 16 + h]; bur += Bre[h] * u; bui += Bim[h] * u; }
                const float nr = lr * xr - li * xi + bur, ni = lr * xi + li * xr + bui; xr = nr; xi = ni; xs[(tt * 64 + p) * 2] = xr; xs[(tt * 64 + p) * 2 + 1] = xi; } }
        __syncthreads();
        { const int tt = tid >> 4, h = tid & 15; float y = 0.f;
          for (int p = 0; p < 64; ++p) y += Cs[(p * 16 + h) * 2] * xs[(tt * 64 + p) * 2] - Cs[(p * 16 + h) * 2 + 1] * xs[(tt * 64 + p) * 2 + 1];
          y += dsk * us[tt * 16 + h]; Y[(size_t)(t0 + tt) * 256 + g * 16 + h] = y; }
        __syncthreads();
    }
}
__device__ __forceinline__ void p_gold_mixers(Frame& F, int l) {
    const Loc L = make_loc();
    const int bx = L.bx;
    if (bx < 8) gold_hgrn(F, l, bx >> 2, bx & 3);
    else if (bx < 24) gold_ret(F, l, (bx - 8) >> 3, (bx - 8) & 7);
    else if (bx < 56) gold_s5(F, l, (bx - 24) >> 4, (bx - 24) & 15);
}
__device__ __forceinline__ float gelu_tanh(float y) { const float x = 0.7978845608028654f * (y + 0.044715f * y * y * y); const float th = 1.0f - 2.0f / (1.0f + __expf(2.0f * x)); return 0.5f * y * (1.0f + th); }
__device__ __forceinline__ void p_s5_glu(Frame& F, int l) {
    const Loc L = make_loc();
    LAS float* gs = (LAS float*)F.lds; LAS float* red = gs + 64 * 256;
    const float* Y = (const float*)(F.ws + WS_YS5); bf16* MX = (bf16*)(F.ws + WS_MIXED); const float* wg = F.in[12] + (size_t)l * 65536; const float* og = F.in[13] + l * 256;
    const int tid = L.tid, c = tid & 255, rh = tid >> 8;
    for (int unit = L.bx; unit < M / 64; unit += L.G) { const int row0 = unit * 64;
        for (int it = tid; it < 64 * 256; it += NT) gs[it] = gelu_tanh(Y[(size_t)row0 * 256 + it]);
        __syncthreads();
        float acc[32];
#pragma unroll
        for (int r = 0; r < 32; ++r) acc[r] = 0.f;
        for (int k4 = 0; k4 < 256; k4 += 4) { const float w0 = wg[(k4 + 0) * 256 + c], w1 = wg[(k4 + 1) * 256 + c], w2 = wg[(k4 + 2) * 256 + c], w3 = wg[(k4 + 3) * 256 + c];
#pragma unroll
            for (int r = 0; r < 32; ++r) { const f32x4 gv = *(const LAS f32x4*)(gs + (rh * 32 + r) * 256 + k4); acc[r] += (gv.x * w0 + gv.y * w1) + (gv.z * w2 + gv.w * w3); } }
#pragma unroll
        for (int r = 0; r < 32; ++r) { acc[r] = gs[(rh * 32 + r) * 256 + c] * sigmoid_f(acc[r]); const float s = wave_sum(acc[r] * acc[r]); if (L.lane == 0) red[(rh * 32 + r) * 4 + (L.wave & 3)] = s; }
        __syncthreads();
#pragma unroll
        for (int r = 0; r < 32; ++r) { const LAS float* rp = red + (rh * 32 + r) * 4; const float tot = (rp[0] + rp[1]) + (rp[2] + rp[3]);
            MX[(size_t)(row0 + rh * 32 + r) * D + c] = f2bf_(acc[r] * rsqrtf(tot * (1.0f / 256.0f) + EPS) * og[c]); }
        __syncthreads();
    }
}
__device__ __forceinline__ void p_route(Frame& F) {
    const Loc L = make_loc();
    const int gw = L.vcu * NWAVES + L.wave, NGW = L.G * NWAVES;
    const float* H = (const float*)(F.ws + WS_H); float* GT = (float*)(F.ws + WS_GT); const float* gff = F.in[19] + D; const float* R = F.in[23];
    for (int m = gw; m < M; m += NGW) {
        float ss = 0.f, part[8];
#pragma unroll
        for (int e = 0; e < 8; ++e) part[e] = 0.f;
#pragma unroll
        for (int j = 0; j < 4; ++j) { const f32x4 v = ((const GAS f32x4*)(H + (size_t)m * D))[L.lane + 64 * j]; const int d0 = 4 * L.lane + 256 * j;
            ss += (v.x * v.x + v.y * v.y) + (v.z * v.z + v.w * v.w);
#pragma unroll
            for (int q = 0; q < 4; ++q) { const float hv = v[q] * gff[d0 + q]; const f32x4 r0 = *(const f32x4*)(R + (d0 + q) * 8), r1 = *(const f32x4*)(R + (d0 + q) * 8 + 4);
                part[0] += hv * r0.x; part[1] += hv * r0.y; part[2] += hv * r0.z; part[3] += hv * r0.w; part[4] += hv * r1.x; part[5] += hv * r1.y; part[6] += hv * r1.z; part[7] += hv * r1.w; } }
        const float rstd = rsqrtf(wave_sum(ss) * (1.0f / 1024.0f) + EPS); float lg[8];
#pragma unroll
        for (int e = 0; e < 8; ++e) lg[e] = wave_sum(part[e]) * rstd;
        int i1 = 0; float l1 = lg[0];
#pragma unroll
        for (int e = 1; e < 8; ++e) if (lg[e] > l1) { l1 = lg[e]; i1 = e; }
        int i2 = -1; float l2 = -3.0e38f;
#pragma unroll
        for (int e = 0; e < 8; ++e) if (e != i1 && lg[e] > l2) { l2 = lg[e]; i2 = e; }
        const float e2 = __expf(l2 - l1), g1 = 1.0f / (1.0f + e2), g2 = e2 * g1;
        if (L.lane < 8) GT[(size_t)m * 8 + L.lane] = (L.lane == i1) ? g1 : ((L.lane == i2) ? g2 : 0.0f);
    }
}
__device__ __forceinline__ void p_final(Frame& F, float* out) {
    const Loc L = make_loc();
    const int gw = L.vcu * NWAVES + L.wave, NGW = L.G * NWAVES; const float* H = (const float*)(F.ws + WS_H); const float* gf = F.in[27];
    for (int r = gw; r < BATCH * SEQ; r += NGW) { const int b = r / SEQ, t = r % SEQ; const size_t m = (size_t)b * TB + 128 + t;
        f32x4 v[4]; float s = 0.f;
#pragma unroll
        for (int j = 0; j < 4; ++j) { v[j] = ((const GAS f32x4*)(H + m * D))[L.lane + 64 * j]; s += (v[j].x * v[j].x + v[j].y * v[j].y) + (v[j].z * v[j].z + v[j].w * v[j].w); }
        const float rstd = rsqrtf(wave_sum(s) * (1.0f / 1024.0f) + EPS);
#pragma unroll
        for (int j = 0; j < 4; ++j) { const f32x4 g = ((const GAS f32x4*)gf)[L.lane + 64 * j]; ((GAS f32x4*)(out + (size_t)r * D))[L.lane + 64 * j] = v[j] * rstd * g; }
    }
}

struct Args { const float* in[28]; float* out; unsigned char* ws; int ph_lo, ph_hi, li, pad; };
__global__ void __launch_bounds__(NWAVES * 64, 2) mk_fwd(Args args) {
    extern __shared__ __attribute__((aligned(16))) unsigned char lds[];
    Frame F;
    F.lds = (LAS unsigned char*)lds; F.MISC = (volatile LAS unsigned*)(F.lds + MISC_OFF);
    F.ws = args.ws; F.ctl = (gu32*)(args.ws + WS_CTL); F.in = args.in;
    for (int u = threadIdx.x; u < (LDS_BYTES - LDSCTL_OFF) / 4; u += NWAVES * 64) ((LAS unsigned*)(F.lds + LDSCTL_OFF))[u] = 0u;
    __syncthreads();
    XcdBarrier bar; bar.bar = (unsigned*)(F.ctl + CW_BAR); bar.x = 0; bar.st = nullptr;
    if (!MK_PER_PHASE) bar = xcd_barrier_post((unsigned*)(F.ctl + CW_BAR), F.MISC + 8);
    const int lo = args.ph_lo, hi = args.ph_hi;
#define IN(k) (lo <= (k) && (k) < hi)
#define SEAM(k) do { if (!MK_PER_PHASE && (k) + 1 < hi) xcd_barrier(bar); } while (0)
    unsigned char* ws = args.ws;
    float* SS = (float*)(ws + WS_SSP);
    if (IN(0)) { p0_prologue(F); SEAM(0); }
    for (int l = 0; l < 2; ++l) {
        const int base = 1 + 24 * l;
        if (IN(base + 0)) {
            pg8::Gemm g{(const bf16*)(ws + WS_HB), (const bf16*)(ws + WS_WIN) + (size_t)l * NIN * D, M, NIN, D}; pg8::StaticOrder S; const Loc L = make_loc(); S.init(M, NIN, L.G, L.bx);
            pg8::EpiProj E{(bf16*)(ws + WS_PROJ), NIN, SS + (size_t)(2 * l) * M * 16};
            pg8::gemm_phase<pg8::EpiProj, pg8::StaticOrder, true, true>(F.lds + RING_OFF, g, S, E);
            SEAM(base + 0);
        }
        if (IN(base + 1)) { p_gold_mixers(F, l); SEAM(base + 1); }
        if (IN(base + 2)) { p_s5_glu(F, l); SEAM(base + 2); }
        if (IN(base + 3)) {
            pg8::Gemm g{(const bf16*)(ws + WS_MIXED), (const bf16*)(ws + WS_WOUT) + (size_t)l * D * D, M, D, D}; pg8::StaticOrder S; const Loc L = make_loc(); S.init(M, D, L.G, L.bx);
            pg8::EpiResid E{(float*)(ws + WS_H), (bf16*)(ws + WS_HB), SS + (size_t)(2 * l + 1) * M * 16, nullptr, 0, 1};
            pg8::gemm_phase<pg8::EpiResid, pg8::StaticOrder, true, true>(F.lds + RING_OFF, g, S, E);
            SEAM(base + 3);
        }
        if (l == 1 && IN(base + 4)) { p_route(F); SEAM(base + 4); }
        const int ne = l == 0 ? 1 : NEXP, nff = l == 0 ? DFF : DFE;
        for (int e = 0; e < ne; ++e) {
            if (IN(base + 5 + 2 * e)) {
                const bf16* W13 = l == 0 ? (const bf16*)(ws + WS_WF13) : (const bf16*)(ws + WS_WM13) + (size_t)e * 2 * DFE * D;
                pg8::Gemm g{(const bf16*)(ws + WS_HB), W13, M, 2 * nff, D}; pg8::StaticOrder S; const Loc L = make_loc(); S.init(M, 2 * nff, L.G, L.bx);
                pg8::EpiSwiglu E{(bf16*)(ws + WS_ACT), nff, SS + (size_t)(2 * l + 1) * M * 16};
                pg8::gemm_phase<pg8::EpiSwiglu, pg8::StaticOrder, true, true>(F.lds + RING_OFF, g, S, E);
                SEAM(base + 5 + 2 * e);
            }
            if (IN(base + 6 + 2 * e)) {
                const bf16* W2 = l == 0 ? (const bf16*)(ws + WS_WF2) : (const bf16*)(ws + WS_WM2) + (size_t)e * D * DFE;
                pg8::Gemm g{(const bf16*)(ws + WS_ACT), W2, M, D, nff}; pg8::StaticOrder S; const Loc L = make_loc(); S.init(M, D, L.G, L.bx);
                pg8::EpiResid E{(float*)(ws + WS_H), (bf16*)(ws + WS_HB), SS + (size_t)(2 * l + 2) * M * 16, l == 0 ? nullptr : (const float*)(ws + WS_GT) + e, 8, e == ne - 1 ? 1 : 0};
                pg8::gemm_phase<pg8::EpiResid, pg8::StaticOrder, true, true>(F.lds + RING_OFF, g, S, E);
                SEAM(base + 6 + 2 * e);
            }
        }
    }
    if (IN(NPH - 1)) p_final(F, args.out);
#undef IN
#undef SEAM
}

extern "C" void kernel_launch(void* const* d_in, const int* in_sizes, int n_in, void* d_out, int out_size, void* d_ws, size_t ws_size, hipStream_t stream) {
    static int grid = 0;
    if (grid == 0) {
        if (n_in != 28 || out_size != BATCH * SEQ * D || ws_size < WS_END) { fprintf(stderr, "kernel_launch: unexpected shapes: n_in %d out %d ws %zu (need %zu)\n", n_in, out_size, ws_size, (size_t)WS_END); grid = -1; return; }
        int dev = 0, cus = 0, per_cu = 0;
        if (hipGetDevice(&dev) != hipSuccess || hipDeviceGetAttribute(&cus, hipDeviceAttributeMultiprocessorCount, dev) != hipSuccess) { grid = -1; return; }
        if (hipFuncSetAttribute((const void*)mk_fwd, hipFuncAttributeMaxDynamicSharedMemorySize, LDS_BYTES) != hipSuccess) { fprintf(stderr, "kernel_launch: hipFuncSetAttribute failed\n"); grid = -1; return; }
        if (hipOccupancyMaxActiveBlocksPerMultiprocessor(&per_cu, (const void*)mk_fwd, NWAVES * 64, LDS_BYTES) != hipSuccess || per_cu < 1) { fprintf(stderr, "kernel_launch: occupancy query says %d\n", per_cu); }
        (void)hipGetLastError();
        grid = cus;
    }
    if (grid < 0) return;
    if (hipMemsetAsync((char*)d_ws + WS_CTL, 0, CTL_ZERO_BYTES, stream) != hipSuccess) return;
    Args a{};
    for (int i = 0; i < 28; ++i) a.in[i] = (const float*)d_in[i];
    a.out = (float*)d_out; a.ws = (unsigned char*)d_ws;
#if MK_PER_PHASE
    for (int k = 0; k < NPH; ++k) { if (!phase_exists(k)) continue; a.ph_lo = k; a.ph_hi = k + 1; a.li = 0; hipLaunchKernelGGL(mk_fwd, dim3(grid), dim3(NWAVES * 64), LDS_BYTES, stream, a); }
#else
    a.ph_lo = 0; a.ph_hi = NPH; a.li = 0;
    hipLaunchKernelGGL(mk_fwd, dim3(grid), dim3(NWAVES * 64), LDS_BYTES, stream, a);
#endif
}
```

```cpp
#include <hip/hip_runtime.h>
#include <cstdio>
#include <cstdint>
#include <cmath>
namespace pg8 {
#define PG8_LAS __attribute__((address_space(3)))
typedef unsigned short bf16_t;
typedef short bf16x8 __attribute__((ext_vector_type(8)));
typedef float f32x4 __attribute__((ext_vector_type(4)));
typedef unsigned u32x4 __attribute__((ext_vector_type(4)));
constexpr int BM = 256, BK = 64, HALF = 128, HTB = HALF * BK * 2  , STAGE_BYTES = 8 * HTB, NXCD = 8, WGM = 8;

__host__ __device__ __forceinline__ int lds_byte(int r, int c) { const int st = (r >> 4) * 2 + (c >> 5), rr = r & 15, cc = c & 31, ob = rr * 64 + cc * 2; return st * 1024 + (ob ^ (((ob >> 9) & 1) << 5)); }
__host__ __device__ __forceinline__ void stage_rc(int b, int& R, int& C) { const int st = b / 1024, sb = b % 1024, swz = sb ^ (((sb >> 9) & 1) << 5); R = (st >> 1) * 16 + swz / 64; C = (st & 1) * 32 + (swz % 64) / 2; }
__host__ __device__ __forceinline__ int perm32(int rho) { const int n = rho >> 4, i = rho & 15; return 8 * (i >> 2) + 4 * n + (i & 3); }

struct Unit { int pm, pn; };
struct Gemm { const bf16_t* A; const bf16_t* Bt; int M, N, K; };

struct StaticOrder {
    int nM, nN, nwg, G, c;
    __host__ __device__ void init(int M, int N, int G_, int c_) { nM = M / BM; nN = N / BM; nwg = nM * nN; G = G_; c = c_; }
    __host__ __device__ bool next(int i, Unit& u) const {
        const long L = (long)i * G + c; if (L >= nwg) return false;
        int wgid = (int)L; { const int q = nwg / NXCD, r = nwg % NXCD, xcd = wgid % NXCD, off = wgid / NXCD; wgid = (xcd < r ? xcd * (q + 1) : r * (q + 1) + (xcd - r) * q) + off; }
        const int nig = WGM * nN, gid = wgid / nig, fm = gid * WGM, gsz = (nM - fm) < WGM ? (nM - fm) : WGM;
        u.pm = fm + ((wgid % nig) % gsz); u.pn = (wgid % nig) / gsz; return true;
    }
    __device__ __forceinline__ void a_ready(const Unit&) const {}
    __device__ __forceinline__ void done(const Unit&) const {}
};

__device__ __forceinline__ unsigned cvt_pk_bf16(float lo, float hi) { unsigned r; asm volatile("v_cvt_pk_bf16_f32 %0, %1, %2" : "=v"(r) : "v"(lo), "v"(hi)); return r; }
typedef float f32x2 __attribute__((ext_vector_type(2)));
constexpr float RMS_EPS = 1e-6f;
__device__ __forceinline__ float fast_silu(float a) { return a * __builtin_amdgcn_rcpf(1.0f + __expf(-a)); }
__device__ __forceinline__ float row_rstd(const float* ss, int row) { const f32x4* p = (const f32x4*)(ss + (size_t)row * 16); const f32x4 a = p[0], b = p[1], c = p[2], d = p[3];
    const float t = (((a[0] + a[1]) + (a[2] + a[3])) + ((b[0] + b[1]) + (b[2] + b[3]))) + (((c[0] + c[1]) + (c[2] + c[3])) + ((d[0] + d[1]) + (d[2] + d[3])));
    return __builtin_amdgcn_rsqf(t * (1.0f / 1024.0f) + RMS_EPS); }
struct EpiProj {
    static constexpr bool PERM = true, AFTER_DRAIN = false;
    bf16_t* O; int ldc; const float* ss;
    __device__ __forceinline__ void operator()(const f32x4 (&acc)[2][2][4][2], const Unit& u, int wr, int wc, int fr, int fq) const {
        const int row0 = u.pm * BM + wr * 64 + fr, col0 = u.pn * BM + wc * 32 + 8 * fq;
#pragma unroll
        for (int ai = 0; ai < 2; ++ai)
#pragma unroll
            for (int m = 0; m < 4; ++m) { const int row = row0 + ai * HALF + m * 16; const float sc = row_rstd(ss, row);
                bf16_t* rowp = O + (size_t)row * ldc + col0;
#pragma unroll
                for (int bj = 0; bj < 2; ++bj) { const f32x4 v0 = acc[ai][bj][m][0] * sc, v1 = acc[ai][bj][m][1] * sc;
                    u32x4 w; w.x = cvt_pk_bf16(v0[0], v0[1]); w.y = cvt_pk_bf16(v0[2], v0[3]); w.z = cvt_pk_bf16(v1[0], v1[1]); w.w = cvt_pk_bf16(v1[2], v1[3]);
                    *(u32x4*)(rowp + bj * HALF) = w; } }
    }
};
struct EpiSwiglu {
    static constexpr bool PERM = true, AFTER_DRAIN = false;
    bf16_t* O; int ldc; const float* ss;
    __device__ __forceinline__ void operator()(const f32x4 (&acc)[2][2][4][2], const Unit& u, int wr, int wc, int fr, int fq) const {
        const int row0 = u.pm * BM + wr * 64 + fr, col0 = u.pn * HALF + wc * 32 + 8 * fq;
#pragma unroll
        for (int ai = 0; ai < 2; ++ai)
#pragma unroll
            for (int m = 0; m < 4; ++m) { const int row = row0 + ai * HALF + m * 16; const float sc = row_rstd(ss, row);
                const f32x4 a0 = acc[ai][0][m][0] * sc, a1 = acc[ai][0][m][1] * sc, b0 = acc[ai][1][m][0] * sc, b1 = acc[ai][1][m][1] * sc;
                u32x4 w; w.x = cvt_pk_bf16(fast_silu(a0[0]) * b0[0], fast_silu(a0[1]) * b0[1]); w.y = cvt_pk_bf16(fast_silu(a0[2]) * b0[2], fast_silu(a0[3]) * b0[3]);
                w.z = cvt_pk_bf16(fast_silu(a1[0]) * b1[0], fast_silu(a1[1]) * b1[1]); w.w = cvt_pk_bf16(fast_silu(a1[2]) * b1[2], fast_silu(a1[3]) * b1[3]);
                *(u32x4*)(O + (size_t)row * ldc + col0) = w; }
    }
};
struct EpiResid {
    static constexpr bool PERM = false, AFTER_DRAIN = false;
    float* H; bf16_t* HB; float* ssout; const float* gate; int gstride; int write_hb;
    __device__ __forceinline__ void operator()(const f32x4 (&acc)[2][2][4][2], const Unit& u, int wr, int wc, int fr, int fq) const {
        const int row0 = u.pm * BM + wr * 64 + fr, col0 = u.pn * BM + wc * 32 + 4 * fq;
#pragma unroll
        for (int ai = 0; ai < 2; ++ai)
#pragma unroll
            for (int m = 0; m < 4; ++m) { const int row = row0 + ai * HALF + m * 16; const float g = gate ? gate[(size_t)row * gstride] : 1.0f;
                float* hp = H + (size_t)row * 1024 + col0; float s = 0.f;
#pragma unroll
                for (int bj = 0; bj < 2; ++bj)
#pragma unroll
                    for (int n = 0; n < 2; ++n) { float* p = hp + bj * HALF + n * 16; const f32x4 o = *(const f32x4*)p + acc[ai][bj][m][n] * g; *(f32x4*)p = o;
                        s += (o[0] * o[0] + o[1] * o[1]) + (o[2] * o[2] + o[3] * o[3]);
                        if (write_hb) { unsigned long long w = (unsigned long long)cvt_pk_bf16(o[0], o[1]) | ((unsigned long long)cvt_pk_bf16(o[2], o[3]) << 32);
                            *(unsigned long long*)(HB + (size_t)row * 1024 + col0 + bj * HALF + n * 16) = w; } }
                if (write_hb) { s += __shfl_xor(s, 16); s += __shfl_xor(s, 32); if (fq == 0) ssout[(size_t)row * 16 + u.pn * 4 + wc] = s; } }
    }
};

template <class Epi, class Sched, bool ALIGN_EPI = false, bool SP2 = false>
__device__ __forceinline__ void gemm_phase(PG8_LAS unsigned char* lds, const Gemm g, const Sched& S, const Epi& E) {
    int tid_ = threadIdx.x; asm volatile("" : "+v"(tid_));
    const int tid = tid_, wid = __builtin_amdgcn_readfirstlane(tid >> 6), lane = tid & 63, wr = wid >> 2, wc = wid & 3, fr = lane & 15, fq = lane >> 4;
    const int K = g.K, nt = K / BK;
    unsigned voffA[2], voffB[2];
#pragma unroll
    for (int i = 0; i < 2; ++i) { int R, C; stage_rc(tid * 16 + i * 8192, R, C); const int Rb = Epi::PERM ? ((R & ~31) + perm32(R & 31)) : R;
        voffA[i] = (unsigned)(R * K + C) * 2u; voffB[i] = (unsigned)(Rb * K + C) * 2u; }
    const size_t kstep = (size_t)(BK * 2);
    const size_t hstep = (size_t)HALF * K * 2;
    const size_t tstep = 2 * hstep;
    const unsigned ldsw = (unsigned)wid * 1024u;
    const int aoff = lds_byte(wr * 64 + fr, fq * 8), boff = lds_byte(wc * 32 + fr, fq * 8);
#define PG8_SA(b, h) (((b) * 2 + (h)) * HTB)
#define PG8_SB(b, h) ((4 + (b) * 2 + (h)) * HTB)
#define PG8_STAGE(bufoff, gbase, voff) do { _Pragma("unroll") for (int _i = 0; _i < 2; ++_i) \
        __builtin_amdgcn_global_load_lds((const unsigned*)((const char*)(gbase) + (voff)[_i]), (PG8_LAS unsigned*)(lds + (bufoff) + ldsw + _i * 8192), 16, 0, 0); } while (0)
#define PG8_LDA(dst, b, h) do { _Pragma("unroll") for (int m = 0; m < 4; ++m) _Pragma("unroll") for (int k = 0; k < 2; ++k) dst[m][k] = *(const PG8_LAS bf16x8*)(lds + PG8_SA(b, h) + aoff + m * 2048 + k * 1024); } while (0)
#define PG8_LDB(dst, b, h) do { _Pragma("unroll") for (int n = 0; n < 2; ++n) _Pragma("unroll") for (int k = 0; k < 2; ++k) dst[n][k] = *(const PG8_LAS bf16x8*)(lds + PG8_SB(b, h) + boff + n * 2048 + k * 1024); } while (0)
#define PG8_MMA(ai, bj, At, Bt) do { __builtin_amdgcn_s_setprio(1); _Pragma("unroll") for (int m = 0; m < 4; ++m) _Pragma("unroll") for (int n = 0; n < 2; ++n) _Pragma("unroll") for (int k = 0; k < 2; ++k) \
        acc[ai][bj][m][n] = __builtin_amdgcn_mfma_f32_16x16x32_bf16(Bt[n][k], At[m][k], acc[ai][bj][m][n], 0, 0, 0); __builtin_amdgcn_s_setprio(0); } while (0)
#define PG8_WAIT_V(n) asm volatile("s_waitcnt vmcnt(" #n ")" ::: "memory")
#define PG8_WAIT_L(n) asm volatile("s_waitcnt lgkmcnt(" #n ")" ::: "memory")
#define PG8_BAR __builtin_amdgcn_s_barrier()
#define PG8_SCHED __builtin_amdgcn_sched_barrier(0)
    Unit cur, nxt; int ui = 0;
    if (!S.next(0, cur)) return;
    f32x4 acc[2][2][4][2];
#pragma unroll
    for (int a = 0; a < 2; ++a)
#pragma unroll
        for (int b = 0; b < 2; ++b)
#pragma unroll
            for (int m = 0; m < 4; ++m)
#pragma unroll
                for (int n = 0; n < 2; ++n) acc[a][b][m][n] = (f32x4){0.f, 0.f, 0.f, 0.f};
    bf16x8 At[4][2], B0[2][2], B1[2][2];
    const char* cA = (const char*)g.A + (size_t)cur.pm * tstep; const char* cB = (const char*)g.Bt + (size_t)cur.pn * tstep;
    S.a_ready(cur);
    if constexpr (SP2) {
        PG8_STAGE(PG8_SB(0, 0), cB, voffB); PG8_STAGE(PG8_SB(0, 1), cB + hstep, voffB); PG8_STAGE(PG8_SA(0, 0), cA, voffA); PG8_STAGE(PG8_SA(0, 1), cA + hstep, voffA);
        if (wr == 1) PG8_BAR;
        PG8_WAIT_V(2); PG8_BAR;
        PG8_STAGE(PG8_SB(1, 0), cB + kstep, voffB); PG8_STAGE(PG8_SA(1, 0), cA + kstep, voffA); PG8_STAGE(PG8_SB(1, 1), cB + hstep + kstep, voffB);
        PG8_WAIT_V(6); PG8_BAR;
    } else {
        PG8_STAGE(PG8_SB(0, 0), cB, voffB); PG8_STAGE(PG8_SA(0, 0), cA, voffA); PG8_STAGE(PG8_SB(0, 1), cB + hstep, voffB); PG8_STAGE(PG8_SA(0, 1), cA + hstep, voffA);
        if (wr == 1) PG8_BAR;
        PG8_WAIT_V(4); PG8_BAR;
        PG8_STAGE(PG8_SB(1, 0), cB + kstep, voffB); PG8_STAGE(PG8_SA(1, 0), cA + kstep, voffA); PG8_STAGE(PG8_SB(1, 1), cB + hstep + kstep, voffB);
        PG8_WAIT_V(6); PG8_BAR;
    }
    for (;;) {
        const bool has_next = S.next(ui + 1, nxt);
        const char* nA = has_next ? (const char*)g.A + (size_t)nxt.pm * tstep : cA; const char* nB = has_next ? (const char*)g.Bt + (size_t)nxt.pn * tstep : cB;
        for (int t = 0; t < nt; t += 2) {
            const bool last = (t == nt - 2);
            const char* a1 = cA + (size_t)(t + 1) * kstep;
            const char* a2 = last ? nA : cA + (size_t)(t + 2) * kstep; const char* b2 = last ? nB : cB + (size_t)(t + 2) * kstep;
            const char* a3 = a2 + kstep; const char* b3 = b2 + kstep;
            if (last && has_next) S.a_ready(nxt);
            if constexpr (SP2) {
            PG8_LDB(B0, 0, 0); PG8_LDB(B1, 0, 1); PG8_SCHED; PG8_LDA(At, 0, 0); PG8_STAGE(PG8_SA(1, 1), a1 + hstep, voffA);
            PG8_WAIT_V(8); PG8_WAIT_L(0); PG8_BAR; PG8_MMA(0, 0, At, B0); PG8_MMA(0, 1, At, B1); PG8_BAR; PG8_SCHED;
            PG8_LDA(At, 0, 1); PG8_STAGE(PG8_SB(0, 0), b2, voffB); PG8_STAGE(PG8_SB(0, 1), b2 + hstep, voffB); PG8_STAGE(PG8_SA(0, 0), a2, voffA);
            PG8_WAIT_V(8); PG8_WAIT_L(0); PG8_BAR; PG8_MMA(1, 0, At, B0); PG8_MMA(1, 1, At, B1); PG8_BAR; PG8_SCHED;
            PG8_LDB(B0, 1, 0); PG8_LDB(B1, 1, 1); PG8_SCHED; PG8_LDA(At, 1, 0); PG8_STAGE(PG8_SA(0, 1), a2 + hstep, voffA);
            PG8_WAIT_V(8); PG8_WAIT_L(0); PG8_BAR; PG8_MMA(0, 0, At, B0); PG8_MMA(0, 1, At, B1); PG8_BAR; PG8_SCHED;
            PG8_LDA(At, 1, 1); PG8_STAGE(PG8_SB(1, 0), b3, voffB); PG8_STAGE(PG8_SB(1, 1), b3 + hstep, voffB); PG8_STAGE(PG8_SA(1, 0), a3, voffA);
            PG8_WAIT_V(8); PG8_WAIT_L(0); PG8_BAR; PG8_MMA(1, 0, At, B0); PG8_MMA(1, 1, At, B1); PG8_BAR; PG8_SCHED;
            } else {
            PG8_LDB(B0, 0, 0); PG8_SCHED; PG8_LDA(At, 0, 0); PG8_STAGE(PG8_SA(1, 1), a1 + hstep, voffA);
            PG8_WAIT_L(8); PG8_BAR; PG8_WAIT_L(0); PG8_MMA(0, 0, At, B0); PG8_BAR; PG8_SCHED;
            PG8_LDB(B1, 0, 1); PG8_STAGE(PG8_SB(0, 0), b2, voffB);
            PG8_BAR; PG8_WAIT_L(0); PG8_MMA(0, 1, At, B1); PG8_BAR;
            PG8_LDA(At, 0, 1); PG8_STAGE(PG8_SA(0, 0), a2, voffA);
            PG8_BAR; PG8_WAIT_L(0); PG8_MMA(1, 0, At, B0); PG8_BAR; PG8_SCHED;
            PG8_STAGE(PG8_SB(0, 1), b2 + hstep, voffB);
            PG8_WAIT_V(6); PG8_BAR; PG8_MMA(1, 1, At, B1); PG8_BAR;
            PG8_LDB(B0, 1, 0); PG8_SCHED; PG8_LDA(At, 1, 0); PG8_STAGE(PG8_SA(0, 1), a2 + hstep, voffA);
            PG8_WAIT_L(8); PG8_BAR; PG8_WAIT_L(0); PG8_MMA(0, 0, At, B0); PG8_BAR; PG8_SCHED;
            PG8_LDB(B1, 1, 1); PG8_STAGE(PG8_SB(1, 0), b3, voffB);
            PG8_BAR; PG8_WAIT_L(0); PG8_MMA(0, 1, At, B1); PG8_BAR;
            PG8_LDA(At, 1, 1); PG8_STAGE(PG8_SA(1, 0), a3, voffA);
            PG8_BAR; PG8_WAIT_L(0); PG8_MMA(1, 0, At, B0); PG8_BAR; PG8_SCHED;
            PG8_STAGE(PG8_SB(1, 1), b3 + hstep, voffB);
            PG8_WAIT_V(6); PG8_BAR; PG8_MMA(1, 1, At, B1); PG8_BAR;
            }
        }
        if constexpr (ALIGN_EPI) { if (wr == 0) PG8_BAR; }
        if constexpr (!Epi::AFTER_DRAIN) { E(acc, cur, wr, wc, fr, fq); S.done(cur); }
        if (!has_next) break;
#pragma unroll
        for (int a = 0; a < 2; ++a)
#pragma unroll
            for (int b = 0; b < 2; ++b)
#pragma unroll
                for (int m = 0; m < 4; ++m)
#pragma unroll
                    for (int n = 0; n < 2; ++n) acc[a][b][m][n] = (f32x4){0.f, 0.f, 0.f, 0.f};
        cur = nxt; cA = nA; cB = nB; ++ui;
        if constexpr (ALIGN_EPI) { if (wr == 1) PG8_BAR; }
    }
    PG8_WAIT_V(0);
    if constexpr (!ALIGN_EPI) { if (wr == 0) PG8_BAR; }
    PG8_BAR;
    if constexpr (Epi::AFTER_DRAIN) { E.fused(acc, cur, wr, wc, fr, fq, lds, wid, lane); S.done(cur); }
#undef PG8_SA
#undef PG8_SB
#undef PG8_STAGE
#undef PG8_LDA
#undef PG8_LDB
#undef PG8_MMA
#undef PG8_WAIT_V
#undef PG8_WAIT_L
#undef PG8_BAR
#undef PG8_SCHED
}
}
#define GAS __attribute__((address_space(1)))
#define LAS __attribute__((address_space(3)))
typedef unsigned short bf16;
typedef unsigned v4u __attribute__((ext_vector_type(4)));
typedef float f32x4 __attribute__((ext_vector_type(4)));
typedef short bf16x8 __attribute__((ext_vector_type(8)));
typedef GAS unsigned gu32;
typedef GAS unsigned long long gu64;
#define RLX_AGENT __ATOMIC_RELAXED, __HIP_MEMORY_SCOPE_AGENT
#define LDS_WAIT() asm volatile("s_waitcnt lgkmcnt(0)" ::: "memory")
#define VM_WAIT() asm volatile("s_waitcnt vmcnt(0)" ::: "memory")
__device__ __forceinline__ unsigned long long rt() { return __builtin_amdgcn_s_memrealtime(); }
__device__ __forceinline__ unsigned f2bf(float f) { unsigned u = __builtin_bit_cast(unsigned, f); return (u + 0x7fffu + ((u >> 16) & 1u)) >> 16; }
__device__ __forceinline__ unsigned pk2(float lo, float hi) { return f2bf(lo) | (f2bf(hi) << 16); }

#define XB_TMO      128
#define XB_XCNT(j)  (256  + 64 * (j))
#define XB_XSUB(j)  (1280 + 64 * (j))
#define XB_XGEN(j)  (2304 + 64 * (j))
#define XB_TOP      3328
#define XB_TOPGEN   3392
#define XCD_BAR_WORDS 3456
#define XB_SPIN_CAP (1u << 18)

__device__ __forceinline__ unsigned xb_ld(unsigned* p)              { return __hip_atomic_load(p, __ATOMIC_RELAXED, __HIP_MEMORY_SCOPE_AGENT); }
__device__ __forceinline__ unsigned xb_add(unsigned* p, unsigned v) { return __hip_atomic_fetch_add(p, v, __ATOMIC_RELAXED, __HIP_MEMORY_SCOPE_AGENT); }
__device__ __forceinline__ unsigned xb_xcc_id() { return (unsigned)__builtin_amdgcn_s_getreg((3 << 11) | 20) & 0xFu; }
#define XB_SPIN(cond, bar) do { unsigned _sp = 0; while (cond) { __builtin_amdgcn_s_sleep(1); \
    if ((++_sp & 255u) == 0u) { if (xb_ld(&(bar)[XB_TMO])) break; if (_sp > XB_SPIN_CAP) { atomicAdd(&(bar)[XB_TMO], 1u); break; } } } } while (0)

struct XcdBarrier {
    unsigned* bar; unsigned x;
    volatile LAS unsigned* st;
};

__device__ __forceinline__ XcdBarrier xcd_barrier_post(unsigned* bar, volatile LAS unsigned* st) {
    XcdBarrier b; b.bar = bar; b.x = xb_xcc_id(); b.st = st;
    if (threadIdx.x == 0) (void)xb_add(&bar[XB_XCNT(b.x)], 1u);
    return b;
}
__device__ __forceinline__ void xcd_barrier_complete(unsigned* bar, unsigned x, unsigned& nloc, unsigned& nx) {
    const unsigned G = gridDim.x * gridDim.y * gridDim.z;
    unsigned sum, cnt, mine, sp = 0u;
    for (;;) {
        sum = 0u; cnt = 0u; mine = 0u;
#pragma unroll
        for (unsigned j = 0; j < 16; ++j) { const unsigned c = xb_ld(&bar[XB_XCNT(j)]); sum += c; cnt += (c > 0u) ? 1u : 0u; mine = (j == x) ? c : mine; }
        if (sum == G) break;
        __builtin_amdgcn_s_sleep(1);
        if ((++sp & 255u) == 0u) { if (xb_ld(&bar[XB_TMO])) break; if (sp > XB_SPIN_CAP) { atomicAdd(&bar[XB_TMO], 1u); break; } }
    }
    nloc = mine > 0u ? mine : 1u; nx = cnt > 0u ? cnt : 1u;
}

__device__ __forceinline__ void xcd_barrier(const XcdBarrier& b) {
    asm volatile("s_waitcnt vmcnt(0)" ::: "memory");
    __syncthreads();
    if (threadIdx.x == 0) {
        unsigned* bar = b.bar;
        __builtin_amdgcn_s_waitcnt(0);
        unsigned nloc = b.st[0], nx = b.st[1];
        if (nloc == 0u) { xcd_barrier_complete(bar, b.x, nloc, nx); b.st[0] = nloc; b.st[1] = nx; }
        const unsigned old = xb_add(&bar[XB_XSUB(b.x)], 1u);
        const unsigned gen = old / nloc;
        if (old + 1u == (gen + 1u) * nloc) {
            __builtin_amdgcn_fence(__ATOMIC_RELEASE, "agent");
            asm volatile("s_waitcnt vmcnt(0)" ::: "memory");
            const unsigned og = xb_add(&bar[XB_TOP], 1u);
            const unsigned tg = og / nx;
            if (og + 1u == (tg + 1u) * nx) xb_add(&bar[XB_TOPGEN], 1u);
            else XB_SPIN(xb_ld(&bar[XB_TOPGEN]) == tg, bar);
            __builtin_amdgcn_fence(__ATOMIC_ACQUIRE, "agent");
            xb_add(&bar[XB_XGEN(b.x)], 1u);
            asm volatile("s_waitcnt vmcnt(0)" ::: "memory");
        } else {
            XB_SPIN(xb_ld(&bar[XB_XGEN(b.x)]) == gen, bar);
            __builtin_amdgcn_fence(__ATOMIC_ACQUIRE, "agent");
            asm volatile("s_waitcnt vmcnt(0)" ::: "memory");
        }
    }
    __syncthreads();
}
constexpr int NWAVES = 8, NT = 512;
constexpr int BATCH = 2, SEQ = 8192, D = 1024, TB = 8320, M = BATCH * TB, PADR = 112;
constexpr int NIN = 2816, DFF = 2816, NEXP = 8, DFE = 3584;
constexpr int C_U = 0, C_HQ = 256, C_HF = 512, C_HI = 768, C_HG = 1024, C_RQ = 1280, C_RK = 1536, C_RV = 1792, C_RG = 2304;
constexpr float EPS = 1e-6f;
#ifndef MK_PER_PHASE
#define MK_PER_PHASE 0
#endif
constexpr int NPH = 62;
__host__ __device__ inline bool phase_exists(int k) {
    if (k == 0 || k == NPH - 1) return true;
    const int l = (k - 1) / 30, r = (k - 1) % 30;
    if (r <= 3 || r == 6) return true;
    if (r < 6) return false;
    if (r == 7) return l == 1;
    if (r >= 24) return false;
    const int e = (r - 8) / 2; return e < (l == 0 ? 1 : NEXP);
}
constexpr size_t MiB = 1u << 20;
constexpr size_t WS_CTL = 0, CTL_ZERO_BYTES = 1 * MiB;
constexpr int CW_TMO = 0, CW_CODE = 1, CW_BAR = 4096;
constexpr size_t WS_LB = 1 * MiB, WS_BB = 1 * MiB + 65536, WS_ROT = 1 * MiB + 524288, WS_LBT = 3 * MiB, WS_GT = 3 * MiB + 65536;
constexpr size_t WS_LB128 = 1 * MiB + 16384, WS_BBT = 1 * MiB + 393216, WS_CCT = 2752512, WS_WGT = 2883584;
static_assert(WS_BBT + 131072 <= WS_ROT && WS_ROT + (size_t)TB * 32 * 4 <= WS_CCT && WS_CCT + 131072 <= WS_WGT && WS_WGT + 262144 <= WS_LBT, "table map");
constexpr size_t WS_WIN = 4 * MiB, WS_WOUT = 15 * MiB, WS_WF13 = 19 * MiB, WS_WF2 = 30 * MiB, WS_WM13 = 36 * MiB, WS_WM2 = 148 * MiB;
constexpr size_t WS_H = 204 * MiB, WS_HB = 269 * MiB, WS_PROJ = 302 * MiB, WS_MIXED = 392 * MiB, WS_ACT = 302 * MiB, WS_YS5 = 425 * MiB, WS_SSP = 442 * MiB, WS_END = 448 * MiB;
static_assert(WS_PROJ + (size_t)M * NIN * 2 <= WS_MIXED && WS_MIXED + (size_t)M * D * 2 <= WS_YS5 && WS_ACT + (size_t)M * DFE * 2 <= WS_YS5 && WS_YS5 + (size_t)M * 256 * 4 <= WS_SSP && WS_SSP + (size_t)5 * M * 16 * 4 <= WS_END, "ws map");
static_assert(WS_H + (size_t)M * D * 4 <= WS_HB && WS_HB + (size_t)M * D * 2 <= WS_PROJ && WS_WM2 + (size_t)NEXP * D * DFE * 2 <= WS_H && WS_WM13 + (size_t)NEXP * 2 * DFE * D * 2 <= WS_WM2, "ws map 2");
constexpr int RING_OFF = 0, RING_BYTES = 131072, LDSCTL_OFF = RING_BYTES, MISC_OFF = LDSCTL_OFF + 320, LDS_BYTES = 147456;

struct Frame { LAS unsigned char* lds; volatile LAS unsigned* MISC; gu32* ctl; unsigned char* ws; const float* const* in; };
struct Loc { int tid, lane, wave, bx, vcu, G; };
__device__ __forceinline__ Loc make_loc() { Loc L; int t = threadIdx.x; asm volatile("" : "+v"(t)); int b = blockIdx.x; asm volatile("" : "+s"(b)); L.tid = t; L.lane = t & 63; L.wave = __builtin_amdgcn_readfirstlane(t >> 6);
    L.bx = b; L.G = gridDim.x; L.vcu = (L.G % 8 == 0) ? (b % 8) * (L.G / 8) + b / 8 : b; return L; }
__device__ __forceinline__ float bf2f(bf16 x) { return __uint_as_float((unsigned)x << 16); }
__device__ __forceinline__ bf16 f2bf_(float f) { return (bf16)f2bf(f); }
__device__ __forceinline__ float wave_sum(float v) {
#pragma unroll
    for (int o = 1; o < 64; o <<= 1) v += __shfl_xor(v, o);
    return v;
}
__device__ __forceinline__ float silu_f(float a) { return a / (1.0f + __expf(-a)); }
__device__ __forceinline__ float sigmoid_f(float a) { return 1.0f / (1.0f + __expf(-a)); }

__device__ __forceinline__ void tr_item(const float* W, int K, int N, bf16* WT, int mode, const float* g, LAS float* scr, int item, int lane) {
    const int nblk = N / 32, kb = item / nblk, nb = item % nblk, k0 = 64 * kb, n0 = 32 * nb;
#pragma unroll 8
    for (int i = 0; i < 32; ++i) { const int kk = 2 * i + (lane >> 5); float w = W[(size_t)(k0 + kk) * N + n0 + (lane & 31)]; if (g) w *= g[k0 + kk]; scr[kk * 33 + (lane & 31)] = w; }
    LDS_WAIT(); asm volatile("" ::: "memory");
    const int c = lane & 7;
#pragma unroll
    for (int j = 0; j < 4; ++j) { const int n = (lane >> 3) + 8 * j; const LAS float* s = scr + (8 * c) * 33 + n;
        v4u o; o.x = pk2(s[0 * 33], s[1 * 33]); o.y = pk2(s[2 * 33], s[3 * 33]); o.z = pk2(s[4 * 33], s[5 * 33]); o.w = pk2(s[6 * 33], s[7 * 33]);
        const int nn = n0 + n, drow = mode == 0 ? nn : ((nn >> 7) * 256 + (nn & 127) + (mode == 2 ? 128 : 0));
        *(GAS v4u*)(WT + (size_t)drow * K + k0 + 8 * c) = o; }
    LDS_WAIT(); asm volatile("" ::: "memory");
}
__device__ __forceinline__ void p0_prologue(Frame& F) {
    const Loc L = make_loc();
    LAS float* scr = (LAS float*)(F.lds + RING_OFF + L.wave * 16384);
    const int gw = L.vcu * NWAVES + L.wave, NGW = L.G * NWAVES;
    unsigned char* ws = F.ws; const float* const* in = F.in;
    constexpr int I_IN = 16 * 88, I_OUT = 16 * 32, I_F = 16 * 88, I_F2 = 44 * 32, I_M = 16 * 112, I_M2 = 56 * 32;
    constexpr int NITEMS = 2 * I_IN + 2 * I_OUT + 2 * I_F + I_F2 + 16 * I_M + 8 * I_M2;
    for (int it = gw; it < NITEMS; it += NGW) {
        int r = it;
        if (r < 2 * I_IN) { const int l = r / I_IN; tr_item(in[3] + (size_t)l * D * NIN, D, NIN, (bf16*)(ws + WS_WIN) + (size_t)l * NIN * D, 0, in[2] + l * D, scr, r % I_IN, L.lane); continue; } r -= 2 * I_IN;
        if (r < 2 * I_OUT) { const int l = r / I_OUT; tr_item(in[18] + (size_t)l * D * D, D, D, (bf16*)(ws + WS_WOUT) + (size_t)l * D * D, 0, nullptr, scr, r % I_OUT, L.lane); continue; } r -= 2 * I_OUT;
        if (r < I_F) { tr_item(in[20], D, DFF, (bf16*)(ws + WS_WF13), 1, in[19], scr, r, L.lane); continue; } r -= I_F;
        if (r < I_F) { tr_item(in[21], D, DFF, (bf16*)(ws + WS_WF13), 2, in[19], scr, r, L.lane); continue; } r -= I_F;
        if (r < I_F2) { tr_item(in[22], DFF, D, (bf16*)(ws + WS_WF2), 0, nullptr, scr, r, L.lane); continue; } r -= I_F2;
        if (r < 8 * I_M) { const int e = r / I_M; tr_item(in[24] + (size_t)e * D * DFE, D, DFE, (bf16*)(ws + WS_WM13) + (size_t)e * 2 * DFE * D, 1, in[19] + D, scr, r % I_M, L.lane); continue; } r -= 8 * I_M;
        if (r < 8 * I_M) { const int e = r / I_M; tr_item(in[25] + (size_t)e * D * DFE, D, DFE, (bf16*)(ws + WS_WM13) + (size_t)e * 2 * DFE * D, 2, in[19] + D, scr, r % I_M, L.lane); continue; } r -= 8 * I_M;
        { const int e = r / I_M2; tr_item(in[26] + (size_t)e * DFE * D, DFE, D, (bf16*)(ws + WS_WM2) + (size_t)e * D * DFE, 0, nullptr, scr, r % I_M2, L.lane); }
    }
    float* H = (float*)(ws + WS_H); bf16* HB = (bf16*)(ws + WS_HB); float* SS0 = (float*)(ws + WS_SSP);
    for (int m = gw; m < M; m += NGW) {
        const int b = m / TB, t = m % TB;
        const float* src = t < PADR ? nullptr : (t < 128 ? in[1] + (size_t)(t - PADR) * D : in[0] + ((size_t)b * SEQ + (t - 128)) * D);
        f32x4 v[4]; float s = 0.f;
#pragma unroll
        for (int j = 0; j < 4; ++j) { v[j] = src ? ((const GAS f32x4*)src)[L.lane + 64 * j] : (f32x4){0.f, 0.f, 0.f, 0.f}; s += (v[j].x * v[j].x + v[j].y * v[j].y) + (v[j].z * v[j].z + v[j].w * v[j].w); }
        s = wave_sum(s);
#pragma unroll
        for (int j = 0; j < 4; ++j) { ((GAS f32x4*)(H + (size_t)m * D))[L.lane + 64 * j] = v[j];
            ((GAS unsigned long long*)(HB + (size_t)m * D))[L.lane + 64 * j] = (unsigned long long)pk2(v[j].x, v[j].y) | ((unsigned long long)pk2(v[j].z, v[j].w) << 32); }
        if (L.lane < 16) SS0[(size_t)m * 16 + L.lane] = L.lane == 0 ? s : 0.0f;
    }
    const int gt = L.vcu * NT + L.tid, NGT = L.G * NT;
    float* LB = (float*)(ws + WS_LB); float* BB = (float*)(ws + WS_BB); float* ROT = (float*)(ws + WS_ROT); float* LBT = (float*)(ws + WS_LBT);
    for (int i = gt; i < 2048; i += NGT) {
        const int lg = i >> 6; const float step = expf(in[11][lg]); const float lre = in[4][i], lim = in[5][i];
        const float mag = expf(lre * step); float sn, cs; sincosf(lim * step, &sn, &cs); const float br = mag * cs, bi = mag * sn;
        const float den = 1.0f / (lre * lre + lim * lim), cr = ((br - 1.0f) * lre + bi * lim) * den, ci = (bi * lre - (br - 1.0f) * lim) * den;
        LB[2 * i] = br; LB[2 * i + 1] = bi;
        for (int h = 0; h < 16; ++h) { const float b_r = in[6][i * 16 + h], b_i = in[7][i * 16 + h]; BB[(i * 16 + h) * 2] = cr * b_r - ci * b_i; BB[(i * 16 + h) * 2 + 1] = cr * b_i + ci * b_r; }
    }
    { bf16* BBT = (bf16*)(ws + WS_BBT); bf16* CCT = (bf16*)(ws + WS_CCT); bf16* WGT = (bf16*)(ws + WS_WGT); float* LB128 = (float*)(ws + WS_LB128);
      for (int i = gt; i < 2048; i += NGT) { const int lg = i >> 6, p = i & 63; const float step = expf(in[11][lg]), lre = in[4][i], lim = in[5][i];
          const float mag = expf(128.0f * lre * step); float sn, cs; sincosf(128.0f * (lim * step), &sn, &cs); LB128[2 * i] = mag * cs; LB128[2 * i + 1] = mag * sn;
          const float m1 = expf(lre * step); float s1, c1; sincosf(lim * step, &s1, &c1); const float br = m1 * c1, bi = m1 * s1, den = 1.0f / (lre * lre + lim * lim), cr = ((br - 1.0f) * lre + bi * lim) * den, ci = (bi * lre - (br - 1.0f) * lim) * den;
          for (int h = 0; h < 16; ++h) { const float b_r = in[6][i * 16 + h], b_i = in[7][i * 16 + h]; BBT[((size_t)lg * 128 + p) * 16 + h] = f2bf_(cr * b_r - ci * b_i); BBT[((size_t)lg * 128 + 64 + p) * 16 + h] = f2bf_(cr * b_i + ci * b_r);
              CCT[((size_t)lg * 16 + h) * 128 + p] = f2bf_(in[8][(lg * 16 + h) * 64 + p]); CCT[((size_t)lg * 16 + h) * 128 + 64 + p] = f2bf_(-in[9][(lg * 16 + h) * 64 + p]); } }
      for (int i = gt; i < 2 * 65536; i += NGT) { const int l = i >> 16, n = (i >> 8) & 255, k = i & 255; WGT[i] = f2bf_(in[12][(size_t)l * 65536 + k * 256 + n]); } }
    for (int i = gt; i < TB * 16; i += NGT) { const int t = i >> 4, f = i & 15; const float pos = (float)(t - PADR), inv = powf(10000.0f, -(float)f / 16.0f); float sn, cs; sincosf(pos * inv, &sn, &cs); ROT[2 * i] = cs; ROT[2 * i + 1] = sn; }
    for (int i = gt; i < 512; i += NGT) { const int l = i >> 8, c = i & 255; float lb = 0.f; if (l == 1) { const float a0 = in[15][c], a1 = in[15][256 + c], mx = fmaxf(a0, a1), e0 = expf(a0 - mx), e1 = expf(a1 - mx); lb = e1 / (e0 + e1); } LBT[i] = lb; }
}

__device__ __forceinline__ void gold_hgrn(Frame& F, int l, int b, int h) {
    const Loc L = make_loc();
    LAS float* qs = (LAS float*)F.lds; LAS float* fs = qs + 1024; LAS float* ks = fs + 1024; LAS float* vs = ks + 1024; LAS float* po = vs + 1024;
    const bf16* P = (const bf16*)(F.ws + WS_PROJ) + (size_t)b * TB * NIN; bf16* MX = (bf16*)(F.ws + WS_MIXED) + (size_t)b * TB * D;
    const float* cw = F.in[14] + l * 4 * 768; const float* lbt = (const float*)(F.ws + WS_LBT) + l * 256; const float* og = F.in[16] + l * 256 + h * 64;
    const int tid = L.tid, kg = tid >> 6, v = tid & 63;
    float S[8];
#pragma unroll
    for (int i = 0; i < 8; ++i) S[i] = 0.f;
    for (int t0 = 0; t0 < TB; t0 += 16) {
        for (int it = tid; it < 1024; it += NT) {
            const int tt = it >> 6, c = it & 63, t = t0 + tt, ch = h * 64 + c; float cq = 0.f, cf = 0.f, ci = 0.f;
#pragma unroll
            for (int j = 0; j < 4; ++j) { const int ts = t - 3 + j; if (ts >= 0) { const bf16* pr = P + (size_t)ts * NIN;
                cq += cw[j * 768 + ch] * bf2f(pr[C_HQ + ch]); cf += cw[j * 768 + 256 + ch] * bf2f(pr[C_HF + ch]); ci += cw[j * 768 + 512 + ch] * bf2f(pr[C_HI + ch]); } }
            const float lb = lbt[ch], f = lb + (1.0f - lb) * sigmoid_f(cf);
            qs[it] = silu_f(cq); fs[it] = f; ks[it] = 1.0f - f; vs[it] = ci;
        }
        __syncthreads();
        for (int tt = 0; tt < 16; ++tt) { float part = 0.f; const float vv = vs[tt * 64 + v];
#pragma unroll
            for (int i = 0; i < 8; ++i) { const int k = kg * 8 + i; S[i] = fs[tt * 64 + k] * S[i] + ks[tt * 64 + k] * vv; part += qs[tt * 64 + k] * S[i]; }
            po[(tt * 8 + kg) * 64 + v] = part; }
        __syncthreads();
        { const int tt = tid >> 5, vq = tid & 31; float o0 = 0.f, o1 = 0.f;
#pragma unroll
          for (int g = 0; g < 8; ++g) { o0 += po[(tt * 8 + g) * 64 + vq]; o1 += po[(tt * 8 + g) * 64 + vq + 32]; }
          float s = o0 * o0 + o1 * o1;
#pragma unroll
          for (int o = 1; o < 32; o <<= 1) s += __shfl_xor(s, o);
          const float r = rsqrtf(s * (1.0f / 64.0f) + EPS); const int t = t0 + tt; const bf16* pr = P + (size_t)t * NIN + C_HG + h * 64;
          bf16* mo = MX + (size_t)t * D + 256 + h * 64;
          mo[vq] = f2bf_(o0 * r * og[vq] * silu_f(bf2f(pr[vq]))); mo[vq + 32] = f2bf_(o1 * r * og[vq + 32] * silu_f(bf2f(pr[vq + 32]))); }
        __syncthreads();
    }
}
__device__ __forceinline__ void gold_ret(Frame& F, int l, int b, int h) {
    const Loc L = make_loc();
    LAS float* qs = (LAS float*)F.lds; LAS float* ks = qs + 512; LAS float* vs = ks + 512; LAS float* po = vs + 1024;
    const bf16* P = (const bf16*)(F.ws + WS_PROJ) + (size_t)b * TB * NIN; bf16* MX = (bf16*)(F.ws + WS_MIXED) + (size_t)b * TB * D;
    const float* ROT = (const float*)(F.ws + WS_ROT); const float* og = F.in[17] + l * 512 + h * 64;
    const int tid = L.tid, kg = tid >> 6, v = tid & 63; const float gamma = 1.0f - exp2f(-5.0f - (float)h), scale = 0.17677669529663687f;
    float S[4];
#pragma unroll
    for (int i = 0; i < 4; ++i) S[i] = 0.f;
    for (int t0 = 0; t0 < TB; t0 += 16) {
        if (tid < 256) { const int tt = tid >> 4, i = tid & 15, t = t0 + tt; const bf16* pr = P + (size_t)t * NIN; const float c = ROT[(t * 16 + i) * 2], s = ROT[(t * 16 + i) * 2 + 1];
            const float q1 = bf2f(pr[C_RQ + h * 32 + i]), q2 = bf2f(pr[C_RQ + h * 32 + 16 + i]), k1 = bf2f(pr[C_RK + h * 32 + i]), k2 = bf2f(pr[C_RK + h * 32 + 16 + i]);
            qs[tt * 32 + i] = (q1 * c - q2 * s) * scale; qs[tt * 32 + 16 + i] = (q1 * s + q2 * c) * scale; ks[tt * 32 + i] = k1 * c - k2 * s; ks[tt * 32 + 16 + i] = k1 * s + k2 * c; }
        for (int it = tid; it < 1024; it += NT) { const int tt = it >> 6, c = it & 63; vs[it] = bf2f(P[(size_t)(t0 + tt) * NIN + C_RV + h * 64 + c]); }
        __syncthreads();
        for (int tt = 0; tt < 16; ++tt) { float part = 0.f; const float vv = vs[tt * 64 + v];
#pragma unroll
            for (int i = 0; i < 4; ++i) { const int k = kg * 4 + i; S[i] = gamma * S[i] + ks[tt * 32 + k] * vv; part += qs[tt * 32 + k] * S[i]; }
            po[(tt * 8 + kg) * 64 + v] = part; }
        __syncthreads();
        { const int tt = tid >> 5, vq = tid & 31; float o0 = 0.f, o1 = 0.f;
#pragma unroll
          for (int g = 0; g < 8; ++g) { o0 += po[(tt * 8 + g) * 64 + vq]; o1 += po[(tt * 8 + g) * 64 + vq + 32]; }
          float s = o0 + o1;
#pragma unroll
          for (int o = 1; o < 32; o <<= 1) s += __shfl_xor(s, o);
          const float mean = s * (1.0f / 64.0f), c0 = o0 - mean, c1 = o1 - mean; float q = c0 * c0 + c1 * c1;
#pragma unroll
          for (int o = 1; o < 32; o <<= 1) q += __shfl_xor(q, o);
          const float r = rsqrtf(q * (1.0f / 64.0f) + EPS); const int t = t0 + tt; const bf16* pr = P + (size_t)t * NIN + C_RG + h * 64;
          bf16* mo = MX + (size_t)t * D + 512 + h * 64;
          mo[vq] = f2bf_(c0 * r * og[vq] * silu_f(bf2f(pr[vq]))); mo[vq + 32] = f2bf_(c1 * r * og[vq + 32] * silu_f(bf2f(pr[vq + 32]))); }
        __syncthreads();
    }
}
__device__ __forceinline__ void gold_s5(Frame& F, int l, int b, int g) {
    const Loc L = make_loc();
    LAS float* us = (LAS float*)F.lds; LAS float* xs = us + 512; LAS float* Cs = xs + 4096;
    const bf16* P = (const bf16*)(F.ws + WS_PROJ) + (size_t)b * TB * NIN; float* Y = (float*)(F.ws + WS_YS5) + (size_t)b * TB * 256;
    const int tid = L.tid, lg = l * 16 + g;
    for (int it = tid; it < 1024; it += NT) { const int h = it >> 6, p = it & 63; Cs[(p * 16 + h) * 2] = F.in[8][(lg * 16 + h) * 64 + p]; Cs[(p * 16 + h) * 2 + 1] = F.in[9][(lg * 16 + h) * 64 + p]; }
    float Bre[16], Bim[16], lr = 0.f, li = 0.f, xr = 0.f, xi = 0.f;
    { const int p = tid & 63; const float* BB = (const float*)(F.ws + WS_BB) + (size_t)(lg * 64 + p) * 32; const float* LB = (const float*)(F.ws + WS_LB) + (lg * 64 + p) * 2;
#pragma unroll
      for (int h = 0; h < 16; ++h) { Bre[h] = BB[2 * h]; Bim[h] = BB[2 * h + 1]; }
      lr = LB[0]; li = LB[1]; }
    const float dsk = F.in[10][lg * 16 + (tid & 15)];
    for (int t0 = 0; t0 < TB; t0 += 32) {
        { const int tt = tid >> 4, h = tid & 15; us[tid] = bf2f(P[(size_t)(t0 + tt) * NIN + C_U + g * 16 + h]); }
        __syncthreads();
        if (tid < 64) { const int p = tid;
            for (int tt = 0; tt < 32; ++tt) { float bur = 0.f, bui = 0.f;
#pragma unroll
                for (int h = 0; h < 16; ++h) { const float u = us[tt * 16 + h]; bur += Bre[h] * u; bui += Bim[h] * u; }
                const float nr = lr * xr - li * xi + bur, ni = lr * xi + li * xr + bui; xr = nr; xi = ni; xs[(tt * 64 + p) * 2] = xr; xs[(tt * 64 + p) * 2 + 1] = xi; } }
        __syncthreads();
        { const int tt = tid >> 4, h = tid & 15; float y = 0.f;
          for (int p = 0; p < 64; ++p) y += Cs[(p * 16 + h) * 2] * xs[(tt * 64 + p) * 2] - Cs[(p * 16 + h) * 2 + 1] * xs[(tt * 64 + p) * 2 + 1];
          y += dsk * us[tt * 16 + h]; Y[(size_t)(t0 + tt) * 256 + g * 16 + h] = y; }
        __syncthreads();
    }
}
__device__ __forceinline__ void p_gold_mixers(Frame& F, int l) {
    const Loc L = make_loc();
    const int bx = L.bx;
    if (bx >= 24 && bx < 56) gold_s5(F, l, (bx - 24) >> 4, (bx - 24) & 15);
}
__device__ __forceinline__ float gelu_tanh(float y) { const float x = 0.7978845608028654f * (y + 0.044715f * y * y * y); const float th = 1.0f - 2.0f / (1.0f + __expf(2.0f * x)); return 0.5f * y * (1.0f + th); }
typedef unsigned u32x4_t __attribute__((ext_vector_type(4)));
__device__ __forceinline__ f32x4 mfma16(bf16x8 a, bf16x8 b, f32x4 c) { return __builtin_amdgcn_mfma_f32_16x16x32_bf16(a, b, c, 0, 0, 0); }
__device__ __forceinline__ unsigned cvtpk(float lo, float hi) { unsigned r; asm volatile("v_cvt_pk_bf16_f32 %0, %1, %2" : "=v"(r) : "v"(lo), "v"(hi)); return r; }
__device__ __forceinline__ bf16x8 pack8(f32x4 a, f32x4 b) { u32x4_t w; w.x = cvtpk(a[0], a[1]); w.y = cvtpk(a[2], a[3]); w.z = cvtpk(b[0], b[1]); w.w = cvtpk(b[2], b[3]); return __builtin_bit_cast(bf16x8, w); }
__device__ __forceinline__ int perm_pos(int j) { return (j & ~31) + 8 * ((j >> 2) & 3) + 4 * ((j >> 4) & 1) + (j & 3); }
constexpr int NCH = TB / 128;
constexpr size_t OUT_RST = 0, OUT_HST = 9 * MiB, OUT_HDK = 18 * MiB, OUT_S5X = 19 * MiB;
__device__ __forceinline__ void ma_ret_unit(Frame& F, const Loc& L, int b, int c, int h, float* outb) {
    LAS float* Ks = (LAS float*)F.lds; LAS float* Vs = Ks + 128 * 32;
    const bf16* P = (const bf16*)(F.ws + WS_PROJ) + ((size_t)b * TB + c * 128) * NIN; const float* ROT = (const float*)(F.ws + WS_ROT) + (size_t)c * 128 * 32;
    const float lg = __log2f(1.0f - exp2f(-5.0f - (float)h));
    for (int it = L.tid; it < 2048; it += NT) { const int j = it >> 4, i = it & 15; const bf16* pr = P + (size_t)j * NIN; const float cs = ROT[(j * 16 + i) * 2], sn = ROT[(j * 16 + i) * 2 + 1];
        const float k1 = bf2f(pr[C_RK + h * 32 + i]), k2 = bf2f(pr[C_RK + h * 32 + 16 + i]), w = exp2f((float)(127 - j) * lg);
        Ks[j * 32 + i] = (k1 * cs - k2 * sn) * w; Ks[j * 32 + 16 + i] = (k1 * sn + k2 * cs) * w; }
    for (int it = L.tid; it < 8192; it += NT) { const int j = it >> 6, v = it & 63; Vs[it] = bf2f(P[(size_t)j * NIN + C_RV + h * 64 + v]); }
    __syncthreads();
    const int v = L.tid & 63, fg = L.tid >> 6; float acc[4] = {0.f, 0.f, 0.f, 0.f};
    for (int j = 0; j < 128; ++j) { const float vv = Vs[j * 64 + v]; const f32x4 kk = *(const LAS f32x4*)(Ks + j * 32 + 4 * fg);
#pragma unroll
        for (int i = 0; i < 4; ++i) acc[i] += kk[i] * vv; }
    float* S = (float*)((unsigned char*)outb + OUT_RST) + (size_t)((b * NCH + c) * 8 + h) * 2048;
#pragma unroll
    for (int i = 0; i < 4; ++i) S[(4 * fg + i) * 64 + v] = acc[i];
    __syncthreads();
}
__device__ __forceinline__ void mb_ret(const Loc& L, float* outb) {
    const int gt = L.vcu * NT + L.tid, NGT = L.G * NT;
    for (int e = gt; e < 2 * 8 * 2048; e += NGT) { const int b = e >> 14, h = (e >> 11) & 7, idx = e & 2047; const float d = exp2f(128.0f * __log2f(1.0f - exp2f(-5.0f - (float)h)));
        float* p = (float*)((unsigned char*)outb + OUT_RST) + (size_t)(b * NCH * 8 + h) * 2048 + idx; float s = 0.f;
        for (int c = 0; c < NCH; ++c) { const float loc = p[(size_t)c * 8 * 2048]; p[(size_t)c * 8 * 2048] = s; s = d * s + loc; } }
}
__device__ __forceinline__ void mc_ret_unit(Frame& F, const Loc& L, int l, int b, int c, int h, const float* outb) {
    LAS bf16* Qrm = (LAS bf16*)F.lds; LAS bf16* Krm = Qrm + 4096; LAS bf16* Vt = Krm + 4096; LAS bf16* SpT = Vt + 64 * 136;
    const size_t row0 = (size_t)b * TB + c * 128; const bf16* P = (const bf16*)(F.ws + WS_PROJ) + row0 * NIN; const float* ROT = (const float*)(F.ws + WS_ROT) + (size_t)c * 128 * 32;
    const float gamma = 1.0f - exp2f(-5.0f - (float)h), lg = __log2f(gamma);
    { const int r = L.tid >> 2, pq = L.tid & 3; const bf16* pr = P + (size_t)r * NIN; const f32x4 r0 = *(const f32x4*)(ROT + (r * 16 + 4 * pq) * 2), r1 = *(const f32x4*)(ROT + (r * 16 + 4 * pq) * 2 + 4);
      const float cs[4] = {r0[0], r0[2], r1[0], r1[2]}, sn[4] = {r0[1], r0[3], r1[1], r1[3]};
      const float wq = 0.17677669529663687f * exp2f((float)r * lg), wk = exp2f(-(float)r * lg);
      const unsigned long long q1 = *(const GAS unsigned long long*)(pr + C_RQ + h * 32 + 4 * pq), q2 = *(const GAS unsigned long long*)(pr + C_RQ + h * 32 + 16 + 4 * pq);
      const unsigned long long k1 = *(const GAS unsigned long long*)(pr + C_RK + h * 32 + 4 * pq), k2 = *(const GAS unsigned long long*)(pr + C_RK + h * 32 + 16 + 4 * pq);
      float qa[4], qb[4], ka[4], kb[4];
#pragma unroll
      for (int e = 0; e < 4; ++e) { const float a1 = bf2f((bf16)(q1 >> (16 * e))), a2 = bf2f((bf16)(q2 >> (16 * e))), b1 = bf2f((bf16)(k1 >> (16 * e))), b2 = bf2f((bf16)(k2 >> (16 * e)));
          qa[e] = (a1 * cs[e] - a2 * sn[e]) * wq; qb[e] = (a1 * sn[e] + a2 * cs[e]) * wq; ka[e] = (b1 * cs[e] - b2 * sn[e]) * wk; kb[e] = (b1 * sn[e] + b2 * cs[e]) * wk; }
      *(LAS unsigned long long*)(Qrm + r * 32 + 4 * pq) = (unsigned long long)cvtpk(qa[0], qa[1]) | ((unsigned long long)cvtpk(qa[2], qa[3]) << 32);
      *(LAS unsigned long long*)(Qrm + r * 32 + 16 + 4 * pq) = (unsigned long long)cvtpk(qb[0], qb[1]) | ((unsigned long long)cvtpk(qb[2], qb[3]) << 32);
      *(LAS unsigned long long*)(Krm + r * 32 + 4 * pq) = (unsigned long long)cvtpk(ka[0], ka[1]) | ((unsigned long long)cvtpk(ka[2], ka[3]) << 32);
      *(LAS unsigned long long*)(Krm + r * 32 + 16 + 4 * pq) = (unsigned long long)cvtpk(kb[0], kb[1]) | ((unsigned long long)cvtpk(kb[2], kb[3]) << 32);
      const int vq = 16 * pq, pj = perm_pos(r); const v4u va = *(const GAS v4u*)(pr + C_RV + h * 64 + vq), vb = *(const GAS v4u*)(pr + C_RV + h * 64 + vq + 8);
#pragma unroll
      for (int e = 0; e < 4; ++e) { Vt[(vq + 2 * e) * 136 + pj] = (bf16)(va[e] & 0xffffu); Vt[(vq + 2 * e + 1) * 136 + pj] = (bf16)(va[e] >> 16);
          Vt[(vq + 8 + 2 * e) * 136 + pj] = (bf16)(vb[e] & 0xffffu); Vt[(vq + 8 + 2 * e + 1) * 136 + pj] = (bf16)(vb[e] >> 16); }
      const int k = L.tid >> 4, v4 = (L.tid & 15) * 4; const f32x4 sp = *(const f32x4*)((const float*)((const unsigned char*)outb + OUT_RST) + (size_t)((b * NCH + c) * 8 + h) * 2048 + k * 64 + v4);
#pragma unroll
      for (int e = 0; e < 4; ++e) SpT[(v4 + e) * 40 + k] = f2bf_(gamma * sp[e]);
    }
    __syncthreads();
    const int w = L.wave, il = L.lane & 15, g = L.lane >> 4;
    const bf16x8 Bq = *(const LAS bf16x8*)(Qrm + (16 * w + il) * 32 + 8 * g);
    const f32x4 zero = {0.f, 0.f, 0.f, 0.f}; f32x4 O[4] = {zero, zero, zero, zero};
#pragma unroll
    for (int jp = 0; jp < 4; ++jp) if (2 * jp <= w) {
        f32x4 p0, p1 = zero;
        { const bf16x8 A = *(const LAS bf16x8*)(Krm + (32 * jp + il) * 32 + 8 * g); p0 = mfma16(A, Bq, zero);
          if (2 * jp == w) {
#pragma unroll
              for (int r = 0; r < 4; ++r) if (4 * g + r > il) p0[r] = 0.f; } }
        if (2 * jp + 1 <= w) { const bf16x8 A = *(const LAS bf16x8*)(Krm + (32 * jp + 16 + il) * 32 + 8 * g); p1 = mfma16(A, Bq, zero);
          if (2 * jp + 1 == w) {
#pragma unroll
              for (int r = 0; r < 4; ++r) if (4 * g + r > il) p1[r] = 0.f; } }
        const bf16x8 Bp = pack8(p0, p1);
#pragma unroll
        for (int vt = 0; vt < 4; ++vt) { const bf16x8 A = *(const LAS bf16x8*)(Vt + (16 * vt + il) * 136 + 32 * jp + 8 * g); O[vt] = mfma16(A, Bp, O[vt]); }
    }
#pragma unroll
    for (int vt = 0; vt < 4; ++vt) { const bf16x8 A = *(const LAS bf16x8*)(SpT + (16 * vt + il) * 40 + 8 * g); O[vt] = mfma16(A, Bq, O[vt]); }
    float s1 = 0.f;
#pragma unroll
    for (int vt = 0; vt < 4; ++vt) s1 += (O[vt][0] + O[vt][1]) + (O[vt][2] + O[vt][3]);
    s1 += __shfl_xor(s1, 16); s1 += __shfl_xor(s1, 32); const float mean = s1 * (1.0f / 64.0f); float s2 = 0.f;
#pragma unroll
    for (int vt = 0; vt < 4; ++vt) { O[vt] = O[vt] - mean; s2 += (O[vt][0] * O[vt][0] + O[vt][1] * O[vt][1]) + (O[vt][2] * O[vt][2] + O[vt][3] * O[vt][3]); }
    s2 += __shfl_xor(s2, 16); s2 += __shfl_xor(s2, 32); const float rstd = rsqrtf(s2 * (1.0f / 64.0f) + EPS);
    const size_t row = row0 + 16 * w + il; const bf16* gp = (const bf16*)(F.ws + WS_PROJ) + row * NIN + C_RG + h * 64; bf16* mo = (bf16*)(F.ws + WS_MIXED) + row * D + 512 + h * 64; const float* og = F.in[17] + l * 512 + h * 64;
#pragma unroll
    for (int vt = 0; vt < 4; ++vt) { const int v0 = 16 * vt + 4 * g; const unsigned long long gg = *(const GAS unsigned long long*)(gp + v0); const f32x4 o4 = *(const f32x4*)(og + v0); float y[4];
#pragma unroll
        for (int r = 0; r < 4; ++r) y[r] = O[vt][r] * rstd * o4[r] * silu_f(bf2f((bf16)(gg >> (16 * r))));
        *(GAS unsigned long long*)(mo + v0) = (unsigned long long)cvtpk(y[0], y[1]) | ((unsigned long long)cvtpk(y[2], y[3]) << 32); }
    __syncthreads();
}
constexpr int HG_LD = 68;
constexpr int SEG_OFF = MISC_OFF + 192;
static_assert(SEG_OFF % 16 == 0 && SEG_OFF + 2048 <= LDS_BYTES, "LDS map (SEG)");
template <bool NEED_Q> __device__ __forceinline__ void hg_rows(const bf16* Pb, int tb0, int ch, const float* cw, float lb, float (&q)[16], float (&kk)[16], float (&vv)[16], float (&gl)[16]) {
    float wq[4], wf[4], wi[4];
#pragma unroll
    for (int j = 0; j < 4; ++j) { wq[j] = cw[j * 768 + ch]; wf[j] = cw[j * 768 + 256 + ch]; wi[j] = cw[j * 768 + 512 + ch]; }
    float hq[3], hf[3], hi[3];
#pragma unroll
    for (int j = 0; j < 3; ++j) { const int ts = tb0 - 3 + j; hq[j] = 0.f; hf[j] = 0.f; hi[j] = 0.f;
        if (ts >= 0) { const bf16* pr = Pb + (size_t)ts * NIN; if (NEED_Q) hq[j] = bf2f(pr[C_HQ + ch]); hf[j] = bf2f(pr[C_HF + ch]); hi[j] = bf2f(pr[C_HI + ch]); } }
    float run = 0.f;
#pragma unroll
    for (int r = 0; r < 16; ++r) { const bf16* pr = Pb + (size_t)(tb0 + r) * NIN; const float xq = NEED_Q ? bf2f(pr[C_HQ + ch]) : 0.f, xf = bf2f(pr[C_HF + ch]), xi = bf2f(pr[C_HI + ch]);
        const float cq = (wq[0] * hq[0] + wq[1] * hq[1]) + (wq[2] * hq[2] + wq[3] * xq), cf = (wf[0] * hf[0] + wf[1] * hf[1]) + (wf[2] * hf[2] + wf[3] * xf), ci = (wi[0] * hi[0] + wi[1] * hi[1]) + (wi[2] * hi[2] + wi[3] * xi);
        hq[0] = hq[1]; hq[1] = hq[2]; hq[2] = xq; hf[0] = hf[1]; hf[1] = hf[2]; hf[2] = xf; hi[0] = hi[1]; hi[1] = hi[2]; hi[2] = xi;
        const float f = fmaxf(lb + (1.0f - lb) * sigmoid_f(cf), 1e-30f); run += __logf(f); gl[r] = run; kk[r] = 1.0f - f; vv[r] = ci; q[r] = NEED_Q ? silu_f(cq) : 0.f; }
}
__device__ __forceinline__ void ma_hg_unit(Frame& F, const Loc& L, int l, int b, int c, int h, float* outb) {
    LAS float* Ks = (LAS float*)F.lds; LAS float* Vs = Ks + 128 * 64; LAS float* SEG = (LAS float*)(F.lds + SEG_OFF);
    const bf16* Pb = (const bf16*)(F.ws + WS_PROJ) + (size_t)b * TB * NIN; const int k = L.tid & 63, w = L.tid >> 6;
    float q[16], kk[16], vv[16], gl[16];
    hg_rows<false>(Pb, c * 128 + 16 * w, h * 64 + k, F.in[14] + l * 4 * 768, ((const float*)(F.ws + WS_LBT))[l * 256 + h * 64 + k], q, kk, vv, gl);
#pragma unroll
    for (int r = 0; r < 16; ++r) Vs[(16 * w + r) * 64 + k] = vv[r];
    SEG[w * 64 + k] = gl[15];
    __syncthreads();
    float off = 0.f, tot = 0.f;
#pragma unroll
    for (int ww = 0; ww < 8; ++ww) { const float s = SEG[ww * 64 + k]; if (ww < w) off += s; tot += s; }
#pragma unroll
    for (int r = 0; r < 16; ++r) Ks[(16 * w + r) * 64 + k] = kk[r] * __expf(tot - off - gl[r]);
    const size_t ui = (size_t)(b * NCH + c) * 4 + h;
    if (w == 0) ((float*)((unsigned char*)outb + OUT_HDK))[ui * 64 + k] = __expf(tot);
    __syncthreads();
    const int v = L.tid & 63, kg = L.tid >> 6; float acc[8] = {0.f, 0.f, 0.f, 0.f, 0.f, 0.f, 0.f, 0.f};
    for (int j = 0; j < 128; ++j) { const float x = Vs[j * 64 + v]; const f32x4 k0 = *(const LAS f32x4*)(Ks + j * 64 + 8 * kg), k1 = *(const LAS f32x4*)(Ks + j * 64 + 8 * kg + 4);
#pragma unroll
        for (int i = 0; i < 4; ++i) { acc[i] += k0[i] * x; acc[4 + i] += k1[i] * x; } }
    float* S = (float*)((unsigned char*)outb + OUT_HST) + ui * 4096;
#pragma unroll
    for (int i = 0; i < 8; ++i) S[(8 * kg + i) * 64 + v] = acc[i];
    __syncthreads();
}
__device__ __forceinline__ void mb_hg(const Loc& L, float* outb) {
    const int gt = L.vcu * NT + L.tid, NGT = L.G * NT;
    for (int e = gt; e < 2 * 4 * 4096; e += NGT) { const int b = e >> 14, h = (e >> 12) & 3, idx = e & 4095;
        float* p = (float*)((unsigned char*)outb + OUT_HST) + (size_t)(b * NCH * 4 + h) * 4096 + idx; const float* dk = (const float*)((unsigned char*)outb + OUT_HDK) + (size_t)(b * NCH * 4 + h) * 64 + (idx >> 6); float s = 0.f;
        for (int c = 0; c < NCH; ++c) { const float loc = p[(size_t)c * 4 * 4096], d = dk[(size_t)c * 4 * 64]; p[(size_t)c * 4 * 4096] = s; s = d * s + loc; } }
}
__device__ __forceinline__ f32x4 ld4(const LAS float* p) { return *(const LAS f32x4*)p; }
__device__ __forceinline__ void mc_hg_unit(Frame& F, const Loc& L, int l, int b, int c, int h, const float* outb) {
    LAS float* Qf = (LAS float*)F.lds; LAS float* Kf = Qf + 128 * HG_LD; LAS float* G = Kf + 128 * HG_LD; LAS bf16* Vt = (LAS bf16*)(G + 128 * HG_LD); LAS bf16* SpT = Vt + 64 * 136; LAS float* SEG = (LAS float*)(F.lds + SEG_OFF);
    static_assert(3 * 128 * HG_LD * 4 + 64 * 136 * 2 + 64 * 72 * 2 <= RING_BYTES, "LDS map (HGRN2 MC)");
    const size_t row0 = (size_t)b * TB + c * 128; const bf16* Pb = (const bf16*)(F.ws + WS_PROJ) + (size_t)b * TB * NIN;
    { const int k = L.tid & 63, w = L.tid >> 6; float q[16], kk[16], vv[16], gl[16];
      hg_rows<true>(Pb, c * 128 + 16 * w, h * 64 + k, F.in[14] + l * 4 * 768, ((const float*)(F.ws + WS_LBT))[l * 256 + h * 64 + k], q, kk, vv, gl);
#pragma unroll
      for (int r = 0; r < 16; ++r) { const int t = 16 * w + r; Qf[t * HG_LD + k] = q[r]; Kf[t * HG_LD + k] = kk[r]; Vt[k * 136 + perm_pos(t)] = f2bf_(vv[r]); }
      SEG[w * 64 + k] = gl[15];
      { const int kr = L.tid >> 3, v8 = (L.tid & 7) * 8; const float* sp = (const float*)((const unsigned char*)outb + OUT_HST) + ((size_t)(b * NCH + c) * 4 + h) * 4096 + kr * 64 + v8; const f32x4 s0 = *(const f32x4*)sp, s1 = *(const f32x4*)(sp + 4);
#pragma unroll
        for (int e = 0; e < 4; ++e) { SpT[(v8 + e) * 72 + kr] = f2bf_(s0[e]); SpT[(v8 + 4 + e) * 72 + kr] = f2bf_(s1[e]); } }
      __syncthreads();
      float off = 0.f;
#pragma unroll
      for (int ww = 0; ww < 8; ++ww) { const float s = SEG[ww * 64 + k]; if (ww < w) off += s; }
#pragma unroll
      for (int r = 0; r < 16; ++r) G[(16 * w + r) * HG_LD + k] = gl[r] + off;
    }
    __syncthreads();
    const int w = L.wave, il = L.lane & 15, g = L.lane >> 4; const f32x4 zero = {0.f, 0.f, 0.f, 0.f};
    f32x4 gr[2][2]; bf16x8 Bq[2], Bqi[2];
#pragma unroll
    for (int ks = 0; ks < 2; ++ks) { const int ko = 32 * ks + 8 * g;
        if (w > 0) { gr[ks][0] = ld4(G + (16 * w - 1) * HG_LD + ko); gr[ks][1] = ld4(G + (16 * w - 1) * HG_LD + ko + 4); } else { gr[ks][0] = zero; gr[ks][1] = zero; }
        const f32x4 q0 = ld4(Qf + (16 * w + il) * HG_LD + ko), q1 = ld4(Qf + (16 * w + il) * HG_LD + ko + 4), g0 = ld4(G + (16 * w + il) * HG_LD + ko), g1 = ld4(G + (16 * w + il) * HG_LD + ko + 4);
        f32x4 a0, a1, b0, b1;
#pragma unroll
        for (int e = 0; e < 4; ++e) { a0[e] = q0[e] * __expf(g0[e] - gr[ks][0][e]); a1[e] = q1[e] * __expf(g1[e] - gr[ks][1][e]); b0[e] = q0[e] * __expf(g0[e]); b1[e] = q1[e] * __expf(g1[e]); }
        Bq[ks] = pack8(a0, a1); Bqi[ks] = pack8(b0, b1); }
    f32x4 O[4] = {zero, zero, zero, zero};
#pragma unroll
    for (int jp = 0; jp < 4; ++jp) if (2 * jp <= w) {
        f32x4 pt[2] = {zero, zero};
#pragma unroll
        for (int hh = 0; hh < 2; ++hh) if (2 * jp + hh <= w) { const int J = 2 * jp + hh;
#pragma unroll
            for (int ks = 0; ks < 2; ++ks) { const int ko = 32 * ks + 8 * g; const f32x4 k0 = ld4(Kf + (16 * J + il) * HG_LD + ko), k1 = ld4(Kf + (16 * J + il) * HG_LD + ko + 4), g0 = ld4(G + (16 * J + il) * HG_LD + ko), g1 = ld4(G + (16 * J + il) * HG_LD + ko + 4);
                f32x4 a0, a1;
#pragma unroll
                for (int e = 0; e < 4; ++e) { a0[e] = k0[e] * __expf(fminf(gr[ks][0][e] - g0[e], 80.0f)); a1[e] = k1[e] * __expf(fminf(gr[ks][1][e] - g1[e], 80.0f)); }
                pt[hh] = mfma16(pack8(a0, a1), Bq[ks], pt[hh]); }
            if (J == w) {
#pragma unroll
                for (int r = 0; r < 4; ++r) if (4 * g + r > il) pt[hh][r] = 0.f; } }
        const bf16x8 Bp = pack8(pt[0], pt[1]);
#pragma unroll
        for (int vt = 0; vt < 4; ++vt) { const bf16x8 A = *(const LAS bf16x8*)(Vt + (16 * vt + il) * 136 + 32 * jp + 8 * g); O[vt] = mfma16(A, Bp, O[vt]); }
    }
#pragma unroll
    for (int vt = 0; vt < 4; ++vt)
#pragma unroll
        for (int ks = 0; ks < 2; ++ks) { const bf16x8 A = *(const LAS bf16x8*)(SpT + (16 * vt + il) * 72 + 32 * ks + 8 * g); O[vt] = mfma16(A, Bqi[ks], O[vt]); }
    float s2 = 0.f;
#pragma unroll
    for (int vt = 0; vt < 4; ++vt) s2 += (O[vt][0] * O[vt][0] + O[vt][1] * O[vt][1]) + (O[vt][2] * O[vt][2] + O[vt][3] * O[vt][3]);
    s2 += __shfl_xor(s2, 16); s2 += __shfl_xor(s2, 32); const float rstd = rsqrtf(s2 * (1.0f / 64.0f) + EPS);
    const size_t row = row0 + 16 * w + il; const bf16* gp = (const bf16*)(F.ws + WS_PROJ) + row * NIN + C_HG + h * 64; bf16* mo = (bf16*)(F.ws + WS_MIXED) + row * D + 256 + h * 64; const float* og = F.in[16] + l * 256 + h * 64;
#pragma unroll
    for (int vt = 0; vt < 4; ++vt) { const int v0 = 16 * vt + 4 * g; const unsigned long long gg = *(const GAS unsigned long long*)(gp + v0); const f32x4 o4 = *(const f32x4*)(og + v0); float y[4];
#pragma unroll
        for (int r = 0; r < 4; ++r) y[r] = O[vt][r] * rstd * o4[r] * silu_f(bf2f((bf16)(gg >> (16 * r))));
        *(GAS unsigned long long*)(mo + v0) = (unsigned long long)cvtpk(y[0], y[1]) | ((unsigned long long)cvtpk(y[2], y[3]) << 32); }
    __syncthreads();
}
constexpr int S5_WREG = 14592, BU_LD = 20, XS_LD = 136, GY_LD = 264;
static_assert(8 * S5_WREG <= RING_BYTES && 128 * GY_LD * 2 + 4096 + 512 <= RING_BYTES, "LDS map (S5)");
template <bool FULL> __device__ __forceinline__ void s5_group(Frame& F, const Loc& L, int l, int gidx, const bf16* Pc  , float& xr, float& xi, unsigned (&gy)[8][2]) {
    LAS float* BUt = (LAS float*)(F.lds + L.wave * S5_WREG); LAS bf16* Xs = (LAS bf16*)(F.lds + L.wave * S5_WREG + 128 * BU_LD * 4);
    const int il = L.lane & 15, g4 = L.lane >> 4, lg = l * 16 + gidx; const f32x4 zero = {0.f, 0.f, 0.f, 0.f}; const bf16x8 bz = {0, 0, 0, 0, 0, 0, 0, 0};
    bf16x8 Bb[8];
#pragma unroll
    for (int ct = 0; ct < 8; ++ct) Bb[ct] = g4 < 2 ? *(const bf16x8*)((const bf16*)(F.ws + WS_BBT) + ((size_t)lg * 128 + 16 * ct + il) * 16 + 8 * g4) : bz;
    bf16x8 Cb[4], Db = bz;
    if (FULL) {
#pragma unroll
        for (int ks = 0; ks < 4; ++ks) Cb[ks] = *(const bf16x8*)((const bf16*)(F.ws + WS_CCT) + ((size_t)lg * 16 + il) * 128 + 32 * ks + 8 * g4);
        const short dsk = (short)f2bf_(F.in[10][lg * 16 + il]);
#pragma unroll
        for (int jj = 0; jj < 8; ++jj) Db[jj] = (8 * g4 + jj == il) ? dsk : (short)0; }
    const float* LB = (const float*)(F.ws + WS_LB) + (size_t)(lg * 64 + L.lane) * 2; const float lr = LB[0], li = LB[1];
    const unsigned avoff = (unsigned)(il * NIN + C_U + 16 * gidx + 8 * g4) * 2u;
#pragma unroll
    for (int s = 0; s < 8; ++s) {
        const bf16x8 A = g4 < 2 ? *(const bf16x8*)((const char*)(Pc + (size_t)16 * s * NIN) + avoff) : bz;
#pragma unroll
        for (int ct = 0; ct < 8; ++ct) { const f32x4 d = mfma16(A, Bb[ct], zero); *(LAS f32x4*)(BUt + (16 * ct + il) * BU_LD + 4 * g4) = d; }
#pragma unroll
        for (int q = 0; q < 4; ++q) { const f32x4 br = *(const LAS f32x4*)(BUt + L.lane * BU_LD + 4 * q), bi = *(const LAS f32x4*)(BUt + (64 + L.lane) * BU_LD + 4 * q);
#pragma unroll
            for (int e = 0; e < 4; ++e) { const float nr = lr * xr - li * xi + br[e], ni = lr * xi + li * xr + bi[e]; xr = nr; xi = ni;
                if (FULL) { Xs[(4 * q + e) * XS_LD + L.lane] = f2bf_(xr); Xs[(4 * q + e) * XS_LD + 64 + L.lane] = f2bf_(xi); } } }
        if (FULL) { f32x4 y = mfma16(A, Db, zero);
#pragma unroll
            for (int ks = 0; ks < 4; ++ks) { const bf16x8 Ax = *(const LAS bf16x8*)(Xs + il * XS_LD + 32 * ks + 8 * g4); y = mfma16(Ax, Cb[ks], y); }
            gy[s][0] = cvtpk(gelu_tanh(y[0]), gelu_tanh(y[1])); gy[s][1] = cvtpk(gelu_tanh(y[2]), gelu_tanh(y[3])); }
        asm volatile("" : "+v"(xr), "+v"(xi) :: "memory");
    }
}
__device__ __forceinline__ void ma_s5_unit(Frame& F, const Loc& L, int l, int b, int c, float* outb) {
    const bf16* Pc = (const bf16*)(F.ws + WS_PROJ) + ((size_t)b * TB + c * 128) * NIN; unsigned gy[8][2];
#pragma unroll
    for (int gi = 0; gi < 2; ++gi) { const int gidx = 2 * L.wave + gi; float xr = 0.f, xi = 0.f; s5_group<false>(F, L, l, gidx, Pc, xr, xi, gy);
        float* xo = (float*)((unsigned char*)outb + OUT_S5X) + (((size_t)(b * NCH + c) * 16 + gidx) * 64 + L.lane) * 2; xo[0] = xr; xo[1] = xi; }
    __syncthreads();
}
__device__ __forceinline__ void mb_s5(Frame& F, const Loc& L, int l, float* outb) {
    const int gt = L.vcu * NT + L.tid, NGT = L.G * NT;
    for (int e = gt; e < 2 * 16 * 64; e += NGT) { const int b = e >> 10, gp = e & 1023; const float* lb = (const float*)(F.ws + WS_LB128) + (size_t)(l * 1024 + gp) * 2; const float dr = lb[0], di = lb[1];
        float* p = (float*)((unsigned char*)outb + OUT_S5X) + ((size_t)b * NCH * 1024 + gp) * 2; float sr = 0.f, si = 0.f;
        for (int c = 0; c < NCH; ++c) { const float a = p[(size_t)c * 2048], bb = p[(size_t)c * 2048 + 1]; p[(size_t)c * 2048] = sr; p[(size_t)c * 2048 + 1] = si; const float nr = dr * sr - di * si + a, ni = dr * si + di * sr + bb; sr = nr; si = ni; } }
}
__device__ __forceinline__ void mc_s5_unit(Frame& F, const Loc& L, int l, int b, int c, const float* outb) {
    const size_t row0 = (size_t)b * TB + c * 128; const bf16* Pc = (const bf16*)(F.ws + WS_PROJ) + row0 * NIN;
    const int il = L.lane & 15, g4 = L.lane >> 4, w = L.wave;
    unsigned gy[2][8][2];
#pragma unroll
    for (int gi = 0; gi < 2; ++gi) { const int gidx = 2 * w + gi; const float* xo = (const float*)((const unsigned char*)outb + OUT_S5X) + (((size_t)(b * NCH + c) * 16 + gidx) * 64 + L.lane) * 2; float xr = xo[0], xi = xo[1];
        s5_group<true>(F, L, l, gidx, Pc, xr, xi, gy[gi]); }
    __syncthreads();
    LAS bf16* GYs = (LAS bf16*)F.lds; LAS float* RED = (LAS float*)(F.lds + 128 * GY_LD * 2); LAS float* RSTD = RED + 1024;
#pragma unroll
    for (int gi = 0; gi < 2; ++gi)
#pragma unroll
        for (int s = 0; s < 8; ++s)
#pragma unroll
            for (int r = 0; r < 4; ++r) GYs[(16 * s + 4 * g4 + r) * GY_LD + 16 * (2 * w + gi) + il] = (bf16)(gy[gi][s][r >> 1] >> (16 * (r & 1)));
    __syncthreads();
    const f32x4 zero = {0.f, 0.f, 0.f, 0.f}; f32x4 acc[8][2];
#pragma unroll
    for (int tt = 0; tt < 8; ++tt) { acc[tt][0] = zero; acc[tt][1] = zero; }
    const bf16* WG = (const bf16*)(F.ws + WS_WGT) + (size_t)l * 65536;
#pragma unroll
    for (int ks = 0; ks < 8; ++ks) { const bf16x8 W0 = *(const bf16x8*)(WG + (size_t)(32 * w + il) * 256 + 32 * ks + 8 * g4), W1 = *(const bf16x8*)(WG + (size_t)(32 * w + 16 + il) * 256 + 32 * ks + 8 * g4);
#pragma unroll
        for (int tt = 0; tt < 8; ++tt) { const bf16x8 Ag = *(const LAS bf16x8*)(GYs + (16 * tt + il) * GY_LD + 32 * ks + 8 * g4); acc[tt][0] = mfma16(W0, Ag, acc[tt][0]); acc[tt][1] = mfma16(W1, Ag, acc[tt][1]); }
        asm volatile("" ::: "memory"); }
#pragma unroll
    for (int tt = 0; tt < 8; ++tt) { float ss = 0.f;
#pragma unroll
        for (int nt = 0; nt < 2; ++nt) { const unsigned long long gq = *(const LAS unsigned long long*)(GYs + (16 * tt + il) * GY_LD + 32 * w + 16 * nt + 4 * g4);
#pragma unroll
            for (int r = 0; r < 4; ++r) { const float v = bf2f((bf16)(gq >> (16 * r))) * sigmoid_f(acc[tt][nt][r]); acc[tt][nt][r] = v; ss += v * v; } }
        ss += __shfl_xor(ss, 16); ss += __shfl_xor(ss, 32); if (g4 == 0) RED[(16 * tt + il) * 8 + w] = ss; }
    __syncthreads();
    if (L.tid < 128) { const f32x4 a = *(const LAS f32x4*)(RED + L.tid * 8), bq = *(const LAS f32x4*)(RED + L.tid * 8 + 4); RSTD[L.tid] = rsqrtf((((a[0] + a[1]) + (a[2] + a[3])) + ((bq[0] + bq[1]) + (bq[2] + bq[3]))) * (1.0f / 256.0f) + EPS); }
    __syncthreads();
    const float* og = F.in[13] + l * 256; bf16* MX = (bf16*)(F.ws + WS_MIXED) + row0 * D;
#pragma unroll
    for (int tt = 0; tt < 8; ++tt) { const float rs = RSTD[16 * tt + il];
#pragma unroll
        for (int nt = 0; nt < 2; ++nt) { const int n0 = 32 * w + 16 * nt + 4 * g4; const f32x4 o4 = *(const f32x4*)(og + n0);
            *(GAS unsigned long long*)((char*)(MX + (size_t)16 * tt * D) + (unsigned)(il * D + n0) * 2u) = (unsigned long long)cvtpk(acc[tt][nt][0] * rs * o4[0], acc[tt][nt][1] * rs * o4[1]) | ((unsigned long long)cvtpk(acc[tt][nt][2] * rs * o4[2], acc[tt][nt][3] * rs * o4[3]) << 32); } }
    __syncthreads();
}
__device__ __forceinline__ void p_ma(Frame& F, int l, float* outb) {
    { const Loc L = make_loc(); for (int u = L.bx; u < 130; u += L.G) ma_s5_unit(F, L, l, u / NCH, u % NCH, outb); }
    { const Loc L = make_loc(); for (int u = (L.bx + 126) % L.G; u < 520; u += L.G) ma_hg_unit(F, L, l, u / 260, (u % 260) >> 2, u & 3, outb); }
    { const Loc L = make_loc(); for (int u = (L.bx + 126) % L.G; u < 1040; u += L.G) ma_ret_unit(F, L, u / 520, (u % 520) >> 3, u & 7, outb); }
}
__device__ __forceinline__ void p_mb(Frame& F, int l, float* outb) { const Loc L = make_loc(); mb_ret(L, outb); mb_hg(L, outb); mb_s5(F, L, l, outb); }
__device__ __forceinline__ void p_mc(Frame& F, int l, const float* outb) {
    { const Loc L = make_loc(); for (int u = L.bx; u < 130; u += L.G) mc_s5_unit(F, L, l, u / NCH, u % NCH, outb); }
    { const Loc L = make_loc(); for (int u = (L.bx + 126) % L.G; u < 520; u += L.G) mc_hg_unit(F, L, l, u / 260, (u % 260) >> 2, u & 3, outb); }
    { const Loc L = make_loc(); for (int u = (L.bx + 126) % L.G; u < 1040; u += L.G) mc_ret_unit(F, L, l, u / 520, (u % 520) >> 3, u & 7, outb); }
}
__device__ __forceinline__ void p_s5_glu(Frame& F, int l) {
    const Loc L = make_loc();
    LAS float* gs = (LAS float*)F.lds; LAS float* red = gs + 64 * 256;
    const float* Y = (const float*)(F.ws + WS_YS5); bf16* MX = (bf16*)(F.ws + WS_MIXED); const float* wg = F.in[12] + (size_t)l * 65536; const float* og = F.in[13] + l * 256;
    const int tid = L.tid, c = tid & 255, rh = tid >> 8;
    for (int unit = L.bx; unit < M / 64; unit += L.G) { const int row0 = unit * 64;
        for (int it = tid; it < 64 * 256; it += NT) gs[it] = gelu_tanh(Y[(size_t)row0 * 256 + it]);
        __syncthreads();
        float acc[32];
#pragma unroll
        for (int r = 0; r < 32; ++r) acc[r] = 0.f;
        for (int k4 = 0; k4 < 256; k4 += 4) { const float w0 = wg[(k4 + 0) * 256 + c], w1 = wg[(k4 + 1) * 256 + c], w2 = wg[(k4 + 2) * 256 + c], w3 = wg[(k4 + 3) * 256 + c];
#pragma unroll
            for (int r = 0; r < 32; ++r) { const f32x4 gv = *(const LAS f32x4*)(gs + (rh * 32 + r) * 256 + k4); acc[r] += (gv.x * w0 + gv.y * w1) + (gv.z * w2 + gv.w * w3); } }
#pragma unroll
        for (int r = 0; r < 32; ++r) { acc[r] = gs[(rh * 32 + r) * 256 + c] * sigmoid_f(acc[r]); const float s = wave_sum(acc[r] * acc[r]); if (L.lane == 0) red[(rh * 32 + r) * 4 + (L.wave & 3)] = s; }
        __syncthreads();
#pragma unroll
        for (int r = 0; r < 32; ++r) { const LAS float* rp = red + (rh * 32 + r) * 4; const float tot = (rp[0] + rp[1]) + (rp[2] + rp[3]);
            MX[(size_t)(row0 + rh * 32 + r) * D + c] = f2bf_(acc[r] * rsqrtf(tot * (1.0f / 256.0f) + EPS) * og[c]); }
        __syncthreads();
    }
}
__device__ __forceinline__ void p_route(Frame& F) {
    const Loc L = make_loc();
    const int gw = L.vcu * NWAVES + L.wave, NGW = L.G * NWAVES;
    const float* H = (const float*)(F.ws + WS_H); float* GT = (float*)(F.ws + WS_GT); const float* gff = F.in[19] + D; const float* R = F.in[23];
    for (int m = gw; m < M; m += NGW) {
        float ss = 0.f, part[8];
#pragma unroll
        for (int e = 0; e < 8; ++e) part[e] = 0.f;
#pragma unroll
        for (int j = 0; j < 4; ++j) { const f32x4 v = ((const GAS f32x4*)(H + (size_t)m * D))[L.lane + 64 * j]; const int d0 = 4 * L.lane + 256 * j;
            ss += (v.x * v.x + v.y * v.y) + (v.z * v.z + v.w * v.w);
#pragma unroll
            for (int q = 0; q < 4; ++q) { const float hv = v[q] * gff[d0 + q]; const f32x4 r0 = *(const f32x4*)(R + (d0 + q) * 8), r1 = *(const f32x4*)(R + (d0 + q) * 8 + 4);
                part[0] += hv * r0.x; part[1] += hv * r0.y; part[2] += hv * r0.z; part[3] += hv * r0.w; part[4] += hv * r1.x; part[5] += hv * r1.y; part[6] += hv * r1.z; part[7] += hv * r1.w; } }
        const float rstd = rsqrtf(wave_sum(ss) * (1.0f / 1024.0f) + EPS); float lg[8];
#pragma unroll
        for (int e = 0; e < 8; ++e) lg[e] = wave_sum(part[e]) * rstd;
        int i1 = 0; float l1 = lg[0];
#pragma unroll
        for (int e = 1; e < 8; ++e) if (lg[e] > l1) { l1 = lg[e]; i1 = e; }
        int i2 = -1; float l2 = -3.0e38f;
#pragma unroll
        for (int e = 0; e < 8; ++e) if (e != i1 && lg[e] > l2) { l2 = lg[e]; i2 = e; }
        const float e2 = __expf(l2 - l1), g1 = 1.0f / (1.0f + e2), g2 = e2 * g1;
        if (L.lane < 8) GT[(size_t)m * 8 + L.lane] = (L.lane == i1) ? g1 : ((L.lane == i2) ? g2 : 0.0f);
    }
}
__device__ __forceinline__ void p_final(Frame& F, float* out) {
    const Loc L = make_loc();
    const int gw = L.vcu * NWAVES + L.wave, NGW = L.G * NWAVES; const float* H = (const float*)(F.ws + WS_H); const float* gf = F.in[27];
    for (int r = gw; r < BATCH * SEQ; r += NGW) { const int b = r / SEQ, t = r % SEQ; const size_t m = (size_t)b * TB + 128 + t;
        f32x4 v[4]; float s = 0.f;
#pragma unroll
        for (int j = 0; j < 4; ++j) { v[j] = ((const GAS f32x4*)(H + m * D))[L.lane + 64 * j]; s += (v[j].x * v[j].x + v[j].y * v[j].y) + (v[j].z * v[j].z + v[j].w * v[j].w); }
        const float rstd = rsqrtf(wave_sum(s) * (1.0f / 1024.0f) + EPS);
#pragma unroll
        for (int j = 0; j < 4; ++j) { const f32x4 g = ((const GAS f32x4*)gf)[L.lane + 64 * j]; ((GAS f32x4*)(out + (size_t)r * D))[L.lane + 64 * j] = v[j] * rstd * g; }
    }
}

struct Args { const float* in[28]; float* out; unsigned char* ws; int ph_lo, ph_hi, li, pad; };
__global__ void __launch_bounds__(NWAVES * 64, 2) mk_fwd(Args args) {
    extern __shared__ __attribute__((aligned(16))) unsigned char lds[];
    Frame F;
    F.lds = (LAS unsigned char*)lds; F.MISC = (volatile LAS unsigned*)(F.lds + MISC_OFF);
    F.ws = args.ws; F.ctl = (gu32*)(args.ws + WS_CTL); F.in = args.in;
    for (int u = threadIdx.x; u < (LDS_BYTES - LDSCTL_OFF) / 4; u += NWAVES * 64) ((LAS unsigned*)(F.lds + LDSCTL_OFF))[u] = 0u;
    __syncthreads();
    XcdBarrier bar; bar.bar = (unsigned*)(F.ctl + CW_BAR); bar.x = 0; bar.st = nullptr;
    if (!MK_PER_PHASE) bar = xcd_barrier_post((unsigned*)(F.ctl + CW_BAR), F.MISC + 8);
    const int lo = args.ph_lo, hi = args.ph_hi;
#define IN(k) (lo <= (k) && (k) < hi)
#define SEAM(k) do { if (!MK_PER_PHASE && (k) + 1 < hi) xcd_barrier(bar); } while (0)
    unsigned char* ws = args.ws;
    float* SS = (float*)(ws + WS_SSP);
    if (IN(0)) { p0_prologue(F); SEAM(0); }
    for (int l = 0; l < 2; ++l) {
        const int base = 1 + 30 * l;
        if (IN(base + 0)) {
            pg8::Gemm g{(const bf16*)(ws + WS_HB), (const bf16*)(ws + WS_WIN) + (size_t)l * NIN * D, M, NIN, D}; pg8::StaticOrder S; const Loc L = make_loc(); S.init(M, NIN, L.G, L.bx);
            pg8::EpiProj E{(bf16*)(ws + WS_PROJ), NIN, SS + (size_t)(2 * l) * M * 16};
            pg8::gemm_phase<pg8::EpiProj, pg8::StaticOrder, true, true>(F.lds + RING_OFF, g, S, E);
            SEAM(base + 0);
        }
        if (IN(base + 1)) { p_ma(F, l, args.out); SEAM(base + 1); }
        if (IN(base + 2)) { p_mb(F, l, args.out); SEAM(base + 2); }
        if (IN(base + 3)) { p_mc(F, l, args.out); SEAM(base + 3); }
        if (IN(base + 6)) {
            pg8::Gemm g{(const bf16*)(ws + WS_MIXED), (const bf16*)(ws + WS_WOUT) + (size_t)l * D * D, M, D, D}; pg8::StaticOrder S; const Loc L = make_loc(); S.init(M, D, L.G, L.bx);
            pg8::EpiResid E{(float*)(ws + WS_H), (bf16*)(ws + WS_HB), SS + (size_t)(2 * l + 1) * M * 16, nullptr, 0, 1};
            pg8::gemm_phase<pg8::EpiResid, pg8::StaticOrder, true, true>(F.lds + RING_OFF, g, S, E);
            SEAM(base + 6);
        }
        if (l == 1 && IN(base + 7)) { p_route(F); SEAM(base + 7); }
        const int ne = l == 0 ? 1 : NEXP, nff = l == 0 ? DFF : DFE;
        for (int e = 0; e < ne; ++e) {
            if (IN(base + 8 + 2 * e)) {
                const bf16* W13 = l == 0 ? (const bf16*)(ws + WS_WF13) : (const bf16*)(ws + WS_WM13) + (size_t)e * 2 * DFE * D;
                pg8::Gemm g{(const bf16*)(ws + WS_HB), W13, M, 2 * nff, D}; pg8::StaticOrder S; const Loc L = make_loc(); S.init(M, 2 * nff, L.G, L.bx);
                pg8::EpiSwiglu E{(bf16*)(ws + WS_ACT), nff, SS + (size_t)(2 * l + 1) * M * 16};
                pg8::gemm_phase<pg8::EpiSwiglu, pg8::StaticOrder, true, true>(F.lds + RING_OFF, g, S, E);
                SEAM(base + 8 + 2 * e);
            }
            if (IN(base + 9 + 2 * e)) {
                const bf16* W2 = l == 0 ? (const bf16*)(ws + WS_WF2) : (const bf16*)(ws + WS_WM2) + (size_t)e * D * DFE;
                pg8::Gemm g{(const bf16*)(ws + WS_ACT), W2, M, D, nff}; pg8::StaticOrder S; const Loc L = make_loc(); S.init(M, D, L.G, L.bx);
                pg8::EpiResid E{(float*)(ws + WS_H), (bf16*)(ws + WS_HB), SS + (size_t)(2 * l + 2) * M * 16, l == 0 ? nullptr : (const float*)(ws + WS_GT) + e, 8, e == ne - 1 ? 1 : 0};
                pg8::gemm_phase<pg8::EpiResid, pg8::StaticOrder, true, true>(F.lds + RING_OFF, g, S, E);
                SEAM(base + 9 + 2 * e);
            }
        }
    }
    if (IN(NPH - 1)) p_final(F, args.out);
#undef IN
#undef SEAM
}

extern "C" void kernel_launch(void* const* d_in, const int* in_sizes, int n_in, void* d_out, int out_size, void* d_ws, size_t ws_size, hipStream_t stream) {
    static int grid = 0;
    if (grid == 0) {
        if (n_in != 28 || out_size != BATCH * SEQ * D || ws_size < WS_END) { fprintf(stderr, "kernel_launch: unexpected shapes: n_in %d out %d ws %zu (need %zu)\n", n_in, out_size, ws_size, (size_t)WS_END); grid = -1; return; }
        int dev = 0, cus = 0, per_cu = 0;
        if (hipGetDevice(&dev) != hipSuccess || hipDeviceGetAttribute(&cus, hipDeviceAttributeMultiprocessorCount, dev) != hipSuccess) { grid = -1; return; }
        if (hipFuncSetAttribute((const void*)mk_fwd, hipFuncAttributeMaxDynamicSharedMemorySize, LDS_BYTES) != hipSuccess) { fprintf(stderr, "kernel_launch: hipFuncSetAttribute failed\n"); grid = -1; return; }
        if (hipOccupancyMaxActiveBlocksPerMultiprocessor(&per_cu, (const void*)mk_fwd, NWAVES * 64, LDS_BYTES) != hipSuccess || per_cu < 1) { fprintf(stderr, "kernel_launch: occupancy query says %d\n", per_cu); }
        (void)hipGetLastError();
        grid = cus;
    }
    if (grid < 0) return;
    if (hipMemsetAsync((char*)d_ws + WS_CTL, 0, CTL_ZERO_BYTES, stream) != hipSuccess) return;
    Args a{};
    for (int i = 0; i < 28; ++i) a.in[i] = (const float*)d_in[i];
    a.out = (float*)d_out; a.ws = (unsigned char*)d_ws;
#if MK_PER_PHASE
    for (int k = 0; k < NPH; ++k) { if (!phase_exists(k)) continue; a.ph_lo = k; a.ph_hi = k + 1; a.li = 0; hipLaunchKernelGGL(mk_fwd, dim3(grid), dim3(NWAVES * 64), LDS_BYTES, stream, a); }
#else
    a.ph_lo = 0; a.ph_hi = NPH; a.li = 0;
    hipLaunchKernelGGL(mk_fwd, dim3(grid), dim3(NWAVES * 64), LDS_BYTES, stream, a);
#endif
}
```

```cpp
#include <hip/hip_runtime.h>
#include <cstdio>
#include <cstdint>
#include <cmath>
namespace pg8 {
#define PG8_LAS __attribute__((address_space(3)))
typedef unsigned short bf16_t;
typedef short bf16x8 __attribute__((ext_vector_type(8)));
typedef float f32x4 __attribute__((ext_vector_type(4)));
typedef unsigned u32x4 __attribute__((ext_vector_type(4)));
constexpr int BM = 256, BK = 64, HALF = 128, HTB = HALF * BK * 2  , STAGE_BYTES = 8 * HTB, NXCD = 8, WGM = 8;

__host__ __device__ __forceinline__ int lds_byte(int r, int c) { const int st = (r >> 4) * 2 + (c >> 5), rr = r & 15, cc = c & 31, ob = rr * 64 + cc * 2; return st * 1024 + (ob ^ (((ob >> 9) & 1) << 5)); }
__host__ __device__ __forceinline__ void stage_rc(int b, int& R, int& C) { const int st = b / 1024, sb = b % 1024, swz = sb ^ (((sb >> 9) & 1) << 5); R = (st >> 1) * 16 + swz / 64; C = (st & 1) * 32 + (swz % 64) / 2; }
__host__ __device__ __forceinline__ int perm32(int rho) { const int n = rho >> 4, i = rho & 15; return 8 * (i >> 2) + 4 * n + (i & 3); }

struct Unit { int pm, pn, e, r0, ce; };
struct Gemm { const bf16_t* A; const bf16_t* Bt; int M, N, K; };

struct StaticOrder {
    static constexpr bool GATHER = false;
    int nM, nN, nwg, G, c;
    __host__ __device__ void init(int M, int N, int G_, int c_) { nM = M / BM; nN = N / BM; nwg = nM * nN; G = G_; c = c_; }
    __host__ __device__ bool next(int i, Unit& u) const {
        const long L = (long)i * G + c; if (L >= nwg) return false;
        int wgid = (int)L; { const int q = nwg / NXCD, r = nwg % NXCD, xcd = wgid % NXCD, off = wgid / NXCD; wgid = (xcd < r ? xcd * (q + 1) : r * (q + 1) + (xcd - r) * q) + off; }
        const int nig = WGM * nN, gid = wgid / nig, fm = gid * WGM, gsz = (nM - fm) < WGM ? (nM - fm) : WGM;
        u.pm = fm + ((wgid % nig) % gsz); u.pn = (wgid % nig) / gsz; return true;
    }
    __device__ __forceinline__ void a_ready(const Unit&) const {}
    __device__ __forceinline__ void done(const Unit&) const {}
    __device__ __forceinline__ int arow(const Unit&, int) const { return 0; }
};

__device__ __forceinline__ unsigned cvt_pk_bf16(float lo, float hi) { unsigned r; asm volatile("v_cvt_pk_bf16_f32 %0, %1, %2" : "=v"(r) : "v"(lo), "v"(hi)); return r; }
typedef float f32x2 __attribute__((ext_vector_type(2)));
constexpr float RMS_EPS = 1e-6f;
__device__ __forceinline__ float fast_silu(float a) { return a * __builtin_amdgcn_rcpf(1.0f + __expf(-a)); }
__device__ __forceinline__ float row_rstd(const float* ss, int row) { const f32x4* p = (const f32x4*)(ss + (size_t)row * 16); const f32x4 a = p[0], b = p[1], c = p[2], d = p[3];
    const float t = (((a[0] + a[1]) + (a[2] + a[3])) + ((b[0] + b[1]) + (b[2] + b[3]))) + (((c[0] + c[1]) + (c[2] + c[3])) + ((d[0] + d[1]) + (d[2] + d[3])));
    return __builtin_amdgcn_rsqf(t * (1.0f / 1024.0f) + RMS_EPS); }
struct EpiProj {
    static constexpr bool PERM = true, AFTER_DRAIN = false;
    bf16_t* O; int ldc; const float* ss;
    __device__ __forceinline__ void operator()(const f32x4 (&acc)[2][2][4][2], const Unit& u, int wr, int wc, int fr, int fq) const {
        const int row0 = u.pm * BM + wr * 64 + fr, col0 = u.pn * BM + wc * 32 + 8 * fq;
#pragma unroll
        for (int ai = 0; ai < 2; ++ai)
#pragma unroll
            for (int m = 0; m < 4; ++m) { const int row = row0 + ai * HALF + m * 16; const float sc = row_rstd(ss, row);
                bf16_t* rowp = O + (size_t)row * ldc + col0;
#pragma unroll
                for (int bj = 0; bj < 2; ++bj) { const f32x4 v0 = acc[ai][bj][m][0] * sc, v1 = acc[ai][bj][m][1] * sc;
                    u32x4 w; w.x = cvt_pk_bf16(v0[0], v0[1]); w.y = cvt_pk_bf16(v0[2], v0[3]); w.z = cvt_pk_bf16(v1[0], v1[1]); w.w = cvt_pk_bf16(v1[2], v1[3]);
                    *(u32x4*)(rowp + bj * HALF) = w; } }
    }
};
struct EpiSwiglu {
    static constexpr bool PERM = true, AFTER_DRAIN = false;
    bf16_t* O; int ldc; const float* ss;
    __device__ __forceinline__ void operator()(const f32x4 (&acc)[2][2][4][2], const Unit& u, int wr, int wc, int fr, int fq) const {
        const int row0 = u.pm * BM + wr * 64 + fr, col0 = u.pn * HALF + wc * 32 + 8 * fq;
#pragma unroll
        for (int ai = 0; ai < 2; ++ai)
#pragma unroll
            for (int m = 0; m < 4; ++m) { const int row = row0 + ai * HALF + m * 16; const float sc = row_rstd(ss, row);
                const f32x4 a0 = acc[ai][0][m][0] * sc, a1 = acc[ai][0][m][1] * sc, b0 = acc[ai][1][m][0] * sc, b1 = acc[ai][1][m][1] * sc;
                u32x4 w; w.x = cvt_pk_bf16(fast_silu(a0[0]) * b0[0], fast_silu(a0[1]) * b0[1]); w.y = cvt_pk_bf16(fast_silu(a0[2]) * b0[2], fast_silu(a0[3]) * b0[3]);
                w.z = cvt_pk_bf16(fast_silu(a1[0]) * b1[0], fast_silu(a1[1]) * b1[1]); w.w = cvt_pk_bf16(fast_silu(a1[2]) * b1[2], fast_silu(a1[3]) * b1[3]);
                *(u32x4*)(O + (size_t)row * ldc + col0) = w; }
    }
};
struct EpiResid {
    static constexpr bool PERM = false, AFTER_DRAIN = false;
    float* H; bf16_t* HB; float* ssout; const float* gate; int gstride; int write_hb;
    __device__ __forceinline__ void operator()(const f32x4 (&acc)[2][2][4][2], const Unit& u, int wr, int wc, int fr, int fq) const {
        const int row0 = u.pm * BM + wr * 64 + fr, col0 = u.pn * BM + wc * 32 + 4 * fq;
#pragma unroll
        for (int ai = 0; ai < 2; ++ai)
#pragma unroll
            for (int m = 0; m < 4; ++m) { const int row = row0 + ai * HALF + m * 16; const float g = gate ? gate[(size_t)row * gstride] : 1.0f;
                float* hp = H + (size_t)row * 1024 + col0; float s = 0.f;
#pragma unroll
                for (int bj = 0; bj < 2; ++bj)
#pragma unroll
                    for (int n = 0; n < 2; ++n) { float* p = hp + bj * HALF + n * 16; const f32x4 o = *(const f32x4*)p + acc[ai][bj][m][n] * g; *(f32x4*)p = o;
                        s += (o[0] * o[0] + o[1] * o[1]) + (o[2] * o[2] + o[3] * o[3]);
                        if (write_hb) { unsigned long long w = (unsigned long long)cvt_pk_bf16(o[0], o[1]) | ((unsigned long long)cvt_pk_bf16(o[2], o[3]) << 32);
                            *(unsigned long long*)(HB + (size_t)row * 1024 + col0 + bj * HALF + n * 16) = w; } }
                if (write_hb) { s += __shfl_xor(s, 16); s += __shfl_xor(s, 32); if (fq == 0) ssout[(size_t)row * 16 + u.pn * 4 + wc] = s; } }
    }
};

template <bool GATH> struct MoeOrder {
    static constexpr bool GATHER = GATH;
    int nNe, nT, nwg, G, c, cap; const int* list; const int* cnt; const PG8_LAS int* tbl;
    __device__ __forceinline__ void init(const int* cnt_, const int* list_, int cap_, int nNe_, int G_, int c_, const PG8_LAS int* tbl_) { list = list_; cnt = cnt_; tbl = tbl_; cap = cap_; nNe = nNe_; G = G_; c = c_; nT = tbl_[8]; nwg = nT * nNe; }
    __device__ __forceinline__ bool next(int i, Unit& u) const {
        const long L = (long)i * G + c; if (L >= nwg) return false;
        int wgid = (int)L; { const int q = nwg / NXCD, r = nwg % NXCD, xcd = wgid % NXCD, off = wgid / NXCD; wgid = (xcd < r ? xcd * (q + 1) : r * (q + 1) + (xcd - r) * q) + off; }
        const int nig = WGM * nNe, gid = wgid / nig, fm = gid * WGM, gsz = (nT - fm) < WGM ? (nT - fm) : WGM;
        const int t = fm + ((wgid % nig) % gsz), pnl = (wgid % nig) / gsz;
        int e = 0;
#pragma unroll
        for (int k = 1; k < 8; ++k) e += (t >= tbl[k]) ? 1 : 0;
        e = __builtin_amdgcn_readfirstlane(e);
        u.pm = t; u.pn = e * nNe + pnl; u.e = e; u.r0 = (t - __builtin_amdgcn_readfirstlane(tbl[e])) * BM; u.ce = cnt[e]; return true;
    }
    __device__ __forceinline__ int arow(const Unit& u, int R) const { const int pos = u.r0 + R; return pos < u.ce ? list[(size_t)u.e * cap + pos] : 0; }
    __device__ __forceinline__ void a_ready(const Unit&) const {}
    __device__ __forceinline__ void done(const Unit&) const {}
};
struct EpiSwigluMoe {
    static constexpr bool PERM = true, AFTER_DRAIN = false;
    bf16_t* O; int ldc; const float* ss; const int* list; int cap, nNe;
    __device__ __forceinline__ void operator()(const f32x4 (&acc)[2][2][4][2], const Unit& u, int wr, int wc, int fr, int fq) const {
        const int r0 = wr * 64 + fr, col0 = (u.pn - u.e * nNe) * HALF + wc * 32 + 8 * fq;
#pragma unroll
        for (int ai = 0; ai < 2; ++ai)
#pragma unroll
            for (int m = 0; m < 4; ++m) { const int R = r0 + ai * HALF + m * 16, pos = u.r0 + R; const int tok = pos < u.ce ? list[(size_t)u.e * cap + pos] : 0; const float sc = row_rstd(ss, tok);
                const f32x4 a0 = acc[ai][0][m][0] * sc, a1 = acc[ai][0][m][1] * sc, b0 = acc[ai][1][m][0] * sc, b1 = acc[ai][1][m][1] * sc;
                u32x4 w; w.x = cvt_pk_bf16(fast_silu(a0[0]) * b0[0], fast_silu(a0[1]) * b0[1]); w.y = cvt_pk_bf16(fast_silu(a0[2]) * b0[2], fast_silu(a0[3]) * b0[3]);
                w.z = cvt_pk_bf16(fast_silu(a1[0]) * b1[0], fast_silu(a1[1]) * b1[1]); w.w = cvt_pk_bf16(fast_silu(a1[2]) * b1[2], fast_silu(a1[3]) * b1[3]);
                *(u32x4*)(O + (size_t)(u.pm * BM + R) * ldc + col0) = w; }
    }
};
struct EpiYs {
    static constexpr bool PERM = true, AFTER_DRAIN = false;
    bf16_t* O;
    __device__ __forceinline__ void operator()(const f32x4 (&acc)[2][2][4][2], const Unit& u, int wr, int wc, int fr, int fq) const {
        const int row0 = u.pm * BM + wr * 64 + fr, col0 = (u.pn - u.e * 4) * BM + wc * 32 + 8 * fq;
#pragma unroll
        for (int ai = 0; ai < 2; ++ai)
#pragma unroll
            for (int m = 0; m < 4; ++m) { bf16_t* rowp = O + (size_t)(row0 + ai * HALF + m * 16) * 1024 + col0;
#pragma unroll
                for (int bj = 0; bj < 2; ++bj) { const f32x4 v0 = acc[ai][bj][m][0], v1 = acc[ai][bj][m][1];
                    u32x4 w; w.x = cvt_pk_bf16(v0[0], v0[1]); w.y = cvt_pk_bf16(v0[2], v0[3]); w.z = cvt_pk_bf16(v1[0], v1[1]); w.w = cvt_pk_bf16(v1[2], v1[3]);
                    *(u32x4*)(rowp + bj * HALF) = w; } }
    }
};
template <class Epi, class Sched, bool ALIGN_EPI = false, bool SP2 = false>
__device__ __forceinline__ void gemm_phase(PG8_LAS unsigned char* lds, const Gemm g, const Sched& S, const Epi& E) {
    int tid_ = threadIdx.x; asm volatile("" : "+v"(tid_));
    const int tid = tid_, wid = __builtin_amdgcn_readfirstlane(tid >> 6), lane = tid & 63, wr = wid >> 2, wc = wid & 3, fr = lane & 15, fq = lane >> 4;
    const int K = g.K, nt = K / BK;
    unsigned voffA[2], voffB[2];
#pragma unroll
    for (int i = 0; i < 2; ++i) { int R, C; stage_rc(tid * 16 + i * 8192, R, C); const int Rb = Epi::PERM ? ((R & ~31) + perm32(R & 31)) : R;
        voffA[i] = (unsigned)(R * K + C) * 2u; voffB[i] = (unsigned)(Rb * K + C) * 2u; }
    const size_t kstep = (size_t)(BK * 2);
    const size_t hstep = (size_t)HALF * K * 2;
    const size_t tstep = 2 * hstep;
    const unsigned ldsw = (unsigned)wid * 1024u;
    const int aoff = lds_byte(wr * 64 + fr, fq * 8), boff = lds_byte(wc * 32 + fr, fq * 8);
#define PG8_SA(b, h) (((b) * 2 + (h)) * HTB)
#define PG8_SB(b, h) ((4 + (b) * 2 + (h)) * HTB)
#define PG8_STAGE(bufoff, gbase, voff) do { _Pragma("unroll") for (int _i = 0; _i < 2; ++_i) \
        __builtin_amdgcn_global_load_lds((const unsigned*)((const char*)(gbase) + (voff)[_i]), (PG8_LAS unsigned*)(lds + (bufoff) + ldsw + _i * 8192), 16, 0, 0); } while (0)
#define PG8_STAGE_A(bufoff, gbase, hh, NX) do { if constexpr (Sched::GATHER) { const unsigned _o[2] = {((NX) && last) ? ngvo[hh][0] : gvo[hh][0], ((NX) && last) ? ngvo[hh][1] : gvo[hh][1]}; PG8_STAGE(bufoff, gbase, _o); } \
        else { PG8_STAGE(bufoff, (gbase) + ((hh) ? hstep : 0), voffA); } } while (0)
#define PG8_LDA(dst, b, h) do { _Pragma("unroll") for (int m = 0; m < 4; ++m) _Pragma("unroll") for (int k = 0; k < 2; ++k) dst[m][k] = *(const PG8_LAS bf16x8*)(lds + PG8_SA(b, h) + aoff + m * 2048 + k * 1024); } while (0)
#define PG8_LDB(dst, b, h) do { _Pragma("unroll") for (int n = 0; n < 2; ++n) _Pragma("unroll") for (int k = 0; k < 2; ++k) dst[n][k] = *(const PG8_LAS bf16x8*)(lds + PG8_SB(b, h) + boff + n * 2048 + k * 1024); } while (0)
#define PG8_MMA(ai, bj, At, Bt) do { __builtin_amdgcn_s_setprio(1); _Pragma("unroll") for (int m = 0; m < 4; ++m) _Pragma("unroll") for (int n = 0; n < 2; ++n) _Pragma("unroll") for (int k = 0; k < 2; ++k) \
        acc[ai][bj][m][n] = __builtin_amdgcn_mfma_f32_16x16x32_bf16(Bt[n][k], At[m][k], acc[ai][bj][m][n], 0, 0, 0); __builtin_amdgcn_s_setprio(0); } while (0)
#define PG8_WAIT_V(n) asm volatile("s_waitcnt vmcnt(" #n ")" ::: "memory")
#define PG8_WAIT_L(n) asm volatile("s_waitcnt lgkmcnt(" #n ")" ::: "memory")
#define PG8_BAR __builtin_amdgcn_s_barrier()
#define PG8_SCHED __builtin_amdgcn_sched_barrier(0)
    Unit cur, nxt; int ui = 0;
    if (!S.next(0, cur)) return;
    f32x4 acc[2][2][4][2];
#pragma unroll
    for (int a = 0; a < 2; ++a)
#pragma unroll
        for (int b = 0; b < 2; ++b)
#pragma unroll
            for (int m = 0; m < 4; ++m)
#pragma unroll
                for (int n = 0; n < 2; ++n) acc[a][b][m][n] = (f32x4){0.f, 0.f, 0.f, 0.f};
    bf16x8 At[4][2], B0[2][2], B1[2][2];
    const char* cA = (const char*)g.A + (Sched::GATHER ? (size_t)0 : (size_t)cur.pm * tstep); const char* cB = (const char*)g.Bt + (size_t)cur.pn * tstep;
    unsigned gvo[2][2] = {{0u, 0u}, {0u, 0u}}, ngvo[2][2] = {{0u, 0u}, {0u, 0u}}; const bool last = false;
    if constexpr (Sched::GATHER) {
#pragma unroll
        for (int hh = 0; hh < 2; ++hh)
#pragma unroll
            for (int i = 0; i < 2; ++i) { int R, C; stage_rc(tid * 16 + i * 8192, R, C); gvo[hh][i] = (unsigned)(S.arow(cur, hh * HALF + R) * K + C) * 2u; } }
    S.a_ready(cur);
    if constexpr (SP2) {
        PG8_STAGE(PG8_SB(0, 0), cB, voffB); PG8_STAGE(PG8_SB(0, 1), cB + hstep, voffB); PG8_STAGE_A(PG8_SA(0, 0), cA, 0, 0); PG8_STAGE_A(PG8_SA(0, 1), cA, 1, 0);
        if (wr == 1) PG8_BAR;
        PG8_WAIT_V(2); PG8_BAR;
        PG8_STAGE(PG8_SB(1, 0), cB + kstep, voffB); PG8_STAGE_A(PG8_SA(1, 0), cA + kstep, 0, 0); PG8_STAGE(PG8_SB(1, 1), cB + hstep + kstep, voffB);
        PG8_WAIT_V(6); PG8_BAR;
    } else {
        PG8_STAGE(PG8_SB(0, 0), cB, voffB); PG8_STAGE_A(PG8_SA(0, 0), cA, 0, 0); PG8_STAGE(PG8_SB(0, 1), cB + hstep, voffB); PG8_STAGE_A(PG8_SA(0, 1), cA, 1, 0);
        if (wr == 1) PG8_BAR;
        PG8_WAIT_V(4); PG8_BAR;
        PG8_STAGE(PG8_SB(1, 0), cB + kstep, voffB); PG8_STAGE_A(PG8_SA(1, 0), cA + kstep, 0, 0); PG8_STAGE(PG8_SB(1, 1), cB + hstep + kstep, voffB);
        PG8_WAIT_V(6); PG8_BAR;
    }
    for (;;) {
        const bool has_next = S.next(ui + 1, nxt);
        const char* nA = (has_next && !Sched::GATHER) ? (const char*)g.A + (size_t)nxt.pm * tstep : cA; const char* nB = has_next ? (const char*)g.Bt + (size_t)nxt.pn * tstep : cB;
        if constexpr (Sched::GATHER) {
#pragma unroll
            for (int hh = 0; hh < 2; ++hh)
#pragma unroll
                for (int i = 0; i < 2; ++i) { int R, C; stage_rc(tid * 16 + i * 8192, R, C); ngvo[hh][i] = has_next ? (unsigned)(S.arow(nxt, hh * HALF + R) * K + C) * 2u : gvo[hh][i]; } }
        for (int t = 0; t < nt; t += 2) {
            const bool last = (t == nt - 2);
            const char* a1 = cA + (size_t)(t + 1) * kstep;
            const char* a2 = last ? nA : cA + (size_t)(t + 2) * kstep; const char* b2 = last ? nB : cB + (size_t)(t + 2) * kstep;
            const char* a3 = a2 + kstep; const char* b3 = b2 + kstep;
            if (last && has_next) S.a_ready(nxt);
            if constexpr (SP2) {
            PG8_LDB(B0, 0, 0); PG8_LDB(B1, 0, 1); PG8_SCHED; PG8_LDA(At, 0, 0); PG8_STAGE_A(PG8_SA(1, 1), a1, 1, 0);
            PG8_WAIT_V(8); PG8_WAIT_L(0); PG8_BAR; PG8_MMA(0, 0, At, B0); PG8_MMA(0, 1, At, B1); PG8_BAR; PG8_SCHED;
            PG8_LDA(At, 0, 1); PG8_STAGE(PG8_SB(0, 0), b2, voffB); PG8_STAGE(PG8_SB(0, 1), b2 + hstep, voffB); PG8_STAGE_A(PG8_SA(0, 0), a2, 0, 1);
            PG8_WAIT_V(8); PG8_WAIT_L(0); PG8_BAR; PG8_MMA(1, 0, At, B0); PG8_MMA(1, 1, At, B1); PG8_BAR; PG8_SCHED;
            PG8_LDB(B0, 1, 0); PG8_LDB(B1, 1, 1); PG8_SCHED; PG8_LDA(At, 1, 0); PG8_STAGE_A(PG8_SA(0, 1), a2, 1, 1);
            PG8_WAIT_V(8); PG8_WAIT_L(0); PG8_BAR; PG8_MMA(0, 0, At, B0); PG8_MMA(0, 1, At, B1); PG8_BAR; PG8_SCHED;
            PG8_LDA(At, 1, 1); PG8_STAGE(PG8_SB(1, 0), b3, voffB); PG8_STAGE(PG8_SB(1, 1), b3 + hstep, voffB); PG8_STAGE_A(PG8_SA(1, 0), a3, 0, 1);
            PG8_WAIT_V(8); PG8_WAIT_L(0); PG8_BAR; PG8_MMA(1, 0, At, B0); PG8_MMA(1, 1, At, B1); PG8_BAR; PG8_SCHED;
            } else {
            PG8_LDB(B0, 0, 0); PG8_SCHED; PG8_LDA(At, 0, 0); PG8_STAGE_A(PG8_SA(1, 1), a1, 1, 0);
            PG8_WAIT_L(8); PG8_BAR; PG8_WAIT_L(0); PG8_MMA(0, 0, At, B0); PG8_BAR; PG8_SCHED;
            PG8_LDB(B1, 0, 1); PG8_STAGE(PG8_SB(0, 0), b2, voffB);
            PG8_BAR; PG8_WAIT_L(0); PG8_MMA(0, 1, At, B1); PG8_BAR;
            PG8_LDA(At, 0, 1); PG8_STAGE_A(PG8_SA(0, 0), a2, 0, 1);
            PG8_BAR; PG8_WAIT_L(0); PG8_MMA(1, 0, At, B0); PG8_BAR; PG8_SCHED;
            PG8_STAGE(PG8_SB(0, 1), b2 + hstep, voffB);
            PG8_WAIT_V(6); PG8_BAR; PG8_MMA(1, 1, At, B1); PG8_BAR;
            PG8_LDB(B0, 1, 0); PG8_SCHED; PG8_LDA(At, 1, 0); PG8_STAGE_A(PG8_SA(0, 1), a2, 1, 1);
            PG8_WAIT_L(8); PG8_BAR; PG8_WAIT_L(0); PG8_MMA(0, 0, At, B0); PG8_BAR; PG8_SCHED;
            PG8_LDB(B1, 1, 1); PG8_STAGE(PG8_SB(1, 0), b3, voffB);
            PG8_BAR; PG8_WAIT_L(0); PG8_MMA(0, 1, At, B1); PG8_BAR;
            PG8_LDA(At, 1, 1); PG8_STAGE_A(PG8_SA(1, 0), a3, 0, 1);
            PG8_BAR; PG8_WAIT_L(0); PG8_MMA(1, 0, At, B0); PG8_BAR; PG8_SCHED;
            PG8_STAGE(PG8_SB(1, 1), b3 + hstep, voffB);
            PG8_WAIT_V(6); PG8_BAR; PG8_MMA(1, 1, At, B1); PG8_BAR;
            }
        }
        if constexpr (ALIGN_EPI) { if (wr == 0) PG8_BAR; }
        if constexpr (!Epi::AFTER_DRAIN) { E(acc, cur, wr, wc, fr, fq); S.done(cur); }
        if (!has_next) break;
#pragma unroll
        for (int a = 0; a < 2; ++a)
#pragma unroll
            for (int b = 0; b < 2; ++b)
#pragma unroll
                for (int m = 0; m < 4; ++m)
#pragma unroll
                    for (int n = 0; n < 2; ++n) acc[a][b][m][n] = (f32x4){0.f, 0.f, 0.f, 0.f};
        cur = nxt; cA = nA; cB = nB; ++ui;
        if constexpr (Sched::GATHER) { gvo[0][0] = ngvo[0][0]; gvo[0][1] = ngvo[0][1]; gvo[1][0] = ngvo[1][0]; gvo[1][1] = ngvo[1][1]; }
        if constexpr (ALIGN_EPI) { if (wr == 1) PG8_BAR; }
    }
    PG8_WAIT_V(0);
    if constexpr (!ALIGN_EPI) { if (wr == 0) PG8_BAR; }
    PG8_BAR;
    if constexpr (Epi::AFTER_DRAIN) { E.fused(acc, cur, wr, wc, fr, fq, lds, wid, lane); S.done(cur); }
#undef PG8_SA
#undef PG8_SB
#undef PG8_STAGE
#undef PG8_STAGE_A
#undef PG8_LDA
#undef PG8_LDB
#undef PG8_MMA
#undef PG8_WAIT_V
#undef PG8_WAIT_L
#undef PG8_BAR
#undef PG8_SCHED
}
}
#define GAS __attribute__((address_space(1)))
#define LAS __attribute__((address_space(3)))
typedef unsigned short bf16;
typedef unsigned v4u __attribute__((ext_vector_type(4)));
typedef float f32x4 __attribute__((ext_vector_type(4)));
typedef short bf16x8 __attribute__((ext_vector_type(8)));
typedef GAS unsigned gu32;
typedef GAS unsigned long long gu64;
#define RLX_AGENT __ATOMIC_RELAXED, __HIP_MEMORY_SCOPE_AGENT
#define LDS_WAIT() asm volatile("s_waitcnt lgkmcnt(0)" ::: "memory")
#define VM_WAIT() asm volatile("s_waitcnt vmcnt(0)" ::: "memory")
__device__ __forceinline__ unsigned long long rt() { return __builtin_amdgcn_s_memrealtime(); }
__device__ __forceinline__ unsigned f2bf(float f) { unsigned u = __builtin_bit_cast(unsigned, f); return (u + 0x7fffu + ((u >> 16) & 1u)) >> 16; }
__device__ __forceinline__ unsigned pk2(float lo, float hi) { return f2bf(lo) | (f2bf(hi) << 16); }

#define XB_TMO      128
#define XB_XCNT(j)  (256  + 64 * (j))
#define XB_XSUB(j)  (1280 + 64 * (j))
#define XB_XGEN(j)  (2304 + 64 * (j))
#define XB_TOP      3328
#define XB_TOPGEN   3392
#define XCD_BAR_WORDS 3456
#define XB_SPIN_CAP (1u << 18)

__device__ __forceinline__ unsigned xb_ld(unsigned* p)              { return __hip_atomic_load(p, __ATOMIC_RELAXED, __HIP_MEMORY_SCOPE_AGENT); }
__device__ __forceinline__ unsigned xb_add(unsigned* p, unsigned v) { return __hip_atomic_fetch_add(p, v, __ATOMIC_RELAXED, __HIP_MEMORY_SCOPE_AGENT); }
__device__ __forceinline__ unsigned xb_xcc_id() { return (unsigned)__builtin_amdgcn_s_getreg((3 << 11) | 20) & 0xFu; }
#define XB_SPIN(cond, bar) do { unsigned _sp = 0; while (cond) { __builtin_amdgcn_s_sleep(1); \
    if ((++_sp & 255u) == 0u) { if (xb_ld(&(bar)[XB_TMO])) break; if (_sp > XB_SPIN_CAP) { atomicAdd(&(bar)[XB_TMO], 1u); break; } } } } while (0)

struct XcdBarrier {
    unsigned* bar; unsigned x;
    volatile LAS unsigned* st;
};

__device__ __forceinline__ XcdBarrier xcd_barrier_post(unsigned* bar, volatile LAS unsigned* st) {
    XcdBarrier b; b.bar = bar; b.x = xb_xcc_id(); b.st = st;
    if (threadIdx.x == 0) (void)xb_add(&bar[XB_XCNT(b.x)], 1u);
    return b;
}
__device__ __forceinline__ void xcd_barrier_complete(unsigned* bar, unsigned x, unsigned& nloc, unsigned& nx) {
    const unsigned G = gridDim.x * gridDim.y * gridDim.z;
    unsigned sum, cnt, mine, sp = 0u;
    for (;;) {
        sum = 0u; cnt = 0u; mine = 0u;
#pragma unroll
        for (unsigned j = 0; j < 16; ++j) { const unsigned c = xb_ld(&bar[XB_XCNT(j)]); sum += c; cnt += (c > 0u) ? 1u : 0u; mine = (j == x) ? c : mine; }
        if (sum == G) break;
        __builtin_amdgcn_s_sleep(1);
        if ((++sp & 255u) == 0u) { if (xb_ld(&bar[XB_TMO])) break; if (sp > XB_SPIN_CAP) { atomicAdd(&bar[XB_TMO], 1u); break; } }
    }
    nloc = mine > 0u ? mine : 1u; nx = cnt > 0u ? cnt : 1u;
}

__device__ __forceinline__ void xcd_barrier(const XcdBarrier& b) {
    asm volatile("s_waitcnt vmcnt(0)" ::: "memory");
    __syncthreads();
    if (threadIdx.x == 0) {
        unsigned* bar = b.bar;
        __builtin_amdgcn_s_waitcnt(0);
        unsigned nloc = b.st[0], nx = b.st[1];
        if (nloc == 0u) { xcd_barrier_complete(bar, b.x, nloc, nx); b.st[0] = nloc; b.st[1] = nx; }
        const unsigned old = xb_add(&bar[XB_XSUB(b.x)], 1u);
        const unsigned gen = old / nloc;
        if (old + 1u == (gen + 1u) * nloc) {
            __builtin_amdgcn_fence(__ATOMIC_RELEASE, "agent");
            asm volatile("s_waitcnt vmcnt(0)" ::: "memory");
            const unsigned og = xb_add(&bar[XB_TOP], 1u);
            const unsigned tg = og / nx;
            if (og + 1u == (tg + 1u) * nx) xb_add(&bar[XB_TOPGEN], 1u);
            else XB_SPIN(xb_ld(&bar[XB_TOPGEN]) == tg, bar);
            __builtin_amdgcn_fence(__ATOMIC_ACQUIRE, "agent");
            xb_add(&bar[XB_XGEN(b.x)], 1u);
            asm volatile("s_waitcnt vmcnt(0)" ::: "memory");
        } else {
            XB_SPIN(xb_ld(&bar[XB_XGEN(b.x)]) == gen, bar);
            __builtin_amdgcn_fence(__ATOMIC_ACQUIRE, "agent");
            asm volatile("s_waitcnt vmcnt(0)" ::: "memory");
        }
    }
    __syncthreads();
}
constexpr int NWAVES = 8, NT = 512;
constexpr int BATCH = 2, SEQ = 8192, D = 1024, TB = 8320, M = BATCH * TB, PADR = 112;
constexpr int NIN = 2816, DFF = 2816, NEXP = 8, DFE = 3584;
constexpr int C_U = 0, C_HQ = 256, C_HF = 512, C_HI = 768, C_HG = 1024, C_RQ = 1280, C_RK = 1536, C_RV = 1792, C_RG = 2304;
constexpr float EPS = 1e-6f;
#ifndef MK_PER_PHASE
#define MK_PER_PHASE 0
#endif
constexpr int NPH = 62;
__host__ __device__ inline bool phase_exists(int k) {
    if (k == 0 || k == NPH - 1) return true;
    const int l = (k - 1) / 30, r = (k - 1) % 30;
    if (r <= 3 || r == 6) return true;
    if (l == 0) return r == 8 || r == 9;
    return r == 7 || r == 10 || r == 11 || r == 12;
}
constexpr size_t MiB = 1u << 20;
constexpr size_t WS_CTL = 0, CTL_ZERO_BYTES = 1 * MiB;
constexpr int CW_TMO = 0, CW_CODE = 1, CW_BAR = 4096, CW_CNT = 16384;
constexpr size_t WS_LB = 1 * MiB, WS_LB128 = 1 * MiB + 16384, WS_BB = 1 * MiB + 65536, WS_BBT = 1 * MiB + 393216, WS_ROT = 1 * MiB + 524288, WS_CCT = 2752512, WS_WGT = 2883584, WS_LBT = 3 * MiB;
constexpr size_t WS_POS = 3 * MiB + 65536, WS_GATE = WS_POS + 131072, WS_LIST = WS_GATE + 131072;
constexpr int MOE_CAP = 16384;
static_assert(WS_BBT + 131072 <= WS_ROT && WS_ROT + (size_t)TB * 32 * 4 <= WS_CCT && WS_CCT + 131072 <= WS_WGT && WS_WGT + 262144 <= WS_LBT && WS_LIST + 8 * MOE_CAP * 4 <= 4 * MiB, "table map");
constexpr size_t WS_WM13 = 4 * MiB, WS_WM2 = 4 * MiB, WS_YS = 60 * MiB, WS_HB = 116 * MiB, WS_H = 149 * MiB, WS_SSP = 214 * MiB, WS_PROJ = 220 * MiB, WS_MIXED = 310 * MiB, WS_ACT = 220 * MiB;
constexpr size_t WS_WIN = 343 * MiB, WS_WOUT = 354 * MiB, WS_WF13 = 358 * MiB, WS_WF2 = 369 * MiB, WS_END = 458 * MiB;
constexpr int MOE_TMAX = 136;
static_assert(WS_WM13 + (size_t)NEXP * 2 * DFE * D * 2 <= WS_HB && WS_WM2 + (size_t)NEXP * D * DFE * 2 <= WS_YS && WS_YS + (size_t)MOE_TMAX * 256 * D * 2 <= WS_HB + (size_t)M * D * 2 && WS_HB + (size_t)M * D * 2 <= WS_H, "ws map 1");
static_assert(WS_H + (size_t)M * D * 4 <= WS_SSP && WS_SSP + (size_t)5 * M * 16 * 4 <= WS_PROJ && WS_PROJ + (size_t)M * NIN * 2 <= WS_MIXED && WS_MIXED + (size_t)M * D * 2 <= WS_WIN, "ws map 2");
static_assert(WS_WIN + (size_t)2 * NIN * D * 2 <= WS_WOUT && WS_WOUT + (size_t)2 * D * D * 2 <= WS_WF13 && WS_WF13 + (size_t)2 * DFF * D * 2 <= WS_WF2 && WS_WF2 + (size_t)D * DFF * 2 <= WS_END, "ws map 3");
static_assert(WS_ACT + (size_t)M * DFF * 2 <= WS_MIXED && WS_ACT + (size_t)MOE_TMAX * 256 * DFE * 2 <= WS_END, "ws map 4");
constexpr int RING_OFF = 0, RING_BYTES = 131072, LDSCTL_OFF = RING_BYTES, MISC_OFF = LDSCTL_OFF + 320, LDS_BYTES = 147456;

struct Frame { LAS unsigned char* lds; volatile LAS unsigned* MISC; gu32* ctl; unsigned char* ws; const float* const* in; };
struct Loc { int tid, lane, wave, bx, vcu, G; };
__device__ __forceinline__ Loc make_loc() { Loc L; int t = threadIdx.x; asm volatile("" : "+v"(t)); int b = blockIdx.x; asm volatile("" : "+s"(b)); L.tid = t; L.lane = t & 63; L.wave = __builtin_amdgcn_readfirstlane(t >> 6);
    L.bx = b; L.G = gridDim.x; L.vcu = (L.G % 8 == 0) ? (b % 8) * (L.G / 8) + b / 8 : b; return L; }
__device__ __forceinline__ float bf2f(bf16 x) { return __uint_as_float((unsigned)x << 16); }
__device__ __forceinline__ bf16 f2bf_(float f) { return (bf16)f2bf(f); }
__device__ __forceinline__ float wave_sum(float v) {
#pragma unroll
    for (int o = 1; o < 64; o <<= 1) v += __shfl_xor(v, o);
    return v;
}
__device__ __forceinline__ float silu_f(float a) { return a / (1.0f + __expf(-a)); }
__device__ __forceinline__ float sigmoid_f(float a) { return 1.0f / (1.0f + __expf(-a)); }

__device__ __forceinline__ void tr_item(const float* W, int K, int N, bf16* WT, int mode, const float* g, LAS float* scr, int item, int lane) {
    const int nblk = N / 32, kb = item / nblk, nb = item % nblk, k0 = 64 * kb, n0 = 32 * nb;
#pragma unroll 8
    for (int i = 0; i < 32; ++i) { const int kk = 2 * i + (lane >> 5); float w = W[(size_t)(k0 + kk) * N + n0 + (lane & 31)]; if (g) w *= g[k0 + kk]; scr[kk * 33 + (lane & 31)] = w; }
    LDS_WAIT(); asm volatile("" ::: "memory");
    const int c = lane & 7;
#pragma unroll
    for (int j = 0; j < 4; ++j) { const int n = (lane >> 3) + 8 * j; const LAS float* s = scr + (8 * c) * 33 + n;
        v4u o; o.x = pk2(s[0 * 33], s[1 * 33]); o.y = pk2(s[2 * 33], s[3 * 33]); o.z = pk2(s[4 * 33], s[5 * 33]); o.w = pk2(s[6 * 33], s[7 * 33]);
        const int nn = n0 + n, drow = mode == 0 ? nn : ((nn >> 7) * 256 + (nn & 127) + (mode == 2 ? 128 : 0));
        *(GAS v4u*)(WT + (size_t)drow * K + k0 + 8 * c) = o; }
    LDS_WAIT(); asm volatile("" ::: "memory");
}
__device__ __forceinline__ void p0_prologue(Frame& F) {
    const Loc L = make_loc();
    LAS float* scr = (LAS float*)(F.lds + RING_OFF + L.wave * 16384);
    const int gw = L.vcu * NWAVES + L.wave, NGW = L.G * NWAVES;
    unsigned char* ws = F.ws; const float* const* in = F.in;
    constexpr int I_IN = 16 * 88, I_OUT = 16 * 32, I_F = 16 * 88, I_F2 = 44 * 32, I_M = 16 * 112;
    constexpr int NITEMS = 2 * I_IN + 2 * I_OUT + 2 * I_F + I_F2 + 16 * I_M;
    for (int it = gw; it < NITEMS; it += NGW) {
        int r = it;
        if (r < 2 * I_IN) { const int l = r / I_IN; tr_item(in[3] + (size_t)l * D * NIN, D, NIN, (bf16*)(ws + WS_WIN) + (size_t)l * NIN * D, 0, in[2] + l * D, scr, r % I_IN, L.lane); continue; } r -= 2 * I_IN;
        if (r < 2 * I_OUT) { const int l = r / I_OUT; tr_item(in[18] + (size_t)l * D * D, D, D, (bf16*)(ws + WS_WOUT) + (size_t)l * D * D, 0, nullptr, scr, r % I_OUT, L.lane); continue; } r -= 2 * I_OUT;
        if (r < I_F) { tr_item(in[20], D, DFF, (bf16*)(ws + WS_WF13), 1, in[19], scr, r, L.lane); continue; } r -= I_F;
        if (r < I_F) { tr_item(in[21], D, DFF, (bf16*)(ws + WS_WF13), 2, in[19], scr, r, L.lane); continue; } r -= I_F;
        if (r < I_F2) { tr_item(in[22], DFF, D, (bf16*)(ws + WS_WF2), 0, nullptr, scr, r, L.lane); continue; } r -= I_F2;
        if (r < 8 * I_M) { const int e = r / I_M; tr_item(in[24] + (size_t)e * D * DFE, D, DFE, (bf16*)(ws + WS_WM13) + (size_t)e * 2 * DFE * D, 1, in[19] + D, scr, r % I_M, L.lane); continue; } r -= 8 * I_M;
        { const int e = r / I_M; tr_item(in[25] + (size_t)e * D * DFE, D, DFE, (bf16*)(ws + WS_WM13) + (size_t)e * 2 * DFE * D, 2, in[19] + D, scr, r % I_M, L.lane); }
    }
    float* H = (float*)(ws + WS_H); bf16* HB = (bf16*)(ws + WS_HB); float* SS0 = (float*)(ws + WS_SSP);
    for (int m = gw; m < M; m += NGW) {
        const int b = m / TB, t = m % TB;
        const float* src = t < PADR ? nullptr : (t < 128 ? in[1] + (size_t)(t - PADR) * D : in[0] + ((size_t)b * SEQ + (t - 128)) * D);
        f32x4 v[4]; float s = 0.f;
#pragma unroll
        for (int j = 0; j < 4; ++j) { v[j] = src ? ((const GAS f32x4*)src)[L.lane + 64 * j] : (f32x4){0.f, 0.f, 0.f, 0.f}; s += (v[j].x * v[j].x + v[j].y * v[j].y) + (v[j].z * v[j].z + v[j].w * v[j].w); }
        s = wave_sum(s);
#pragma unroll
        for (int j = 0; j < 4; ++j) { ((GAS f32x4*)(H + (size_t)m * D))[L.lane + 64 * j] = v[j];
            ((GAS unsigned long long*)(HB + (size_t)m * D))[L.lane + 64 * j] = (unsigned long long)pk2(v[j].x, v[j].y) | ((unsigned long long)pk2(v[j].z, v[j].w) << 32); }
        if (L.lane < 16) SS0[(size_t)m * 16 + L.lane] = L.lane == 0 ? s : 0.0f;
    }
    const int gt = L.vcu * NT + L.tid, NGT = L.G * NT;
    float* LB = (float*)(ws + WS_LB); float* BB = (float*)(ws + WS_BB); float* ROT = (float*)(ws + WS_ROT); float* LBT = (float*)(ws + WS_LBT);
    for (int i = gt; i < 2048; i += NGT) {
        const int lg = i >> 6; const float step = expf(in[11][lg]); const float lre = in[4][i], lim = in[5][i];
        const float mag = expf(lre * step); float sn, cs; sincosf(lim * step, &sn, &cs); const float br = mag * cs, bi = mag * sn;
        const float den = 1.0f / (lre * lre + lim * lim), cr = ((br - 1.0f) * lre + bi * lim) * den, ci = (bi * lre - (br - 1.0f) * lim) * den;
        LB[2 * i] = br; LB[2 * i + 1] = bi;
        for (int h = 0; h < 16; ++h) { const float b_r = in[6][i * 16 + h], b_i = in[7][i * 16 + h]; BB[(i * 16 + h) * 2] = cr * b_r - ci * b_i; BB[(i * 16 + h) * 2 + 1] = cr * b_i + ci * b_r; }
    }
    { bf16* BBT = (bf16*)(ws + WS_BBT); bf16* CCT = (bf16*)(ws + WS_CCT); bf16* WGT = (bf16*)(ws + WS_WGT); float* LB128 = (float*)(ws + WS_LB128);
      for (int i = gt; i < 2048; i += NGT) { const int lg = i >> 6, p = i & 63; const float step = expf(in[11][lg]), lre = in[4][i], lim = in[5][i];
          const float mag = expf(128.0f * lre * step); float sn, cs; sincosf(128.0f * (lim * step), &sn, &cs); LB128[2 * i] = mag * cs; LB128[2 * i + 1] = mag * sn;
          const float m1 = expf(lre * step); float s1, c1; sincosf(lim * step, &s1, &c1); const float br = m1 * c1, bi = m1 * s1, den = 1.0f / (lre * lre + lim * lim), cr = ((br - 1.0f) * lre + bi * lim) * den, ci = (bi * lre - (br - 1.0f) * lim) * den;
          for (int h = 0; h < 16; ++h) { const float b_r = in[6][i * 16 + h], b_i = in[7][i * 16 + h]; BBT[((size_t)lg * 128 + p) * 16 + h] = f2bf_(cr * b_r - ci * b_i); BBT[((size_t)lg * 128 + 64 + p) * 16 + h] = f2bf_(cr * b_i + ci * b_r);
              CCT[((size_t)lg * 16 + h) * 128 + p] = f2bf_(in[8][(lg * 16 + h) * 64 + p]); CCT[((size_t)lg * 16 + h) * 128 + 64 + p] = f2bf_(-in[9][(lg * 16 + h) * 64 + p]); } }
      for (int i = gt; i < 2 * 65536; i += NGT) { const int l = i >> 16, n = (i >> 8) & 255, k = i & 255; WGT[i] = f2bf_(in[12][(size_t)l * 65536 + k * 256 + n]); } }
    for (int i = gt; i < TB * 16; i += NGT) { const int t = i >> 4, f = i & 15; const float pos = (float)(t - PADR), inv = powf(10000.0f, -(float)f / 16.0f); float sn, cs; sincosf(pos * inv, &sn, &cs); ROT[2 * i] = cs; ROT[2 * i + 1] = sn; }
    for (int i = gt; i < 512; i += NGT) { const int l = i >> 8, c = i & 255; float lb = 0.f; if (l == 1) { const float a0 = in[15][c], a1 = in[15][256 + c], mx = fmaxf(a0, a1), e0 = expf(a0 - mx), e1 = expf(a1 - mx); lb = e1 / (e0 + e1); } LBT[i] = lb; }
}

__device__ __forceinline__ float gelu_tanh(float y) { const float x = 0.7978845608028654f * (y + 0.044715f * y * y * y); const float th = 1.0f - 2.0f / (1.0f + __expf(2.0f * x)); return 0.5f * y * (1.0f + th); }
typedef unsigned u32x4_t __attribute__((ext_vector_type(4)));
__device__ __forceinline__ f32x4 mfma16(bf16x8 a, bf16x8 b, f32x4 c) { return __builtin_amdgcn_mfma_f32_16x16x32_bf16(a, b, c, 0, 0, 0); }
__device__ __forceinline__ unsigned cvtpk(float lo, float hi) { unsigned r; asm volatile("v_cvt_pk_bf16_f32 %0, %1, %2" : "=v"(r) : "v"(lo), "v"(hi)); return r; }
__device__ __forceinline__ bf16x8 pack8(f32x4 a, f32x4 b) { u32x4_t w; w.x = cvtpk(a[0], a[1]); w.y = cvtpk(a[2], a[3]); w.z = cvtpk(b[0], b[1]); w.w = cvtpk(b[2], b[3]); return __builtin_bit_cast(bf16x8, w); }
__device__ __forceinline__ int perm_pos(int j) { return (j & ~31) + 8 * ((j >> 2) & 3) + 4 * ((j >> 4) & 1) + (j & 3); }
constexpr int NCH = TB / 128;
constexpr size_t OUT_RST = 0, OUT_HST = 9 * MiB, OUT_HDK = 18 * MiB, OUT_S5X = 19 * MiB;
__device__ __forceinline__ void ma_ret_unit(Frame& F, const Loc& L, int b, int c, int h, float* outb) {
    LAS float* Ks = (LAS float*)F.lds; LAS float* Vs = Ks + 128 * 32;
    const bf16* P = (const bf16*)(F.ws + WS_PROJ) + ((size_t)b * TB + c * 128) * NIN; const float* ROT = (const float*)(F.ws + WS_ROT) + (size_t)c * 128 * 32;
    const float lg = __log2f(1.0f - exp2f(-5.0f - (float)h));
    for (int it = L.tid; it < 2048; it += NT) { const int j = it >> 4, i = it & 15; const bf16* pr = P + (size_t)j * NIN; const float cs = ROT[(j * 16 + i) * 2], sn = ROT[(j * 16 + i) * 2 + 1];
        const float k1 = bf2f(pr[C_RK + h * 32 + i]), k2 = bf2f(pr[C_RK + h * 32 + 16 + i]), w = exp2f((float)(127 - j) * lg);
        Ks[j * 32 + i] = (k1 * cs - k2 * sn) * w; Ks[j * 32 + 16 + i] = (k1 * sn + k2 * cs) * w; }
    for (int it = L.tid; it < 8192; it += NT) { const int j = it >> 6, v = it & 63; Vs[it] = bf2f(P[(size_t)j * NIN + C_RV + h * 64 + v]); }
    __syncthreads();
    const int v = L.tid & 63, fg = L.tid >> 6; float acc[4] = {0.f, 0.f, 0.f, 0.f};
    for (int j = 0; j < 128; ++j) { const float vv = Vs[j * 64 + v]; const f32x4 kk = *(const LAS f32x4*)(Ks + j * 32 + 4 * fg);
#pragma unroll
        for (int i = 0; i < 4; ++i) acc[i] += kk[i] * vv; }
    float* S = (float*)((unsigned char*)outb + OUT_RST) + (size_t)((b * NCH + c) * 8 + h) * 2048;
#pragma unroll
    for (int i = 0; i < 4; ++i) S[(4 * fg + i) * 64 + v] = acc[i];
    __syncthreads();
}
__device__ __forceinline__ void mb_ret(const Loc& L, float* outb) {
    const int gt = L.vcu * NT + L.tid, NGT = L.G * NT;
    for (int e = gt; e < 2 * 8 * 2048; e += NGT) { const int b = e >> 14, h = (e >> 11) & 7, idx = e & 2047; const float d = exp2f(128.0f * __log2f(1.0f - exp2f(-5.0f - (float)h)));
        float* p = (float*)((unsigned char*)outb + OUT_RST) + (size_t)(b * NCH * 8 + h) * 2048 + idx; float s = 0.f;
        for (int c = 0; c < NCH; ++c) { const float loc = p[(size_t)c * 8 * 2048]; p[(size_t)c * 8 * 2048] = s; s = d * s + loc; } }
}
__device__ __forceinline__ void mc_ret_unit(Frame& F, const Loc& L, int l, int b, int c, int h, const float* outb) {
    LAS bf16* Qrm = (LAS bf16*)F.lds; LAS bf16* Krm = Qrm + 4096; LAS bf16* Vt = Krm + 4096; LAS bf16* SpT = Vt + 64 * 136;
    const size_t row0 = (size_t)b * TB + c * 128; const bf16* P = (const bf16*)(F.ws + WS_PROJ) + row0 * NIN; const float* ROT = (const float*)(F.ws + WS_ROT) + (size_t)c * 128 * 32;
    const float gamma = 1.0f - exp2f(-5.0f - (float)h), lg = __log2f(gamma);
    { const int r = L.tid >> 2, pq = L.tid & 3; const bf16* pr = P + (size_t)r * NIN; const f32x4 r0 = *(const f32x4*)(ROT + (r * 16 + 4 * pq) * 2), r1 = *(const f32x4*)(ROT + (r * 16 + 4 * pq) * 2 + 4);
      const float cs[4] = {r0[0], r0[2], r1[0], r1[2]}, sn[4] = {r0[1], r0[3], r1[1], r1[3]};
      const float wq = 0.17677669529663687f * exp2f((float)r * lg), wk = exp2f(-(float)r * lg);
      const unsigned long long q1 = *(const GAS unsigned long long*)(pr + C_RQ + h * 32 + 4 * pq), q2 = *(const GAS unsigned long long*)(pr + C_RQ + h * 32 + 16 + 4 * pq);
      const unsigned long long k1 = *(const GAS unsigned long long*)(pr + C_RK + h * 32 + 4 * pq), k2 = *(const GAS unsigned long long*)(pr + C_RK + h * 32 + 16 + 4 * pq);
      float qa[4], qb[4], ka[4], kb[4];
#pragma unroll
      for (int e = 0; e < 4; ++e) { const float a1 = bf2f((bf16)(q1 >> (16 * e))), a2 = bf2f((bf16)(q2 >> (16 * e))), b1 = bf2f((bf16)(k1 >> (16 * e))), b2 = bf2f((bf16)(k2 >> (16 * e)));
          qa[e] = (a1 * cs[e] - a2 * sn[e]) * wq; qb[e] = (a1 * sn[e] + a2 * cs[e]) * wq; ka[e] = (b1 * cs[e] - b2 * sn[e]) * wk; kb[e] = (b1 * sn[e] + b2 * cs[e]) * wk; }
      *(LAS unsigned long long*)(Qrm + r * 32 + 4 * pq) = (unsigned long long)cvtpk(qa[0], qa[1]) | ((unsigned long long)cvtpk(qa[2], qa[3]) << 32);
      *(LAS unsigned long long*)(Qrm + r * 32 + 16 + 4 * pq) = (unsigned long long)cvtpk(qb[0], qb[1]) | ((unsigned long long)cvtpk(qb[2], qb[3]) << 32);
      *(LAS unsigned long long*)(Krm + r * 32 + 4 * pq) = (unsigned long long)cvtpk(ka[0], ka[1]) | ((unsigned long long)cvtpk(ka[2], ka[3]) << 32);
      *(LAS unsigned long long*)(Krm + r * 32 + 16 + 4 * pq) = (unsigned long long)cvtpk(kb[0], kb[1]) | ((unsigned long long)cvtpk(kb[2], kb[3]) << 32);
      const int vq = 16 * pq, pj = perm_pos(r); const v4u va = *(const GAS v4u*)(pr + C_RV + h * 64 + vq), vb = *(const GAS v4u*)(pr + C_RV + h * 64 + vq + 8);
#pragma unroll
      for (int e = 0; e < 4; ++e) { Vt[(vq + 2 * e) * 136 + pj] = (bf16)(va[e] & 0xffffu); Vt[(vq + 2 * e + 1) * 136 + pj] = (bf16)(va[e] >> 16);
          Vt[(vq + 8 + 2 * e) * 136 + pj] = (bf16)(vb[e] & 0xffffu); Vt[(vq + 8 + 2 * e + 1) * 136 + pj] = (bf16)(vb[e] >> 16); }
      const int k = L.tid >> 4, v4 = (L.tid & 15) * 4; const f32x4 sp = *(const f32x4*)((const float*)((const unsigned char*)outb + OUT_RST) + (size_t)((b * NCH + c) * 8 + h) * 2048 + k * 64 + v4);
#pragma unroll
      for (int e = 0; e < 4; ++e) SpT[(v4 + e) * 40 + k] = f2bf_(gamma * sp[e]);
    }
    __syncthreads();
    const int w = L.wave, il = L.lane & 15, g = L.lane >> 4;
    const bf16x8 Bq = *(const LAS bf16x8*)(Qrm + (16 * w + il) * 32 + 8 * g);
    const f32x4 zero = {0.f, 0.f, 0.f, 0.f}; f32x4 O[4] = {zero, zero, zero, zero};
#pragma unroll
    for (int jp = 0; jp < 4; ++jp) if (2 * jp <= w) {
        f32x4 p0, p1 = zero;
        { const bf16x8 A = *(const LAS bf16x8*)(Krm + (32 * jp + il) * 32 + 8 * g); p0 = mfma16(A, Bq, zero);
          if (2 * jp == w) {
#pragma unroll
              for (int r = 0; r < 4; ++r) if (4 * g + r > il) p0[r] = 0.f; } }
        if (2 * jp + 1 <= w) { const bf16x8 A = *(const LAS bf16x8*)(Krm + (32 * jp + 16 + il) * 32 + 8 * g); p1 = mfma16(A, Bq, zero);
          if (2 * jp + 1 == w) {
#pragma unroll
              for (int r = 0; r < 4; ++r) if (4 * g + r > il) p1[r] = 0.f; } }
        const bf16x8 Bp = pack8(p0, p1);
#pragma unroll
        for (int vt = 0; vt < 4; ++vt) { const bf16x8 A = *(const LAS bf16x8*)(Vt + (16 * vt + il) * 136 + 32 * jp + 8 * g); O[vt] = mfma16(A, Bp, O[vt]); }
    }
#pragma unroll
    for (int vt = 0; vt < 4; ++vt) { const bf16x8 A = *(const LAS bf16x8*)(SpT + (16 * vt + il) * 40 + 8 * g); O[vt] = mfma16(A, Bq, O[vt]); }
    float s1 = 0.f;
#pragma unroll
    for (int vt = 0; vt < 4; ++vt) s1 += (O[vt][0] + O[vt][1]) + (O[vt][2] + O[vt][3]);
    s1 += __shfl_xor(s1, 16); s1 += __shfl_xor(s1, 32); const float mean = s1 * (1.0f / 64.0f); float s2 = 0.f;
#pragma unroll
    for (int vt = 0; vt < 4; ++vt) { O[vt] = O[vt] - mean; s2 += (O[vt][0] * O[vt][0] + O[vt][1] * O[vt][1]) + (O[vt][2] * O[vt][2] + O[vt][3] * O[vt][3]); }
    s2 += __shfl_xor(s2, 16); s2 += __shfl_xor(s2, 32); const float rstd = rsqrtf(s2 * (1.0f / 64.0f) + EPS);
    const size_t row = row0 + 16 * w + il; const bf16* gp = (const bf16*)(F.ws + WS_PROJ) + row * NIN + C_RG + h * 64; bf16* mo = (bf16*)(F.ws + WS_MIXED) + row * D + 512 + h * 64; const float* og = F.in[17] + l * 512 + h * 64;
#pragma unroll
    for (int vt = 0; vt < 4; ++vt) { const int v0 = 16 * vt + 4 * g; const unsigned long long gg = *(const GAS unsigned long long*)(gp + v0); const f32x4 o4 = *(const f32x4*)(og + v0); float y[4];
#pragma unroll
        for (int r = 0; r < 4; ++r) y[r] = O[vt][r] * rstd * o4[r] * silu_f(bf2f((bf16)(gg >> (16 * r))));
        *(GAS unsigned long long*)(mo + v0) = (unsigned long long)cvtpk(y[0], y[1]) | ((unsigned long long)cvtpk(y[2], y[3]) << 32); }
    __syncthreads();
}
constexpr int HG_LD = 68;
constexpr int SEG_OFF = MISC_OFF + 192;
static_assert(SEG_OFF % 16 == 0 && SEG_OFF + 2048 <= LDS_BYTES, "LDS map (SEG)");
template <bool NEED_Q> __device__ __forceinline__ void hg_rows(const bf16* Pb, int tb0, int ch, const float* cw, float lb, float (&q)[16], float (&kk)[16], float (&vv)[16], float (&gl)[16]) {
    float wq[4], wf[4], wi[4];
#pragma unroll
    for (int j = 0; j < 4; ++j) { wq[j] = cw[j * 768 + ch]; wf[j] = cw[j * 768 + 256 + ch]; wi[j] = cw[j * 768 + 512 + ch]; }
    float hq[3], hf[3], hi[3];
#pragma unroll
    for (int j = 0; j < 3; ++j) { const int ts = tb0 - 3 + j; hq[j] = 0.f; hf[j] = 0.f; hi[j] = 0.f;
        if (ts >= 0) { const bf16* pr = Pb + (size_t)ts * NIN; if (NEED_Q) hq[j] = bf2f(pr[C_HQ + ch]); hf[j] = bf2f(pr[C_HF + ch]); hi[j] = bf2f(pr[C_HI + ch]); } }
    float run = 0.f;
#pragma unroll
    for (int r = 0; r < 16; ++r) { const bf16* pr = Pb + (size_t)(tb0 + r) * NIN; const float xq = NEED_Q ? bf2f(pr[C_HQ + ch]) : 0.f, xf = bf2f(pr[C_HF + ch]), xi = bf2f(pr[C_HI + ch]);
        const float cq = (wq[0] * hq[0] + wq[1] * hq[1]) + (wq[2] * hq[2] + wq[3] * xq), cf = (wf[0] * hf[0] + wf[1] * hf[1]) + (wf[2] * hf[2] + wf[3] * xf), ci = (wi[0] * hi[0] + wi[1] * hi[1]) + (wi[2] * hi[2] + wi[3] * xi);
        hq[0] = hq[1]; hq[1] = hq[2]; hq[2] = xq; hf[0] = hf[1]; hf[1] = hf[2]; hf[2] = xf; hi[0] = hi[1]; hi[1] = hi[2]; hi[2] = xi;
        const float f = fmaxf(lb + (1.0f - lb) * sigmoid_f(cf), 1e-30f); run += __logf(f); gl[r] = run; kk[r] = 1.0f - f; vv[r] = ci; q[r] = NEED_Q ? silu_f(cq) : 0.f; }
}
__device__ __forceinline__ void ma_hg_unit(Frame& F, const Loc& L, int l, int b, int c, int h, float* outb) {
    LAS float* Ks = (LAS float*)F.lds; LAS float* Vs = Ks + 128 * 64; LAS float* SEG = (LAS float*)(F.lds + SEG_OFF);
    const bf16* Pb = (const bf16*)(F.ws + WS_PROJ) + (size_t)b * TB * NIN; const int k = L.tid & 63, w = L.tid >> 6;
    float q[16], kk[16], vv[16], gl[16];
    hg_rows<false>(Pb, c * 128 + 16 * w, h * 64 + k, F.in[14] + l * 4 * 768, ((const float*)(F.ws + WS_LBT))[l * 256 + h * 64 + k], q, kk, vv, gl);
#pragma unroll
    for (int r = 0; r < 16; ++r) Vs[(16 * w + r) * 64 + k] = vv[r];
    SEG[w * 64 + k] = gl[15];
    __syncthreads();
    float off = 0.f, tot = 0.f;
#pragma unroll
    for (int ww = 0; ww < 8; ++ww) { const float s = SEG[ww * 64 + k]; if (ww < w) off += s; tot += s; }
#pragma unroll
    for (int r = 0; r < 16; ++r) Ks[(16 * w + r) * 64 + k] = kk[r] * __expf(tot - off - gl[r]);
    const size_t ui = (size_t)(b * NCH + c) * 4 + h;
    if (w == 0) ((float*)((unsigned char*)outb + OUT_HDK))[ui * 64 + k] = __expf(tot);
    __syncthreads();
    const int v = L.tid & 63, kg = L.tid >> 6; float acc[8] = {0.f, 0.f, 0.f, 0.f, 0.f, 0.f, 0.f, 0.f};
    for (int j = 0; j < 128; ++j) { const float x = Vs[j * 64 + v]; const f32x4 k0 = *(const LAS f32x4*)(Ks + j * 64 + 8 * kg), k1 = *(const LAS f32x4*)(Ks + j * 64 + 8 * kg + 4);
#pragma unroll
        for (int i = 0; i < 4; ++i) { acc[i] += k0[i] * x; acc[4 + i] += k1[i] * x; } }
    float* S = (float*)((unsigned char*)outb + OUT_HST) + ui * 4096;
#pragma unroll
    for (int i = 0; i < 8; ++i) S[(8 * kg + i) * 64 + v] = acc[i];
    __syncthreads();
}
__device__ __forceinline__ void mb_hg(const Loc& L, float* outb) {
    const int gt = L.vcu * NT + L.tid, NGT = L.G * NT;
    for (int e = gt; e < 2 * 4 * 4096; e += NGT) { const int b = e >> 14, h = (e >> 12) & 3, idx = e & 4095;
        float* p = (float*)((unsigned char*)outb + OUT_HST) + (size_t)(b * NCH * 4 + h) * 4096 + idx; const float* dk = (const float*)((unsigned char*)outb + OUT_HDK) + (size_t)(b * NCH * 4 + h) * 64 + (idx >> 6); float s = 0.f;
        for (int c = 0; c < NCH; ++c) { const float loc = p[(size_t)c * 4 * 4096], d = dk[(size_t)c * 4 * 64]; p[(size_t)c * 4 * 4096] = s; s = d * s + loc; } }
}
__device__ __forceinline__ f32x4 ld4(const LAS float* p) { return *(const LAS f32x4*)p; }
__device__ __forceinline__ void mc_hg_unit(Frame& F, const Loc& L, int l, int b, int c, int h, const float* outb) {
    LAS float* Qf = (LAS float*)F.lds; LAS float* Kf = Qf + 128 * HG_LD; LAS float* G = Kf + 128 * HG_LD; LAS bf16* Vt = (LAS bf16*)(G + 128 * HG_LD); LAS bf16* SpT = Vt + 64 * 136; LAS float* SEG = (LAS float*)(F.lds + SEG_OFF);
    static_assert(3 * 128 * HG_LD * 4 + 64 * 136 * 2 + 64 * 72 * 2 <= RING_BYTES, "LDS map (HGRN2 MC)");
    const size_t row0 = (size_t)b * TB + c * 128; const bf16* Pb = (const bf16*)(F.ws + WS_PROJ) + (size_t)b * TB * NIN;
    { const int k = L.tid & 63, w = L.tid >> 6; float q[16], kk[16], vv[16], gl[16];
      hg_rows<true>(Pb, c * 128 + 16 * w, h * 64 + k, F.in[14] + l * 4 * 768, ((const float*)(F.ws + WS_LBT))[l * 256 + h * 64 + k], q, kk, vv, gl);
#pragma unroll
      for (int r = 0; r < 16; ++r) { const int t = 16 * w + r; Qf[t * HG_LD + k] = q[r]; Kf[t * HG_LD + k] = kk[r]; Vt[k * 136 + perm_pos(t)] = f2bf_(vv[r]); }
      SEG[w * 64 + k] = gl[15];
      { const int kr = L.tid >> 3, v8 = (L.tid & 7) * 8; const float* sp = (const float*)((const unsigned char*)outb + OUT_HST) + ((size_t)(b * NCH + c) * 4 + h) * 4096 + kr * 64 + v8; const f32x4 s0 = *(const f32x4*)sp, s1 = *(const f32x4*)(sp + 4);
#pragma unroll
        for (int e = 0; e < 4; ++e) { SpT[(v8 + e) * 72 + kr] = f2bf_(s0[e]); SpT[(v8 + 4 + e) * 72 + kr] = f2bf_(s1[e]); } }
      __syncthreads();
      float off = 0.f;
#pragma unroll
      for (int ww = 0; ww < 8; ++ww) { const float s = SEG[ww * 64 + k]; if (ww < w) off += s; }
#pragma unroll
      for (int r = 0; r < 16; ++r) G[(16 * w + r) * HG_LD + k] = gl[r] + off;
    }
    __syncthreads();
    const int w = L.wave, il = L.lane & 15, g = L.lane >> 4; const f32x4 zero = {0.f, 0.f, 0.f, 0.f};
    f32x4 gr[2][2]; bf16x8 Bq[2], Bqi[2];
#pragma unroll
    for (int ks = 0; ks < 2; ++ks) { const int ko = 32 * ks + 8 * g;
        if (w > 0) { gr[ks][0] = ld4(G + (16 * w - 1) * HG_LD + ko); gr[ks][1] = ld4(G + (16 * w - 1) * HG_LD + ko + 4); } else { gr[ks][0] = zero; gr[ks][1] = zero; }
        const f32x4 q0 = ld4(Qf + (16 * w + il) * HG_LD + ko), q1 = ld4(Qf + (16 * w + il) * HG_LD + ko + 4), g0 = ld4(G + (16 * w + il) * HG_LD + ko), g1 = ld4(G + (16 * w + il) * HG_LD + ko + 4);
        f32x4 a0, a1, b0, b1;
#pragma unroll
        for (int e = 0; e < 4; ++e) { a0[e] = q0[e] * __expf(g0[e] - gr[ks][0][e]); a1[e] = q1[e] * __expf(g1[e] - gr[ks][1][e]); b0[e] = q0[e] * __expf(g0[e]); b1[e] = q1[e] * __expf(g1[e]); }
        Bq[ks] = pack8(a0, a1); Bqi[ks] = pack8(b0, b1); }
    f32x4 O[4] = {zero, zero, zero, zero};
#pragma unroll
    for (int jp = 0; jp < 4; ++jp) if (2 * jp <= w) {
        f32x4 pt[2] = {zero, zero};
#pragma unroll
        for (int hh = 0; hh < 2; ++hh) if (2 * jp + hh <= w) { const int J = 2 * jp + hh;
#pragma unroll
            for (int ks = 0; ks < 2; ++ks) { const int ko = 32 * ks + 8 * g; const f32x4 k0 = ld4(Kf + (16 * J + il) * HG_LD + ko), k1 = ld4(Kf + (16 * J + il) * HG_LD + ko + 4), g0 = ld4(G + (16 * J + il) * HG_LD + ko), g1 = ld4(G + (16 * J + il) * HG_LD + ko + 4);
                f32x4 a0, a1;
#pragma unroll
                for (int e = 0; e < 4; ++e) { a0[e] = k0[e] * __expf(fminf(gr[ks][0][e] - g0[e], 80.0f)); a1[e] = k1[e] * __expf(fminf(gr[ks][1][e] - g1[e], 80.0f)); }
                pt[hh] = mfma16(pack8(a0, a1), Bq[ks], pt[hh]); }
            if (J == w) {
#pragma unroll
                for (int r = 0; r < 4; ++r) if (4 * g + r > il) pt[hh][r] = 0.f; } }
        const bf16x8 Bp = pack8(pt[0], pt[1]);
#pragma unroll
        for (int vt = 0; vt < 4; ++vt) { const bf16x8 A = *(const LAS bf16x8*)(Vt + (16 * vt + il) * 136 + 32 * jp + 8 * g); O[vt] = mfma16(A, Bp, O[vt]); }
    }
#pragma unroll
    for (int vt = 0; vt < 4; ++vt)
#pragma unroll
        for (int ks = 0; ks < 2; ++ks) { const bf16x8 A = *(const LAS bf16x8*)(SpT + (16 * vt + il) * 72 + 32 * ks + 8 * g); O[vt] = mfma16(A, Bqi[ks], O[vt]); }
    float s2 = 0.f;
#pragma unroll
    for (int vt = 0; vt < 4; ++vt) s2 += (O[vt][0] * O[vt][0] + O[vt][1] * O[vt][1]) + (O[vt][2] * O[vt][2] + O[vt][3] * O[vt][3]);
    s2 += __shfl_xor(s2, 16); s2 += __shfl_xor(s2, 32); const float rstd = rsqrtf(s2 * (1.0f / 64.0f) + EPS);
    const size_t row = row0 + 16 * w + il; const bf16* gp = (const bf16*)(F.ws + WS_PROJ) + row * NIN + C_HG + h * 64; bf16* mo = (bf16*)(F.ws + WS_MIXED) + row * D + 256 + h * 64; const float* og = F.in[16] + l * 256 + h * 64;
#pragma unroll
    for (int vt = 0; vt < 4; ++vt) { const int v0 = 16 * vt + 4 * g; const unsigned long long gg = *(const GAS unsigned long long*)(gp + v0); const f32x4 o4 = *(const f32x4*)(og + v0); float y[4];
#pragma unroll
        for (int r = 0; r < 4; ++r) y[r] = O[vt][r] * rstd * o4[r] * silu_f(bf2f((bf16)(gg >> (16 * r))));
        *(GAS unsigned long long*)(mo + v0) = (unsigned long long)cvtpk(y[0], y[1]) | ((unsigned long long)cvtpk(y[2], y[3]) << 32); }
    __syncthreads();
}
constexpr int S5_WREG = 14592, BU_LD = 20, XS_LD = 136, GY_LD = 264;
static_assert(8 * S5_WREG <= RING_BYTES && 128 * GY_LD * 2 + 4096 + 512 <= RING_BYTES, "LDS map (S5)");
template <bool FULL> __device__ __forceinline__ void s5_group(Frame& F, const Loc& L, int l, int gidx, const bf16* Pc  , float& xr, float& xi, unsigned (&gy)[8][2]) {
    LAS float* BUt = (LAS float*)(F.lds + L.wave * S5_WREG); LAS bf16* Xs = (LAS bf16*)(F.lds + L.wave * S5_WREG + 128 * BU_LD * 4);
    const int il = L.lane & 15, g4 = L.lane >> 4, lg = l * 16 + gidx; const f32x4 zero = {0.f, 0.f, 0.f, 0.f}; const bf16x8 bz = {0, 0, 0, 0, 0, 0, 0, 0};
    bf16x8 Bb[8];
#pragma unroll
    for (int ct = 0; ct < 8; ++ct) Bb[ct] = g4 < 2 ? *(const bf16x8*)((const bf16*)(F.ws + WS_BBT) + ((size_t)lg * 128 + 16 * ct + il) * 16 + 8 * g4) : bz;
    bf16x8 Cb[4], Db = bz;
    if (FULL) {
#pragma unroll
        for (int ks = 0; ks < 4; ++ks) Cb[ks] = *(const bf16x8*)((const bf16*)(F.ws + WS_CCT) + ((size_t)lg * 16 + il) * 128 + 32 * ks + 8 * g4);
        const short dsk = (short)f2bf_(F.in[10][lg * 16 + il]);
#pragma unroll
        for (int jj = 0; jj < 8; ++jj) Db[jj] = (8 * g4 + jj == il) ? dsk : (short)0; }
    const float* LB = (const float*)(F.ws + WS_LB) + (size_t)(lg * 64 + L.lane) * 2; const float lr = LB[0], li = LB[1];
    const unsigned avoff = (unsigned)(il * NIN + C_U + 16 * gidx + 8 * g4) * 2u;
#pragma unroll
    for (int s = 0; s < 8; ++s) {
        const bf16x8 A = g4 < 2 ? *(const bf16x8*)((const char*)(Pc + (size_t)16 * s * NIN) + avoff) : bz;
#pragma unroll
        for (int ct = 0; ct < 8; ++ct) { const f32x4 d = mfma16(A, Bb[ct], zero); *(LAS f32x4*)(BUt + (16 * ct + il) * BU_LD + 4 * g4) = d; }
#pragma unroll
        for (int q = 0; q < 4; ++q) { const f32x4 br = *(const LAS f32x4*)(BUt + L.lane * BU_LD + 4 * q), bi = *(const LAS f32x4*)(BUt + (64 + L.lane) * BU_LD + 4 * q);
#pragma unroll
            for (int e = 0; e < 4; ++e) { const float nr = lr * xr - li * xi + br[e], ni = lr * xi + li * xr + bi[e]; xr = nr; xi = ni;
                if (FULL) { Xs[(4 * q + e) * XS_LD + L.lane] = f2bf_(xr); Xs[(4 * q + e) * XS_LD + 64 + L.lane] = f2bf_(xi); } } }
        if (FULL) { f32x4 y = mfma16(A, Db, zero);
#pragma unroll
            for (int ks = 0; ks < 4; ++ks) { const bf16x8 Ax = *(const LAS bf16x8*)(Xs + il * XS_LD + 32 * ks + 8 * g4); y = mfma16(Ax, Cb[ks], y); }
            gy[s][0] = cvtpk(gelu_tanh(y[0]), gelu_tanh(y[1])); gy[s][1] = cvtpk(gelu_tanh(y[2]), gelu_tanh(y[3])); }
        asm volatile("" : "+v"(xr), "+v"(xi) :: "memory");
    }
}
__device__ __forceinline__ void ma_s5_unit(Frame& F, const Loc& L, int l, int b, int c, float* outb) {
    const bf16* Pc = (const bf16*)(F.ws + WS_PROJ) + ((size_t)b * TB + c * 128) * NIN; unsigned gy[8][2];
#pragma unroll
    for (int gi = 0; gi < 2; ++gi) { const int gidx = 2 * L.wave + gi; float xr = 0.f, xi = 0.f; s5_group<false>(F, L, l, gidx, Pc, xr, xi, gy);
        float* xo = (float*)((unsigned char*)outb + OUT_S5X) + (((size_t)(b * NCH + c) * 16 + gidx) * 64 + L.lane) * 2; xo[0] = xr; xo[1] = xi; }
    __syncthreads();
}
__device__ __forceinline__ void mb_s5(Frame& F, const Loc& L, int l, float* outb) {
    const int gt = L.vcu * NT + L.tid, NGT = L.G * NT;
    for (int e = gt; e < 2 * 16 * 64; e += NGT) { const int b = e >> 10, gp = e & 1023; const float* lb = (const float*)(F.ws + WS_LB128) + (size_t)(l * 1024 + gp) * 2; const float dr = lb[0], di = lb[1];
        float* p = (float*)((unsigned char*)outb + OUT_S5X) + ((size_t)b * NCH * 1024 + gp) * 2; float sr = 0.f, si = 0.f;
        for (int c = 0; c < NCH; ++c) { const float a = p[(size_t)c * 2048], bb = p[(size_t)c * 2048 + 1]; p[(size_t)c * 2048] = sr; p[(size_t)c * 2048 + 1] = si; const float nr = dr * sr - di * si + a, ni = dr * si + di * sr + bb; sr = nr; si = ni; } }
}
__device__ __forceinline__ void mc_s5_unit(Frame& F, const Loc& L, int l, int b, int c, const float* outb) {
    const size_t row0 = (size_t)b * TB + c * 128; const bf16* Pc = (const bf16*)(F.ws + WS_PROJ) + row0 * NIN;
    const int il = L.lane & 15, g4 = L.lane >> 4, w = L.wave;
    unsigned gy[2][8][2];
#pragma unroll
    for (int gi = 0; gi < 2; ++gi) { const int gidx = 2 * w + gi; const float* xo = (const float*)((const unsigned char*)outb + OUT_S5X) + (((size_t)(b * NCH + c) * 16 + gidx) * 64 + L.lane) * 2; float xr = xo[0], xi = xo[1];
        s5_group<true>(F, L, l, gidx, Pc, xr, xi, gy[gi]); }
    __syncthreads();
    LAS bf16* GYs = (LAS bf16*)F.lds; LAS float* RED = (LAS float*)(F.lds + 128 * GY_LD * 2); LAS float* RSTD = RED + 1024;
#pragma unroll
    for (int gi = 0; gi < 2; ++gi)
#pragma unroll
        for (int s = 0; s < 8; ++s)
#pragma unroll
            for (int r = 0; r < 4; ++r) GYs[(16 * s + 4 * g4 + r) * GY_LD + 16 * (2 * w + gi) + il] = (bf16)(gy[gi][s][r >> 1] >> (16 * (r & 1)));
    __syncthreads();
    const f32x4 zero = {0.f, 0.f, 0.f, 0.f}; f32x4 acc[8][2];
#pragma unroll
    for (int tt = 0; tt < 8; ++tt) { acc[tt][0] = zero; acc[tt][1] = zero; }
    const bf16* WG = (const bf16*)(F.ws + WS_WGT) + (size_t)l * 65536;
#pragma unroll
    for (int ks = 0; ks < 8; ++ks) { const bf16x8 W0 = *(const bf16x8*)(WG + (size_t)(32 * w + il) * 256 + 32 * ks + 8 * g4), W1 = *(const bf16x8*)(WG + (size_t)(32 * w + 16 + il) * 256 + 32 * ks + 8 * g4);
#pragma unroll
        for (int tt = 0; tt < 8; ++tt) { const bf16x8 Ag = *(const LAS bf16x8*)(GYs + (16 * tt + il) * GY_LD + 32 * ks + 8 * g4); acc[tt][0] = mfma16(W0, Ag, acc[tt][0]); acc[tt][1] = mfma16(W1, Ag, acc[tt][1]); }
        asm volatile("" ::: "memory"); }
#pragma unroll
    for (int tt = 0; tt < 8; ++tt) { float ss = 0.f;
#pragma unroll
        for (int nt = 0; nt < 2; ++nt) { const unsigned long long gq = *(const LAS unsigned long long*)(GYs + (16 * tt + il) * GY_LD + 32 * w + 16 * nt + 4 * g4);
#pragma unroll
            for (int r = 0; r < 4; ++r) { const float v = bf2f((bf16)(gq >> (16 * r))) * sigmoid_f(acc[tt][nt][r]); acc[tt][nt][r] = v; ss += v * v; } }
        ss += __shfl_xor(ss, 16); ss += __shfl_xor(ss, 32); if (g4 == 0) RED[(16 * tt + il) * 8 + w] = ss; }
    __syncthreads();
    if (L.tid < 128) { const f32x4 a = *(const LAS f32x4*)(RED + L.tid * 8), bq = *(const LAS f32x4*)(RED + L.tid * 8 + 4); RSTD[L.tid] = rsqrtf((((a[0] + a[1]) + (a[2] + a[3])) + ((bq[0] + bq[1]) + (bq[2] + bq[3]))) * (1.0f / 256.0f) + EPS); }
    __syncthreads();
    const float* og = F.in[13] + l * 256; bf16* MX = (bf16*)(F.ws + WS_MIXED) + row0 * D;
#pragma unroll
    for (int tt = 0; tt < 8; ++tt) { const float rs = RSTD[16 * tt + il];
#pragma unroll
        for (int nt = 0; nt < 2; ++nt) { const int n0 = 32 * w + 16 * nt + 4 * g4; const f32x4 o4 = *(const f32x4*)(og + n0);
            *(GAS unsigned long long*)((char*)(MX + (size_t)16 * tt * D) + (unsigned)(il * D + n0) * 2u) = (unsigned long long)cvtpk(acc[tt][nt][0] * rs * o4[0], acc[tt][nt][1] * rs * o4[1]) | ((unsigned long long)cvtpk(acc[tt][nt][2] * rs * o4[2], acc[tt][nt][3] * rs * o4[3]) << 32); } }
    __syncthreads();
}
__device__ __forceinline__ void p_ma(Frame& F, int l, float* outb) {
    { const Loc L = make_loc(); for (int u = L.bx; u < 130; u += L.G) ma_s5_unit(F, L, l, u / NCH, u % NCH, outb); }
    { const Loc L = make_loc(); for (int u = (L.bx + 126) % L.G; u < 520; u += L.G) ma_hg_unit(F, L, l, u / 260, (u % 260) >> 2, u & 3, outb); }
    { const Loc L = make_loc(); for (int u = (L.bx + 126) % L.G; u < 1040; u += L.G) ma_ret_unit(F, L, u / 520, (u % 520) >> 3, u & 7, outb); }
}
__device__ __forceinline__ void p_mb(Frame& F, int l, float* outb) { const Loc L = make_loc(); mb_ret(L, outb); mb_hg(L, outb); mb_s5(F, L, l, outb); }
__device__ __forceinline__ void p_mc(Frame& F, int l, const float* outb) {
    { const Loc L = make_loc(); for (int u = L.bx; u < 130; u += L.G) mc_s5_unit(F, L, l, u / NCH, u % NCH, outb); }
    { const Loc L = make_loc(); for (int u = (L.bx + 126) % L.G; u < 520; u += L.G) mc_hg_unit(F, L, l, u / 260, (u % 260) >> 2, u & 3, outb); }
    { const Loc L = make_loc(); for (int u = (L.bx + 126) % L.G; u < 1040; u += L.G) mc_ret_unit(F, L, l, u / 520, (u % 520) >> 3, u & 7, outb); }
}
constexpr int MOETBL_OFF = SEG_OFF + 2048;
static_assert(MOETBL_OFF % 16 == 0 && MOETBL_OFF + 64 <= LDS_BYTES, "LDS map (MoE table)");
__device__ __forceinline__ void moe_table(Frame& F) {
    if (threadIdx.x == 0) { LAS int* tbl = (LAS int*)(F.lds + MOETBL_OFF); const unsigned* cnt = (const unsigned*)(F.ctl + CW_CNT); int acc = 0;
        for (int e = 0; e < 8; ++e) { tbl[e] = acc; acc += ((int)cnt[e] + 255) >> 8; } tbl[8] = acc; }
    __syncthreads();
}
__device__ __forceinline__ void p_w2conv(Frame& F) {
    const Loc L = make_loc(); LAS float* scr = (LAS float*)(F.lds + RING_OFF + L.wave * 16384); const int gw = L.vcu * NWAVES + L.wave, NGW = L.G * NWAVES; constexpr int I_M2 = 56 * 32;
    for (int it = gw; it < 8 * I_M2; it += NGW) { const int e = it / I_M2; tr_item(F.in[26] + (size_t)e * DFE * D, DFE, D, (bf16*)(F.ws + WS_WM2) + (size_t)e * D * DFE, 0, nullptr, scr, it % I_M2, L.lane); }
}
__device__ __forceinline__ void p_route(Frame& F) {
    const Loc L = make_loc();
    const float* H = (const float*)(F.ws + WS_H); const float* gff = F.in[19] + D; const float* R = F.in[23];
    int* POS = (int*)(F.ws + WS_POS); float* GATE = (float*)(F.ws + WS_GATE); int* LIST = (int*)(F.ws + WS_LIST); unsigned* CNT = (unsigned*)(F.ctl + CW_CNT);
    LAS float* RT = (LAS float*)F.lds;
    for (int grp = L.bx; grp < BATCH * SEQ / 64; grp += L.G) {
        for (int j = 0; j < 8; ++j) { const int tk = grp * 64 + L.wave * 8 + j; const size_t m = (size_t)(tk / SEQ) * TB + 128 + (tk % SEQ);
            float ss = 0.f, part[8];
#pragma unroll
            for (int e = 0; e < 8; ++e) part[e] = 0.f;
#pragma unroll
            for (int jj = 0; jj < 4; ++jj) { const f32x4 v = ((const GAS f32x4*)(H + m * D))[L.lane + 64 * jj]; const int d0 = 4 * L.lane + 256 * jj;
                ss += (v.x * v.x + v.y * v.y) + (v.z * v.z + v.w * v.w);
#pragma unroll
                for (int q = 0; q < 4; ++q) { const float hv = v[q] * gff[d0 + q]; const f32x4 r0 = *(const f32x4*)(R + (d0 + q) * 8), r1 = *(const f32x4*)(R + (d0 + q) * 8 + 4);
                    part[0] += hv * r0.x; part[1] += hv * r0.y; part[2] += hv * r0.z; part[3] += hv * r0.w; part[4] += hv * r1.x; part[5] += hv * r1.y; part[6] += hv * r1.z; part[7] += hv * r1.w; } }
            const float rstd = rsqrtf(wave_sum(ss) * (1.0f / 1024.0f) + EPS); float lg[8];
#pragma unroll
            for (int e = 0; e < 8; ++e) lg[e] = wave_sum(part[e]) * rstd;
            int i1 = 0; float l1 = lg[0];
#pragma unroll
            for (int e = 1; e < 8; ++e) if (lg[e] > l1) { l1 = lg[e]; i1 = e; }
            int i2 = -1; float l2 = -3.0e38f;
#pragma unroll
            for (int e = 0; e < 8; ++e) if (e != i1 && lg[e] > l2) { l2 = lg[e]; i2 = e; }
            const float e2 = __expf(l2 - l1), g1 = 1.0f / (1.0f + e2), g2 = e2 * g1;
            if (L.lane == 0) { const int sl = L.wave * 8 + j; RT[sl * 4 + 0] = __int_as_float(i1); RT[sl * 4 + 1] = __int_as_float(i2); RT[sl * 4 + 2] = g1; RT[sl * 4 + 3] = g2; } }
        __syncthreads();
        if (L.wave == 0) { const int tk = grp * 64 + L.lane; const int e1 = __float_as_int(RT[L.lane * 4 + 0]), e2 = __float_as_int(RT[L.lane * 4 + 1]); const float g1 = RT[L.lane * 4 + 2], g2 = RT[L.lane * 4 + 3];
            const int row = (tk / SEQ) * TB + 128 + (tk % SEQ); const unsigned long long lt = (1ull << L.lane) - 1ull; int p1 = 0, p2 = 0;
#pragma unroll
            for (int e = 0; e < 8; ++e) { const unsigned long long m1 = __ballot(e1 == e), m2 = __ballot(e2 == e); const int n1 = __popcll(m1), n2 = __popcll(m2);
                unsigned base = 0u; if (L.lane == 0 && n1 + n2 > 0) base = atomicAdd(CNT + e, (unsigned)(n1 + n2)); base = __shfl(base, 0);
                if (e1 == e) p1 = (int)base + __popcll(m1 & lt); if (e2 == e) p2 = (int)base + n1 + __popcll(m2 & lt); }
            LIST[(size_t)e1 * MOE_CAP + p1] = row; LIST[(size_t)e2 * MOE_CAP + p2] = row;
            POS[tk * 2] = (e1 << 20) | p1; POS[tk * 2 + 1] = (e2 << 20) | p2; GATE[tk * 2] = g1; GATE[tk * 2 + 1] = g2; }
        __syncthreads();
    }
}
__device__ __forceinline__ void p_final(Frame& F, float* out) {
    const Loc L = make_loc();
    const int gw = L.vcu * NWAVES + L.wave, NGW = L.G * NWAVES; const float* H = (const float*)(F.ws + WS_H); const float* gf = F.in[27];
    const int* POS = (const int*)(F.ws + WS_POS); const float* GATE = (const float*)(F.ws + WS_GATE); const bf16* YS = (const bf16*)(F.ws + WS_YS); const unsigned* CNT = (const unsigned*)(F.ctl + CW_CNT);
    moe_table(F); const LAS int* tbl = (const LAS int*)(F.lds + MOETBL_OFF);
    for (int r = gw; r < BATCH * SEQ; r += NGW) { const int b = r / SEQ, t = r % SEQ; const size_t m = (size_t)b * TB + 128 + t;
        const int q1 = POS[r * 2], q2 = POS[r * 2 + 1]; const float g1 = GATE[r * 2], g2 = GATE[r * 2 + 1]; const int t1 = tbl[q1 >> 20], t2 = tbl[q2 >> 20];
        const size_t s1 = (size_t)t1 * 256 + (q1 & 0xfffff), s2 = (size_t)t2 * 256 + (q2 & 0xfffff);
        f32x4 v[4]; float s = 0.f;
#pragma unroll
        for (int j = 0; j < 4; ++j) { v[j] = ((const GAS f32x4*)(H + m * D))[L.lane + 64 * j];
            const unsigned long long y1 = ((const GAS unsigned long long*)(YS + s1 * D))[L.lane + 64 * j], y2 = ((const GAS unsigned long long*)(YS + s2 * D))[L.lane + 64 * j];
#pragma unroll
            for (int q = 0; q < 4; ++q) v[j][q] += g1 * bf2f((bf16)(y1 >> (16 * q))) + g2 * bf2f((bf16)(y2 >> (16 * q)));
            s += (v[j].x * v[j].x + v[j].y * v[j].y) + (v[j].z * v[j].z + v[j].w * v[j].w); }
        const float rstd = rsqrtf(wave_sum(s) * (1.0f / 1024.0f) + EPS);
#pragma unroll
        for (int j = 0; j < 4; ++j) { const f32x4 g = ((const GAS f32x4*)gf)[L.lane + 64 * j]; ((GAS f32x4*)(out + (size_t)r * D))[L.lane + 64 * j] = v[j] * rstd * g; }
    }
}

struct Args { const float* in[28]; float* out; unsigned char* ws; int ph_lo, ph_hi, li, pad; };
__global__ void __launch_bounds__(NWAVES * 64, 2) mk_fwd(Args args) {
    extern __shared__ __attribute__((aligned(16))) unsigned char lds[];
    Frame F;
    F.lds = (LAS unsigned char*)lds; F.MISC = (volatile LAS unsigned*)(F.lds + MISC_OFF);
    F.ws = args.ws; F.ctl = (gu32*)(args.ws + WS_CTL); F.in = args.in;
    for (int u = threadIdx.x; u < (LDS_BYTES - LDSCTL_OFF) / 4; u += NWAVES * 64) ((LAS unsigned*)(F.lds + LDSCTL_OFF))[u] = 0u;
    __syncthreads();
    XcdBarrier bar; bar.bar = (unsigned*)(F.ctl + CW_BAR); bar.x = 0; bar.st = nullptr;
    if (!MK_PER_PHASE) bar = xcd_barrier_post((unsigned*)(F.ctl + CW_BAR), F.MISC + 8);
    const int lo = args.ph_lo, hi = args.ph_hi;
#define IN(k) (lo <= (k) && (k) < hi)
#define SEAM(k) do { if (!MK_PER_PHASE && (k) + 1 < hi) xcd_barrier(bar); } while (0)
    unsigned char* ws = args.ws;
    float* SS = (float*)(ws + WS_SSP);
    if (IN(0)) { p0_prologue(F); SEAM(0); }
    for (int l = 0; l < 2; ++l) {
        const int base = 1 + 30 * l;
        if (IN(base + 0)) {
            pg8::Gemm g{(const bf16*)(ws + WS_HB), (const bf16*)(ws + WS_WIN) + (size_t)l * NIN * D, M, NIN, D}; pg8::StaticOrder S; const Loc L = make_loc(); S.init(M, NIN, L.G, L.bx);
            pg8::EpiProj E{(bf16*)(ws + WS_PROJ), NIN, SS + (size_t)(2 * l) * M * 16};
            pg8::gemm_phase<pg8::EpiProj, pg8::StaticOrder, true, true>(F.lds + RING_OFF, g, S, E);
            SEAM(base + 0);
        }
        if (IN(base + 1)) { p_ma(F, l, args.out); SEAM(base + 1); }
        if (IN(base + 2)) { p_mb(F, l, args.out); SEAM(base + 2); }
        if (IN(base + 3)) { p_mc(F, l, args.out); SEAM(base + 3); }
        if (IN(base + 6)) {
            pg8::Gemm g{(const bf16*)(ws + WS_MIXED), (const bf16*)(ws + WS_WOUT) + (size_t)l * D * D, M, D, D}; pg8::StaticOrder S; const Loc L = make_loc(); S.init(M, D, L.G, L.bx);
            pg8::EpiResid E{(float*)(ws + WS_H), (bf16*)(ws + WS_HB), SS + (size_t)(2 * l + 1) * M * 16, nullptr, 0, 1};
            pg8::gemm_phase<pg8::EpiResid, pg8::StaticOrder, true, true>(F.lds + RING_OFF, g, S, E);
            SEAM(base + 6);
        }
        if (l == 0) {
            if (IN(base + 8)) {
                pg8::Gemm g{(const bf16*)(ws + WS_HB), (const bf16*)(ws + WS_WF13), M, 2 * DFF, D}; pg8::StaticOrder S; const Loc L = make_loc(); S.init(M, 2 * DFF, L.G, L.bx);
                pg8::EpiSwiglu E{(bf16*)(ws + WS_ACT), DFF, SS + (size_t)1 * M * 16};
                pg8::gemm_phase<pg8::EpiSwiglu, pg8::StaticOrder, true, true>(F.lds + RING_OFF, g, S, E);
                SEAM(base + 8);
            }
            if (IN(base + 9)) {
                pg8::Gemm g{(const bf16*)(ws + WS_ACT), (const bf16*)(ws + WS_WF2), M, D, DFF}; pg8::StaticOrder S; const Loc L = make_loc(); S.init(M, D, L.G, L.bx);
                pg8::EpiResid E{(float*)(ws + WS_H), (bf16*)(ws + WS_HB), SS + (size_t)2 * M * 16, nullptr, 0, 1};
                pg8::gemm_phase<pg8::EpiResid, pg8::StaticOrder, true, true>(F.lds + RING_OFF, g, S, E);
                SEAM(base + 9);
            }
        } else {
            if (IN(base + 7)) { p_route(F); SEAM(base + 7); }
            if (IN(base + 10)) {
                pg8::Gemm g{(const bf16*)(ws + WS_HB), (const bf16*)(ws + WS_WM13), MOE_TMAX * 256, NEXP * 2 * DFE, D}; const Loc L = make_loc();
                moe_table(F); pg8::MoeOrder<true> S; S.init((const int*)(F.ctl + CW_CNT), (const int*)(ws + WS_LIST), MOE_CAP, 2 * DFE / 256, L.G, L.bx, (const LAS int*)(F.lds + MOETBL_OFF));
                pg8::EpiSwigluMoe E{(bf16*)(ws + WS_ACT), DFE, SS + (size_t)3 * M * 16, (const int*)(ws + WS_LIST), MOE_CAP, 2 * DFE / 256};
                pg8::gemm_phase<pg8::EpiSwigluMoe, pg8::MoeOrder<true>, true, true>(F.lds + RING_OFF, g, S, E);
                SEAM(base + 10);
            }
            if (IN(base + 11)) { p_w2conv(F); SEAM(base + 11); }
            if (IN(base + 12)) {
                pg8::Gemm g{(const bf16*)(ws + WS_ACT), (const bf16*)(ws + WS_WM2), MOE_TMAX * 256, NEXP * D, DFE}; const Loc L = make_loc();
                moe_table(F); pg8::MoeOrder<false> S; S.init((const int*)(F.ctl + CW_CNT), (const int*)(ws + WS_LIST), MOE_CAP, D / 256, L.G, L.bx, (const LAS int*)(F.lds + MOETBL_OFF));
                pg8::EpiYs E{(bf16*)(ws + WS_YS)};
                pg8::gemm_phase<pg8::EpiYs, pg8::MoeOrder<false>, true, true>(F.lds + RING_OFF, g, S, E);
                SEAM(base + 12);
            }
        }
    }
    if (IN(NPH - 1)) p_final(F, args.out);
#undef IN
#undef SEAM
}

extern "C" void kernel_launch(void* const* d_in, const int* in_sizes, int n_in, void* d_out, int out_size, void* d_ws, size_t ws_size, hipStream_t stream) {
    static int grid = 0;
    if (grid == 0) {
        if (n_in != 28 || out_size != BATCH * SEQ * D || ws_size < WS_END) { fprintf(stderr, "kernel_launch: unexpected shapes: n_in %d out %d ws %zu (need %zu)\n", n_in, out_size, ws_size, (size_t)WS_END); grid = -1; return; }
        int dev = 0, cus = 0, per_cu = 0;
        if (hipGetDevice(&dev) != hipSuccess || hipDeviceGetAttribute(&cus, hipDeviceAttributeMultiprocessorCount, dev) != hipSuccess) { grid = -1; return; }
        if (hipFuncSetAttribute((const void*)mk_fwd, hipFuncAttributeMaxDynamicSharedMemorySize, LDS_BYTES) != hipSuccess) { fprintf(stderr, "kernel_launch: hipFuncSetAttribute failed\n"); grid = -1; return; }
        if (hipOccupancyMaxActiveBlocksPerMultiprocessor(&per_cu, (const void*)mk_fwd, NWAVES * 64, LDS_BYTES) != hipSuccess || per_cu < 1) { fprintf(stderr, "kernel_launch: occupancy query says %d\n", per_cu); }
        (void)hipGetLastError();
        grid = cus;
    }
    if (grid < 0) return;
    if (hipMemsetAsync((char*)d_ws + WS_CTL, 0, CTL_ZERO_BYTES, stream) != hipSuccess) return;
    Args a{};
    for (int i = 0; i < 28; ++i) a.in[i] = (const float*)d_in[i];
    a.out = (float*)d_out; a.ws = (unsigned char*)d_ws;
#if MK_PER_PHASE
    for (int k = 0; k < NPH; ++k) { if (!phase_exists(k)) continue; a.ph_lo = k; a.ph_hi = k + 1; a.li = 0; hipLaunchKernelGGL(mk_fwd, dim3(grid), dim3(NWAVES * 64), LDS_BYTES, stream, a); }
#else
    a.ph_lo = 0; a.ph_hi = NPH; a.li = 0;
    hipLaunchKernelGGL(mk_fwd, dim3(grid), dim3(NWAVES * 64), LDS_BYTES, stream, a);
#endif
}
```

```cpp
#include <hip/hip_runtime.h>
#include <cstdio>
#include <cstdint>
#include <cmath>
#define PIN4(a, b, c, d) asm volatile("" : "+v"(a), "+v"(b), "+v"(c), "+v"(d) :: "memory")
#define PIN8(a, b, c, d, e, f, g, h) asm volatile("" : "+v"(a), "+v"(b), "+v"(c), "+v"(d), "+v"(e), "+v"(f), "+v"(g), "+v"(h) :: "memory")
#define PIN16O(A, o) asm volatile("" : "+v"(A[(o) + 0]), "+v"(A[(o) + 1]), "+v"(A[(o) + 2]), "+v"(A[(o) + 3]), "+v"(A[(o) + 4]), "+v"(A[(o) + 5]), "+v"(A[(o) + 6]), "+v"(A[(o) + 7]), "+v"(A[(o) + 8]), "+v"(A[(o) + 9]), "+v"(A[(o) + 10]), "+v"(A[(o) + 11]), "+v"(A[(o) + 12]), "+v"(A[(o) + 13]), "+v"(A[(o) + 14]), "+v"(A[(o) + 15]) :: "memory")
#define PIN16(A) asm volatile("" : "+v"(A[0]), "+v"(A[1]), "+v"(A[2]), "+v"(A[3]), "+v"(A[4]), "+v"(A[5]), "+v"(A[6]), "+v"(A[7]), "+v"(A[8]), "+v"(A[9]), "+v"(A[10]), "+v"(A[11]), "+v"(A[12]), "+v"(A[13]), "+v"(A[14]), "+v"(A[15]) :: "memory")
__device__ __forceinline__ int mk_tid(int wave_s) { int z = 0; asm volatile("" : "+v"(z)); return wave_s * 64 + (int)__builtin_amdgcn_mbcnt_hi(~0u, __builtin_amdgcn_mbcnt_lo(~0u, (unsigned)z)); }
namespace pg8 {
#define PG8_LAS __attribute__((address_space(3)))
typedef unsigned short bf16_t;
typedef short bf16x8 __attribute__((ext_vector_type(8)));
typedef float f32x4 __attribute__((ext_vector_type(4)));
typedef unsigned u32x4 __attribute__((ext_vector_type(4)));
constexpr int BM = 256, BK = 64, HALF = 128, HTB = HALF * BK * 2  , STAGE_BYTES = 8 * HTB, NXCD = 8, WGM = 8;

__host__ __device__ __forceinline__ int lds_byte(int r, int c) { const int st = (r >> 4) * 2 + (c >> 5), rr = r & 15, cc = c & 31, ob = rr * 64 + cc * 2; return st * 1024 + (ob ^ (((ob >> 9) & 1) << 5)); }
__host__ __device__ __forceinline__ void stage_rc(int b, int& R, int& C) { const int st = b / 1024, sb = b % 1024, swz = sb ^ (((sb >> 9) & 1) << 5); R = (st >> 1) * 16 + swz / 64; C = (st & 1) * 32 + (swz % 64) / 2; }
__host__ __device__ __forceinline__ int perm32(int rho) { const int n = rho >> 4, i = rho & 15; return 8 * (i >> 2) + 4 * n + (i & 3); }

struct Unit { int pm, pn, e, r0, ce; };
struct Gemm { const bf16_t* A; const bf16_t* Bt; int M, N, K, wv; };

struct StaticOrder {
    static constexpr bool GATHER = false;
    int nM, nN, nwg, G, c;
    __host__ __device__ void init(int M, int N, int G_, int c_) { nM = M / BM; nN = N / BM; nwg = nM * nN; G = G_; c = c_; }
    __host__ __device__ bool next(int i, Unit& u) const {
        const long L = (long)i * G + c; if (L >= nwg) return false;
        int wgid = (int)L; { const int q = nwg / NXCD, r = nwg % NXCD, xcd = wgid % NXCD, off = wgid / NXCD; wgid = (xcd < r ? xcd * (q + 1) : r * (q + 1) + (xcd - r) * q) + off; }
        const int nig = WGM * nN, gid = wgid / nig, fm = gid * WGM, gsz = (nM - fm) < WGM ? (nM - fm) : WGM;
        u.pm = fm + ((wgid % nig) % gsz); u.pn = (wgid % nig) / gsz; return true;
    }
    __device__ __forceinline__ void a_ready(const Unit&) const {}
    __device__ __forceinline__ void done(const Unit&) const {}
    __device__ __forceinline__ int arow(const Unit&, int) const { return 0; }
};

__device__ __forceinline__ unsigned cvt_pk_bf16(float lo, float hi) { unsigned r; asm volatile("v_cvt_pk_bf16_f32 %0, %1, %2" : "=v"(r) : "v"(lo), "v"(hi)); return r; }
typedef float f32x2 __attribute__((ext_vector_type(2)));
constexpr float RMS_EPS = 1e-6f;
__device__ __forceinline__ float fast_silu(float a) { return a * __builtin_amdgcn_rcpf(1.0f + __expf(-a)); }
__device__ __forceinline__ float row_rstd(const float* ss, int row) { const f32x4* p = (const f32x4*)(ss + (size_t)row * 16); const f32x4 a = p[0], b = p[1], c = p[2], d = p[3];
    const float t = (((a[0] + a[1]) + (a[2] + a[3])) + ((b[0] + b[1]) + (b[2] + b[3]))) + (((c[0] + c[1]) + (c[2] + c[3])) + ((d[0] + d[1]) + (d[2] + d[3])));
    return __builtin_amdgcn_rsqf(t * (1.0f / 1024.0f) + RMS_EPS); }
struct EpiProj {
    static constexpr bool PERM = true, AFTER_DRAIN = false;
    bf16_t* O; int ldc; const float* ss;
    __device__ __forceinline__ void operator()(const f32x4 (&acc)[2][2][4][2], const Unit& u, int wr, int wc, int fr, int fq) const {
        const int row0 = u.pm * BM + wr * 64 + fr, col0 = u.pn * BM + wc * 32 + 8 * fq;
#pragma unroll
        for (int ai = 0; ai < 2; ++ai)
#pragma unroll
            for (int m = 0; m < 4; ++m) { const int row = row0 + ai * HALF + m * 16; const float sc = row_rstd(ss, row);
                bf16_t* rowp = O + (size_t)row * ldc + col0;
#pragma unroll
                for (int bj = 0; bj < 2; ++bj) { const f32x4 v0 = acc[ai][bj][m][0] * sc, v1 = acc[ai][bj][m][1] * sc;
                    u32x4 w; w.x = cvt_pk_bf16(v0[0], v0[1]); w.y = cvt_pk_bf16(v0[2], v0[3]); w.z = cvt_pk_bf16(v1[0], v1[1]); w.w = cvt_pk_bf16(v1[2], v1[3]);
                    *(u32x4*)(rowp + bj * HALF) = w; } }
    }
};
struct EpiSwiglu {
    static constexpr bool PERM = true, AFTER_DRAIN = false;
    bf16_t* O; int ldc; const float* ss;
    __device__ __forceinline__ void operator()(const f32x4 (&acc)[2][2][4][2], const Unit& u, int wr, int wc, int fr, int fq) const {
        const int row0 = u.pm * BM + wr * 64 + fr, col0 = u.pn * HALF + wc * 32 + 8 * fq;
#pragma unroll
        for (int ai = 0; ai < 2; ++ai)
#pragma unroll
            for (int m = 0; m < 4; ++m) { const int row = row0 + ai * HALF + m * 16; const float sc = row_rstd(ss, row);
                const f32x4 a0 = acc[ai][0][m][0] * sc, a1 = acc[ai][0][m][1] * sc, b0 = acc[ai][1][m][0] * sc, b1 = acc[ai][1][m][1] * sc;
                u32x4 w; w.x = cvt_pk_bf16(fast_silu(a0[0]) * b0[0], fast_silu(a0[1]) * b0[1]); w.y = cvt_pk_bf16(fast_silu(a0[2]) * b0[2], fast_silu(a0[3]) * b0[3]);
                w.z = cvt_pk_bf16(fast_silu(a1[0]) * b1[0], fast_silu(a1[1]) * b1[1]); w.w = cvt_pk_bf16(fast_silu(a1[2]) * b1[2], fast_silu(a1[3]) * b1[3]);
                *(u32x4*)(O + (size_t)row * ldc + col0) = w; }
    }
};
struct EpiResid {
    static constexpr bool PERM = false, AFTER_DRAIN = false;
    float* H; bf16_t* HB; float* ssout; const float* gate; int gstride; int write_hb;
    __device__ __forceinline__ void operator()(const f32x4 (&acc)[2][2][4][2], const Unit& u, int wr, int wc, int fr, int fq) const {
        const int row0 = u.pm * BM + wr * 64 + fr, col0 = u.pn * BM + wc * 32 + 4 * fq;
#pragma unroll
        for (int ai = 0; ai < 2; ++ai)
#pragma unroll
            for (int m = 0; m < 4; ++m) { const int row = row0 + ai * HALF + m * 16; const float g = gate ? gate[(size_t)row * gstride] : 1.0f;
                float* hp = H + (size_t)row * 1024 + col0; float s = 0.f;
                f32x4 hv[2][2];
#pragma unroll
                for (int bj = 0; bj < 2; ++bj)
#pragma unroll
                    for (int n = 0; n < 2; ++n) hv[bj][n] = *(const f32x4*)(hp + bj * HALF + n * 16);
                PIN4(hv[0][0], hv[0][1], hv[1][0], hv[1][1]);
#pragma unroll
                for (int bj = 0; bj < 2; ++bj)
#pragma unroll
                    for (int n = 0; n < 2; ++n) { float* p = hp + bj * HALF + n * 16; const f32x4 o = hv[bj][n] + acc[ai][bj][m][n] * g; *(f32x4*)p = o;
                        s += (o[0] * o[0] + o[1] * o[1]) + (o[2] * o[2] + o[3] * o[3]);
                        if (write_hb) { unsigned long long w = (unsigned long long)cvt_pk_bf16(o[0], o[1]) | ((unsigned long long)cvt_pk_bf16(o[2], o[3]) << 32);
                            *(unsigned long long*)(HB + (size_t)row * 1024 + col0 + bj * HALF + n * 16) = w; } }
                if (write_hb) { s += __shfl_xor(s, 16); s += __shfl_xor(s, 32); if (fq == 0) ssout[(size_t)row * 16 + u.pn * 4 + wc] = s; } }
    }
};

template <bool GATH> struct MoeOrder {
    static constexpr bool GATHER = GATH;
    int nNe, nT, nwg, G, c, cap; const int* list; const int* cnt; const PG8_LAS int* tbl;
    __device__ __forceinline__ void init(const int* cnt_, const int* list_, int cap_, int nNe_, int G_, int c_, const PG8_LAS int* tbl_) { list = list_; cnt = cnt_; tbl = tbl_; cap = cap_; nNe = nNe_; G = G_; c = c_; nT = tbl_[8]; nwg = nT * nNe; }
    __device__ __forceinline__ bool next(int i, Unit& u) const {
        const long L = (long)i * G + c; if (L >= nwg) return false;
        int wgid = (int)L; { const int q = nwg / NXCD, r = nwg % NXCD, xcd = wgid % NXCD, off = wgid / NXCD; wgid = (xcd < r ? xcd * (q + 1) : r * (q + 1) + (xcd - r) * q) + off; }
        const int nig = WGM * nNe, gid = wgid / nig, fm = gid * WGM, gsz = (nT - fm) < WGM ? (nT - fm) : WGM;
        const int t = fm + ((wgid % nig) % gsz), pnl = (wgid % nig) / gsz;
        int e = 0;
#pragma unroll
        for (int k = 1; k < 8; ++k) e += (t >= tbl[k]) ? 1 : 0;
        e = __builtin_amdgcn_readfirstlane(e);
        u.pm = t; u.pn = e * nNe + pnl; u.e = e; u.r0 = (t - __builtin_amdgcn_readfirstlane(tbl[e])) * BM; u.ce = cnt[e]; return true;
    }
    __device__ __forceinline__ int arow(const Unit& u, int R) const { const int pos = u.r0 + R; return pos < u.ce ? list[(size_t)u.e * cap + pos] : 0; }
    __device__ __forceinline__ void a_ready(const Unit&) const {}
    __device__ __forceinline__ void done(const Unit&) const {}
};
struct EpiSwigluMoe {
    static constexpr bool PERM = true, AFTER_DRAIN = false;
    bf16_t* O; int ldc; const float* ss; const int* list; int cap, nNe;
    __device__ __forceinline__ void operator()(const f32x4 (&acc)[2][2][4][2], const Unit& u, int wr, int wc, int fr, int fq) const {
        const int r0 = wr * 64 + fr, col0 = (u.pn - u.e * nNe) * HALF + wc * 32 + 8 * fq;
#pragma unroll
        for (int ai = 0; ai < 2; ++ai)
#pragma unroll
            for (int m = 0; m < 4; ++m) { const int R = r0 + ai * HALF + m * 16, pos = u.r0 + R; const int tok = pos < u.ce ? list[(size_t)u.e * cap + pos] : 0; const float sc = row_rstd(ss, tok);
                const f32x4 a0 = acc[ai][0][m][0] * sc, a1 = acc[ai][0][m][1] * sc, b0 = acc[ai][1][m][0] * sc, b1 = acc[ai][1][m][1] * sc;
                u32x4 w; w.x = cvt_pk_bf16(fast_silu(a0[0]) * b0[0], fast_silu(a0[1]) * b0[1]); w.y = cvt_pk_bf16(fast_silu(a0[2]) * b0[2], fast_silu(a0[3]) * b0[3]);
                w.z = cvt_pk_bf16(fast_silu(a1[0]) * b1[0], fast_silu(a1[1]) * b1[1]); w.w = cvt_pk_bf16(fast_silu(a1[2]) * b1[2], fast_silu(a1[3]) * b1[3]);
                *(u32x4*)(O + (size_t)(u.pm * BM + R) * ldc + col0) = w; }
    }
};
struct EpiYs {
    static constexpr bool PERM = true, AFTER_DRAIN = false;
    bf16_t* O;
    __device__ __forceinline__ void operator()(const f32x4 (&acc)[2][2][4][2], const Unit& u, int wr, int wc, int fr, int fq) const {
        const int row0 = u.pm * BM + wr * 64 + fr, col0 = (u.pn - u.e * 4) * BM + wc * 32 + 8 * fq;
#pragma unroll
        for (int ai = 0; ai < 2; ++ai)
#pragma unroll
            for (int m = 0; m < 4; ++m) { bf16_t* rowp = O + (size_t)(row0 + ai * HALF + m * 16) * 1024 + col0;
#pragma unroll
                for (int bj = 0; bj < 2; ++bj) { const f32x4 v0 = acc[ai][bj][m][0], v1 = acc[ai][bj][m][1];
                    u32x4 w; w.x = cvt_pk_bf16(v0[0], v0[1]); w.y = cvt_pk_bf16(v0[2], v0[3]); w.z = cvt_pk_bf16(v1[0], v1[1]); w.w = cvt_pk_bf16(v1[2], v1[3]);
                    *(u32x4*)(rowp + bj * HALF) = w; } }
    }
};
template <class Epi, class Sched, bool ALIGN_EPI = false, bool SP2 = false>
__device__ __forceinline__ void gemm_phase(PG8_LAS unsigned char* lds, const Gemm g, const Sched& S, const Epi& E) {
    int tid_ = mk_tid(g.wv); asm volatile("" : "+v"(tid_));
    const int tid = tid_, wid = __builtin_amdgcn_readfirstlane(tid >> 6), lane = tid & 63, wr = wid >> 2, wc = wid & 3, fr = lane & 15, fq = lane >> 4;
    const int K = g.K, nt = K / BK;
    unsigned voffA[2], voffB[2];
#pragma unroll
    for (int i = 0; i < 2; ++i) { int R, C; stage_rc(tid * 16 + i * 8192, R, C); const int Rb = Epi::PERM ? ((R & ~31) + perm32(R & 31)) : R;
        voffA[i] = (unsigned)(R * K + C) * 2u; voffB[i] = (unsigned)(Rb * K + C) * 2u; }
    const size_t kstep = (size_t)(BK * 2);
    const size_t hstep = (size_t)HALF * K * 2;
    const size_t tstep = 2 * hstep;
    const unsigned ldsw = (unsigned)wid * 1024u;
    const int aoff = lds_byte(wr * 64 + fr, fq * 8), boff = lds_byte(wc * 32 + fr, fq * 8);
#define PG8_SA(b, h) (((b) * 2 + (h)) * HTB)
#define PG8_SB(b, h) ((4 + (b) * 2 + (h)) * HTB)
#define PG8_STAGE(bufoff, gbase, voff) do { _Pragma("unroll") for (int _i = 0; _i < 2; ++_i) \
        __builtin_amdgcn_global_load_lds((const unsigned*)((const char*)(gbase) + (voff)[_i]), (PG8_LAS unsigned*)(lds + (bufoff) + ldsw + _i * 8192), 16, 0, 0); } while (0)
#define PG8_STAGE_A(bufoff, gbase, hh, NX) do { if constexpr (Sched::GATHER) { const unsigned _o[2] = {((NX) && last) ? ngvo[hh][0] : gvo[hh][0], ((NX) && last) ? ngvo[hh][1] : gvo[hh][1]}; PG8_STAGE(bufoff, gbase, _o); } \
        else { PG8_STAGE(bufoff, (gbase) + ((hh) ? hstep : 0), voffA); } } while (0)
#define PG8_LDA(dst, b, h) do { _Pragma("unroll") for (int m = 0; m < 4; ++m) _Pragma("unroll") for (int k = 0; k < 2; ++k) dst[m][k] = *(const PG8_LAS bf16x8*)(lds + PG8_SA(b, h) + aoff + m * 2048 + k * 1024); } while (0)
#define PG8_LDB(dst, b, h) do { _Pragma("unroll") for (int n = 0; n < 2; ++n) _Pragma("unroll") for (int k = 0; k < 2; ++k) dst[n][k] = *(const PG8_LAS bf16x8*)(lds + PG8_SB(b, h) + boff + n * 2048 + k * 1024); } while (0)
#define PG8_MMA(ai, bj, At, Bt) do { __builtin_amdgcn_s_setprio(1); _Pragma("unroll") for (int m = 0; m < 4; ++m) _Pragma("unroll") for (int n = 0; n < 2; ++n) _Pragma("unroll") for (int k = 0; k < 2; ++k) \
        acc[ai][bj][m][n] = __builtin_amdgcn_mfma_f32_16x16x32_bf16(Bt[n][k], At[m][k], acc[ai][bj][m][n], 0, 0, 0); __builtin_amdgcn_s_setprio(0); } while (0)
#define PG8_WAIT_V(n) asm volatile("s_waitcnt vmcnt(" #n ")" ::: "memory")
#define PG8_WAIT_L(n) asm volatile("s_waitcnt lgkmcnt(" #n ")" ::: "memory")
#define PG8_BAR __builtin_amdgcn_s_barrier()
#define PG8_SCHED __builtin_amdgcn_sched_barrier(0)
    Unit cur, nxt; int ui = 0;
    if (!S.next(0, cur)) return;
    f32x4 acc[2][2][4][2];
#pragma unroll
    for (int a = 0; a < 2; ++a)
#pragma unroll
        for (int b = 0; b < 2; ++b)
#pragma unroll
            for (int m = 0; m < 4; ++m)
#pragma unroll
                for (int n = 0; n < 2; ++n) acc[a][b][m][n] = (f32x4){0.f, 0.f, 0.f, 0.f};
    bf16x8 At[4][2], B0[2][2], B1[2][2];
    const char* cA = (const char*)g.A + (Sched::GATHER ? (size_t)0 : (size_t)cur.pm * tstep); const char* cB = (const char*)g.Bt + (size_t)cur.pn * tstep;
    unsigned gvo[2][2] = {{0u, 0u}, {0u, 0u}}, ngvo[2][2] = {{0u, 0u}, {0u, 0u}}; const bool last = false;
    if constexpr (Sched::GATHER) {
#pragma unroll
        for (int hh = 0; hh < 2; ++hh)
#pragma unroll
            for (int i = 0; i < 2; ++i) { int R, C; stage_rc(tid * 16 + i * 8192, R, C); gvo[hh][i] = (unsigned)(S.arow(cur, hh * HALF + R) * K + C) * 2u; } }
    S.a_ready(cur);
    if constexpr (SP2) {
        PG8_STAGE(PG8_SB(0, 0), cB, voffB); PG8_STAGE(PG8_SB(0, 1), cB + hstep, voffB); PG8_STAGE_A(PG8_SA(0, 0), cA, 0, 0); PG8_STAGE_A(PG8_SA(0, 1), cA, 1, 0);
        if (wr == 1) PG8_BAR;
        PG8_WAIT_V(2); PG8_BAR;
        PG8_STAGE(PG8_SB(1, 0), cB + kstep, voffB); PG8_STAGE_A(PG8_SA(1, 0), cA + kstep, 0, 0); PG8_STAGE(PG8_SB(1, 1), cB + hstep + kstep, voffB);
        PG8_WAIT_V(6); PG8_BAR;
    } else {
        PG8_STAGE(PG8_SB(0, 0), cB, voffB); PG8_STAGE_A(PG8_SA(0, 0), cA, 0, 0); PG8_STAGE(PG8_SB(0, 1), cB + hstep, voffB); PG8_STAGE_A(PG8_SA(0, 1), cA, 1, 0);
        if (wr == 1) PG8_BAR;
        PG8_WAIT_V(4); PG8_BAR;
        PG8_STAGE(PG8_SB(1, 0), cB + kstep, voffB); PG8_STAGE_A(PG8_SA(1, 0), cA + kstep, 0, 0); PG8_STAGE(PG8_SB(1, 1), cB + hstep + kstep, voffB);
        PG8_WAIT_V(6); PG8_BAR;
    }
    for (;;) {
        const bool has_next = S.next(ui + 1, nxt);
        const char* nA = (has_next && !Sched::GATHER) ? (const char*)g.A + (size_t)nxt.pm * tstep : cA; const char* nB = has_next ? (const char*)g.Bt + (size_t)nxt.pn * tstep : cB;
        if constexpr (Sched::GATHER) {
#pragma unroll
            for (int hh = 0; hh < 2; ++hh)
#pragma unroll
                for (int i = 0; i < 2; ++i) { int R, C; stage_rc(tid * 16 + i * 8192, R, C); ngvo[hh][i] = has_next ? (unsigned)(S.arow(nxt, hh * HALF + R) * K + C) * 2u : gvo[hh][i]; } }
        for (int t = 0; t < nt; t += 2) {
            const bool last = (t == nt - 2);
            const char* a1 = cA + (size_t)(t + 1) * kstep;
            const char* a2 = last ? nA : cA + (size_t)(t + 2) * kstep; const char* b2 = last ? nB : cB + (size_t)(t + 2) * kstep;
            const char* a3 = a2 + kstep; const char* b3 = b2 + kstep;
            if (last && has_next) S.a_ready(nxt);
            if constexpr (SP2) {
            PG8_LDB(B0, 0, 0); PG8_LDB(B1, 0, 1); PG8_SCHED; PG8_LDA(At, 0, 0); PG8_STAGE_A(PG8_SA(1, 1), a1, 1, 0);
            PG8_WAIT_V(8); PG8_WAIT_L(0); PG8_BAR; PG8_MMA(0, 0, At, B0); PG8_MMA(0, 1, At, B1); PG8_BAR; PG8_SCHED;
            PG8_LDA(At, 0, 1); PG8_STAGE(PG8_SB(0, 0), b2, voffB); PG8_STAGE(PG8_SB(0, 1), b2 + hstep, voffB); PG8_STAGE_A(PG8_SA(0, 0), a2, 0, 1);
            PG8_WAIT_V(8); PG8_WAIT_L(0); PG8_BAR; PG8_MMA(1, 0, At, B0); PG8_MMA(1, 1, At, B1); PG8_BAR; PG8_SCHED;
            PG8_LDB(B0, 1, 0); PG8_LDB(B1, 1, 1); PG8_SCHED; PG8_LDA(At, 1, 0); PG8_STAGE_A(PG8_SA(0, 1), a2, 1, 1);
            PG8_WAIT_V(8); PG8_WAIT_L(0); PG8_BAR; PG8_MMA(0, 0, At, B0); PG8_MMA(0, 1, At, B1); PG8_BAR; PG8_SCHED;
            PG8_LDA(At, 1, 1); PG8_STAGE(PG8_SB(1, 0), b3, voffB); PG8_STAGE(PG8_SB(1, 1), b3 + hstep, voffB); PG8_STAGE_A(PG8_SA(1, 0), a3, 0, 1);
            PG8_WAIT_V(8); PG8_WAIT_L(0); PG8_BAR; PG8_MMA(1, 0, At, B0); PG8_MMA(1, 1, At, B1); PG8_BAR; PG8_SCHED;
            } else {
            PG8_LDB(B0, 0, 0); PG8_SCHED; PG8_LDA(At, 0, 0); PG8_STAGE_A(PG8_SA(1, 1), a1, 1, 0);
            PG8_WAIT_L(8); PG8_BAR; PG8_WAIT_L(0); PG8_MMA(0, 0, At, B0); PG8_BAR; PG8_SCHED;
            PG8_LDB(B1, 0, 1); PG8_STAGE(PG8_SB(0, 0), b2, voffB);
            PG8_BAR; PG8_WAIT_L(0); PG8_MMA(0, 1, At, B1); PG8_BAR;
            PG8_LDA(At, 0, 1); PG8_STAGE_A(PG8_SA(0, 0), a2, 0, 1);
            PG8_BAR; PG8_WAIT_L(0); PG8_MMA(1, 0, At, B0); PG8_BAR; PG8_SCHED;
            PG8_STAGE(PG8_SB(0, 1), b2 + hstep, voffB);
            PG8_WAIT_V(6); PG8_BAR; PG8_MMA(1, 1, At, B1); PG8_BAR;
            PG8_LDB(B0, 1, 0); PG8_SCHED; PG8_LDA(At, 1, 0); PG8_STAGE_A(PG8_SA(0, 1), a2, 1, 1);
            PG8_WAIT_L(8); PG8_BAR; PG8_WAIT_L(0); PG8_MMA(0, 0, At, B0); PG8_BAR; PG8_SCHED;
            PG8_LDB(B1, 1, 1); PG8_STAGE(PG8_SB(1, 0), b3, voffB);
            PG8_BAR; PG8_WAIT_L(0); PG8_MMA(0, 1, At, B1); PG8_BAR;
            PG8_LDA(At, 1, 1); PG8_STAGE_A(PG8_SA(1, 0), a3, 0, 1);
            PG8_BAR; PG8_WAIT_L(0); PG8_MMA(1, 0, At, B0); PG8_BAR; PG8_SCHED;
            PG8_STAGE(PG8_SB(1, 1), b3 + hstep, voffB);
            PG8_WAIT_V(6); PG8_BAR; PG8_MMA(1, 1, At, B1); PG8_BAR;
            }
        }
        if constexpr (ALIGN_EPI) { if (wr == 0) PG8_BAR; }
        if constexpr (!Epi::AFTER_DRAIN) { E(acc, cur, wr, wc, fr, fq); S.done(cur); }
        if (!has_next) break;
#pragma unroll
        for (int a = 0; a < 2; ++a)
#pragma unroll
            for (int b = 0; b < 2; ++b)
#pragma unroll
                for (int m = 0; m < 4; ++m)
#pragma unroll
                    for (int n = 0; n < 2; ++n) acc[a][b][m][n] = (f32x4){0.f, 0.f, 0.f, 0.f};
        cur = nxt; cA = nA; cB = nB; ++ui;
        if constexpr (Sched::GATHER) { gvo[0][0] = ngvo[0][0]; gvo[0][1] = ngvo[0][1]; gvo[1][0] = ngvo[1][0]; gvo[1][1] = ngvo[1][1]; }
        if constexpr (ALIGN_EPI) { if (wr == 1) PG8_BAR; }
    }
    PG8_WAIT_V(0);
    if constexpr (!ALIGN_EPI) { if (wr == 0) PG8_BAR; }
    PG8_BAR;
    if constexpr (Epi::AFTER_DRAIN) { E.fused(acc, cur, wr, wc, fr, fq, lds, wid, lane); S.done(cur); }
#undef PG8_SA
#undef PG8_SB
#undef PG8_STAGE
#undef PG8_STAGE_A
#undef PG8_LDA
#undef PG8_LDB
#undef PG8_MMA
#undef PG8_WAIT_V
#undef PG8_WAIT_L
#undef PG8_BAR
#undef PG8_SCHED
}
}
#define GAS __attribute__((address_space(1)))
#define LAS __attribute__((address_space(3)))
typedef unsigned short bf16;
typedef unsigned v4u __attribute__((ext_vector_type(4)));
typedef float f32x4 __attribute__((ext_vector_type(4)));
typedef short bf16x8 __attribute__((ext_vector_type(8)));
typedef GAS unsigned gu32;
typedef GAS unsigned long long gu64;
#define RLX_AGENT __ATOMIC_RELAXED, __HIP_MEMORY_SCOPE_AGENT
#define LDS_WAIT() asm volatile("s_waitcnt lgkmcnt(0)" ::: "memory")
#define VM_WAIT() asm volatile("s_waitcnt vmcnt(0)" ::: "memory")
__device__ __forceinline__ unsigned long long rt() { return __builtin_amdgcn_s_memrealtime(); }
__device__ __forceinline__ unsigned f2bf(float f) { unsigned u = __builtin_bit_cast(unsigned, f); return (u + 0x7fffu + ((u >> 16) & 1u)) >> 16; }
__device__ __forceinline__ unsigned pk2(float lo, float hi) { return f2bf(lo) | (f2bf(hi) << 16); }

#define XB_TMO      128
#define XB_XCNT(j)  (256  + 64 * (j))
#define XB_XSUB(j)  (1280 + 64 * (j))
#define XB_XGEN(j)  (2304 + 64 * (j))
#define XB_TOP      3328
#define XB_TOPGEN   3392
#define XCD_BAR_WORDS 3456
#define XB_SPIN_CAP (1u << 18)

__device__ __forceinline__ unsigned xb_ld(unsigned* p)              { return __hip_atomic_load(p, __ATOMIC_RELAXED, __HIP_MEMORY_SCOPE_AGENT); }
__device__ __forceinline__ unsigned xb_add(unsigned* p, unsigned v) { return __hip_atomic_fetch_add(p, v, __ATOMIC_RELAXED, __HIP_MEMORY_SCOPE_AGENT); }
__device__ __forceinline__ unsigned xb_xcc_id() { return (unsigned)__builtin_amdgcn_s_getreg((3 << 11) | 20) & 0xFu; }
#define XB_SPIN(cond, bar) do { unsigned _sp = 0; while (cond) { __builtin_amdgcn_s_sleep(1); \
    if ((++_sp & 255u) == 0u) { if (xb_ld(&(bar)[XB_TMO])) break; if (_sp > XB_SPIN_CAP) { atomicAdd(&(bar)[XB_TMO], 1u); break; } } } } while (0)

struct XcdBarrier {
    int wv;
    unsigned* bar; unsigned x;
    volatile LAS unsigned* st;
};

__device__ __forceinline__ XcdBarrier xcd_barrier_post(unsigned* bar, volatile LAS unsigned* st, int wv) {
    XcdBarrier b; b.bar = bar; b.x = xb_xcc_id(); b.st = st; b.wv = wv;
    if (mk_tid(wv) == 0) (void)xb_add(&bar[XB_XCNT(b.x)], 1u);
    return b;
}
__device__ __forceinline__ void xcd_barrier_complete(unsigned* bar, unsigned x, unsigned& nloc, unsigned& nx) {
    const unsigned G = gridDim.x * gridDim.y * gridDim.z;
    unsigned sum, cnt, mine, sp = 0u;
    for (;;) {
        sum = 0u; cnt = 0u; mine = 0u;
#pragma unroll
        for (unsigned j = 0; j < 16; ++j) { const unsigned c = xb_ld(&bar[XB_XCNT(j)]); sum += c; cnt += (c > 0u) ? 1u : 0u; mine = (j == x) ? c : mine; }
        if (sum == G) break;
        __builtin_amdgcn_s_sleep(1);
        if ((++sp & 255u) == 0u) { if (xb_ld(&bar[XB_TMO])) break; if (sp > XB_SPIN_CAP) { atomicAdd(&bar[XB_TMO], 1u); break; } }
    }
    nloc = mine > 0u ? mine : 1u; nx = cnt > 0u ? cnt : 1u;
}

__device__ __forceinline__ void xcd_barrier(const XcdBarrier& b) {
    asm volatile("s_waitcnt vmcnt(0)" ::: "memory");
    __syncthreads();
    if (mk_tid(b.wv) == 0) {
        unsigned* bar = b.bar;
        __builtin_amdgcn_s_waitcnt(0);
        unsigned nloc = b.st[0], nx = b.st[1];
        if (nloc == 0u) { xcd_barrier_complete(bar, b.x, nloc, nx); b.st[0] = nloc; b.st[1] = nx; }
        const unsigned old = xb_add(&bar[XB_XSUB(b.x)], 1u);
        const unsigned gen = old / nloc;
        if (old + 1u == (gen + 1u) * nloc) {
            __builtin_amdgcn_fence(__ATOMIC_RELEASE, "agent");
            asm volatile("s_waitcnt vmcnt(0)" ::: "memory");
            const unsigned og = xb_add(&bar[XB_TOP], 1u);
            const unsigned tg = og / nx;
            if (og + 1u == (tg + 1u) * nx) xb_add(&bar[XB_TOPGEN], 1u);
            else XB_SPIN(xb_ld(&bar[XB_TOPGEN]) == tg, bar);
            __builtin_amdgcn_fence(__ATOMIC_ACQUIRE, "agent");
            xb_add(&bar[XB_XGEN(b.x)], 1u);
            asm volatile("s_waitcnt vmcnt(0)" ::: "memory");
        } else {
            XB_SPIN(xb_ld(&bar[XB_XGEN(b.x)]) == gen, bar);
            __builtin_amdgcn_fence(__ATOMIC_ACQUIRE, "agent");
            asm volatile("s_waitcnt vmcnt(0)" ::: "memory");
        }
    }
    __syncthreads();
}
constexpr int NWAVES = 8, NT = 512;
constexpr int BATCH = 2, SEQ = 8192, D = 1024, TB = 8320, M = BATCH * TB, PADR = 112;
constexpr int NIN = 2816, DFF = 2816, NEXP = 8, DFE = 3584;
constexpr int C_U = 0, C_HQ = 256, C_HF = 512, C_HI = 768, C_HG = 1024, C_RQ = 1280, C_RK = 1536, C_RV = 1792, C_RG = 2304;
constexpr float EPS = 1e-6f;
#ifndef PROBE_DUP
#define PROBE_DUP 0
#endif
#define REP(n) ((PROBE_DUP == (n)) ? 2 : 1)
#ifndef PROBE_TA
#define PROBE_TA -1
#define PROBE_TB -1
#endif
#ifndef PROBE_BLK
#define PROBE_BLK 200
#endif
#ifndef MK_PER_PHASE
#define MK_PER_PHASE 0
#endif
constexpr int NPH = 62;
__host__ __device__ inline bool phase_exists(int k) {
    if (k == 0 || k == NPH - 1) return true;
    const int l = (k - 1) / 30, r = (k - 1) % 30;
    if (r <= 3 || r == 6) return true;
    if (l == 0) return r == 8 || r == 9;
    return r == 7 || r == 10 || r == 11 || r == 12;
}
constexpr size_t MiB = 1u << 20;
constexpr size_t WS_CTL = 0, CTL_ZERO_BYTES = 1 * MiB;
constexpr int CW_TMO = 0, CW_CODE = 1, CW_BAR = 4096, CW_CNT = 16384, CW_PROBE = 16448;
constexpr size_t WS_LB = 1 * MiB, WS_LB128 = 1 * MiB + 16384, WS_BB = 1 * MiB + 65536, WS_BBT = 1 * MiB + 393216, WS_ROT = 1 * MiB + 524288, WS_CCT = 2752512, WS_WGT = 2883584, WS_LBT = 3 * MiB;
constexpr size_t WS_POS = 3 * MiB + 65536, WS_GATE = WS_POS + 131072, WS_LIST = WS_GATE + 131072;
constexpr int MOE_CAP = 16384;
static_assert(WS_BBT + 131072 <= WS_ROT && WS_ROT + (size_t)TB * 32 * 4 <= WS_CCT && WS_CCT + 131072 <= WS_WGT && WS_WGT + 262144 <= WS_LBT && WS_LIST + 8 * MOE_CAP * 4 <= 4 * MiB, "table map");
constexpr size_t WS_WM13 = 4 * MiB, WS_WM2 = 4 * MiB, WS_YS = 60 * MiB, WS_HB = 116 * MiB, WS_H = 149 * MiB, WS_SSP = 214 * MiB, WS_PROJ = 220 * MiB, WS_MIXED = 310 * MiB, WS_ACT = 220 * MiB;
constexpr size_t WS_WIN = 343 * MiB, WS_WOUT = 354 * MiB, WS_WF13 = 358 * MiB, WS_WF2 = 369 * MiB, WS_END = 458 * MiB;
constexpr int MOE_TMAX = 136;
static_assert(WS_WM13 + (size_t)NEXP * 2 * DFE * D * 2 <= WS_HB && WS_WM2 + (size_t)NEXP * D * DFE * 2 <= WS_YS && WS_YS + (size_t)MOE_TMAX * 256 * D * 2 <= WS_HB + (size_t)M * D * 2 && WS_HB + (size_t)M * D * 2 <= WS_H, "ws map 1");
static_assert(WS_H + (size_t)M * D * 4 <= WS_SSP && WS_SSP + (size_t)5 * M * 16 * 4 <= WS_PROJ && WS_PROJ + (size_t)M * NIN * 2 <= WS_MIXED && WS_MIXED + (size_t)M * D * 2 <= WS_WIN, "ws map 2");
static_assert(WS_WIN + (size_t)2 * NIN * D * 2 <= WS_WOUT && WS_WOUT + (size_t)2 * D * D * 2 <= WS_WF13 && WS_WF13 + (size_t)2 * DFF * D * 2 <= WS_WF2 && WS_WF2 + (size_t)D * DFF * 2 <= WS_END, "ws map 3");
static_assert(WS_ACT + (size_t)M * DFF * 2 <= WS_MIXED && WS_ACT + (size_t)MOE_TMAX * 256 * DFE * 2 <= WS_END, "ws map 4");
constexpr int RING_OFF = 0, RING_BYTES = 131072, LDSCTL_OFF = RING_BYTES, MISC_OFF = LDSCTL_OFF + 320, LDS_BYTES = 147456;

struct Frame { LAS unsigned char* lds; volatile LAS unsigned* MISC; gu32* ctl; unsigned char* ws; const float* const* in; int wave_s; };
#define STAMP(k) do { if (PROBE_TA >= 0 && blockIdx.x == PROBE_BLK && mk_tid(F.wave_s) == 0) { gu32* _p = F.ctl + CW_PROBE + (k); if (__hip_atomic_load(_p, RLX_AGENT) == 0u) __hip_atomic_store(_p, (unsigned)__builtin_amdgcn_s_memrealtime(), RLX_AGENT); } } while (0)
struct Loc { int tid, lane, wave, bx, vcu, G; };
__device__ __forceinline__ Loc make_loc(int wave_s) { Loc L; int t = mk_tid(wave_s); asm volatile("" : "+v"(t));   int b = blockIdx.x; asm volatile("" : "+s"(b)); L.tid = t; L.lane = t & 63; L.wave = __builtin_amdgcn_readfirstlane(t >> 6);
    L.bx = b; L.G = gridDim.x; L.vcu = (L.G % 8 == 0) ? (b % 8) * (L.G / 8) + b / 8 : b; return L; }
__device__ __forceinline__ float bf2f(bf16 x) { return __uint_as_float((unsigned)x << 16); }
__device__ __forceinline__ bf16 f2bf_(float f) { return (bf16)f2bf(f); }
__device__ __forceinline__ float wave_sum(float v) {
#pragma unroll
    for (int o = 1; o < 64; o <<= 1) v += __shfl_xor(v, o);
    return v;
}
__device__ __forceinline__ float silu_f(float a) { return a / (1.0f + __expf(-a)); }
__device__ __forceinline__ float sigmoid_f(float a) { return 1.0f / (1.0f + __expf(-a)); }

__device__ __forceinline__ void tr_item(const float* W, int K, int N, bf16* WT, int mode, const float* g, LAS float* scr, int item, int lane) {
    const int nblk = N / 32, kb = item / nblk, nb = item % nblk, k0 = 64 * kb, n0 = 32 * nb;
    float wv[32], gv[32];
#pragma unroll
    for (int i = 0; i < 32; ++i) { const int kk = 2 * i + (lane >> 5); wv[i] = W[(size_t)(k0 + kk) * N + n0 + (lane & 31)]; gv[i] = g ? g[k0 + kk] : 1.0f; }
    PIN16(wv); PIN16O(wv, 16); PIN16(gv); PIN16O(gv, 16);
#pragma unroll
    for (int i = 0; i < 32; ++i) { const int kk = 2 * i + (lane >> 5); scr[kk * 33 + (lane & 31)] = wv[i] * gv[i]; }
    LDS_WAIT(); asm volatile("" ::: "memory");
    const int c = lane & 7;
#pragma unroll
    for (int j = 0; j < 4; ++j) { const int n = (lane >> 3) + 8 * j; const LAS float* s = scr + (8 * c) * 33 + n;
        v4u o; o.x = pk2(s[0 * 33], s[1 * 33]); o.y = pk2(s[2 * 33], s[3 * 33]); o.z = pk2(s[4 * 33], s[5 * 33]); o.w = pk2(s[6 * 33], s[7 * 33]);
        const int nn = n0 + n, drow = mode == 0 ? nn : ((nn >> 7) * 256 + (nn & 127) + (mode == 2 ? 128 : 0));
        *(GAS v4u*)(WT + (size_t)drow * K + k0 + 8 * c) = o; }
    LDS_WAIT(); asm volatile("" ::: "memory");
}
__device__ __forceinline__ void p0_prologue(Frame& F) {
    const Loc L = make_loc(F.wave_s);
    LAS float* scr = (LAS float*)(F.lds + RING_OFF + L.wave * 16384);
    const int gw = L.vcu * NWAVES + L.wave, NGW = L.G * NWAVES;
    unsigned char* ws = F.ws; const float* const* in = F.in;
    constexpr int I_IN = 16 * 88, I_OUT = 16 * 32, I_F = 16 * 88, I_F2 = 44 * 32, I_M = 16 * 112;
    constexpr int NITEMS = 2 * I_IN + 2 * I_OUT + 2 * I_F + I_F2 + 16 * I_M;
    for (int it = gw; it < NITEMS; it += NGW) {
        int r = it;
        if (r < 2 * I_IN) { const int l = r / I_IN; tr_item(in[3] + (size_t)l * D * NIN, D, NIN, (bf16*)(ws + WS_WIN) + (size_t)l * NIN * D, 0, in[2] + l * D, scr, r % I_IN, L.lane); continue; } r -= 2 * I_IN;
        if (r < 2 * I_OUT) { const int l = r / I_OUT; tr_item(in[18] + (size_t)l * D * D, D, D, (bf16*)(ws + WS_WOUT) + (size_t)l * D * D, 0, nullptr, scr, r % I_OUT, L.lane); continue; } r -= 2 * I_OUT;
        if (r < I_F) { tr_item(in[20], D, DFF, (bf16*)(ws + WS_WF13), 1, in[19], scr, r, L.lane); continue; } r -= I_F;
        if (r < I_F) { tr_item(in[21], D, DFF, (bf16*)(ws + WS_WF13), 2, in[19], scr, r, L.lane); continue; } r -= I_F;
        if (r < I_F2) { tr_item(in[22], DFF, D, (bf16*)(ws + WS_WF2), 0, nullptr, scr, r, L.lane); continue; } r -= I_F2;
        if (r < 8 * I_M) { const int e = r / I_M; tr_item(in[24] + (size_t)e * D * DFE, D, DFE, (bf16*)(ws + WS_WM13) + (size_t)e * 2 * DFE * D, 1, in[19] + D, scr, r % I_M, L.lane); continue; } r -= 8 * I_M;
        { const int e = r / I_M; tr_item(in[25] + (size_t)e * D * DFE, D, DFE, (bf16*)(ws + WS_WM13) + (size_t)e * 2 * DFE * D, 2, in[19] + D, scr, r % I_M, L.lane); }
    }
    float* H = (float*)(ws + WS_H); bf16* HB = (bf16*)(ws + WS_HB); float* SS0 = (float*)(ws + WS_SSP);
    for (int m = gw; m < M; m += NGW) {
        const int b = m / TB, t = m % TB;
        const float* src = t < PADR ? nullptr : (t < 128 ? in[1] + (size_t)(t - PADR) * D : in[0] + ((size_t)b * SEQ + (t - 128)) * D);
        f32x4 v[4]; float s = 0.f;
#pragma unroll
        for (int j = 0; j < 4; ++j) { v[j] = src ? ((const GAS f32x4*)src)[L.lane + 64 * j] : (f32x4){0.f, 0.f, 0.f, 0.f}; s += (v[j].x * v[j].x + v[j].y * v[j].y) + (v[j].z * v[j].z + v[j].w * v[j].w); }
        s = wave_sum(s);
#pragma unroll
        for (int j = 0; j < 4; ++j) { ((GAS f32x4*)(H + (size_t)m * D))[L.lane + 64 * j] = v[j];
            ((GAS unsigned long long*)(HB + (size_t)m * D))[L.lane + 64 * j] = (unsigned long long)pk2(v[j].x, v[j].y) | ((unsigned long long)pk2(v[j].z, v[j].w) << 32); }
        if (L.lane < 16) SS0[(size_t)m * 16 + L.lane] = L.lane == 0 ? s : 0.0f;
    }
    const int gt = L.vcu * NT + L.tid, NGT = L.G * NT;
    float* LB = (float*)(ws + WS_LB); float* BB = (float*)(ws + WS_BB); float* ROT = (float*)(ws + WS_ROT); float* LBT = (float*)(ws + WS_LBT);
    for (int i = gt; i < 2048; i += NGT) {
        const int lg = i >> 6; const float step = expf(in[11][lg]); const float lre = in[4][i], lim = in[5][i];
        const float mag = expf(lre * step); float sn, cs; sincosf(lim * step, &sn, &cs); const float br = mag * cs, bi = mag * sn;
        const float den = 1.0f / (lre * lre + lim * lim), cr = ((br - 1.0f) * lre + bi * lim) * den, ci = (bi * lre - (br - 1.0f) * lim) * den;
        LB[2 * i] = br; LB[2 * i + 1] = bi;
        for (int h = 0; h < 16; ++h) { const float b_r = in[6][i * 16 + h], b_i = in[7][i * 16 + h]; BB[(i * 16 + h) * 2] = cr * b_r - ci * b_i; BB[(i * 16 + h) * 2 + 1] = cr * b_i + ci * b_r; }
    }
    { bf16* BBT = (bf16*)(ws + WS_BBT); bf16* CCT = (bf16*)(ws + WS_CCT); bf16* WGT = (bf16*)(ws + WS_WGT); float* LB128 = (float*)(ws + WS_LB128);
      for (int i = gt; i < 2048; i += NGT) { const int lg = i >> 6, p = i & 63; const float step = expf(in[11][lg]), lre = in[4][i], lim = in[5][i];
          const float mag = expf(128.0f * lre * step); float sn, cs; sincosf(128.0f * (lim * step), &sn, &cs); LB128[2 * i] = mag * cs; LB128[2 * i + 1] = mag * sn;
          const float m1 = expf(lre * step); float s1, c1; sincosf(lim * step, &s1, &c1); const float br = m1 * c1, bi = m1 * s1, den = 1.0f / (lre * lre + lim * lim), cr = ((br - 1.0f) * lre + bi * lim) * den, ci = (bi * lre - (br - 1.0f) * lim) * den;
          for (int h = 0; h < 16; ++h) { const float b_r = in[6][i * 16 + h], b_i = in[7][i * 16 + h]; BBT[((size_t)lg * 128 + p) * 16 + h] = f2bf_(cr * b_r - ci * b_i); BBT[((size_t)lg * 128 + 64 + p) * 16 + h] = f2bf_(cr * b_i + ci * b_r);
              CCT[((size_t)lg * 16 + h) * 128 + p] = f2bf_(in[8][(lg * 16 + h) * 64 + p]); CCT[((size_t)lg * 16 + h) * 128 + 64 + p] = f2bf_(-in[9][(lg * 16 + h) * 64 + p]); } }
      for (int i = gt; i < 2 * 65536; i += NGT) { const int l = i >> 16, n = (i >> 8) & 255, k = i & 255; WGT[i] = f2bf_(in[12][(size_t)l * 65536 + k * 256 + n]); } }
    for (int i = gt; i < TB * 16; i += NGT) { const int t = i >> 4, f = i & 15; const float pos = (float)(t - PADR), inv = powf(10000.0f, -(float)f / 16.0f); float sn, cs; sincosf(pos * inv, &sn, &cs); ROT[2 * i] = cs; ROT[2 * i + 1] = sn; }
    for (int i = gt; i < 512; i += NGT) { const int l = i >> 8, c = i & 255; float lb = 0.f; if (l == 1) { const float a0 = in[15][c], a1 = in[15][256 + c], mx = fmaxf(a0, a1), e0 = expf(a0 - mx), e1 = expf(a1 - mx); lb = e1 / (e0 + e1); } LBT[i] = lb; }
}

__device__ __forceinline__ float gelu_tanh(float y) { const float x = 0.7978845608028654f * (y + 0.044715f * y * y * y); const float th = 1.0f - 2.0f / (1.0f + __expf(2.0f * x)); return 0.5f * y * (1.0f + th); }
typedef unsigned u32x4_t __attribute__((ext_vector_type(4)));
__device__ __forceinline__ f32x4 mfma16(bf16x8 a, bf16x8 b, f32x4 c) { return __builtin_amdgcn_mfma_f32_16x16x32_bf16(a, b, c, 0, 0, 0); }
__device__ __forceinline__ unsigned cvtpk(float lo, float hi) { unsigned r; asm volatile("v_cvt_pk_bf16_f32 %0, %1, %2" : "=v"(r) : "v"(lo), "v"(hi)); return r; }
__device__ __forceinline__ bf16x8 pack8(f32x4 a, f32x4 b) { u32x4_t w; w.x = cvtpk(a[0], a[1]); w.y = cvtpk(a[2], a[3]); w.z = cvtpk(b[0], b[1]); w.w = cvtpk(b[2], b[3]); return __builtin_bit_cast(bf16x8, w); }
__device__ __forceinline__ int perm_pos(int j) { return (j & ~31) + 8 * ((j >> 2) & 3) + 4 * ((j >> 4) & 1) + (j & 3); }
constexpr int NCH = TB / 128;
constexpr size_t OUT_RST = 0, OUT_HST = 9 * MiB, OUT_HDK = 18 * MiB, OUT_S5X = 19 * MiB;
__device__ __forceinline__ void ma_ret_unit(Frame& F, const Loc& L, int b, int c, int h, float* outb) {
    LAS bf16* Vt = (LAS bf16*)F.lds; LAS bf16* Kt = Vt + 64 * 136;
    const bf16* P = (const bf16*)(F.ws + WS_PROJ) + ((size_t)b * TB + c * 128) * NIN; const float* ROT = (const float*)(F.ws + WS_ROT) + (size_t)c * 128 * 32;
    const float lg = __log2f(1.0f - exp2f(-5.0f - (float)h));
    STAMP(5);
    { const int ch = L.tid & 63, seg = L.tid >> 6; const bf16* pv = P + (size_t)(16 * seg) * NIN + C_RV + h * 64 + ch; unsigned x[16];
#pragma unroll
      for (int r = 0; r < 16; ++r) x[r] = pv[(size_t)r * NIN];
      PIN16(x);
      u32x4_t w0, w1; w0.x = x[0] | ((unsigned)x[1] << 16); w0.y = x[2] | ((unsigned)x[3] << 16); w0.z = x[4] | ((unsigned)x[5] << 16); w0.w = x[6] | ((unsigned)x[7] << 16);
      w1.x = x[8] | ((unsigned)x[9] << 16); w1.y = x[10] | ((unsigned)x[11] << 16); w1.z = x[12] | ((unsigned)x[13] << 16); w1.w = x[14] | ((unsigned)x[15] << 16);
      *(LAS u32x4_t*)(Vt + ch * 136 + 16 * seg) = w0; *(LAS u32x4_t*)(Vt + ch * 136 + 16 * seg + 8) = w1; }
    if (L.tid < 128) { const int i = L.tid & 15, seg = L.tid >> 4; const bf16* pk = P + (size_t)(16 * seg) * NIN + C_RK + h * 32 + i; const float* rp = ROT + (16 * seg * 16 + i) * 2; float ka[16], kb[16];
      unsigned x1[16], x2[16]; float crc[16], crs[16];
#pragma unroll
      for (int r = 0; r < 16; ++r) { x1[r] = pk[(size_t)r * NIN]; x2[r] = pk[(size_t)r * NIN + 16]; const float2 t = *(const float2*)(rp + r * 32); crc[r] = t.x; crs[r] = t.y; }
      PIN16(x1); PIN16(x2); PIN16(crc); PIN16(crs);
#pragma unroll
      for (int r = 0; r < 16; ++r) { const float k1 = __uint_as_float(x1[r] << 16), k2 = __uint_as_float(x2[r] << 16), cs = crc[r], sn = crs[r], w = __builtin_amdgcn_exp2f((float)(127 - 16 * seg - r) * lg);
          ka[r] = (k1 * cs - k2 * sn) * w; kb[r] = (k1 * sn + k2 * cs) * w; }
      u32x4_t w0, w1; w0.x = cvtpk(ka[0], ka[1]); w0.y = cvtpk(ka[2], ka[3]); w0.z = cvtpk(ka[4], ka[5]); w0.w = cvtpk(ka[6], ka[7]); w1.x = cvtpk(ka[8], ka[9]); w1.y = cvtpk(ka[10], ka[11]); w1.z = cvtpk(ka[12], ka[13]); w1.w = cvtpk(ka[14], ka[15]);
      *(LAS u32x4_t*)(Kt + i * 136 + 16 * seg) = w0; *(LAS u32x4_t*)(Kt + i * 136 + 16 * seg + 8) = w1;
      w0.x = cvtpk(kb[0], kb[1]); w0.y = cvtpk(kb[2], kb[3]); w0.z = cvtpk(kb[4], kb[5]); w0.w = cvtpk(kb[6], kb[7]); w1.x = cvtpk(kb[8], kb[9]); w1.y = cvtpk(kb[10], kb[11]); w1.z = cvtpk(kb[12], kb[13]); w1.w = cvtpk(kb[14], kb[15]);
      *(LAS u32x4_t*)(Kt + (16 + i) * 136 + 16 * seg) = w0; *(LAS u32x4_t*)(Kt + (16 + i) * 136 + 16 * seg + 8) = w1; }
    STAMP(6);
    __syncthreads();
    { const int il = L.lane & 15, g = L.lane >> 4, ft = L.wave & 1, vt = L.wave >> 1; f32x4 acc = {0.f, 0.f, 0.f, 0.f};
#pragma unroll
      for (int ks = 0; ks < 4; ++ks) { const bf16x8 A = *(const LAS bf16x8*)(Kt + (16 * ft + il) * 136 + 32 * ks + 8 * g), B = *(const LAS bf16x8*)(Vt + (16 * vt + il) * 136 + 32 * ks + 8 * g); acc = mfma16(A, B, acc); }
      float* S = (float*)((unsigned char*)outb + OUT_RST) + (size_t)((b * NCH + c) * 8 + h) * 2048;
#pragma unroll
      for (int r = 0; r < 4; ++r) S[(16 * ft + 4 * g + r) * 64 + 16 * vt + il] = acc[r]; }
    __syncthreads();
    STAMP(7);
}
__device__ __forceinline__ void mb_ret(const Loc& L, float* outb) {
    const int gt = L.vcu * NT + L.tid, NGT = L.G * NT;
    for (int e = gt; e < 2 * 8 * 2048; e += NGT) { const int b = e >> 14, h = (e >> 11) & 7, idx = e & 2047; const float d = exp2f(128.0f * __log2f(1.0f - exp2f(-5.0f - (float)h)));
        float* p = (float*)((unsigned char*)outb + OUT_RST) + (size_t)(b * NCH * 8 + h) * 2048 + idx; float s = 0.f;
        float loc[NCH];
#pragma unroll
        for (int c = 0; c < NCH; ++c) loc[c] = p[(size_t)c * 8 * 2048];
        PIN16(loc); PIN16O(loc, 16); PIN16O(loc, 32); PIN16O(loc, 48); asm volatile("" : "+v"(loc[64]) :: "memory");
        asm volatile("" : "+v"(p));
#pragma unroll
        for (int c = 0; c < NCH; ++c) { p[(size_t)c * 8 * 2048] = s; s = d * s + loc[c]; } }
}
__device__ __forceinline__ void mc_ret_unit(Frame& F, const Loc& L, int l, int b, int c, int h, const float* outb) {
    LAS bf16* Qrm = (LAS bf16*)F.lds; LAS bf16* Krm = Qrm + 4096; LAS bf16* Vt = Krm + 4096; LAS bf16* SpT = Vt + 64 * 136;
    const size_t row0 = (size_t)b * TB + c * 128; const bf16* P = (const bf16*)(F.ws + WS_PROJ) + row0 * NIN; const float* ROT = (const float*)(F.ws + WS_ROT) + (size_t)c * 128 * 32;
    const float gamma = 1.0f - exp2f(-5.0f - (float)h), lg = __log2f(gamma);
    { const int r = L.tid >> 2, pq = L.tid & 3; const bf16* pr = P + (size_t)r * NIN; const f32x4 r0 = *(const f32x4*)(ROT + (r * 16 + 4 * pq) * 2), r1 = *(const f32x4*)(ROT + (r * 16 + 4 * pq) * 2 + 4);
      const float cs[4] = {r0[0], r0[2], r1[0], r1[2]}, sn[4] = {r0[1], r0[3], r1[1], r1[3]};
      const float wq = 0.17677669529663687f * exp2f((float)r * lg), wk = exp2f(-(float)r * lg);
      const unsigned long long q1 = *(const GAS unsigned long long*)(pr + C_RQ + h * 32 + 4 * pq), q2 = *(const GAS unsigned long long*)(pr + C_RQ + h * 32 + 16 + 4 * pq);
      const unsigned long long k1 = *(const GAS unsigned long long*)(pr + C_RK + h * 32 + 4 * pq), k2 = *(const GAS unsigned long long*)(pr + C_RK + h * 32 + 16 + 4 * pq);
      const int vq = 16 * pq, pj = perm_pos(r); v4u va = *(const GAS v4u*)(pr + C_RV + h * 64 + vq), vb = *(const GAS v4u*)(pr + C_RV + h * 64 + vq + 8);
      const int ksp = L.tid >> 4, v4 = (L.tid & 15) * 4; f32x4 sp = *(const f32x4*)((const float*)((const unsigned char*)outb + OUT_RST) + (size_t)((b * NCH + c) * 8 + h) * 2048 + ksp * 64 + v4);
      { unsigned long long q1_ = q1, q2_ = q2, k1_ = k1, k2_ = k2; asm volatile("" : "+v"(q1_), "+v"(q2_), "+v"(k1_), "+v"(k2_), "+v"(va), "+v"(vb), "+v"(sp) :: "memory"); (void)q1_; }
      float qa[4], qb[4], ka[4], kb[4];
#pragma unroll
      for (int e = 0; e < 4; ++e) { const float a1 = bf2f((bf16)(q1 >> (16 * e))), a2 = bf2f((bf16)(q2 >> (16 * e))), b1 = bf2f((bf16)(k1 >> (16 * e))), b2 = bf2f((bf16)(k2 >> (16 * e)));
          qa[e] = (a1 * cs[e] - a2 * sn[e]) * wq; qb[e] = (a1 * sn[e] + a2 * cs[e]) * wq; ka[e] = (b1 * cs[e] - b2 * sn[e]) * wk; kb[e] = (b1 * sn[e] + b2 * cs[e]) * wk; }
      *(LAS unsigned long long*)(Qrm + r * 32 + 4 * pq) = (unsigned long long)cvtpk(qa[0], qa[1]) | ((unsigned long long)cvtpk(qa[2], qa[3]) << 32);
      *(LAS unsigned long long*)(Qrm + r * 32 + 16 + 4 * pq) = (unsigned long long)cvtpk(qb[0], qb[1]) | ((unsigned long long)cvtpk(qb[2], qb[3]) << 32);
      *(LAS unsigned long long*)(Krm + r * 32 + 4 * pq) = (unsigned long long)cvtpk(ka[0], ka[1]) | ((unsigned long long)cvtpk(ka[2], ka[3]) << 32);
      *(LAS unsigned long long*)(Krm + r * 32 + 16 + 4 * pq) = (unsigned long long)cvtpk(kb[0], kb[1]) | ((unsigned long long)cvtpk(kb[2], kb[3]) << 32);
#pragma unroll
      for (int e = 0; e < 4; ++e) { Vt[(vq + 2 * e) * 136 + pj] = (bf16)(va[e] & 0xffffu); Vt[(vq + 2 * e + 1) * 136 + pj] = (bf16)(va[e] >> 16);
          Vt[(vq + 8 + 2 * e) * 136 + pj] = (bf16)(vb[e] & 0xffffu); Vt[(vq + 8 + 2 * e + 1) * 136 + pj] = (bf16)(vb[e] >> 16); }
#pragma unroll
      for (int e = 0; e < 4; ++e) SpT[(v4 + e) * 40 + ksp] = f2bf_(gamma * sp[e]);
    }
    __syncthreads();
    const int w = L.wave, il = L.lane & 15, g = L.lane >> 4;
    const size_t row = row0 + 16 * w + il; const bf16* gp = (const bf16*)(F.ws + WS_PROJ) + row * NIN + C_RG + h * 64; const float* og = F.in[17] + l * 512 + h * 64;
    unsigned long long gg4[4]; f32x4 og4[4];
#pragma unroll
    for (int vt = 0; vt < 4; ++vt) { gg4[vt] = *(const GAS unsigned long long*)(gp + 16 * vt + 4 * g); og4[vt] = *(const f32x4*)(og + 16 * vt + 4 * g); }
    const bf16x8 Bq = *(const LAS bf16x8*)(Qrm + (16 * w + il) * 32 + 8 * g);
    const f32x4 zero = {0.f, 0.f, 0.f, 0.f}; f32x4 O[4] = {zero, zero, zero, zero};
#pragma unroll
    for (int jp = 0; jp < 4; ++jp) if (2 * jp <= w) {
        f32x4 p0, p1 = zero;
        { const bf16x8 A = *(const LAS bf16x8*)(Krm + (32 * jp + il) * 32 + 8 * g); p0 = mfma16(A, Bq, zero);
          if (2 * jp == w) {
#pragma unroll
              for (int r = 0; r < 4; ++r) if (4 * g + r > il) p0[r] = 0.f; } }
        if (2 * jp + 1 <= w) { const bf16x8 A = *(const LAS bf16x8*)(Krm + (32 * jp + 16 + il) * 32 + 8 * g); p1 = mfma16(A, Bq, zero);
          if (2 * jp + 1 == w) {
#pragma unroll
              for (int r = 0; r < 4; ++r) if (4 * g + r > il) p1[r] = 0.f; } }
        const bf16x8 Bp = pack8(p0, p1);
#pragma unroll
        for (int vt = 0; vt < 4; ++vt) { const bf16x8 A = *(const LAS bf16x8*)(Vt + (16 * vt + il) * 136 + 32 * jp + 8 * g); O[vt] = mfma16(A, Bp, O[vt]); }
    }
#pragma unroll
    for (int vt = 0; vt < 4; ++vt) { const bf16x8 A = *(const LAS bf16x8*)(SpT + (16 * vt + il) * 40 + 8 * g); O[vt] = mfma16(A, Bq, O[vt]); }
    float s1 = 0.f;
#pragma unroll
    for (int vt = 0; vt < 4; ++vt) s1 += (O[vt][0] + O[vt][1]) + (O[vt][2] + O[vt][3]);
    s1 += __shfl_xor(s1, 16); s1 += __shfl_xor(s1, 32); const float mean = s1 * (1.0f / 64.0f); float s2 = 0.f;
#pragma unroll
    for (int vt = 0; vt < 4; ++vt) { O[vt] = O[vt] - mean; s2 += (O[vt][0] * O[vt][0] + O[vt][1] * O[vt][1]) + (O[vt][2] * O[vt][2] + O[vt][3] * O[vt][3]); }
    s2 += __shfl_xor(s2, 16); s2 += __shfl_xor(s2, 32); const float rstd = rsqrtf(s2 * (1.0f / 64.0f) + EPS);
    bf16* mo = (bf16*)(F.ws + WS_MIXED) + row * D + 512 + h * 64;
#pragma unroll
    for (int vt = 0; vt < 4; ++vt) { const int v0 = 16 * vt + 4 * g; const unsigned long long gg = gg4[vt]; const f32x4 o4 = og4[vt]; float y[4];
#pragma unroll
        for (int r = 0; r < 4; ++r) y[r] = O[vt][r] * rstd * o4[r] * silu_f(bf2f((bf16)(gg >> (16 * r))));
        *(GAS unsigned long long*)(mo + v0) = (unsigned long long)cvtpk(y[0], y[1]) | ((unsigned long long)cvtpk(y[2], y[3]) << 32); }
    __syncthreads();
}
constexpr int HG_LD = 68;
constexpr int SEG_OFF = MISC_OFF + 192;
static_assert(SEG_OFF % 16 == 0 && SEG_OFF + 2048 <= LDS_BYTES, "LDS map (SEG)");
template <bool NEED_Q> __device__ __forceinline__ void hg_rows(const bf16* Pb, int tb0, int ch, const float* cw, float lb, float (&q)[16], float (&kk)[16], float (&vv)[16], float (&gl)[16]) {
    float wq[4], wf[4], wi[4];
#pragma unroll
    for (int j = 0; j < 4; ++j) { wq[j] = cw[j * 768 + ch]; wf[j] = cw[j * 768 + 256 + ch]; wi[j] = cw[j * 768 + 512 + ch]; }
    unsigned hq0[3] = {0u, 0u, 0u}, hf0[3] = {0u, 0u, 0u}, hi0[3] = {0u, 0u, 0u}, rq[16], rf[16], ri[16];
#pragma unroll
    for (int j = 0; j < 3; ++j) { const int ts = tb0 - 3 + j; if (ts >= 0) { const bf16* pr = Pb + (size_t)ts * NIN; if (NEED_Q) hq0[j] = pr[C_HQ + ch]; hf0[j] = pr[C_HF + ch]; hi0[j] = pr[C_HI + ch]; } }
#pragma unroll
    for (int r = 0; r < 16; ++r) { const bf16* pr = Pb + (size_t)(tb0 + r) * NIN; rq[r] = NEED_Q ? (unsigned)pr[C_HQ + ch] : 0u; rf[r] = pr[C_HF + ch]; ri[r] = pr[C_HI + ch]; }
    if (NEED_Q) { PIN16(rq); PIN4(hq0[0], hq0[1], hq0[2], wq[0]); } PIN16(rf); PIN16(ri); PIN8(hf0[0], hf0[1], hf0[2], hi0[0], hi0[1], hi0[2], wf[0], wi[0]);
    float hq[3], hf[3], hi[3];
#pragma unroll
    for (int j = 0; j < 3; ++j) { hq[j] = __uint_as_float(hq0[j] << 16); hf[j] = __uint_as_float(hf0[j] << 16); hi[j] = __uint_as_float(hi0[j] << 16); }
    float run = 0.f;
#pragma unroll
    for (int r = 0; r < 16; ++r) { const float xq = __uint_as_float(rq[r] << 16), xf = __uint_as_float(rf[r] << 16), xi = __uint_as_float(ri[r] << 16);
        const float cq = (wq[0] * hq[0] + wq[1] * hq[1]) + (wq[2] * hq[2] + wq[3] * xq), cf = (wf[0] * hf[0] + wf[1] * hf[1]) + (wf[2] * hf[2] + wf[3] * xf), ci = (wi[0] * hi[0] + wi[1] * hi[1]) + (wi[2] * hi[2] + wi[3] * xi);
        hq[0] = hq[1]; hq[1] = hq[2]; hq[2] = xq; hf[0] = hf[1]; hf[1] = hf[2]; hf[2] = xf; hi[0] = hi[1]; hi[1] = hi[2]; hi[2] = xi;
        const float f = fmaxf(lb + (1.0f - lb) * sigmoid_f(cf), 1e-30f); run += __logf(f); gl[r] = run; kk[r] = 1.0f - f; vv[r] = ci; q[r] = NEED_Q ? silu_f(cq) : 0.f; }
}
__device__ __forceinline__ void ma_hg_unit(Frame& F, const Loc& L, int l, int b, int c, int h, float* outb) {
    LAS bf16* Vt = (LAS bf16*)F.lds; LAS bf16* Kt = Vt + 64 * 136; LAS float* SEG = (LAS float*)(F.lds + SEG_OFF);
    const bf16* Pb = (const bf16*)(F.ws + WS_PROJ) + (size_t)b * TB * NIN; const int k = L.tid & 63, w = L.tid >> 6;
    float q[16], kk[16], vv[16], gl[16];
    STAMP(0);
    hg_rows<false>(Pb, c * 128 + 16 * w, h * 64 + k, F.in[14] + l * 4 * 768, ((const float*)(F.ws + WS_LBT))[l * 256 + h * 64 + k], q, kk, vv, gl);
    STAMP(1);
    { u32x4_t w0, w1; w0.x = cvtpk(vv[0], vv[1]); w0.y = cvtpk(vv[2], vv[3]); w0.z = cvtpk(vv[4], vv[5]); w0.w = cvtpk(vv[6], vv[7]); w1.x = cvtpk(vv[8], vv[9]); w1.y = cvtpk(vv[10], vv[11]); w1.z = cvtpk(vv[12], vv[13]); w1.w = cvtpk(vv[14], vv[15]);
      *(LAS u32x4_t*)(Vt + k * 136 + 16 * w) = w0; *(LAS u32x4_t*)(Vt + k * 136 + 16 * w + 8) = w1; }
    SEG[w * 64 + k] = gl[15];
    __syncthreads();
    STAMP(2);
    float off = 0.f, tot = 0.f;
#pragma unroll
    for (int ww = 0; ww < 8; ++ww) { const float s = SEG[ww * 64 + k]; if (ww < w) off += s; tot += s; }
    { float e[16];
#pragma unroll
      for (int r = 0; r < 16; ++r) e[r] = kk[r] * __expf(tot - off - gl[r]);
      u32x4_t w0, w1; w0.x = cvtpk(e[0], e[1]); w0.y = cvtpk(e[2], e[3]); w0.z = cvtpk(e[4], e[5]); w0.w = cvtpk(e[6], e[7]); w1.x = cvtpk(e[8], e[9]); w1.y = cvtpk(e[10], e[11]); w1.z = cvtpk(e[12], e[13]); w1.w = cvtpk(e[14], e[15]);
      *(LAS u32x4_t*)(Kt + k * 136 + 16 * w) = w0; *(LAS u32x4_t*)(Kt + k * 136 + 16 * w + 8) = w1; }
    const size_t ui = (size_t)(b * NCH + c) * 4 + h;
    if (w == 0) ((float*)((unsigned char*)outb + OUT_HDK))[ui * 64 + k] = __expf(tot);
    __syncthreads();
    STAMP(3);
    { const int il = L.lane & 15, g = L.lane >> 4, kt = L.wave >> 1, vt0 = 2 * (L.wave & 1); const f32x4 zero = {0.f, 0.f, 0.f, 0.f}; f32x4 acc[2] = {zero, zero};
#pragma unroll
      for (int ks = 0; ks < 4; ++ks) { const bf16x8 A = *(const LAS bf16x8*)(Kt + (16 * kt + il) * 136 + 32 * ks + 8 * g);
#pragma unroll
          for (int t = 0; t < 2; ++t) { const bf16x8 B = *(const LAS bf16x8*)(Vt + (16 * (vt0 + t) + il) * 136 + 32 * ks + 8 * g); acc[t] = mfma16(A, B, acc[t]); } }
      float* S = (float*)((unsigned char*)outb + OUT_HST) + ui * 4096;
#pragma unroll
      for (int t = 0; t < 2; ++t)
#pragma unroll
          for (int r = 0; r < 4; ++r) S[(16 * kt + 4 * g + r) * 64 + 16 * (vt0 + t) + il] = acc[t][r]; }
    __syncthreads();
    STAMP(4);
}
__device__ __forceinline__ void mb_hg(const Loc& L, float* outb) {
    const int gt = L.vcu * NT + L.tid, NGT = L.G * NT;
    for (int e = gt; e < 2 * 4 * 4096; e += NGT) { const int b = e >> 14, h = (e >> 12) & 3, idx = e & 4095;
        float* p = (float*)((unsigned char*)outb + OUT_HST) + (size_t)(b * NCH * 4 + h) * 4096 + idx; const float* dk = (const float*)((unsigned char*)outb + OUT_HDK) + (size_t)(b * NCH * 4 + h) * 64 + (idx >> 6); float s = 0.f;
        float loc[NCH], dd[NCH];
#pragma unroll
        for (int c = 0; c < NCH; ++c) { loc[c] = p[(size_t)c * 4 * 4096]; dd[c] = dk[(size_t)c * 4 * 64]; }
        PIN16(loc); PIN16O(loc, 16); PIN16O(loc, 32); PIN16O(loc, 48); PIN16(dd); PIN16O(dd, 16); PIN16O(dd, 32); PIN16O(dd, 48); asm volatile("" : "+v"(loc[64]), "+v"(dd[64]) :: "memory");
        asm volatile("" : "+v"(p));
#pragma unroll
        for (int c = 0; c < NCH; ++c) { p[(size_t)c * 4 * 4096] = s; s = dd[c] * s + loc[c]; } }
}
__device__ __forceinline__ f32x4 ld4(const LAS float* p) { return *(const LAS f32x4*)p; }
__device__ __forceinline__ void mc_hg_unit(Frame& F, const Loc& L, int l, int b, int c, int h, const float* outb) {
    LAS float* Qf = (LAS float*)F.lds; LAS float* Kf = Qf + 128 * HG_LD; LAS float* G = Kf + 128 * HG_LD; LAS bf16* Vt = (LAS bf16*)(G + 128 * HG_LD); LAS bf16* SpT = Vt + 64 * 136; LAS float* SEG = (LAS float*)(F.lds + SEG_OFF);
    static_assert(3 * 128 * HG_LD * 4 + 64 * 136 * 2 + 64 * 72 * 2 <= RING_BYTES, "LDS map (HGRN2 MC)");
    const size_t row0 = (size_t)b * TB + c * 128; const bf16* Pb = (const bf16*)(F.ws + WS_PROJ) + (size_t)b * TB * NIN;
    { const int k = L.tid & 63, w = L.tid >> 6; float q[16], kk[16], vv[16], gl[16];
      hg_rows<true>(Pb, c * 128 + 16 * w, h * 64 + k, F.in[14] + l * 4 * 768, ((const float*)(F.ws + WS_LBT))[l * 256 + h * 64 + k], q, kk, vv, gl);
#pragma unroll
      for (int r = 0; r < 16; ++r) { const int t = 16 * w + r; Qf[t * HG_LD + k] = q[r]; Kf[t * HG_LD + k] = kk[r]; Vt[k * 136 + perm_pos(t)] = f2bf_(vv[r]); }
      SEG[w * 64 + k] = gl[15];
      { const int kr = L.tid >> 3, v8 = (L.tid & 7) * 8; const float* sp = (const float*)((const unsigned char*)outb + OUT_HST) + ((size_t)(b * NCH + c) * 4 + h) * 4096 + kr * 64 + v8; const f32x4 s0 = *(const f32x4*)sp, s1 = *(const f32x4*)(sp + 4);
#pragma unroll
        for (int e = 0; e < 4; ++e) { SpT[(v8 + e) * 72 + kr] = f2bf_(s0[e]); SpT[(v8 + 4 + e) * 72 + kr] = f2bf_(s1[e]); } }
      __syncthreads();
      float off = 0.f;
#pragma unroll
      for (int ww = 0; ww < 8; ++ww) { const float s = SEG[ww * 64 + k]; if (ww < w) off += s; }
#pragma unroll
      for (int r = 0; r < 16; ++r) G[(16 * w + r) * HG_LD + k] = gl[r] + off;
    }
    __syncthreads();
    const int w = L.wave, il = L.lane & 15, g = L.lane >> 4; const f32x4 zero = {0.f, 0.f, 0.f, 0.f};
    const size_t row = row0 + 16 * w + il; const bf16* gp = (const bf16*)(F.ws + WS_PROJ) + row * NIN + C_HG + h * 64; const float* og = F.in[16] + l * 256 + h * 64;
    unsigned long long gg4[4]; f32x4 og4[4];
#pragma unroll
    for (int vt = 0; vt < 4; ++vt) { gg4[vt] = *(const GAS unsigned long long*)(gp + 16 * vt + 4 * g); og4[vt] = *(const f32x4*)(og + 16 * vt + 4 * g); }
    f32x4 gr[2][2]; bf16x8 Bq[2], Bqi[2];
#pragma unroll
    for (int ks = 0; ks < 2; ++ks) { const int ko = 32 * ks + 8 * g;
        if (w > 0) { gr[ks][0] = ld4(G + (16 * w - 1) * HG_LD + ko); gr[ks][1] = ld4(G + (16 * w - 1) * HG_LD + ko + 4); } else { gr[ks][0] = zero; gr[ks][1] = zero; }
        const f32x4 q0 = ld4(Qf + (16 * w + il) * HG_LD + ko), q1 = ld4(Qf + (16 * w + il) * HG_LD + ko + 4), g0 = ld4(G + (16 * w + il) * HG_LD + ko), g1 = ld4(G + (16 * w + il) * HG_LD + ko + 4);
        f32x4 a0, a1, b0, b1;
#pragma unroll
        for (int e = 0; e < 4; ++e) { a0[e] = q0[e] * __expf(g0[e] - gr[ks][0][e]); a1[e] = q1[e] * __expf(g1[e] - gr[ks][1][e]); b0[e] = q0[e] * __expf(g0[e]); b1[e] = q1[e] * __expf(g1[e]); }
        Bq[ks] = pack8(a0, a1); Bqi[ks] = pack8(b0, b1); }
    f32x4 O[4] = {zero, zero, zero, zero};
#pragma unroll
    for (int jp = 0; jp < 4; ++jp) if (2 * jp <= w) {
        f32x4 pt[2] = {zero, zero};
#pragma unroll
        for (int hh = 0; hh < 2; ++hh) if (2 * jp + hh <= w) { const int J = 2 * jp + hh;
#pragma unroll
            for (int ks = 0; ks < 2; ++ks) { const int ko = 32 * ks + 8 * g; const f32x4 k0 = ld4(Kf + (16 * J + il) * HG_LD + ko), k1 = ld4(Kf + (16 * J + il) * HG_LD + ko + 4), g0 = ld4(G + (16 * J + il) * HG_LD + ko), g1 = ld4(G + (16 * J + il) * HG_LD + ko + 4);
                f32x4 a0, a1;
#pragma unroll
                for (int e = 0; e < 4; ++e) { a0[e] = k0[e] * __expf(fminf(gr[ks][0][e] - g0[e], 80.0f)); a1[e] = k1[e] * __expf(fminf(gr[ks][1][e] - g1[e], 80.0f)); }
                pt[hh] = mfma16(pack8(a0, a1), Bq[ks], pt[hh]); }
            if (J == w) {
#pragma unroll
                for (int r = 0; r < 4; ++r) if (4 * g + r > il) pt[hh][r] = 0.f; } }
        const bf16x8 Bp = pack8(pt[0], pt[1]);
#pragma unroll
        for (int vt = 0; vt < 4; ++vt) { const bf16x8 A = *(const LAS bf16x8*)(Vt + (16 * vt + il) * 136 + 32 * jp + 8 * g); O[vt] = mfma16(A, Bp, O[vt]); }
    }
#pragma unroll
    for (int vt = 0; vt < 4; ++vt)
#pragma unroll
        for (int ks = 0; ks < 2; ++ks) { const bf16x8 A = *(const LAS bf16x8*)(SpT + (16 * vt + il) * 72 + 32 * ks + 8 * g); O[vt] = mfma16(A, Bqi[ks], O[vt]); }
    float s2 = 0.f;
#pragma unroll
    for (int vt = 0; vt < 4; ++vt) s2 += (O[vt][0] * O[vt][0] + O[vt][1] * O[vt][1]) + (O[vt][2] * O[vt][2] + O[vt][3] * O[vt][3]);
    s2 += __shfl_xor(s2, 16); s2 += __shfl_xor(s2, 32); const float rstd = rsqrtf(s2 * (1.0f / 64.0f) + EPS);
    bf16* mo = (bf16*)(F.ws + WS_MIXED) + row * D + 256 + h * 64;
#pragma unroll
    for (int vt = 0; vt < 4; ++vt) { const int v0 = 16 * vt + 4 * g; const unsigned long long gg = gg4[vt]; const f32x4 o4 = og4[vt]; float y[4];
#pragma unroll
        for (int r = 0; r < 4; ++r) y[r] = O[vt][r] * rstd * o4[r] * silu_f(bf2f((bf16)(gg >> (16 * r))));
        *(GAS unsigned long long*)(mo + v0) = (unsigned long long)cvtpk(y[0], y[1]) | ((unsigned long long)cvtpk(y[2], y[3]) << 32); }
    __syncthreads();
}
constexpr int S5_WREG = 14592, BU_LD = 20, XS_LD = 136, GY_LD = 264;
static_assert(8 * S5_WREG <= RING_BYTES && 128 * GY_LD * 2 + 4096 + 512 <= RING_BYTES, "LDS map (S5)");
template <bool FULL> __device__ __forceinline__ void s5_group(Frame& F, const Loc& L, int l, int gidx, const bf16* Pc  , float& xr, float& xi, unsigned (&gy)[8][2]) {
    LAS float* BUt = (LAS float*)(F.lds + L.wave * S5_WREG); LAS bf16* Xs = (LAS bf16*)(F.lds + L.wave * S5_WREG + 128 * BU_LD * 4);
    const int il = L.lane & 15, g4 = L.lane >> 4, lg = l * 16 + gidx; const f32x4 zero = {0.f, 0.f, 0.f, 0.f}; const bf16x8 bz = {0, 0, 0, 0, 0, 0, 0, 0};
    bf16x8 Bb[8];
#pragma unroll
    for (int ct = 0; ct < 8; ++ct) Bb[ct] = g4 < 2 ? *(const bf16x8*)((const bf16*)(F.ws + WS_BBT) + ((size_t)lg * 128 + 16 * ct + il) * 16 + 8 * g4) : bz;
    bf16x8 Cb[4], Db = bz;
    if (FULL) {
#pragma unroll
        for (int ks = 0; ks < 4; ++ks) Cb[ks] = *(const bf16x8*)((const bf16*)(F.ws + WS_CCT) + ((size_t)lg * 16 + il) * 128 + 32 * ks + 8 * g4);
        const short dsk = (short)f2bf_(F.in[10][lg * 16 + il]);
#pragma unroll
        for (int jj = 0; jj < 8; ++jj) Db[jj] = (8 * g4 + jj == il) ? dsk : (short)0; }
    const float* LB = (const float*)(F.ws + WS_LB) + (size_t)(lg * 64 + L.lane) * 2; const float lr = LB[0], li = LB[1];
    const unsigned avoff = (unsigned)(il * NIN + C_U + 16 * gidx + 8 * g4) * 2u;
    bf16x8 Aall[8];
#pragma unroll
    for (int s = 0; s < 8; ++s) Aall[s] = g4 < 2 ? *(const bf16x8*)((const char*)(Pc + (size_t)16 * s * NIN) + avoff) : bz;
#pragma unroll
    for (int s = 0; s < 8; ++s) {
        const bf16x8 A = Aall[s];
#pragma unroll
        for (int ct = 0; ct < 8; ++ct) { const f32x4 d = mfma16(A, Bb[ct], zero); *(LAS f32x4*)(BUt + (16 * ct + il) * BU_LD + 4 * g4) = d; }
#pragma unroll
        for (int q = 0; q < 4; ++q) { const f32x4 br = *(const LAS f32x4*)(BUt + L.lane * BU_LD + 4 * q), bi = *(const LAS f32x4*)(BUt + (64 + L.lane) * BU_LD + 4 * q);
#pragma unroll
            for (int e = 0; e < 4; ++e) { const float nr = lr * xr - li * xi + br[e], ni = lr * xi + li * xr + bi[e]; xr = nr; xi = ni;
                if (FULL) { Xs[(4 * q + e) * XS_LD + L.lane] = f2bf_(xr); Xs[(4 * q + e) * XS_LD + 64 + L.lane] = f2bf_(xi); } } }
        if (FULL) { f32x4 y = mfma16(A, Db, zero);
#pragma unroll
            for (int ks = 0; ks < 4; ++ks) { const bf16x8 Ax = *(const LAS bf16x8*)(Xs + il * XS_LD + 32 * ks + 8 * g4); y = mfma16(Ax, Cb[ks], y); }
            gy[s][0] = cvtpk(gelu_tanh(y[0]), gelu_tanh(y[1])); gy[s][1] = cvtpk(gelu_tanh(y[2]), gelu_tanh(y[3])); }
        asm volatile("" : "+v"(xr), "+v"(xi) :: "memory");
    }
}
__device__ __forceinline__ void ma_s5_unit(Frame& F, const Loc& L, int l, int b, int c, float* outb) {
    const bf16* Pc = (const bf16*)(F.ws + WS_PROJ) + ((size_t)b * TB + c * 128) * NIN; unsigned gy[8][2];
#pragma unroll
    for (int gi = 0; gi < 2; ++gi) { const int gidx = 2 * L.wave + gi; float xr = 0.f, xi = 0.f; s5_group<false>(F, L, l, gidx, Pc, xr, xi, gy);
        float* xo = (float*)((unsigned char*)outb + OUT_S5X) + (((size_t)(b * NCH + c) * 16 + gidx) * 64 + L.lane) * 2; xo[0] = xr; xo[1] = xi; }
    __syncthreads();
}
__device__ __forceinline__ void mb_s5(Frame& F, const Loc& L, int l, float* outb) {
    const int gt = L.vcu * NT + L.tid, NGT = L.G * NT;
    for (int e = gt; e < 2 * 16 * 64; e += NGT) { const int b = e >> 10, gp = e & 1023; const float* lb = (const float*)(F.ws + WS_LB128) + (size_t)(l * 1024 + gp) * 2; const float dr = lb[0], di = lb[1];
        float* p = (float*)((unsigned char*)outb + OUT_S5X) + ((size_t)b * NCH * 1024 + gp) * 2; float sr = 0.f, si = 0.f;
        float la[NCH], lbv[NCH];
#pragma unroll
        for (int c = 0; c < NCH; ++c) { const float2 t = *(const float2*)(p + (size_t)c * 2048); la[c] = t.x; lbv[c] = t.y; }
        PIN16(la); PIN16O(la, 16); PIN16O(la, 32); PIN16O(la, 48); PIN16(lbv); PIN16O(lbv, 16); PIN16O(lbv, 32); PIN16O(lbv, 48); asm volatile("" : "+v"(la[64]), "+v"(lbv[64]) :: "memory");
        asm volatile("" : "+v"(p));
#pragma unroll
        for (int c = 0; c < NCH; ++c) { *(float2*)(p + (size_t)c * 2048) = make_float2(sr, si); const float nr = dr * sr - di * si + la[c], ni = dr * si + di * sr + lbv[c]; sr = nr; si = ni; } }
}
__device__ __forceinline__ void mc_s5_unit(Frame& F, const Loc& L, int l, int b, int c, const float* outb) {
    const size_t row0 = (size_t)b * TB + c * 128; const bf16* Pc = (const bf16*)(F.ws + WS_PROJ) + row0 * NIN;
    const int il = L.lane & 15, g4 = L.lane >> 4, w = L.wave;
    unsigned gy[2][8][2];
#pragma unroll
    for (int gi = 0; gi < 2; ++gi) { const int gidx = 2 * w + gi; const float* xo = (const float*)((const unsigned char*)outb + OUT_S5X) + (((size_t)(b * NCH + c) * 16 + gidx) * 64 + L.lane) * 2; float xr = xo[0], xi = xo[1];
        s5_group<true>(F, L, l, gidx, Pc, xr, xi, gy[gi]); }
    __syncthreads();
    LAS bf16* GYs = (LAS bf16*)F.lds; LAS float* RED = (LAS float*)(F.lds + 128 * GY_LD * 2); LAS float* RSTD = RED + 1024;
#pragma unroll
    for (int gi = 0; gi < 2; ++gi)
#pragma unroll
        for (int s = 0; s < 8; ++s)
#pragma unroll
            for (int r = 0; r < 4; ++r) GYs[(16 * s + 4 * g4 + r) * GY_LD + 16 * (2 * w + gi) + il] = (bf16)(gy[gi][s][r >> 1] >> (16 * (r & 1)));
    __syncthreads();
    const f32x4 zero = {0.f, 0.f, 0.f, 0.f}; f32x4 acc[8][2];
#pragma unroll
    for (int tt = 0; tt < 8; ++tt) { acc[tt][0] = zero; acc[tt][1] = zero; }
    const bf16* WG = (const bf16*)(F.ws + WS_WGT) + (size_t)l * 65536;
    bf16x8 Wf[8][2];
#pragma unroll
    for (int ks = 0; ks < 8; ++ks) { Wf[ks][0] = *(const bf16x8*)(WG + (size_t)(32 * w + il) * 256 + 32 * ks + 8 * g4); Wf[ks][1] = *(const bf16x8*)(WG + (size_t)(32 * w + 16 + il) * 256 + 32 * ks + 8 * g4); }
#pragma unroll
    for (int ks = 0; ks < 8; ++ks) {
#pragma unroll
        for (int tt = 0; tt < 8; ++tt) { const bf16x8 Ag = *(const LAS bf16x8*)(GYs + (16 * tt + il) * GY_LD + 32 * ks + 8 * g4); acc[tt][0] = mfma16(Wf[ks][0], Ag, acc[tt][0]); acc[tt][1] = mfma16(Wf[ks][1], Ag, acc[tt][1]); } }
#pragma unroll
    for (int tt = 0; tt < 8; ++tt) { float ss = 0.f;
#pragma unroll
        for (int nt = 0; nt < 2; ++nt) { const unsigned long long gq = *(const LAS unsigned long long*)(GYs + (16 * tt + il) * GY_LD + 32 * w + 16 * nt + 4 * g4);
#pragma unroll
            for (int r = 0; r < 4; ++r) { const float v = bf2f((bf16)(gq >> (16 * r))) * sigmoid_f(acc[tt][nt][r]); acc[tt][nt][r] = v; ss += v * v; } }
        ss += __shfl_xor(ss, 16); ss += __shfl_xor(ss, 32); if (g4 == 0) RED[(16 * tt + il) * 8 + w] = ss; }
    __syncthreads();
    if (L.tid < 128) { const f32x4 a = *(const LAS f32x4*)(RED + L.tid * 8), bq = *(const LAS f32x4*)(RED + L.tid * 8 + 4); RSTD[L.tid] = rsqrtf((((a[0] + a[1]) + (a[2] + a[3])) + ((bq[0] + bq[1]) + (bq[2] + bq[3]))) * (1.0f / 256.0f) + EPS); }
    __syncthreads();
    const float* og = F.in[13] + l * 256; bf16* MX = (bf16*)(F.ws + WS_MIXED) + row0 * D;
#pragma unroll
    for (int tt = 0; tt < 8; ++tt) { const float rs = RSTD[16 * tt + il];
#pragma unroll
        for (int nt = 0; nt < 2; ++nt) { const int n0 = 32 * w + 16 * nt + 4 * g4; const f32x4 o4 = *(const f32x4*)(og + n0);
            *(GAS unsigned long long*)((char*)(MX + (size_t)16 * tt * D) + (unsigned)(il * D + n0) * 2u) = (unsigned long long)cvtpk(acc[tt][nt][0] * rs * o4[0], acc[tt][nt][1] * rs * o4[1]) | ((unsigned long long)cvtpk(acc[tt][nt][2] * rs * o4[2], acc[tt][nt][3] * rs * o4[3]) << 32); } }
    __syncthreads();
}
__device__ __forceinline__ void p_ma(Frame& F, int l, float* outb) {
    for (int rep = 0; rep < REP(13); ++rep) { const Loc L = make_loc(F.wave_s); for (int u = L.bx; u < 130; u += L.G) ma_s5_unit(F, L, l, u / NCH, u % NCH, outb); }
    for (int rep = 0; rep < REP(14); ++rep) { const Loc L = make_loc(F.wave_s); for (int u = (L.bx + 126) % L.G; u < 520; u += L.G) ma_hg_unit(F, L, l, u / 260, (u % 260) >> 2, u & 3, outb); }
    for (int rep = 0; rep < REP(15); ++rep) { const Loc L = make_loc(F.wave_s); for (int u = (L.bx + 126) % L.G; u < 1040; u += L.G) ma_ret_unit(F, L, u / 520, (u % 520) >> 3, u & 7, outb); }
}
__device__ __forceinline__ void p_mb(Frame& F, int l, float* outb) { const Loc L = make_loc(F.wave_s); mb_ret(L, outb); mb_hg(L, outb); mb_s5(F, L, l, outb); }
__device__ __forceinline__ void p_mc(Frame& F, int l, const float* outb) {
    for (int rep = 0; rep < REP(10); ++rep) { const Loc L = make_loc(F.wave_s); for (int u = L.bx; u < 130; u += L.G) mc_s5_unit(F, L, l, u / NCH, u % NCH, outb); }
    for (int rep = 0; rep < REP(11); ++rep) { const Loc L = make_loc(F.wave_s); for (int u = (L.bx + 126) % L.G; u < 520; u += L.G) mc_hg_unit(F, L, l, u / 260, (u % 260) >> 2, u & 3, outb); }
    for (int rep = 0; rep < REP(12); ++rep) { const Loc L = make_loc(F.wave_s); for (int u = (L.bx + 126) % L.G; u < 1040; u += L.G) mc_ret_unit(F, L, l, u / 520, (u % 520) >> 3, u & 7, outb); }
}
constexpr int MOETBL_OFF = SEG_OFF + 2048;
static_assert(MOETBL_OFF % 16 == 0 && MOETBL_OFF + 64 <= LDS_BYTES, "LDS map (MoE table)");
__device__ __forceinline__ void moe_table(Frame& F) {
    if (mk_tid(F.wave_s) == 0) { LAS int* tbl = (LAS int*)(F.lds + MOETBL_OFF); const unsigned* cnt = (const unsigned*)(F.ctl + CW_CNT); int acc = 0;
        for (int e = 0; e < 8; ++e) { tbl[e] = acc; acc += ((int)cnt[e] + 255) >> 8; } tbl[8] = acc; }
    __syncthreads();
}
__device__ __forceinline__ void p_w2conv(Frame& F) {
    const Loc L = make_loc(F.wave_s); LAS float* scr = (LAS float*)(F.lds + RING_OFF + L.wave * 16384); const int gw = L.vcu * NWAVES + L.wave, NGW = L.G * NWAVES; constexpr int I_M2 = 56 * 32;
    for (int it = gw; it < 8 * I_M2; it += NGW) { const int e = it / I_M2; tr_item(F.in[26] + (size_t)e * DFE * D, DFE, D, (bf16*)(F.ws + WS_WM2) + (size_t)e * D * DFE, 0, nullptr, scr, it % I_M2, L.lane); }
}
__device__ __forceinline__ void p_route(Frame& F) {
    const Loc L = make_loc(F.wave_s);
    const float* H = (const float*)(F.ws + WS_H); const float* gff = F.in[19] + D; const float* R = F.in[23];
    int* POS = (int*)(F.ws + WS_POS); float* GATE = (float*)(F.ws + WS_GATE); int* LIST = (int*)(F.ws + WS_LIST); unsigned* CNT = (unsigned*)(F.ctl + CW_CNT);
    LAS float* RT = (LAS float*)F.lds;
    for (int grp = L.bx; grp < BATCH * SEQ / 64; grp += L.G) {
        for (int j = 0; j < 8; ++j) { const int tk = grp * 64 + L.wave * 8 + j; const size_t m = (size_t)(tk / SEQ) * TB + 128 + (tk % SEQ);
            float ss = 0.f, part[8];
#pragma unroll
            for (int e = 0; e < 8; ++e) part[e] = 0.f;
#pragma unroll
            for (int jj = 0; jj < 4; ++jj) { const f32x4 v = ((const GAS f32x4*)(H + m * D))[L.lane + 64 * jj]; const int d0 = 4 * L.lane + 256 * jj;
                ss += (v.x * v.x + v.y * v.y) + (v.z * v.z + v.w * v.w);
#pragma unroll
                for (int q = 0; q < 4; ++q) { const float hv = v[q] * gff[d0 + q]; const f32x4 r0 = *(const f32x4*)(R + (d0 + q) * 8), r1 = *(const f32x4*)(R + (d0 + q) * 8 + 4);
                    part[0] += hv * r0.x; part[1] += hv * r0.y; part[2] += hv * r0.z; part[3] += hv * r0.w; part[4] += hv * r1.x; part[5] += hv * r1.y; part[6] += hv * r1.z; part[7] += hv * r1.w; } }
            const float rstd = rsqrtf(wave_sum(ss) * (1.0f / 1024.0f) + EPS); float lg[8];
#pragma unroll
            for (int e = 0; e < 8; ++e) lg[e] = wave_sum(part[e]) * rstd;
            int i1 = 0; float l1 = lg[0];
#pragma unroll
            for (int e = 1; e < 8; ++e) if (lg[e] > l1) { l1 = lg[e]; i1 = e; }
            int i2 = -1; float l2 = -3.0e38f;
#pragma unroll
            for (int e = 0; e < 8; ++e) if (e != i1 && lg[e] > l2) { l2 = lg[e]; i2 = e; }
            const float e2 = __expf(l2 - l1), g1 = 1.0f / (1.0f + e2), g2 = e2 * g1;
            if (L.lane == 0) { const int sl = L.wave * 8 + j; RT[sl * 4 + 0] = __int_as_float(i1); RT[sl * 4 + 1] = __int_as_float(i2); RT[sl * 4 + 2] = g1; RT[sl * 4 + 3] = g2; } }
        __syncthreads();
        if (L.wave == 0) { const int tk = grp * 64 + L.lane; const int e1 = __float_as_int(RT[L.lane * 4 + 0]), e2 = __float_as_int(RT[L.lane * 4 + 1]); const float g1 = RT[L.lane * 4 + 2], g2 = RT[L.lane * 4 + 3];
            const int row = (tk / SEQ) * TB + 128 + (tk % SEQ); const unsigned long long lt = (1ull << L.lane) - 1ull; int p1 = 0, p2 = 0;
#pragma unroll
            for (int e = 0; e < 8; ++e) { const unsigned long long m1 = __ballot(e1 == e), m2 = __ballot(e2 == e); const int n1 = __popcll(m1), n2 = __popcll(m2);
                unsigned base = 0u; if (L.lane == 0 && n1 + n2 > 0) base = atomicAdd(CNT + e, (unsigned)(n1 + n2)); base = __shfl(base, 0);
                if (e1 == e) p1 = (int)base + __popcll(m1 & lt); if (e2 == e) p2 = (int)base + n1 + __popcll(m2 & lt); }
            LIST[(size_t)e1 * MOE_CAP + p1] = row; LIST[(size_t)e2 * MOE_CAP + p2] = row;
            POS[tk * 2] = (e1 << 20) | p1; POS[tk * 2 + 1] = (e2 << 20) | p2; GATE[tk * 2] = g1; GATE[tk * 2 + 1] = g2; }
        __syncthreads();
    }
}
__device__ __forceinline__ void p_final(Frame& F, float* out) {
    const Loc L = make_loc(F.wave_s);
    const int gw = L.vcu * NWAVES + L.wave, NGW = L.G * NWAVES; const float* H = (const float*)(F.ws + WS_H); const float* gf = F.in[27];
    const int* POS = (const int*)(F.ws + WS_POS); const float* GATE = (const float*)(F.ws + WS_GATE); const bf16* YS = (const bf16*)(F.ws + WS_YS); const unsigned* CNT = (const unsigned*)(F.ctl + CW_CNT);
    moe_table(F); const LAS int* tbl = (const LAS int*)(F.lds + MOETBL_OFF);
    for (int r = gw; r < BATCH * SEQ; r += NGW) { const int b = r / SEQ, t = r % SEQ; const size_t m = (size_t)b * TB + 128 + t;
        const int q1 = POS[r * 2], q2 = POS[r * 2 + 1]; const float g1 = GATE[r * 2], g2 = GATE[r * 2 + 1]; const int t1 = tbl[q1 >> 20], t2 = tbl[q2 >> 20];
        const size_t s1 = (size_t)t1 * 256 + (q1 & 0xfffff), s2 = (size_t)t2 * 256 + (q2 & 0xfffff);
        f32x4 v[4]; float s = 0.f;
#pragma unroll
        for (int j = 0; j < 4; ++j) { v[j] = ((const GAS f32x4*)(H + m * D))[L.lane + 64 * j];
            const unsigned long long y1 = ((const GAS unsigned long long*)(YS + s1 * D))[L.lane + 64 * j], y2 = ((const GAS unsigned long long*)(YS + s2 * D))[L.lane + 64 * j];
#pragma unroll
            for (int q = 0; q < 4; ++q) v[j][q] += g1 * bf2f((bf16)(y1 >> (16 * q))) + g2 * bf2f((bf16)(y2 >> (16 * q)));
            s += (v[j].x * v[j].x + v[j].y * v[j].y) + (v[j].z * v[j].z + v[j].w * v[j].w); }
        const float rstd = rsqrtf(wave_sum(s) * (1.0f / 1024.0f) + EPS);
#pragma unroll
        for (int j = 0; j < 4; ++j) { const f32x4 g = ((const GAS f32x4*)gf)[L.lane + 64 * j]; ((GAS f32x4*)(out + (size_t)r * D))[L.lane + 64 * j] = v[j] * rstd * g; }
        if (PROBE_TA >= 0 && r == 0 && L.lane == 0) { asm volatile("s_waitcnt vmcnt(0)" ::: "memory"); out[0] = 0.01f * (float)(__hip_atomic_load(F.ctl + CW_PROBE + (PROBE_TB >= 0 ? PROBE_TB : 0), RLX_AGENT) - __hip_atomic_load(F.ctl + CW_PROBE + (PROBE_TA >= 0 ? PROBE_TA : 0), RLX_AGENT)); }
    }
}

struct Args { const float* in[28]; float* out; unsigned char* ws; int ph_lo, ph_hi, li, pad; };
__global__ void __launch_bounds__(NWAVES * 64, 2) __attribute__((amdgpu_waves_per_eu(2, 2))) mk_fwd(Args args) {
    extern __shared__ __attribute__((aligned(16))) unsigned char lds[];
    Frame F;
    F.lds = (LAS unsigned char*)lds; F.MISC = (volatile LAS unsigned*)(F.lds + MISC_OFF);
    F.ws = args.ws; F.ctl = (gu32*)(args.ws + WS_CTL); F.in = args.in; F.wave_s = __builtin_amdgcn_readfirstlane((int)threadIdx.x >> 6);
    for (int u = mk_tid(F.wave_s); u < (LDS_BYTES - LDSCTL_OFF) / 4; u += NWAVES * 64) ((LAS unsigned*)(F.lds + LDSCTL_OFF))[u] = 0u;
    __syncthreads();
    XcdBarrier bar; bar.bar = (unsigned*)(F.ctl + CW_BAR); bar.x = 0; bar.st = nullptr; bar.wv = F.wave_s;
    if (!MK_PER_PHASE) bar = xcd_barrier_post((unsigned*)(F.ctl + CW_BAR), F.MISC + 8, F.wave_s);
    const int lo = args.ph_lo, hi = args.ph_hi;
#define IN(k) (lo <= (k) && (k) < hi)
#define SEAM(k) do { if (!MK_PER_PHASE && (k) + 1 < hi) xcd_barrier(bar); } while (0)
    unsigned char* ws = args.ws;
    float* SS = (float*)(ws + WS_SSP);
    if (IN(0)) for (int rep = 0; rep < REP(1); ++rep) { p0_prologue(F); SEAM(0); }
    for (int l = 0; l < 2; ++l) {
        const int base = 1 + 30 * l;
        if (IN(base + 0)) for (int rep = 0; rep < REP(2); ++rep) {
            pg8::Gemm g{(const bf16*)(ws + WS_HB), (const bf16*)(ws + WS_WIN) + (size_t)l * NIN * D, M, NIN, D, F.wave_s}; pg8::StaticOrder S; const Loc L = make_loc(F.wave_s); S.init(M, NIN, L.G, L.bx);
            pg8::EpiProj E{(bf16*)(ws + WS_PROJ), NIN, SS + (size_t)(2 * l) * M * 16};
            pg8::gemm_phase<pg8::EpiProj, pg8::StaticOrder, true, true>(F.lds + RING_OFF, g, S, E);
            SEAM(base + 0);
        }
        if (IN(base + 1)) for (int rep = 0; rep < REP(3); ++rep) { p_ma(F, l, args.out); SEAM(base + 1); }
        if (IN(base + 2)) { p_mb(F, l, args.out); SEAM(base + 2); }
        if (IN(base + 3)) for (int rep = 0; rep < REP(4); ++rep) { p_mc(F, l, args.out); SEAM(base + 3); }
        if (IN(base + 6)) {
            pg8::Gemm g{(const bf16*)(ws + WS_MIXED), (const bf16*)(ws + WS_WOUT) + (size_t)l * D * D, M, D, D, F.wave_s}; pg8::StaticOrder S; const Loc L = make_loc(F.wave_s); S.init(M, D, L.G, L.bx);
            pg8::EpiResid E{(float*)(ws + WS_H), (bf16*)(ws + WS_HB), SS + (size_t)(2 * l + 1) * M * 16, nullptr, 0, 1};
            pg8::gemm_phase<pg8::EpiResid, pg8::StaticOrder, true, true>(F.lds + RING_OFF, g, S, E);
            SEAM(base + 6);
        }
        if (l == 0) {
            if (IN(base + 8)) for (int rep = 0; rep < REP(5); ++rep) {
                pg8::Gemm g{(const bf16*)(ws + WS_HB), (const bf16*)(ws + WS_WF13), M, 2 * DFF, D, F.wave_s}; pg8::StaticOrder S; const Loc L = make_loc(F.wave_s); S.init(M, 2 * DFF, L.G, L.bx);
                pg8::EpiSwiglu E{(bf16*)(ws + WS_ACT), DFF, SS + (size_t)1 * M * 16};
                pg8::gemm_phase<pg8::EpiSwiglu, pg8::StaticOrder, true, true>(F.lds + RING_OFF, g, S, E);
                SEAM(base + 8);
            }
            if (IN(base + 9)) {
                pg8::Gemm g{(const bf16*)(ws + WS_ACT), (const bf16*)(ws + WS_WF2), M, D, DFF, F.wave_s}; pg8::StaticOrder S; const Loc L = make_loc(F.wave_s); S.init(M, D, L.G, L.bx);
                pg8::EpiResid E{(float*)(ws + WS_H), (bf16*)(ws + WS_HB), SS + (size_t)2 * M * 16, nullptr, 0, 1};
                pg8::gemm_phase<pg8::EpiResid, pg8::StaticOrder, true, true>(F.lds + RING_OFF, g, S, E);
                SEAM(base + 9);
            }
        } else {
            if (IN(base + 7)) { p_route(F); SEAM(base + 7); }
            if (IN(base + 10)) for (int rep = 0; rep < REP(6); ++rep) {
                pg8::Gemm g{(const bf16*)(ws + WS_HB), (const bf16*)(ws + WS_WM13), MOE_TMAX * 256, NEXP * 2 * DFE, D, F.wave_s}; const Loc L = make_loc(F.wave_s);
                moe_table(F); pg8::MoeOrder<true> S; S.init((const int*)(F.ctl + CW_CNT), (const int*)(ws + WS_LIST), MOE_CAP, 2 * DFE / 256, L.G, L.bx, (const LAS int*)(F.lds + MOETBL_OFF));
                pg8::EpiSwigluMoe E{(bf16*)(ws + WS_ACT), DFE, SS + (size_t)3 * M * 16, (const int*)(ws + WS_LIST), MOE_CAP, 2 * DFE / 256};
                pg8::gemm_phase<pg8::EpiSwigluMoe, pg8::MoeOrder<true>, true, true>(F.lds + RING_OFF, g, S, E);
                SEAM(base + 10);
            }
            if (IN(base + 11)) for (int rep = 0; rep < REP(8); ++rep) { p_w2conv(F); SEAM(base + 11); }
            if (IN(base + 12)) for (int rep = 0; rep < REP(7); ++rep) {
                pg8::Gemm g{(const bf16*)(ws + WS_ACT), (const bf16*)(ws + WS_WM2), MOE_TMAX * 256, NEXP * D, DFE, F.wave_s}; const Loc L = make_loc(F.wave_s);
                moe_table(F); pg8::MoeOrder<false> S; S.init((const int*)(F.ctl + CW_CNT), (const int*)(ws + WS_LIST), MOE_CAP, D / 256, L.G, L.bx, (const LAS int*)(F.lds + MOETBL_OFF));
                pg8::EpiYs E{(bf16*)(ws + WS_YS)};
                pg8::gemm_phase<pg8::EpiYs, pg8::MoeOrder<false>, true, true>(F.lds + RING_OFF, g, S, E);
                SEAM(base + 12);
            }
        }
    }
    if (IN(NPH - 1)) p_final(F, args.out);
#undef IN
#undef SEAM
}

extern "C" void kernel_launch(void* const* d_in, const int* in_sizes, int n_in, void* d_out, int out_size, void* d_ws, size_t ws_size, hipStream_t stream) {
    static int grid = 0;
    if (grid == 0) {
        if (n_in != 28 || out_size != BATCH * SEQ * D || ws_size < WS_END) { fprintf(stderr, "kernel_launch: unexpected shapes: n_in %d out %d ws %zu (need %zu)\n", n_in, out_size, ws_size, (size_t)WS_END); grid = -1; return; }
        int dev = 0, cus = 0, per_cu = 0;
        if (hipGetDevice(&dev) != hipSuccess || hipDeviceGetAttribute(&cus, hipDeviceAttributeMultiprocessorCount, dev) != hipSuccess) { grid = -1; return; }
        if (hipFuncSetAttribute((const void*)mk_fwd, hipFuncAttributeMaxDynamicSharedMemorySize, LDS_BYTES) != hipSuccess) { fprintf(stderr, "kernel_launch: hipFuncSetAttribute failed\n"); grid = -1; return; }
        if (hipOccupancyMaxActiveBlocksPerMultiprocessor(&per_cu, (const void*)mk_fwd, NWAVES * 64, LDS_BYTES) != hipSuccess || per_cu < 1) { fprintf(stderr, "kernel_launch: occupancy query says %d\n", per_cu); }
        (void)hipGetLastError();
        grid = cus;
    }
    if (grid < 0) return;
    if (hipMemsetAsync((char*)d_ws + WS_CTL, 0, CTL_ZERO_BYTES, stream) != hipSuccess) return;
    Args a{};
    for (int i = 0; i < 28; ++i) a.in[i] = (const float*)d_in[i];
    a.out = (float*)d_out; a.ws = (unsigned char*)d_ws;
#if MK_PER_PHASE
    for (int k = 0; k < NPH; ++k) { if (!phase_exists(k)) continue; a.ph_lo = k; a.ph_hi = k + 1; a.li = 0; hipLaunchKernelGGL(mk_fwd, dim3(grid), dim3(NWAVES * 64), LDS_BYTES, stream, a); }
#else
    a.ph_lo = 0; a.ph_hi = NPH; a.li = 0;
    hipLaunchKernelGGL(mk_fwd, dim3(grid), dim3(NWAVES * 64), LDS_BYTES, stream, a);
#endif
}
```

```cpp
#include <hip/hip_runtime.h>
#include <cstdio>
#include <cstdint>
#include <cmath>
#define PIN4(a, b, c, d) asm volatile("" : "+v"(a), "+v"(b), "+v"(c), "+v"(d) :: "memory")
#define PIN8(a, b, c, d, e, f, g, h) asm volatile("" : "+v"(a), "+v"(b), "+v"(c), "+v"(d), "+v"(e), "+v"(f), "+v"(g), "+v"(h) :: "memory")
#define PIN16O(A, o) asm volatile("" : "+v"(A[(o) + 0]), "+v"(A[(o) + 1]), "+v"(A[(o) + 2]), "+v"(A[(o) + 3]), "+v"(A[(o) + 4]), "+v"(A[(o) + 5]), "+v"(A[(o) + 6]), "+v"(A[(o) + 7]), "+v"(A[(o) + 8]), "+v"(A[(o) + 9]), "+v"(A[(o) + 10]), "+v"(A[(o) + 11]), "+v"(A[(o) + 12]), "+v"(A[(o) + 13]), "+v"(A[(o) + 14]), "+v"(A[(o) + 15]) :: "memory")
#define PIN16(A) asm volatile("" : "+v"(A[0]), "+v"(A[1]), "+v"(A[2]), "+v"(A[3]), "+v"(A[4]), "+v"(A[5]), "+v"(A[6]), "+v"(A[7]), "+v"(A[8]), "+v"(A[9]), "+v"(A[10]), "+v"(A[11]), "+v"(A[12]), "+v"(A[13]), "+v"(A[14]), "+v"(A[15]) :: "memory")
__device__ __forceinline__ int mk_tid(int wave_s) { int z = 0; asm volatile("" : "+v"(z)); return wave_s * 64 + (int)__builtin_amdgcn_mbcnt_hi(~0u, __builtin_amdgcn_mbcnt_lo(~0u, (unsigned)z)); }
namespace pg8 {
#define PG8_LAS __attribute__((address_space(3)))
typedef unsigned short bf16_t;
typedef short bf16x8 __attribute__((ext_vector_type(8)));
typedef float f32x4 __attribute__((ext_vector_type(4)));
typedef unsigned u32x4 __attribute__((ext_vector_type(4)));
constexpr int BM = 256, BK = 64, HALF = 128, HTB = HALF * BK * 2  , STAGE_BYTES = 8 * HTB, NXCD = 8, WGM = 8;

__host__ __device__ __forceinline__ int lds_byte(int r, int c) { const int st = (r >> 4) * 2 + (c >> 5), rr = r & 15, cc = c & 31, ob = rr * 64 + cc * 2; return st * 1024 + (ob ^ (((ob >> 9) & 1) << 5)); }
__host__ __device__ __forceinline__ void stage_rc(int b, int& R, int& C) { const int st = b / 1024, sb = b % 1024, swz = sb ^ (((sb >> 9) & 1) << 5); R = (st >> 1) * 16 + swz / 64; C = (st & 1) * 32 + (swz % 64) / 2; }
__host__ __device__ __forceinline__ int perm32(int rho) { const int n = rho >> 4, i = rho & 15; return 8 * (i >> 2) + 4 * n + (i & 3); }

struct Unit { int pm, pn, e, r0, ce; };
struct Gemm { const bf16_t* A; const bf16_t* Bt; int M, N, K, wv; };

struct StaticOrder {
    static constexpr bool GATHER = false;
    int nM, nN, nwg, G, c;
    __host__ __device__ void init(int M, int N, int G_, int c_) { nM = M / BM; nN = N / BM; nwg = nM * nN; G = G_; c = c_; }
    __host__ __device__ bool next(int i, Unit& u) const {
        const long L = (long)i * G + c; if (L >= nwg) return false;
        int wgid = (int)L; { const int q = nwg / NXCD, r = nwg % NXCD, xcd = wgid % NXCD, off = wgid / NXCD; wgid = (xcd < r ? xcd * (q + 1) : r * (q + 1) + (xcd - r) * q) + off; }
        const int nig = WGM * nN, gid = wgid / nig, fm = gid * WGM, gsz = (nM - fm) < WGM ? (nM - fm) : WGM;
        u.pm = fm + ((wgid % nig) % gsz); u.pn = (wgid % nig) / gsz; return true;
    }
    __device__ __forceinline__ void a_ready(const Unit&) const {}
    __device__ __forceinline__ void done(const Unit&) const {}
    __device__ __forceinline__ int arow(const Unit&, int) const { return 0; }
};

__device__ __forceinline__ unsigned cvt_pk_bf16(float lo, float hi) { unsigned r; asm volatile("v_cvt_pk_bf16_f32 %0, %1, %2" : "=v"(r) : "v"(lo), "v"(hi)); return r; }
typedef float f32x2 __attribute__((ext_vector_type(2)));
constexpr float RMS_EPS = 1e-6f;
__device__ __forceinline__ float fast_silu(float a) { return a * __builtin_amdgcn_rcpf(1.0f + __expf(-a)); }
__device__ __forceinline__ float rstd_of(const f32x4 a, const f32x4 b, const f32x4 c, const f32x4 d) {
    const float t = (((a[0] + a[1]) + (a[2] + a[3])) + ((b[0] + b[1]) + (b[2] + b[3]))) + (((c[0] + c[1]) + (c[2] + c[3])) + ((d[0] + d[1]) + (d[2] + d[3])));
    return __builtin_amdgcn_rsqf(t * (1.0f / 1024.0f) + RMS_EPS); }
__device__ __forceinline__ float row_rstd(const float* ss, int row) { const f32x4* p = (const f32x4*)(ss + (size_t)row * 16); return rstd_of(p[0], p[1], p[2], p[3]); }
__device__ __forceinline__ void row_rstd4(const float* ss, int row0, float (&sc)[4]) {
    f32x4 v[4][4];
#pragma unroll
    for (int m = 0; m < 4; ++m)
#pragma unroll
        for (int j = 0; j < 4; ++j) v[m][j] = *(const f32x4*)(ss + (size_t)(row0 + 16 * m) * 16 + 4 * j);
    PIN8(v[0][0], v[0][1], v[0][2], v[0][3], v[1][0], v[1][1], v[1][2], v[1][3]); PIN8(v[2][0], v[2][1], v[2][2], v[2][3], v[3][0], v[3][1], v[3][2], v[3][3]);
#pragma unroll
    for (int m = 0; m < 4; ++m) sc[m] = rstd_of(v[m][0], v[m][1], v[m][2], v[m][3]);
}
struct EpiProj {
    static constexpr bool PERM = true, AFTER_DRAIN = false;
    bf16_t* O; int ldc; const float* ss;
    __device__ __forceinline__ void operator()(const f32x4 (&acc)[2][2][4][2], const Unit& u, int wr, int wc, int fr, int fq) const {
        const int row0 = u.pm * BM + wr * 64 + fr, col0 = u.pn * BM + wc * 32 + 8 * fq;
#pragma unroll
        for (int ai = 0; ai < 2; ++ai) { float sc4[4]; row_rstd4(ss, row0 + ai * HALF, sc4);
#pragma unroll
            for (int m = 0; m < 4; ++m) { const int row = row0 + ai * HALF + m * 16; const float sc = sc4[m];
                bf16_t* rowp = O + (size_t)row * ldc + col0;
#pragma unroll
                for (int bj = 0; bj < 2; ++bj) { const f32x4 v0 = acc[ai][bj][m][0] * sc, v1 = acc[ai][bj][m][1] * sc;
                    u32x4 w; w.x = cvt_pk_bf16(v0[0], v0[1]); w.y = cvt_pk_bf16(v0[2], v0[3]); w.z = cvt_pk_bf16(v1[0], v1[1]); w.w = cvt_pk_bf16(v1[2], v1[3]);
                    *(u32x4*)(rowp + bj * HALF) = w; } } }
    }
};
struct EpiSwiglu {
    static constexpr bool PERM = true, AFTER_DRAIN = false;
    bf16_t* O; int ldc; const float* ss;
    __device__ __forceinline__ void operator()(const f32x4 (&acc)[2][2][4][2], const Unit& u, int wr, int wc, int fr, int fq) const {
        const int row0 = u.pm * BM + wr * 64 + fr, col0 = u.pn * HALF + wc * 32 + 8 * fq;
#pragma unroll
        for (int ai = 0; ai < 2; ++ai) { float sc4[4]; row_rstd4(ss, row0 + ai * HALF, sc4);
#pragma unroll
            for (int m = 0; m < 4; ++m) { const int row = row0 + ai * HALF + m * 16; const float sc = sc4[m];
                const f32x4 a0 = acc[ai][0][m][0] * sc, a1 = acc[ai][0][m][1] * sc, b0 = acc[ai][1][m][0] * sc, b1 = acc[ai][1][m][1] * sc;
                u32x4 w; w.x = cvt_pk_bf16(fast_silu(a0[0]) * b0[0], fast_silu(a0[1]) * b0[1]); w.y = cvt_pk_bf16(fast_silu(a0[2]) * b0[2], fast_silu(a0[3]) * b0[3]);
                w.z = cvt_pk_bf16(fast_silu(a1[0]) * b1[0], fast_silu(a1[1]) * b1[1]); w.w = cvt_pk_bf16(fast_silu(a1[2]) * b1[2], fast_silu(a1[3]) * b1[3]);
                *(u32x4*)(O + (size_t)row * ldc + col0) = w; } }
    }
};
struct EpiResid {
    static constexpr bool PERM = false, AFTER_DRAIN = false;
    bf16_t* HB; float* ssout; const float* gate; int gstride; int write_ss;
    __device__ __forceinline__ void operator()(const f32x4 (&acc)[2][2][4][2], const Unit& u, int wr, int wc, int fr, int fq) const {
        const int row0 = u.pm * BM + wr * 64 + fr, col0 = u.pn * BM + wc * 32 + 4 * fq;
#pragma unroll
        for (int ai = 0; ai < 2; ++ai) {
            unsigned long long hv[4][2][2];
#pragma unroll
            for (int m = 0; m < 4; ++m)
#pragma unroll
                for (int bj = 0; bj < 2; ++bj)
#pragma unroll
                    for (int n = 0; n < 2; ++n) hv[m][bj][n] = *(const unsigned long long*)(HB + (size_t)(row0 + ai * HALF + m * 16) * 1024 + col0 + bj * HALF + n * 16);
            PIN8(hv[0][0][0], hv[0][0][1], hv[0][1][0], hv[0][1][1], hv[1][0][0], hv[1][0][1], hv[1][1][0], hv[1][1][1]); PIN8(hv[2][0][0], hv[2][0][1], hv[2][1][0], hv[2][1][1], hv[3][0][0], hv[3][0][1], hv[3][1][0], hv[3][1][1]);
#pragma unroll
            for (int m = 0; m < 4; ++m) { const int row = row0 + ai * HALF + m * 16; const float g = gate ? gate[(size_t)row * gstride] : 1.0f; float s = 0.f;
#pragma unroll
                for (int bj = 0; bj < 2; ++bj)
#pragma unroll
                    for (int n = 0; n < 2; ++n) { const unsigned long long h = hv[m][bj][n]; f32x4 o;
                        o[0] = __uint_as_float((unsigned)h << 16); o[1] = __uint_as_float((unsigned)h & 0xffff0000u); o[2] = __uint_as_float((unsigned)(h >> 32) << 16); o[3] = __uint_as_float((unsigned)(h >> 32) & 0xffff0000u);
                        o = o + acc[ai][bj][m][n] * g; s += (o[0] * o[0] + o[1] * o[1]) + (o[2] * o[2] + o[3] * o[3]);
                        *(unsigned long long*)(HB + (size_t)row * 1024 + col0 + bj * HALF + n * 16) = (unsigned long long)cvt_pk_bf16(o[0], o[1]) | ((unsigned long long)cvt_pk_bf16(o[2], o[3]) << 32); }
                if (write_ss) { s += __shfl_xor(s, 16); s += __shfl_xor(s, 32); if (fq == 0) ssout[(size_t)row * 16 + u.pn * 4 + wc] = s; } } }
    }
};
template <bool GATH> struct MoeOrder {
    static constexpr bool GATHER = GATH;
    int nNe, nT, nwg, G, c, cap; const int* list; const int* cnt; const PG8_LAS int* tbl;
    __device__ __forceinline__ void init(const int* cnt_, const int* list_, int cap_, int nNe_, int G_, int c_, const PG8_LAS int* tbl_) { list = list_; cnt = cnt_; tbl = tbl_; cap = cap_; nNe = nNe_; G = G_; c = c_; nT = tbl_[8]; nwg = nT * nNe; }
    __device__ __forceinline__ bool next(int i, Unit& u) const {
        const long L = (long)i * G + c; if (L >= nwg) return false;
        int wgid = (int)L; { const int q = nwg / NXCD, r = nwg % NXCD, xcd = wgid % NXCD, off = wgid / NXCD; wgid = (xcd < r ? xcd * (q + 1) : r * (q + 1) + (xcd - r) * q) + off; }
        const int nig = WGM * nNe, gid = wgid / nig, fm = gid * WGM, gsz = (nT - fm) < WGM ? (nT - fm) : WGM;
        const int t = fm + ((wgid % nig) % gsz), pnl = (wgid % nig) / gsz;
        int e = 0;
#pragma unroll
        for (int k = 1; k < 8; ++k) e += (t >= tbl[k]) ? 1 : 0;
        e = __builtin_amdgcn_readfirstlane(e);
        u.pm = t; u.pn = e * nNe + pnl; u.e = e; u.r0 = (t - __builtin_amdgcn_readfirstlane(tbl[e])) * BM; u.ce = cnt[e]; return true;
    }
    __device__ __forceinline__ int arow(const Unit& u, int R) const { const int pos = u.r0 + R; return pos < u.ce ? list[(size_t)u.e * cap + pos] : 0; }
    __device__ __forceinline__ void a_ready(const Unit&) const {}
    __device__ __forceinline__ void done(const Unit&) const {}
};
struct EpiSwigluMoe {
    static constexpr bool PERM = true, AFTER_DRAIN = false;
    bf16_t* O; int ldc; const float* rs; int cap, nNe;
    __device__ __forceinline__ void operator()(const f32x4 (&acc)[2][2][4][2], const Unit& u, int wr, int wc, int fr, int fq) const {
        const int r0 = wr * 64 + fr, col0 = (u.pn - u.e * nNe) * HALF + wc * 32 + 8 * fq;
        float sc8[8];
#pragma unroll
        for (int i = 0; i < 8; ++i) { const int pos = u.r0 + r0 + (i >> 2) * HALF + (i & 3) * 16; sc8[i] = pos < u.ce ? rs[(size_t)u.e * cap + pos] : 0.0f; }
        PIN8(sc8[0], sc8[1], sc8[2], sc8[3], sc8[4], sc8[5], sc8[6], sc8[7]);
#pragma unroll
        for (int ai = 0; ai < 2; ++ai)
#pragma unroll
            for (int m = 0; m < 4; ++m) { const int R = r0 + ai * HALF + m * 16; const float sc = sc8[ai * 4 + m];
                const f32x4 a0 = acc[ai][0][m][0] * sc, a1 = acc[ai][0][m][1] * sc, b0 = acc[ai][1][m][0] * sc, b1 = acc[ai][1][m][1] * sc;
                u32x4 w; w.x = cvt_pk_bf16(fast_silu(a0[0]) * b0[0], fast_silu(a0[1]) * b0[1]); w.y = cvt_pk_bf16(fast_silu(a0[2]) * b0[2], fast_silu(a0[3]) * b0[3]);
                w.z = cvt_pk_bf16(fast_silu(a1[0]) * b1[0], fast_silu(a1[1]) * b1[1]); w.w = cvt_pk_bf16(fast_silu(a1[2]) * b1[2], fast_silu(a1[3]) * b1[3]);
                *(u32x4*)(O + (size_t)(u.pm * BM + R) * ldc + col0) = w; }
    }
};
struct EpiYs {
    static constexpr bool PERM = true, AFTER_DRAIN = false;
    bf16_t* O;
    __device__ __forceinline__ void operator()(const f32x4 (&acc)[2][2][4][2], const Unit& u, int wr, int wc, int fr, int fq) const {
        const int row0 = u.pm * BM + wr * 64 + fr, col0 = (u.pn - u.e * 4) * BM + wc * 32 + 8 * fq;
#pragma unroll
        for (int ai = 0; ai < 2; ++ai)
#pragma unroll
            for (int m = 0; m < 4; ++m) { bf16_t* rowp = O + (size_t)(row0 + ai * HALF + m * 16) * 1024 + col0;
#pragma unroll
                for (int bj = 0; bj < 2; ++bj) { const f32x4 v0 = acc[ai][bj][m][0], v1 = acc[ai][bj][m][1];
                    u32x4 w; w.x = cvt_pk_bf16(v0[0], v0[1]); w.y = cvt_pk_bf16(v0[2], v0[3]); w.z = cvt_pk_bf16(v1[0], v1[1]); w.w = cvt_pk_bf16(v1[2], v1[3]);
                    *(u32x4*)(rowp + bj * HALF) = w; } }
    }
};
template <class Epi, class Sched, bool ALIGN_EPI = false, bool SP2 = false>
__device__ __forceinline__ void gemm_phase(PG8_LAS unsigned char* lds, const Gemm g, const Sched& S, const Epi& E) {
    int tid_ = mk_tid(g.wv); asm volatile("" : "+v"(tid_));
    const int tid = tid_, wid = __builtin_amdgcn_readfirstlane(tid >> 6), lane = tid & 63, wr = wid >> 2, wc = wid & 3, fr = lane & 15, fq = lane >> 4;
    const int K = g.K, nt = K / BK;
    unsigned voffA[2], voffB[2];
#pragma unroll
    for (int i = 0; i < 2; ++i) { int R, C; stage_rc(tid * 16 + i * 8192, R, C); const int Rb = Epi::PERM ? ((R & ~31) + perm32(R & 31)) : R;
        voffA[i] = (unsigned)(R * K + C) * 2u; voffB[i] = (unsigned)(Rb * K + C) * 2u; }
    const size_t kstep = (size_t)(BK * 2);
    const size_t hstep = (size_t)HALF * K * 2;
    const size_t tstep = 2 * hstep;
    const unsigned ldsw = (unsigned)wid * 1024u;
    const int aoff = lds_byte(wr * 64 + fr, fq * 8), boff = lds_byte(wc * 32 + fr, fq * 8);
#define PG8_SA(b, h) (((b) * 2 + (h)) * HTB)
#define PG8_SB(b, h) ((4 + (b) * 2 + (h)) * HTB)
#define PG8_STAGE(bufoff, gbase, voff) do { _Pragma("unroll") for (int _i = 0; _i < 2; ++_i) \
        __builtin_amdgcn_global_load_lds((const unsigned*)((const char*)(gbase) + (voff)[_i]), (PG8_LAS unsigned*)(lds + (bufoff) + ldsw + _i * 8192), 16, 0, 0); } while (0)
#define PG8_STAGE_A(bufoff, gbase, hh, NX) do { if constexpr (Sched::GATHER) { const unsigned _o[2] = {((NX) && last) ? ngvo[hh][0] : gvo[hh][0], ((NX) && last) ? ngvo[hh][1] : gvo[hh][1]}; PG8_STAGE(bufoff, gbase, _o); } \
        else { PG8_STAGE(bufoff, (gbase) + ((hh) ? hstep : 0), voffA); } } while (0)
#define PG8_LDA(dst, b, h) do { _Pragma("unroll") for (int m = 0; m < 4; ++m) _Pragma("unroll") for (int k = 0; k < 2; ++k) dst[m][k] = *(const PG8_LAS bf16x8*)(lds + PG8_SA(b, h) + aoff + m * 2048 + k * 1024); } while (0)
#define PG8_LDB(dst, b, h) do { _Pragma("unroll") for (int n = 0; n < 2; ++n) _Pragma("unroll") for (int k = 0; k < 2; ++k) dst[n][k] = *(const PG8_LAS bf16x8*)(lds + PG8_SB(b, h) + boff + n * 2048 + k * 1024); } while (0)
#define PG8_MMA(ai, bj, At, Bt) do { __builtin_amdgcn_s_setprio(1); _Pragma("unroll") for (int m = 0; m < 4; ++m) _Pragma("unroll") for (int n = 0; n < 2; ++n) _Pragma("unroll") for (int k = 0; k < 2; ++k) \
        acc[ai][bj][m][n] = __builtin_amdgcn_mfma_f32_16x16x32_bf16(Bt[n][k], At[m][k], acc[ai][bj][m][n], 0, 0, 0); __builtin_amdgcn_s_setprio(0); } while (0)
#define PG8_WAIT_V(n) asm volatile("s_waitcnt vmcnt(" #n ")" ::: "memory")
#define PG8_WAIT_L(n) asm volatile("s_waitcnt lgkmcnt(" #n ")" ::: "memory")
#define PG8_BAR __builtin_amdgcn_s_barrier()
#define PG8_SCHED __builtin_amdgcn_sched_barrier(0)
    Unit cur, nxt; int ui = 0;
    if (!S.next(0, cur)) return;
    f32x4 acc[2][2][4][2];
#pragma unroll
    for (int a = 0; a < 2; ++a)
#pragma unroll
        for (int b = 0; b < 2; ++b)
#pragma unroll
            for (int m = 0; m < 4; ++m)
#pragma unroll
                for (int n = 0; n < 2; ++n) acc[a][b][m][n] = (f32x4){0.f, 0.f, 0.f, 0.f};
    bf16x8 At[4][2], B0[2][2], B1[2][2];
    const char* cA = (const char*)g.A + (Sched::GATHER ? (size_t)0 : (size_t)cur.pm * tstep); const char* cB = (const char*)g.Bt + (size_t)cur.pn * tstep;
    unsigned gvo[2][2] = {{0u, 0u}, {0u, 0u}}, ngvo[2][2] = {{0u, 0u}, {0u, 0u}}; const bool last = false;
    if constexpr (Sched::GATHER) {
#pragma unroll
        for (int hh = 0; hh < 2; ++hh)
#pragma unroll
            for (int i = 0; i < 2; ++i) { int R, C; stage_rc(tid * 16 + i * 8192, R, C); gvo[hh][i] = (unsigned)(S.arow(cur, hh * HALF + R) * K + C) * 2u; } }
    S.a_ready(cur);
    if constexpr (SP2) {
        PG8_STAGE(PG8_SB(0, 0), cB, voffB); PG8_STAGE(PG8_SB(0, 1), cB + hstep, voffB); PG8_STAGE_A(PG8_SA(0, 0), cA, 0, 0); PG8_STAGE_A(PG8_SA(0, 1), cA, 1, 0);
        if (wr == 1) PG8_BAR;
        PG8_WAIT_V(2); PG8_BAR;
        PG8_STAGE(PG8_SB(1, 0), cB + kstep, voffB); PG8_STAGE_A(PG8_SA(1, 0), cA + kstep, 0, 0); PG8_STAGE(PG8_SB(1, 1), cB + hstep + kstep, voffB);
        PG8_WAIT_V(6); PG8_BAR;
    } else {
        PG8_STAGE(PG8_SB(0, 0), cB, voffB); PG8_STAGE_A(PG8_SA(0, 0), cA, 0, 0); PG8_STAGE(PG8_SB(0, 1), cB + hstep, voffB); PG8_STAGE_A(PG8_SA(0, 1), cA, 1, 0);
        if (wr == 1) PG8_BAR;
        PG8_WAIT_V(4); PG8_BAR;
        PG8_STAGE(PG8_SB(1, 0), cB + kstep, voffB); PG8_STAGE_A(PG8_SA(1, 0), cA + kstep, 0, 0); PG8_STAGE(PG8_SB(1, 1), cB + hstep + kstep, voffB);
        PG8_WAIT_V(6); PG8_BAR;
    }
    for (;;) {
        const bool has_next = S.next(ui + 1, nxt);
        const char* nA = (has_next && !Sched::GATHER) ? (const char*)g.A + (size_t)nxt.pm * tstep : cA; const char* nB = has_next ? (const char*)g.Bt + (size_t)nxt.pn * tstep : cB;
        if constexpr (Sched::GATHER) {
#pragma unroll
            for (int hh = 0; hh < 2; ++hh)
#pragma unroll
                for (int i = 0; i < 2; ++i) { int R, C; stage_rc(tid * 16 + i * 8192, R, C); ngvo[hh][i] = has_next ? (unsigned)(S.arow(nxt, hh * HALF + R) * K + C) * 2u : gvo[hh][i]; } }
        for (int t = 0; t < nt; t += 2) {
            const bool last = (t == nt - 2);
            const char* a1 = cA + (size_t)(t + 1) * kstep;
            const char* a2 = last ? nA : cA + (size_t)(t + 2) * kstep; const char* b2 = last ? nB : cB + (size_t)(t + 2) * kstep;
            const char* a3 = a2 + kstep; const char* b3 = b2 + kstep;
            if (last && has_next) S.a_ready(nxt);
            if constexpr (SP2) {
            PG8_LDB(B0, 0, 0); PG8_LDB(B1, 0, 1); PG8_SCHED; PG8_LDA(At, 0, 0); PG8_STAGE_A(PG8_SA(1, 1), a1, 1, 0);
            PG8_WAIT_V(8); PG8_WAIT_L(0); PG8_BAR; PG8_MMA(0, 0, At, B0); PG8_MMA(0, 1, At, B1); PG8_BAR; PG8_SCHED;
            PG8_LDA(At, 0, 1); PG8_STAGE(PG8_SB(0, 0), b2, voffB); PG8_STAGE(PG8_SB(0, 1), b2 + hstep, voffB); PG8_STAGE_A(PG8_SA(0, 0), a2, 0, 1);
            PG8_WAIT_V(8); PG8_WAIT_L(0); PG8_BAR; PG8_MMA(1, 0, At, B0); PG8_MMA(1, 1, At, B1); PG8_BAR; PG8_SCHED;
            PG8_LDB(B0, 1, 0); PG8_LDB(B1, 1, 1); PG8_SCHED; PG8_LDA(At, 1, 0); PG8_STAGE_A(PG8_SA(0, 1), a2, 1, 1);
            PG8_WAIT_V(8); PG8_WAIT_L(0); PG8_BAR; PG8_MMA(0, 0, At, B0); PG8_MMA(0, 1, At, B1); PG8_BAR; PG8_SCHED;
            PG8_LDA(At, 1, 1); PG8_STAGE(PG8_SB(1, 0), b3, voffB); PG8_STAGE(PG8_SB(1, 1), b3 + hstep, voffB); PG8_STAGE_A(PG8_SA(1, 0), a3, 0, 1);
            PG8_WAIT_V(8); PG8_WAIT_L(0); PG8_BAR; PG8_MMA(1, 0, At, B0); PG8_MMA(1, 1, At, B1); PG8_BAR; PG8_SCHED;
            } else {
            PG8_LDB(B0, 0, 0); PG8_SCHED; PG8_LDA(At, 0, 0); PG8_STAGE_A(PG8_SA(1, 1), a1, 1, 0);
            PG8_WAIT_L(8); PG8_BAR; PG8_WAIT_L(0); PG8_MMA(0, 0, At, B0); PG8_BAR; PG8_SCHED;
            PG8_LDB(B1, 0, 1); PG8_STAGE(PG8_SB(0, 0), b2, voffB);
            PG8_BAR; PG8_WAIT_L(0); PG8_MMA(0, 1, At, B1); PG8_BAR;
            PG8_LDA(At, 0, 1); PG8_STAGE_A(PG8_SA(0, 0), a2, 0, 1);
            PG8_BAR; PG8_WAIT_L(0); PG8_MMA(1, 0, At, B0); PG8_BAR; PG8_SCHED;
            PG8_STAGE(PG8_SB(0, 1), b2 + hstep, voffB);
            PG8_WAIT_V(6); PG8_BAR; PG8_MMA(1, 1, At, B1); PG8_BAR;
            PG8_LDB(B0, 1, 0); PG8_SCHED; PG8_LDA(At, 1, 0); PG8_STAGE_A(PG8_SA(0, 1), a2, 1, 1);
            PG8_WAIT_L(8); PG8_BAR; PG8_WAIT_L(0); PG8_MMA(0, 0, At, B0); PG8_BAR; PG8_SCHED;
            PG8_LDB(B1, 1, 1); PG8_STAGE(PG8_SB(1, 0), b3, voffB);
            PG8_BAR; PG8_WAIT_L(0); PG8_MMA(0, 1, At, B1); PG8_BAR;
            PG8_LDA(At, 1, 1); PG8_STAGE_A(PG8_SA(1, 0), a3, 0, 1);
            PG8_BAR; PG8_WAIT_L(0); PG8_MMA(1, 0, At, B0); PG8_BAR; PG8_SCHED;
            PG8_STAGE(PG8_SB(1, 1), b3 + hstep, voffB);
            PG8_WAIT_V(6); PG8_BAR; PG8_MMA(1, 1, At, B1); PG8_BAR;
            }
        }
        if constexpr (ALIGN_EPI) { if (wr == 0) PG8_BAR; }
        if constexpr (!Epi::AFTER_DRAIN) { E(acc, cur, wr, wc, fr, fq); S.done(cur); }
        if (!has_next) break;
#pragma unroll
        for (int a = 0; a < 2; ++a)
#pragma unroll
            for (int b = 0; b < 2; ++b)
#pragma unroll
                for (int m = 0; m < 4; ++m)
#pragma unroll
                    for (int n = 0; n < 2; ++n) acc[a][b][m][n] = (f32x4){0.f, 0.f, 0.f, 0.f};
        cur = nxt; cA = nA; cB = nB; ++ui;
        if constexpr (Sched::GATHER) { gvo[0][0] = ngvo[0][0]; gvo[0][1] = ngvo[0][1]; gvo[1][0] = ngvo[1][0]; gvo[1][1] = ngvo[1][1]; }
        if constexpr (ALIGN_EPI) { if (wr == 1) PG8_BAR; }
    }
    PG8_WAIT_V(0);
    if constexpr (!ALIGN_EPI) { if (wr == 0) PG8_BAR; }
    PG8_BAR;
    if constexpr (Epi::AFTER_DRAIN) { E.fused(acc, cur, wr, wc, fr, fq, lds, wid, lane); S.done(cur); }
#undef PG8_SA
#undef PG8_SB
#undef PG8_STAGE
#undef PG8_STAGE_A
#undef PG8_LDA
#undef PG8_LDB
#undef PG8_MMA
#undef PG8_WAIT_V
#undef PG8_WAIT_L
#undef PG8_BAR
#undef PG8_SCHED
}
}
#define GAS __attribute__((address_space(1)))
#define LAS __attribute__((address_space(3)))
typedef unsigned short bf16;
typedef unsigned v4u __attribute__((ext_vector_type(4)));
typedef float f32x4 __attribute__((ext_vector_type(4)));
typedef short bf16x8 __attribute__((ext_vector_type(8)));
typedef GAS unsigned gu32;
typedef GAS unsigned long long gu64;
#define RLX_AGENT __ATOMIC_RELAXED, __HIP_MEMORY_SCOPE_AGENT
#define LDS_WAIT() asm volatile("s_waitcnt lgkmcnt(0)" ::: "memory")
#define VM_WAIT() asm volatile("s_waitcnt vmcnt(0)" ::: "memory")
__device__ __forceinline__ unsigned long long rt() { return __builtin_amdgcn_s_memrealtime(); }
__device__ __forceinline__ unsigned f2bf(float f) { unsigned u = __builtin_bit_cast(unsigned, f); return (u + 0x7fffu + ((u >> 16) & 1u)) >> 16; }
__device__ __forceinline__ unsigned pk2(float lo, float hi) { return f2bf(lo) | (f2bf(hi) << 16); }

#define XB_TMO      128
#define XB_XCNT(j)  (256  + 64 * (j))
#define XB_XSUB(j)  (1280 + 64 * (j))
#define XB_XGEN(j)  (2304 + 64 * (j))
#define XB_TOP      3328
#define XB_TOPGEN   3392
#define XCD_BAR_WORDS 3456
#define XB_SPIN_CAP (1u << 18)

__device__ __forceinline__ unsigned xb_ld(unsigned* p)              { return __hip_atomic_load(p, __ATOMIC_RELAXED, __HIP_MEMORY_SCOPE_AGENT); }
__device__ __forceinline__ unsigned xb_add(unsigned* p, unsigned v) { return __hip_atomic_fetch_add(p, v, __ATOMIC_RELAXED, __HIP_MEMORY_SCOPE_AGENT); }
__device__ __forceinline__ unsigned xb_xcc_id() { return (unsigned)__builtin_amdgcn_s_getreg((3 << 11) | 20) & 0xFu; }
#define XB_SPIN(cond, bar) do { unsigned _sp = 0; while (cond) { __builtin_amdgcn_s_sleep(1); \
    if ((++_sp & 255u) == 0u) { if (xb_ld(&(bar)[XB_TMO])) break; if (_sp > XB_SPIN_CAP) { atomicAdd(&(bar)[XB_TMO], 1u); break; } } } } while (0)

struct XcdBarrier {
    int wv;
    unsigned* bar; unsigned x;
    volatile LAS unsigned* st;
};

__device__ __forceinline__ XcdBarrier xcd_barrier_post(unsigned* bar, volatile LAS unsigned* st, int wv) {
    XcdBarrier b; b.bar = bar; b.x = xb_xcc_id(); b.st = st; b.wv = wv;
    if (mk_tid(wv) == 0) (void)xb_add(&bar[XB_XCNT(b.x)], 1u);
    return b;
}
__device__ __forceinline__ void xcd_barrier_complete(unsigned* bar, unsigned x, unsigned& nloc, unsigned& nx) {
    const unsigned G = gridDim.x * gridDim.y * gridDim.z;
    unsigned sum, cnt, mine, sp = 0u;
    for (;;) {
        sum = 0u; cnt = 0u; mine = 0u;
#pragma unroll
        for (unsigned j = 0; j < 16; ++j) { const unsigned c = xb_ld(&bar[XB_XCNT(j)]); sum += c; cnt += (c > 0u) ? 1u : 0u; mine = (j == x) ? c : mine; }
        if (sum == G) break;
        __builtin_amdgcn_s_sleep(1);
        if ((++sp & 255u) == 0u) { if (xb_ld(&bar[XB_TMO])) break; if (sp > XB_SPIN_CAP) { atomicAdd(&bar[XB_TMO], 1u); break; } }
    }
    nloc = mine > 0u ? mine : 1u; nx = cnt > 0u ? cnt : 1u;
}

__device__ __forceinline__ void xcd_barrier(const XcdBarrier& b) {
    asm volatile("s_waitcnt vmcnt(0)" ::: "memory");
    __syncthreads();
    if (mk_tid(b.wv) == 0) {
        unsigned* bar = b.bar;
        __builtin_amdgcn_s_waitcnt(0);
        unsigned nloc = b.st[0], nx = b.st[1];
        if (nloc == 0u) { xcd_barrier_complete(bar, b.x, nloc, nx); b.st[0] = nloc; b.st[1] = nx; }
        const unsigned old = xb_add(&bar[XB_XSUB(b.x)], 1u);
        const unsigned gen = old / nloc;
        if (old + 1u == (gen + 1u) * nloc) {
            __builtin_amdgcn_fence(__ATOMIC_RELEASE, "agent");
            asm volatile("s_waitcnt vmcnt(0)" ::: "memory");
            const unsigned og = xb_add(&bar[XB_TOP], 1u);
            const unsigned tg = og / nx;
            if (og + 1u == (tg + 1u) * nx) xb_add(&bar[XB_TOPGEN], 1u);
            else XB_SPIN(xb_ld(&bar[XB_TOPGEN]) == tg, bar);
            __builtin_amdgcn_fence(__ATOMIC_ACQUIRE, "agent");
            xb_add(&bar[XB_XGEN(b.x)], 1u);
            asm volatile("s_waitcnt vmcnt(0)" ::: "memory");
        } else {
            XB_SPIN(xb_ld(&bar[XB_XGEN(b.x)]) == gen, bar);
            __builtin_amdgcn_fence(__ATOMIC_ACQUIRE, "agent");
            asm volatile("s_waitcnt vmcnt(0)" ::: "memory");
        }
    }
    __syncthreads();
}
constexpr int NWAVES = 8, NT = 512;
constexpr int BATCH = 2, SEQ = 8192, D = 1024, TB = 8320, M = BATCH * TB, PADR = 112;
constexpr int NIN = 2816, DFF = 2816, NEXP = 8, DFE = 3584;
constexpr int C_U = 0, C_HQ = 256, C_HF = 512, C_HI = 768, C_HG = 1024, C_RQ = 1280, C_RK = 1536, C_RV = 1792, C_RG = 2304;
constexpr float EPS = 1e-6f;
#ifndef PROBE_DUP
#define PROBE_DUP 0
#endif
#define REP(n) ((PROBE_DUP == (n)) ? 2 : 1)
#ifndef PROBE_TA
#define PROBE_TA -1
#define PROBE_TB -1
#endif
#ifndef PROBE_SCALE
#define PROBE_SCALE 0.01f
#endif
#ifndef PROBE_BLK
#define PROBE_BLK 200
#endif
#ifndef MK_PER_PHASE
#define MK_PER_PHASE 0
#endif
constexpr int NPH = 62;
__host__ __device__ inline bool phase_exists(int k) {
    if (k == 0 || k == NPH - 1) return true;
    const int l = (k - 1) / 30, r = (k - 1) % 30;
    if (r <= 3 || r == 6) return true;
    if (l == 0) return r == 8 || r == 9;
    return r == 7 || r == 10 || r == 11 || r == 12;
}
constexpr size_t MiB = 1u << 20;
constexpr size_t WS_CTL = 0, CTL_ZERO_BYTES = 1 * MiB;
constexpr int CW_TMO = 0, CW_CODE = 1, CW_BAR = 4096, CW_CNT = 16384, CW_PROBE = 16448, CW_QUEUE = 16640;
constexpr size_t WS_LB = 1 * MiB, WS_LB128 = 1 * MiB + 16384, WS_BB = 1 * MiB + 65536, WS_BBT = 1 * MiB + 393216, WS_ROT = 1 * MiB + 524288, WS_CCT = 2752512, WS_WGT = 2883584, WS_LBT = 3 * MiB;
constexpr size_t WS_POS = 3 * MiB + 65536, WS_GATE = WS_POS + 131072, WS_LIST = WS_GATE + 131072;
constexpr int MOE_CAP = 16384;
static_assert(WS_BBT + 131072 <= WS_ROT && WS_ROT + (size_t)TB * 32 * 4 <= WS_CCT && WS_CCT + 131072 <= WS_WGT && WS_WGT + 262144 <= WS_LBT && WS_LIST + 8 * MOE_CAP * 4 <= 4 * MiB, "table map");
constexpr size_t WS_WM13 = 4 * MiB, WS_WM2 = 4 * MiB, WS_YS = 60 * MiB, WS_HB = 149 * MiB, WS_SSP = 214 * MiB, WS_PROJ = 220 * MiB, WS_MIXED = 310 * MiB, WS_ACT = 220 * MiB;
constexpr size_t WS_WIN = 343 * MiB, WS_WOUT = 354 * MiB, WS_WF13 = 358 * MiB, WS_WF2 = 369 * MiB, WS_RSL = 458 * MiB, WS_END = 459 * MiB;
constexpr int MOE_TMAX = 136;
static_assert(WS_WM13 + (size_t)NEXP * 2 * DFE * D * 2 <= WS_HB && WS_WM2 + (size_t)NEXP * D * DFE * 2 <= WS_YS && WS_YS + (size_t)MOE_TMAX * 256 * D * 2 <= WS_HB && WS_HB + (size_t)M * D * 2 <= WS_SSP, "ws map 1");
static_assert(WS_SSP + (size_t)5 * M * 16 * 4 <= WS_PROJ && WS_PROJ + (size_t)M * NIN * 2 <= WS_MIXED && WS_MIXED + (size_t)M * D * 2 <= WS_WIN, "ws map 2");
static_assert(WS_WIN + (size_t)2 * NIN * D * 2 <= WS_WOUT && WS_WOUT + (size_t)2 * D * D * 2 <= WS_WF13 && WS_WF13 + (size_t)2 * DFF * D * 2 <= WS_WF2 && WS_WF2 + (size_t)D * DFF * 2 <= WS_END, "ws map 3");
static_assert(WS_ACT + (size_t)M * DFF * 2 <= WS_MIXED && WS_ACT + (size_t)MOE_TMAX * 256 * DFE * 2 <= WS_RSL && WS_RSL + (size_t)8 * MOE_CAP * 4 <= WS_END, "ws map 4");
constexpr int RING_OFF = 0, RING_BYTES = 131072, LDSCTL_OFF = RING_BYTES, MISC_OFF = LDSCTL_OFF + 320, LDS_BYTES = 147456;

struct Frame { LAS unsigned char* lds; volatile LAS unsigned* MISC; gu32* ctl; unsigned char* ws; const float* const* in; int wave_s; };
#define STAMP(k) do { if (PROBE_TA >= 0 && blockIdx.x == PROBE_BLK && mk_tid(F.wave_s) == 0) { gu32* _p = F.ctl + CW_PROBE + (k); if (__hip_atomic_load(_p, RLX_AGENT) == 0u) __hip_atomic_store(_p, (unsigned)__builtin_amdgcn_s_memrealtime(), RLX_AGENT); } } while (0)
struct Loc { int tid, lane, wave, bx, vcu, G; };
__device__ __forceinline__ Loc make_loc(int wave_s) { Loc L; int t = mk_tid(wave_s); asm volatile("" : "+v"(t));   int b = blockIdx.x; asm volatile("" : "+s"(b)); L.tid = t; L.lane = t & 63; L.wave = __builtin_amdgcn_readfirstlane(t >> 6);
    L.bx = b; L.G = gridDim.x; L.vcu = (L.G % 8 == 0) ? (b % 8) * (L.G / 8) + b / 8 : b; return L; }
__device__ __forceinline__ float bf2f(bf16 x) { return __uint_as_float((unsigned)x << 16); }
__device__ __forceinline__ bf16 f2bf_(float f) { return (bf16)f2bf(f); }
__device__ __forceinline__ float wave_sum(float v) {
#pragma unroll
    for (int o = 1; o < 64; o <<= 1) v += __shfl_xor(v, o);
    return v;
}
__device__ __forceinline__ float silu_f(float a) { return a * __builtin_amdgcn_rcpf(1.0f + __expf(-a)); }
__device__ __forceinline__ float sigmoid_f(float a) { return __builtin_amdgcn_rcpf(1.0f + __expf(-a)); }

struct TrP { const float* W; int K, N; bf16* WT; int mode; const float* g; int item; };
constexpr int TR_LD = 257;
static_assert(64 * TR_LD * 4 <= RING_BYTES, "LDS map (transposer)");
__device__ __forceinline__ void tr_item_wg(const TrP& q, LAS float* scr, int tid) {
    const int nblk = q.N / 256, kb = q.item / nblk, nb = q.item % nblk, k0 = 64 * kb, n0 = 256 * nb, wv = tid >> 6, ln = tid & 63;
    f32x4 v[8]; float gk[8];
#pragma unroll
    for (int i = 0; i < 8; ++i) { const int kk = 8 * i + wv; v[i] = *(const GAS f32x4*)(q.W + (size_t)(k0 + kk) * q.N + n0 + 4 * ln); gk[i] = q.g ? q.g[k0 + kk] : 1.0f; }
    PIN8(v[0], v[1], v[2], v[3], v[4], v[5], v[6], v[7]); PIN8(gk[0], gk[1], gk[2], gk[3], gk[4], gk[5], gk[6], gk[7]);
#pragma unroll
    for (int i = 0; i < 8; ++i) { const int kk = 8 * i + wv; LAS float* d = scr + kk * TR_LD + 4 * ln; d[0] = v[i][0] * gk[i]; d[1] = v[i][1] * gk[i]; d[2] = v[i][2] * gk[i]; d[3] = v[i][3] * gk[i]; }
    __syncthreads();
    const int c = tid & 7;
#pragma unroll
    for (int j = 0; j < 4; ++j) { const int n = (tid >> 3) + 64 * j; const LAS float* s = scr + (8 * c) * TR_LD + n;
        v4u o; o.x = pk2(s[0 * TR_LD], s[1 * TR_LD]); o.y = pk2(s[2 * TR_LD], s[3 * TR_LD]); o.z = pk2(s[4 * TR_LD], s[5 * TR_LD]); o.w = pk2(s[6 * TR_LD], s[7 * TR_LD]);
        const int nn = n0 + n, drow = q.mode == 0 ? nn : ((nn >> 7) * 256 + (nn & 127) + (q.mode == 2 ? 128 : 0));
        *(GAS v4u*)(q.WT + (size_t)drow * q.K + k0 + 8 * c) = o; }
    __syncthreads();
}
constexpr int I_M13 = 16 * 14, N_M13 = 16 * I_M13;
__device__ __forceinline__ TrP moe13_item(Frame& F, int it) { constexpr int I_M = I_M13; const int half = it / (8 * I_M), r = it % (8 * I_M), e = r / I_M;
    return TrP{F.in[24 + half] + (size_t)e * D * DFE, D, DFE, (bf16*)(F.ws + WS_WM13) + (size_t)e * 2 * DFE * D, 1 + half, F.in[19] + D, r % I_M}; }
__device__ __forceinline__ void conv_moe13(Frame& F, int rank, int nranks, int i0, int i1, int tid) {
    LAS float* scr = (LAS float*)(F.lds + RING_OFF);
    for (int it = i0 + rank; it < i1; it += nranks) tr_item_wg(moe13_item(F, it), scr, tid);
}
__device__ __forceinline__ void p0_prologue(Frame& F) {
    const Loc L = make_loc(F.wave_s);
    LAS float* scr = (LAS float*)(F.lds + RING_OFF);
    const int gw = L.vcu * NWAVES + L.wave, NGW = L.G * NWAVES;
    unsigned char* ws = F.ws; const float* const* in = F.in;
    constexpr int I_IN = 16 * 11, I_OUT = 16 * 4, I_F = 16 * 11, I_F2 = 44 * 4;
    constexpr int NITEMS = 2 * I_IN + 2 * I_OUT + 2 * I_F + I_F2;
    auto small_item = [&](int it) -> TrP { int r = it;
        if (r < 2 * I_IN) { const int l = r / I_IN; return TrP{in[3] + (size_t)l * D * NIN, D, NIN, (bf16*)(ws + WS_WIN) + (size_t)l * NIN * D, 0, in[2] + l * D, r % I_IN}; } r -= 2 * I_IN;
        if (r < 2 * I_OUT) { const int l = r / I_OUT; return TrP{in[18] + (size_t)l * D * D, D, D, (bf16*)(ws + WS_WOUT) + (size_t)l * D * D, 0, nullptr, r % I_OUT}; } r -= 2 * I_OUT;
        if (r < I_F) return TrP{in[20], D, DFF, (bf16*)(ws + WS_WF13), 1, in[19], r}; r -= I_F;
        if (r < I_F) return TrP{in[21], D, DFF, (bf16*)(ws + WS_WF13), 2, in[19], r}; r -= I_F;
        return TrP{in[22], DFF, D, (bf16*)(ws + WS_WF2), 0, nullptr, r}; };
    for (int it = L.vcu; it < NITEMS; it += L.G) tr_item_wg(small_item(it), scr, L.tid);
    conv_moe13(F, L.vcu, L.G, 0, 2580, L.tid);
    bf16* HB = (bf16*)(ws + WS_HB); float* SS0 = (float*)(ws + WS_SSP);
    for (int m = gw; m < M; m += NGW) {
        const int b = m / TB, t = m % TB;
        const float* src = t < PADR ? nullptr : (t < 128 ? in[1] + (size_t)(t - PADR) * D : in[0] + ((size_t)b * SEQ + (t - 128)) * D);
        f32x4 v[4]; float s = 0.f;
#pragma unroll
        for (int j = 0; j < 4; ++j) v[j] = src ? ((const GAS f32x4*)src)[L.lane + 64 * j] : (f32x4){0.f, 0.f, 0.f, 0.f};
        PIN4(v[0], v[1], v[2], v[3]);
#pragma unroll
        for (int j = 0; j < 4; ++j) s += (v[j].x * v[j].x + v[j].y * v[j].y) + (v[j].z * v[j].z + v[j].w * v[j].w);
        s = wave_sum(s);
#pragma unroll
        for (int j = 0; j < 4; ++j) ((GAS unsigned long long*)(HB + (size_t)m * D))[L.lane + 64 * j] = (unsigned long long)pk2(v[j].x, v[j].y) | ((unsigned long long)pk2(v[j].z, v[j].w) << 32);
        if (L.lane < 16) SS0[(size_t)m * 16 + L.lane] = L.lane == 0 ? s : 0.0f;
    }
    const int gt = L.vcu * NT + L.tid, NGT = L.G * NT;
    float* LB = (float*)(ws + WS_LB); float* BB = (float*)(ws + WS_BB); float* ROT = (float*)(ws + WS_ROT); float* LBT = (float*)(ws + WS_LBT);
    for (int i = gt; i < 2048; i += NGT) {
        const int lg = i >> 6; const float step = expf(in[11][lg]); const float lre = in[4][i], lim = in[5][i];
        const float mag = expf(lre * step); float sn, cs; sincosf(lim * step, &sn, &cs); const float br = mag * cs, bi = mag * sn;
        const float den = 1.0f / (lre * lre + lim * lim), cr = ((br - 1.0f) * lre + bi * lim) * den, ci = (bi * lre - (br - 1.0f) * lim) * den;
        LB[2 * i] = br; LB[2 * i + 1] = bi;
        for (int h = 0; h < 16; ++h) { const float b_r = in[6][i * 16 + h], b_i = in[7][i * 16 + h]; BB[(i * 16 + h) * 2] = cr * b_r - ci * b_i; BB[(i * 16 + h) * 2 + 1] = cr * b_i + ci * b_r; }
    }
    { bf16* BBT = (bf16*)(ws + WS_BBT); bf16* CCT = (bf16*)(ws + WS_CCT); bf16* WGT = (bf16*)(ws + WS_WGT); float* LB128 = (float*)(ws + WS_LB128);
      for (int i = gt; i < 2048; i += NGT) { const int lg = i >> 6, p = i & 63; const float step = expf(in[11][lg]), lre = in[4][i], lim = in[5][i];
          const float mag = expf(64.0f * lre * step); float sn, cs; sincosf(64.0f * (lim * step), &sn, &cs); LB128[2 * i] = mag * cs; LB128[2 * i + 1] = mag * sn;
          const float m1 = expf(lre * step); float s1, c1; sincosf(lim * step, &s1, &c1); const float br = m1 * c1, bi = m1 * s1, den = 1.0f / (lre * lre + lim * lim), cr = ((br - 1.0f) * lre + bi * lim) * den, ci = (bi * lre - (br - 1.0f) * lim) * den;
          for (int h = 0; h < 16; ++h) { const float b_r = in[6][i * 16 + h], b_i = in[7][i * 16 + h]; BBT[((size_t)lg * 128 + p) * 16 + h] = f2bf_(cr * b_r - ci * b_i); BBT[((size_t)lg * 128 + 64 + p) * 16 + h] = f2bf_(cr * b_i + ci * b_r);
              CCT[((size_t)lg * 16 + h) * 128 + 2 * p] = f2bf_(in[8][(lg * 16 + h) * 64 + p]); CCT[((size_t)lg * 16 + h) * 128 + 2 * p + 1] = f2bf_(-in[9][(lg * 16 + h) * 64 + p]); } }
      for (int i = gt; i < 2 * 65536; i += NGT) { const int l = i >> 16, n = (i >> 8) & 255, k = i & 255; WGT[i] = f2bf_(in[12][(size_t)l * 65536 + k * 256 + n]); } }
    for (int i = gt; i < TB * 16; i += NGT) { const int t = i >> 4, f = i & 15; const float pos = (float)(t - PADR), inv = powf(10000.0f, -(float)f / 16.0f); float sn, cs; sincosf(pos * inv, &sn, &cs); ROT[2 * i] = cs; ROT[2 * i + 1] = sn; }
    for (int i = gt; i < 512; i += NGT) { const int l = i >> 8, c = i & 255; float lb = 0.f; if (l == 1) { const float a0 = in[15][c], a1 = in[15][256 + c], mx = fmaxf(a0, a1), e0 = expf(a0 - mx), e1 = expf(a1 - mx); lb = e1 / (e0 + e1); } LBT[i] = lb; }
}

__device__ __forceinline__ float gelu_tanh(float y) { const float x = 0.7978845608028654f * (y + 0.044715f * y * y * y); const float th = 1.0f - 2.0f * __builtin_amdgcn_rcpf(1.0f + __expf(2.0f * x)); return 0.5f * y * (1.0f + th); }
typedef unsigned u32x4_t __attribute__((ext_vector_type(4)));
__device__ __forceinline__ f32x4 mfma16(bf16x8 a, bf16x8 b, f32x4 c) { return __builtin_amdgcn_mfma_f32_16x16x32_bf16(a, b, c, 0, 0, 0); }
__device__ __forceinline__ unsigned cvtpk(float lo, float hi) { unsigned r; asm volatile("v_cvt_pk_bf16_f32 %0, %1, %2" : "=v"(r) : "v"(lo), "v"(hi)); return r; }
__device__ __forceinline__ bf16x8 pack8(f32x4 a, f32x4 b) { u32x4_t w; w.x = cvtpk(a[0], a[1]); w.y = cvtpk(a[2], a[3]); w.z = cvtpk(b[0], b[1]); w.w = cvtpk(b[2], b[3]); return __builtin_bit_cast(bf16x8, w); }
__device__ __forceinline__ int perm_pos(int j) { return (j & ~31) + 8 * ((j >> 2) & 3) + 4 * ((j >> 4) & 1) + (j & 3); }
constexpr int NCH = TB / 128;
constexpr size_t OUT_RST = 0, OUT_HST = 9 * MiB, OUT_HDK = 18 * MiB, OUT_S5X = 19 * MiB;
__device__ __forceinline__ void ma_ret_unit(Frame& F, const Loc& L, int b, int c, int h, float* outb) {
    LAS bf16* Vt = (LAS bf16*)F.lds; LAS bf16* Kt = Vt + 64 * 136;
    const bf16* P = (const bf16*)(F.ws + WS_PROJ) + ((size_t)b * TB + c * 128) * NIN; const float* ROT = (const float*)(F.ws + WS_ROT) + (size_t)c * 128 * 32;
    const float lg = __log2f(1.0f - exp2f(-5.0f - (float)h));
    STAMP(5);
    { const int ch = L.tid & 63, seg = L.tid >> 6; const bf16* pv = P + (size_t)(16 * seg) * NIN + C_RV + h * 64 + ch; unsigned x[16];
#pragma unroll
      for (int r = 0; r < 16; ++r) x[r] = pv[(size_t)r * NIN];
      PIN16(x);
      u32x4_t w0, w1; w0.x = x[0] | ((unsigned)x[1] << 16); w0.y = x[2] | ((unsigned)x[3] << 16); w0.z = x[4] | ((unsigned)x[5] << 16); w0.w = x[6] | ((unsigned)x[7] << 16);
      w1.x = x[8] | ((unsigned)x[9] << 16); w1.y = x[10] | ((unsigned)x[11] << 16); w1.z = x[12] | ((unsigned)x[13] << 16); w1.w = x[14] | ((unsigned)x[15] << 16);
      *(LAS u32x4_t*)(Vt + ch * 136 + 16 * seg) = w0; *(LAS u32x4_t*)(Vt + ch * 136 + 16 * seg + 8) = w1; }
    if (L.tid < 128) { const int i = L.tid & 15, seg = L.tid >> 4; const bf16* pk = P + (size_t)(16 * seg) * NIN + C_RK + h * 32 + i; const float* rp = ROT + (16 * seg * 16 + i) * 2; float ka[16], kb[16];
      unsigned x1[16], x2[16]; float crc[16], crs[16];
#pragma unroll
      for (int r = 0; r < 16; ++r) { x1[r] = pk[(size_t)r * NIN]; x2[r] = pk[(size_t)r * NIN + 16]; const float2 t = *(const float2*)(rp + r * 32); crc[r] = t.x; crs[r] = t.y; }
      PIN16(x1); PIN16(x2); PIN16(crc); PIN16(crs);
#pragma unroll
      for (int r = 0; r < 16; ++r) { const float k1 = __uint_as_float(x1[r] << 16), k2 = __uint_as_float(x2[r] << 16), cs = crc[r], sn = crs[r], w = __builtin_amdgcn_exp2f((float)(127 - 16 * seg - r) * lg);
          ka[r] = (k1 * cs - k2 * sn) * w; kb[r] = (k1 * sn + k2 * cs) * w; }
      u32x4_t w0, w1; w0.x = cvtpk(ka[0], ka[1]); w0.y = cvtpk(ka[2], ka[3]); w0.z = cvtpk(ka[4], ka[5]); w0.w = cvtpk(ka[6], ka[7]); w1.x = cvtpk(ka[8], ka[9]); w1.y = cvtpk(ka[10], ka[11]); w1.z = cvtpk(ka[12], ka[13]); w1.w = cvtpk(ka[14], ka[15]);
      *(LAS u32x4_t*)(Kt + i * 136 + 16 * seg) = w0; *(LAS u32x4_t*)(Kt + i * 136 + 16 * seg + 8) = w1;
      w0.x = cvtpk(kb[0], kb[1]); w0.y = cvtpk(kb[2], kb[3]); w0.z = cvtpk(kb[4], kb[5]); w0.w = cvtpk(kb[6], kb[7]); w1.x = cvtpk(kb[8], kb[9]); w1.y = cvtpk(kb[10], kb[11]); w1.z = cvtpk(kb[12], kb[13]); w1.w = cvtpk(kb[14], kb[15]);
      *(LAS u32x4_t*)(Kt + (16 + i) * 136 + 16 * seg) = w0; *(LAS u32x4_t*)(Kt + (16 + i) * 136 + 16 * seg + 8) = w1; }
    STAMP(6);
    __syncthreads();
    { const int il = L.lane & 15, g = L.lane >> 4, ft = L.wave & 1, vt = L.wave >> 1; f32x4 acc = {0.f, 0.f, 0.f, 0.f};
#pragma unroll
      for (int ks = 0; ks < 4; ++ks) { const bf16x8 A = *(const LAS bf16x8*)(Kt + (16 * ft + il) * 136 + 32 * ks + 8 * g), B = *(const LAS bf16x8*)(Vt + (16 * vt + il) * 136 + 32 * ks + 8 * g); acc = mfma16(A, B, acc); }
      float* S = (float*)((unsigned char*)outb + OUT_RST) + (size_t)((b * NCH + c) * 8 + h) * 2048;
#pragma unroll
      for (int r = 0; r < 4; ++r) S[(16 * ft + 4 * g + r) * 64 + 16 * vt + il] = acc[r]; }
    __syncthreads();
    STAMP(7);
}
__device__ __forceinline__ void mb_ret(const Loc& L, float* outb, int e) {
    { const int b = e >> 14, h = (e >> 11) & 7, idx = e & 2047; const float d = exp2f(128.0f * __log2f(1.0f - exp2f(-5.0f - (float)h)));
        float* p = (float*)((unsigned char*)outb + OUT_RST) + (size_t)(b * NCH * 8 + h) * 2048 + idx; float s = 0.f;
        float loc[NCH];
#pragma unroll
        for (int c = 0; c < NCH; ++c) loc[c] = p[(size_t)c * 8 * 2048];
        PIN16(loc); PIN16O(loc, 16); PIN16O(loc, 32); PIN16O(loc, 48); asm volatile("" : "+v"(loc[64]) :: "memory");
        asm volatile("" : "+v"(p));
#pragma unroll
        for (int c = 0; c < NCH; ++c) { p[(size_t)c * 8 * 2048] = s; s = d * s + loc[c]; } }
}
__device__ __forceinline__ void mc_ret_unit(Frame& F, const Loc& L, int l, int b, int c, int h, const float* outb) {
    LAS bf16* Qrm = (LAS bf16*)F.lds; LAS bf16* Krm = Qrm + 4096; LAS bf16* Vt = Krm + 4096; LAS bf16* SpT = Vt + 64 * 136;
    const size_t row0 = (size_t)b * TB + c * 128; const bf16* P = (const bf16*)(F.ws + WS_PROJ) + row0 * NIN; const float* ROT = (const float*)(F.ws + WS_ROT) + (size_t)c * 128 * 32;
    const float gamma = 1.0f - exp2f(-5.0f - (float)h), lg = __log2f(gamma);
    { const int r = L.tid >> 2, pq = L.tid & 3; const bf16* pr = P + (size_t)r * NIN; const f32x4 r0 = *(const f32x4*)(ROT + (r * 16 + 4 * pq) * 2), r1 = *(const f32x4*)(ROT + (r * 16 + 4 * pq) * 2 + 4);
      const float cs[4] = {r0[0], r0[2], r1[0], r1[2]}, sn[4] = {r0[1], r0[3], r1[1], r1[3]};
      const float wq = 0.17677669529663687f * exp2f((float)r * lg), wk = exp2f(-(float)r * lg);
      const unsigned long long q1 = *(const GAS unsigned long long*)(pr + C_RQ + h * 32 + 4 * pq), q2 = *(const GAS unsigned long long*)(pr + C_RQ + h * 32 + 16 + 4 * pq);
      const unsigned long long k1 = *(const GAS unsigned long long*)(pr + C_RK + h * 32 + 4 * pq), k2 = *(const GAS unsigned long long*)(pr + C_RK + h * 32 + 16 + 4 * pq);
      const int vq = 16 * pq, pj = perm_pos(r); v4u va = *(const GAS v4u*)(pr + C_RV + h * 64 + vq), vb = *(const GAS v4u*)(pr + C_RV + h * 64 + vq + 8);
      const int ksp = L.tid >> 4, v4 = (L.tid & 15) * 4; f32x4 sp = *(const f32x4*)((const float*)((const unsigned char*)outb + OUT_RST) + (size_t)((b * NCH + c) * 8 + h) * 2048 + ksp * 64 + v4);
      { unsigned long long q1_ = q1, q2_ = q2, k1_ = k1, k2_ = k2; asm volatile("" : "+v"(q1_), "+v"(q2_), "+v"(k1_), "+v"(k2_), "+v"(va), "+v"(vb), "+v"(sp) :: "memory"); (void)q1_; }
      float qa[4], qb[4], ka[4], kb[4];
#pragma unroll
      for (int e = 0; e < 4; ++e) { const float a1 = bf2f((bf16)(q1 >> (16 * e))), a2 = bf2f((bf16)(q2 >> (16 * e))), b1 = bf2f((bf16)(k1 >> (16 * e))), b2 = bf2f((bf16)(k2 >> (16 * e)));
          qa[e] = (a1 * cs[e] - a2 * sn[e]) * wq; qb[e] = (a1 * sn[e] + a2 * cs[e]) * wq; ka[e] = (b1 * cs[e] - b2 * sn[e]) * wk; kb[e] = (b1 * sn[e] + b2 * cs[e]) * wk; }
      *(LAS unsigned long long*)(Qrm + r * 32 + 4 * pq) = (unsigned long long)cvtpk(qa[0], qa[1]) | ((unsigned long long)cvtpk(qa[2], qa[3]) << 32);
      *(LAS unsigned long long*)(Qrm + r * 32 + 16 + 4 * pq) = (unsigned long long)cvtpk(qb[0], qb[1]) | ((unsigned long long)cvtpk(qb[2], qb[3]) << 32);
      *(LAS unsigned long long*)(Krm + r * 32 + 4 * pq) = (unsigned long long)cvtpk(ka[0], ka[1]) | ((unsigned long long)cvtpk(ka[2], ka[3]) << 32);
      *(LAS unsigned long long*)(Krm + r * 32 + 16 + 4 * pq) = (unsigned long long)cvtpk(kb[0], kb[1]) | ((unsigned long long)cvtpk(kb[2], kb[3]) << 32);
#pragma unroll
      for (int e = 0; e < 4; ++e) { Vt[(vq + 2 * e) * 136 + pj] = (bf16)(va[e] & 0xffffu); Vt[(vq + 2 * e + 1) * 136 + pj] = (bf16)(va[e] >> 16);
          Vt[(vq + 8 + 2 * e) * 136 + pj] = (bf16)(vb[e] & 0xffffu); Vt[(vq + 8 + 2 * e + 1) * 136 + pj] = (bf16)(vb[e] >> 16); }
#pragma unroll
      for (int e = 0; e < 4; ++e) SpT[(v4 + e) * 40 + ksp] = f2bf_(gamma * sp[e]);
    }
    __syncthreads();
    const int w = L.wave, il = L.lane & 15, g = L.lane >> 4;
    const size_t row = row0 + 16 * w + il; const bf16* gp = (const bf16*)(F.ws + WS_PROJ) + row * NIN + C_RG + h * 64; const float* og = F.in[17] + l * 512 + h * 64;
    unsigned long long gg4[4]; f32x4 og4[4];
#pragma unroll
    for (int vt = 0; vt < 4; ++vt) { gg4[vt] = *(const GAS unsigned long long*)(gp + 16 * vt + 4 * g); og4[vt] = *(const f32x4*)(og + 16 * vt + 4 * g); }
    const bf16x8 Bq = *(const LAS bf16x8*)(Qrm + (16 * w + il) * 32 + 8 * g);
    const f32x4 zero = {0.f, 0.f, 0.f, 0.f}; f32x4 O[4] = {zero, zero, zero, zero};
#pragma unroll
    for (int jp = 0; jp < 4; ++jp) if (2 * jp <= w) {
        f32x4 p0, p1 = zero;
        { const bf16x8 A = *(const LAS bf16x8*)(Krm + (32 * jp + il) * 32 + 8 * g); p0 = mfma16(A, Bq, zero);
          if (2 * jp == w) {
#pragma unroll
              for (int r = 0; r < 4; ++r) if (4 * g + r > il) p0[r] = 0.f; } }
        if (2 * jp + 1 <= w) { const bf16x8 A = *(const LAS bf16x8*)(Krm + (32 * jp + 16 + il) * 32 + 8 * g); p1 = mfma16(A, Bq, zero);
          if (2 * jp + 1 == w) {
#pragma unroll
              for (int r = 0; r < 4; ++r) if (4 * g + r > il) p1[r] = 0.f; } }
        const bf16x8 Bp = pack8(p0, p1);
#pragma unroll
        for (int vt = 0; vt < 4; ++vt) { const bf16x8 A = *(const LAS bf16x8*)(Vt + (16 * vt + il) * 136 + 32 * jp + 8 * g); O[vt] = mfma16(A, Bp, O[vt]); }
    }
#pragma unroll
    for (int vt = 0; vt < 4; ++vt) { const bf16x8 A = *(const LAS bf16x8*)(SpT + (16 * vt + il) * 40 + 8 * g); O[vt] = mfma16(A, Bq, O[vt]); }
    float s1 = 0.f;
#pragma unroll
    for (int vt = 0; vt < 4; ++vt) s1 += (O[vt][0] + O[vt][1]) + (O[vt][2] + O[vt][3]);
    s1 += __shfl_xor(s1, 16); s1 += __shfl_xor(s1, 32); const float mean = s1 * (1.0f / 64.0f); float s2 = 0.f;
#pragma unroll
    for (int vt = 0; vt < 4; ++vt) { O[vt] = O[vt] - mean; s2 += (O[vt][0] * O[vt][0] + O[vt][1] * O[vt][1]) + (O[vt][2] * O[vt][2] + O[vt][3] * O[vt][3]); }
    s2 += __shfl_xor(s2, 16); s2 += __shfl_xor(s2, 32); const float rstd = rsqrtf(s2 * (1.0f / 64.0f) + EPS);
    bf16* mo = (bf16*)(F.ws + WS_MIXED) + row * D + 512 + h * 64;
#pragma unroll
    for (int vt = 0; vt < 4; ++vt) { const int v0 = 16 * vt + 4 * g; const unsigned long long gg = gg4[vt]; const f32x4 o4 = og4[vt]; float y[4];
#pragma unroll
        for (int r = 0; r < 4; ++r) y[r] = O[vt][r] * rstd * o4[r] * silu_f(bf2f((bf16)(gg >> (16 * r))));
        *(GAS unsigned long long*)(mo + v0) = (unsigned long long)cvtpk(y[0], y[1]) | ((unsigned long long)cvtpk(y[2], y[3]) << 32); }
    __syncthreads();
}
constexpr int HG_LD = 68;
constexpr int SEG_OFF = MISC_OFF + 192;
static_assert(SEG_OFF % 16 == 0 && SEG_OFF + 2048 <= LDS_BYTES, "LDS map (SEG)");
template <bool NEED_Q> __device__ __forceinline__ void hg_rows(const bf16* Pb, int tb0, int ch, const float* cw, float lb, float (&q)[16], float (&kk)[16], float (&vv)[16], float (&gl)[16]) {
    float wq[4], wf[4], wi[4];
#pragma unroll
    for (int j = 0; j < 4; ++j) { wq[j] = cw[j * 768 + ch]; wf[j] = cw[j * 768 + 256 + ch]; wi[j] = cw[j * 768 + 512 + ch]; }
    unsigned hq0[3] = {0u, 0u, 0u}, hf0[3] = {0u, 0u, 0u}, hi0[3] = {0u, 0u, 0u}, rq[16], rf[16], ri[16];
#pragma unroll
    for (int j = 0; j < 3; ++j) { const int ts = tb0 - 3 + j; if (ts >= 0) { const bf16* pr = Pb + (size_t)ts * NIN; if (NEED_Q) hq0[j] = pr[C_HQ + ch]; hf0[j] = pr[C_HF + ch]; hi0[j] = pr[C_HI + ch]; } }
#pragma unroll
    for (int r = 0; r < 16; ++r) { const bf16* pr = Pb + (size_t)(tb0 + r) * NIN; rq[r] = NEED_Q ? (unsigned)pr[C_HQ + ch] : 0u; rf[r] = pr[C_HF + ch]; ri[r] = pr[C_HI + ch]; }
    if (NEED_Q) { PIN16(rq); PIN4(hq0[0], hq0[1], hq0[2], wq[0]); } PIN16(rf); PIN16(ri); PIN8(hf0[0], hf0[1], hf0[2], hi0[0], hi0[1], hi0[2], wf[0], wi[0]);
    float hq[3], hf[3], hi[3];
#pragma unroll
    for (int j = 0; j < 3; ++j) { hq[j] = __uint_as_float(hq0[j] << 16); hf[j] = __uint_as_float(hf0[j] << 16); hi[j] = __uint_as_float(hi0[j] << 16); }
    float run = 0.f;
#pragma unroll
    for (int r = 0; r < 16; ++r) { const float xq = __uint_as_float(rq[r] << 16), xf = __uint_as_float(rf[r] << 16), xi = __uint_as_float(ri[r] << 16);
        const float cq = (wq[0] * hq[0] + wq[1] * hq[1]) + (wq[2] * hq[2] + wq[3] * xq), cf = (wf[0] * hf[0] + wf[1] * hf[1]) + (wf[2] * hf[2] + wf[3] * xf), ci = (wi[0] * hi[0] + wi[1] * hi[1]) + (wi[2] * hi[2] + wi[3] * xi);
        hq[0] = hq[1]; hq[1] = hq[2]; hq[2] = xq; hf[0] = hf[1]; hf[1] = hf[2]; hf[2] = xf; hi[0] = hi[1]; hi[1] = hi[2]; hi[2] = xi;
        const float f = fmaxf(lb + (1.0f - lb) * sigmoid_f(cf), 1e-30f); run += __logf(f); gl[r] = run; kk[r] = 1.0f - f; vv[r] = ci; q[r] = NEED_Q ? silu_f(cq) : 0.f; }
}
__device__ __forceinline__ void ma_hg_unit(Frame& F, const Loc& L, int l, int b, int c, int h, float* outb) {
    LAS bf16* Vt = (LAS bf16*)F.lds; LAS bf16* Kt = Vt + 64 * 136; LAS float* SEG = (LAS float*)(F.lds + SEG_OFF);
    const bf16* Pb = (const bf16*)(F.ws + WS_PROJ) + (size_t)b * TB * NIN; const int k = L.tid & 63, w = L.tid >> 6;
    float q[16], kk[16], vv[16], gl[16];
    STAMP(0);
    hg_rows<false>(Pb, c * 128 + 16 * w, h * 64 + k, F.in[14] + l * 4 * 768, ((const float*)(F.ws + WS_LBT))[l * 256 + h * 64 + k], q, kk, vv, gl);
    STAMP(1);
    { u32x4_t w0, w1; w0.x = cvtpk(vv[0], vv[1]); w0.y = cvtpk(vv[2], vv[3]); w0.z = cvtpk(vv[4], vv[5]); w0.w = cvtpk(vv[6], vv[7]); w1.x = cvtpk(vv[8], vv[9]); w1.y = cvtpk(vv[10], vv[11]); w1.z = cvtpk(vv[12], vv[13]); w1.w = cvtpk(vv[14], vv[15]);
      *(LAS u32x4_t*)(Vt + k * 136 + 16 * w) = w0; *(LAS u32x4_t*)(Vt + k * 136 + 16 * w + 8) = w1; }
    SEG[w * 64 + k] = gl[15];
    __syncthreads();
    STAMP(2);
    float off = 0.f, tot = 0.f;
#pragma unroll
    for (int ww = 0; ww < 8; ++ww) { const float s = SEG[ww * 64 + k]; if (ww < w) off += s; tot += s; }
    { float e[16];
#pragma unroll
      for (int r = 0; r < 16; ++r) e[r] = kk[r] * __expf(tot - off - gl[r]);
      u32x4_t w0, w1; w0.x = cvtpk(e[0], e[1]); w0.y = cvtpk(e[2], e[3]); w0.z = cvtpk(e[4], e[5]); w0.w = cvtpk(e[6], e[7]); w1.x = cvtpk(e[8], e[9]); w1.y = cvtpk(e[10], e[11]); w1.z = cvtpk(e[12], e[13]); w1.w = cvtpk(e[14], e[15]);
      *(LAS u32x4_t*)(Kt + k * 136 + 16 * w) = w0; *(LAS u32x4_t*)(Kt + k * 136 + 16 * w + 8) = w1; }
    const size_t ui = (size_t)(b * NCH + c) * 4 + h;
    if (w == 0) ((float*)((unsigned char*)outb + OUT_HDK))[ui * 64 + k] = __expf(tot);
    __syncthreads();
    STAMP(3);
    { const int il = L.lane & 15, g = L.lane >> 4, kt = L.wave >> 1, vt0 = 2 * (L.wave & 1); const f32x4 zero = {0.f, 0.f, 0.f, 0.f}; f32x4 acc[2] = {zero, zero};
#pragma unroll
      for (int ks = 0; ks < 4; ++ks) { const bf16x8 A = *(const LAS bf16x8*)(Kt + (16 * kt + il) * 136 + 32 * ks + 8 * g);
#pragma unroll
          for (int t = 0; t < 2; ++t) { const bf16x8 B = *(const LAS bf16x8*)(Vt + (16 * (vt0 + t) + il) * 136 + 32 * ks + 8 * g); acc[t] = mfma16(A, B, acc[t]); } }
      float* S = (float*)((unsigned char*)outb + OUT_HST) + ui * 4096;
#pragma unroll
      for (int t = 0; t < 2; ++t)
#pragma unroll
          for (int r = 0; r < 4; ++r) S[(16 * kt + 4 * g + r) * 64 + 16 * (vt0 + t) + il] = acc[t][r]; }
    __syncthreads();
    STAMP(4);
}
__device__ __forceinline__ void mb_hg(const Loc& L, float* outb, int e) {
    { const int b = e >> 14, h = (e >> 12) & 3, idx = e & 4095;
        float* p = (float*)((unsigned char*)outb + OUT_HST) + (size_t)(b * NCH * 4 + h) * 4096 + idx; const float* dk = (const float*)((unsigned char*)outb + OUT_HDK) + (size_t)(b * NCH * 4 + h) * 64 + (idx >> 6); float s = 0.f;
        float loc[NCH], dd[NCH];
#pragma unroll
        for (int c = 0; c < NCH; ++c) { loc[c] = p[(size_t)c * 4 * 4096]; dd[c] = dk[(size_t)c * 4 * 64]; }
        PIN16(loc); PIN16O(loc, 16); PIN16O(loc, 32); PIN16O(loc, 48); PIN16(dd); PIN16O(dd, 16); PIN16O(dd, 32); PIN16O(dd, 48); asm volatile("" : "+v"(loc[64]), "+v"(dd[64]) :: "memory");
        asm volatile("" : "+v"(p));
#pragma unroll
        for (int c = 0; c < NCH; ++c) { p[(size_t)c * 4 * 4096] = s; s = dd[c] * s + loc[c]; } }
}
__device__ __forceinline__ f32x4 ld4(const LAS float* p) { return *(const LAS f32x4*)p; }
__device__ __forceinline__ void mc_hg_unit(Frame& F, const Loc& L, int l, int b, int c, int h, const float* outb) {
    LAS float* Qf = (LAS float*)F.lds; LAS float* Kf = Qf + 128 * HG_LD; LAS float* G = Kf + 128 * HG_LD; LAS bf16* Vt = (LAS bf16*)(G + 128 * HG_LD); LAS bf16* SpT = Vt + 64 * 136; LAS float* SEG = (LAS float*)(F.lds + SEG_OFF);
    static_assert(3 * 128 * HG_LD * 4 + 64 * 136 * 2 + 64 * 72 * 2 <= RING_BYTES, "LDS map (HGRN2 MC)");
    const size_t row0 = (size_t)b * TB + c * 128; const bf16* Pb = (const bf16*)(F.ws + WS_PROJ) + (size_t)b * TB * NIN;
    { const int k = L.tid & 63, w = L.tid >> 6; float q[16], kk[16], vv[16], gl[16];
      hg_rows<true>(Pb, c * 128 + 16 * w, h * 64 + k, F.in[14] + l * 4 * 768, ((const float*)(F.ws + WS_LBT))[l * 256 + h * 64 + k], q, kk, vv, gl);
#pragma unroll
      for (int r = 0; r < 16; ++r) { const int t = 16 * w + r; Qf[t * HG_LD + k] = q[r]; Kf[t * HG_LD + k] = kk[r]; Vt[k * 136 + perm_pos(t)] = f2bf_(vv[r]); }
      SEG[w * 64 + k] = gl[15];
      { const int kr = L.tid >> 3, v8 = (L.tid & 7) * 8; const float* sp = (const float*)((const unsigned char*)outb + OUT_HST) + ((size_t)(b * NCH + c) * 4 + h) * 4096 + kr * 64 + v8; const f32x4 s0 = *(const f32x4*)sp, s1 = *(const f32x4*)(sp + 4);
#pragma unroll
        for (int e = 0; e < 4; ++e) { SpT[(v8 + e) * 72 + kr] = f2bf_(s0[e]); SpT[(v8 + 4 + e) * 72 + kr] = f2bf_(s1[e]); } }
      __syncthreads();
      float off = 0.f;
#pragma unroll
      for (int ww = 0; ww < 8; ++ww) { const float s = SEG[ww * 64 + k]; if (ww < w) off += s; }
#pragma unroll
      for (int r = 0; r < 16; ++r) G[(16 * w + r) * HG_LD + k] = gl[r] + off;
    }
    __syncthreads();
    const int w = L.wave, il = L.lane & 15, g = L.lane >> 4; const f32x4 zero = {0.f, 0.f, 0.f, 0.f};
    const size_t row = row0 + 16 * w + il; const bf16* gp = (const bf16*)(F.ws + WS_PROJ) + row * NIN + C_HG + h * 64; const float* og = F.in[16] + l * 256 + h * 64;
    unsigned long long gg4[4]; f32x4 og4[4];
#pragma unroll
    for (int vt = 0; vt < 4; ++vt) { gg4[vt] = *(const GAS unsigned long long*)(gp + 16 * vt + 4 * g); og4[vt] = *(const f32x4*)(og + 16 * vt + 4 * g); }
    f32x4 gr[2][2]; bf16x8 Bq[2], Bqi[2];
#pragma unroll
    for (int ks = 0; ks < 2; ++ks) { const int ko = 32 * ks + 8 * g;
        if (w > 0) { gr[ks][0] = ld4(G + (16 * w - 1) * HG_LD + ko); gr[ks][1] = ld4(G + (16 * w - 1) * HG_LD + ko + 4); } else { gr[ks][0] = zero; gr[ks][1] = zero; }
        const f32x4 q0 = ld4(Qf + (16 * w + il) * HG_LD + ko), q1 = ld4(Qf + (16 * w + il) * HG_LD + ko + 4), g0 = ld4(G + (16 * w + il) * HG_LD + ko), g1 = ld4(G + (16 * w + il) * HG_LD + ko + 4);
        f32x4 a0, a1, b0, b1;
#pragma unroll
        for (int e = 0; e < 4; ++e) { a0[e] = q0[e] * __expf(g0[e] - gr[ks][0][e]); a1[e] = q1[e] * __expf(g1[e] - gr[ks][1][e]); b0[e] = q0[e] * __expf(g0[e]); b1[e] = q1[e] * __expf(g1[e]); }
        Bq[ks] = pack8(a0, a1); Bqi[ks] = pack8(b0, b1); }
    f32x4 O[4] = {zero, zero, zero, zero};
#pragma unroll
    for (int jp = 0; jp < 4; ++jp) if (2 * jp <= w) {
        f32x4 pt[2] = {zero, zero};
#pragma unroll
        for (int hh = 0; hh < 2; ++hh) if (2 * jp + hh <= w) { const int J = 2 * jp + hh;
#pragma unroll
            for (int ks = 0; ks < 2; ++ks) { const int ko = 32 * ks + 8 * g; const f32x4 k0 = ld4(Kf + (16 * J + il) * HG_LD + ko), k1 = ld4(Kf + (16 * J + il) * HG_LD + ko + 4), g0 = ld4(G + (16 * J + il) * HG_LD + ko), g1 = ld4(G + (16 * J + il) * HG_LD + ko + 4);
                f32x4 a0, a1;
#pragma unroll
                for (int e = 0; e < 4; ++e) { a0[e] = k0[e] * __expf(fminf(gr[ks][0][e] - g0[e], 80.0f)); a1[e] = k1[e] * __expf(fminf(gr[ks][1][e] - g1[e], 80.0f)); }
                pt[hh] = mfma16(pack8(a0, a1), Bq[ks], pt[hh]); }
            if (J == w) {
#pragma unroll
                for (int r = 0; r < 4; ++r) if (4 * g + r > il) pt[hh][r] = 0.f; } }
        const bf16x8 Bp = pack8(pt[0], pt[1]);
#pragma unroll
        for (int vt = 0; vt < 4; ++vt) { const bf16x8 A = *(const LAS bf16x8*)(Vt + (16 * vt + il) * 136 + 32 * jp + 8 * g); O[vt] = mfma16(A, Bp, O[vt]); }
    }
#pragma unroll
    for (int vt = 0; vt < 4; ++vt)
#pragma unroll
        for (int ks = 0; ks < 2; ++ks) { const bf16x8 A = *(const LAS bf16x8*)(SpT + (16 * vt + il) * 72 + 32 * ks + 8 * g); O[vt] = mfma16(A, Bqi[ks], O[vt]); }
    float s2 = 0.f;
#pragma unroll
    for (int vt = 0; vt < 4; ++vt) s2 += (O[vt][0] * O[vt][0] + O[vt][1] * O[vt][1]) + (O[vt][2] * O[vt][2] + O[vt][3] * O[vt][3]);
    s2 += __shfl_xor(s2, 16); s2 += __shfl_xor(s2, 32); const float rstd = rsqrtf(s2 * (1.0f / 64.0f) + EPS);
    bf16* mo = (bf16*)(F.ws + WS_MIXED) + row * D + 256 + h * 64;
#pragma unroll
    for (int vt = 0; vt < 4; ++vt) { const int v0 = 16 * vt + 4 * g; const unsigned long long gg = gg4[vt]; const f32x4 o4 = og4[vt]; float y[4];
#pragma unroll
        for (int r = 0; r < 4; ++r) y[r] = O[vt][r] * rstd * o4[r] * silu_f(bf2f((bf16)(gg >> (16 * r))));
        *(GAS unsigned long long*)(mo + v0) = (unsigned long long)cvtpk(y[0], y[1]) | ((unsigned long long)cvtpk(y[2], y[3]) << 32); }
    __syncthreads();
}
constexpr int NCH5 = TB / 64, S5R = 64, S5S = 4;
constexpr int S5_WREG = 14592, BU_LD = 20, XS_LD = 136, GY_LD = 264;
static_assert(8 * S5_WREG <= RING_BYTES && S5R * GY_LD * 2 + 4096 + 512 <= RING_BYTES, "LDS map (S5)");
template <bool FULL> __device__ __forceinline__ void s5_group(Frame& F, const Loc& L, int l, int gidx, const bf16* Pc  , float& xr, float& xi, unsigned (&gy)[S5S][2]) {
    LAS float* BUt = (LAS float*)(F.lds + L.wave * S5_WREG); LAS bf16* Xs = (LAS bf16*)(F.lds + L.wave * S5_WREG + 128 * BU_LD * 4);
    const int il = L.lane & 15, g4 = L.lane >> 4, lg = l * 16 + gidx; const f32x4 zero = {0.f, 0.f, 0.f, 0.f}; const bf16x8 bz = {0, 0, 0, 0, 0, 0, 0, 0};
    bf16x8 Bb[8];
#pragma unroll
    for (int ct = 0; ct < 8; ++ct) Bb[ct] = g4 < 2 ? *(const bf16x8*)((const bf16*)(F.ws + WS_BBT) + ((size_t)lg * 128 + 16 * ct + il) * 16 + 8 * g4) : bz;
    bf16x8 Cb[4], Db = bz;
    if (FULL) {
#pragma unroll
        for (int ks = 0; ks < 4; ++ks) Cb[ks] = *(const bf16x8*)((const bf16*)(F.ws + WS_CCT) + ((size_t)lg * 16 + il) * 128 + 32 * ks + 8 * g4);
        const short dsk = (short)f2bf_(F.in[10][lg * 16 + il]);
#pragma unroll
        for (int jj = 0; jj < 8; ++jj) Db[jj] = (8 * g4 + jj == il) ? dsk : (short)0; }
    const float* LB = (const float*)(F.ws + WS_LB) + (size_t)(lg * 64 + L.lane) * 2; const float lr = LB[0], li = LB[1];
    const unsigned avoff = (unsigned)(il * NIN + C_U + 16 * gidx + 8 * g4) * 2u;
    bf16x8 Aall[S5S];
#pragma unroll
    for (int s = 0; s < S5S; ++s) Aall[s] = g4 < 2 ? *(const bf16x8*)((const char*)(Pc + (size_t)16 * s * NIN) + avoff) : bz;
#pragma unroll
    for (int s = 0; s < S5S; ++s) {
        const bf16x8 A = Aall[s];
#pragma unroll
        for (int ct = 0; ct < 8; ++ct) { const f32x4 d = mfma16(A, Bb[ct], zero); *(LAS f32x4*)(BUt + (16 * ct + il) * BU_LD + 4 * g4) = d; }
#pragma unroll
        for (int q = 0; q < 4; ++q) { const f32x4 br = *(const LAS f32x4*)(BUt + L.lane * BU_LD + 4 * q), bi = *(const LAS f32x4*)(BUt + (64 + L.lane) * BU_LD + 4 * q);
#pragma unroll
            for (int e = 0; e < 4; ++e) { const float nr = fmaf(lr, xr, fmaf(-li, xi, br[e])), ni = fmaf(lr, xi, fmaf(li, xr, bi[e])); xr = nr; xi = ni;
                if (FULL) *(LAS unsigned*)(Xs + (4 * q + e) * XS_LD + 2 * L.lane) = cvtpk(xr, xi); } }
        if (FULL) { f32x4 y = mfma16(A, Db, zero);
#pragma unroll
            for (int ks = 0; ks < 4; ++ks) { const bf16x8 Ax = *(const LAS bf16x8*)(Xs + il * XS_LD + 32 * ks + 8 * g4); y = mfma16(Ax, Cb[ks], y); }
            gy[s][0] = cvtpk(gelu_tanh(y[0]), gelu_tanh(y[1])); gy[s][1] = cvtpk(gelu_tanh(y[2]), gelu_tanh(y[3])); }
        asm volatile("" : "+v"(xr), "+v"(xi) :: "memory");
    }
}
__device__ __forceinline__ void ma_s5_unit(Frame& F, const Loc& L, int l, int b, int c, float* outb) {
    const bf16* Pc = (const bf16*)(F.ws + WS_PROJ) + ((size_t)b * TB + c * S5R) * NIN; unsigned gy[S5S][2];
#pragma unroll
    for (int gi = 0; gi < 2; ++gi) { const int gidx = 2 * L.wave + gi; float xr = 0.f, xi = 0.f; s5_group<false>(F, L, l, gidx, Pc, xr, xi, gy);
        float* xo = (float*)((unsigned char*)outb + OUT_S5X) + (((size_t)(b * NCH5 + c) * 16 + gidx) * 64 + L.lane) * 2; xo[0] = xr; xo[1] = xi; }
    __syncthreads();
}
__device__ __forceinline__ void mb_s5(Frame& F, const Loc& L, int l, float* outb, int e) {
    { const int b = e >> 10, gp = e & 1023; const float* lb = (const float*)(F.ws + WS_LB128) + (size_t)(l * 1024 + gp) * 2; const float dr = lb[0], di = lb[1];
        float* p = (float*)((unsigned char*)outb + OUT_S5X) + ((size_t)b * NCH5 * 1024 + gp) * 2; float sr = 0.f, si = 0.f; asm volatile("" : "+v"(sr), "+v"(si));
#pragma unroll
        for (int hf = 0; hf < 2; ++hf) {
            float la[65], lbv[65];
#pragma unroll
            for (int c = 0; c < 65; ++c) { const float2 t = *(const float2*)(p + (size_t)c * 2048); la[c] = t.x; lbv[c] = t.y; }
            PIN16(la); PIN16O(la, 16); PIN16O(la, 32); PIN16O(la, 48); PIN16(lbv); PIN16O(lbv, 16); PIN16O(lbv, 32); PIN16O(lbv, 48); asm volatile("" : "+v"(la[64]), "+v"(lbv[64]) :: "memory");
            asm volatile("" : "+v"(p));
#pragma unroll
            for (int c = 0; c < 65; ++c) { *(float2*)(p + (size_t)c * 2048) = make_float2(sr, si); const float nr = dr * sr - di * si + la[c], ni = dr * si + di * sr + lbv[c]; sr = nr; si = ni; }
            p += (size_t)65 * 2048; } }
}
__device__ __forceinline__ void mc_s5_unit(Frame& F, const Loc& L, int l, int b, int c, const float* outb) {
    const size_t row0 = (size_t)b * TB + c * S5R; const bf16* Pc = (const bf16*)(F.ws + WS_PROJ) + row0 * NIN;
    const int il = L.lane & 15, g4 = L.lane >> 4, w = L.wave;
    unsigned gy[2][S5S][2];
    STAMP(40);
#pragma unroll
    for (int gi = 0; gi < 2; ++gi) { const int gidx = 2 * w + gi; const float* xo = (const float*)((const unsigned char*)outb + OUT_S5X) + (((size_t)(b * NCH5 + c) * 16 + gidx) * 64 + L.lane) * 2; float xr = xo[0], xi = xo[1];
        s5_group<true>(F, L, l, gidx, Pc, xr, xi, gy[gi]); if (gi == 0) STAMP(41); }
    STAMP(42);
    __syncthreads();
    LAS bf16* GYs = (LAS bf16*)F.lds; LAS float* RED = (LAS float*)(F.lds + S5R * GY_LD * 2); LAS float* RSTD = RED + S5R * 8;
#pragma unroll
    for (int gi = 0; gi < 2; ++gi)
#pragma unroll
        for (int s = 0; s < S5S; ++s)
#pragma unroll
            for (int r = 0; r < 4; ++r) GYs[(16 * s + 4 * g4 + r) * GY_LD + 16 * (2 * w + gi) + il] = (bf16)(gy[gi][s][r >> 1] >> (16 * (r & 1)));
    __syncthreads();
    STAMP(43);
    const f32x4 zero = {0.f, 0.f, 0.f, 0.f}; f32x4 acc[S5S][2];
#pragma unroll
    for (int tt = 0; tt < S5S; ++tt) { acc[tt][0] = zero; acc[tt][1] = zero; }
    const bf16* WG = (const bf16*)(F.ws + WS_WGT) + (size_t)l * 65536;
    bf16x8 Wf[8][2];
#pragma unroll
    for (int ks = 0; ks < 8; ++ks) { Wf[ks][0] = *(const bf16x8*)(WG + (size_t)(32 * w + il) * 256 + 32 * ks + 8 * g4); Wf[ks][1] = *(const bf16x8*)(WG + (size_t)(32 * w + 16 + il) * 256 + 32 * ks + 8 * g4); }
#pragma unroll
    for (int ks = 0; ks < 8; ++ks) {
#pragma unroll
        for (int tt = 0; tt < S5S; ++tt) { const bf16x8 Ag = *(const LAS bf16x8*)(GYs + (16 * tt + il) * GY_LD + 32 * ks + 8 * g4); acc[tt][0] = mfma16(Wf[ks][0], Ag, acc[tt][0]); acc[tt][1] = mfma16(Wf[ks][1], Ag, acc[tt][1]); } }
#pragma unroll
    for (int tt = 0; tt < S5S; ++tt) { float ss = 0.f;
#pragma unroll
        for (int nt = 0; nt < 2; ++nt) { const unsigned long long gq = *(const LAS unsigned long long*)(GYs + (16 * tt + il) * GY_LD + 32 * w + 16 * nt + 4 * g4);
#pragma unroll
            for (int r = 0; r < 4; ++r) { const float v = bf2f((bf16)(gq >> (16 * r))) * sigmoid_f(acc[tt][nt][r]); acc[tt][nt][r] = v; ss += v * v; } }
        ss += __shfl_xor(ss, 16); ss += __shfl_xor(ss, 32); if (g4 == 0) RED[(16 * tt + il) * 8 + w] = ss; }
    STAMP(44);
    __syncthreads();
    if (L.tid < S5R) { const f32x4 a = *(const LAS f32x4*)(RED + L.tid * 8), bq = *(const LAS f32x4*)(RED + L.tid * 8 + 4); RSTD[L.tid] = rsqrtf((((a[0] + a[1]) + (a[2] + a[3])) + ((bq[0] + bq[1]) + (bq[2] + bq[3]))) * (1.0f / 256.0f) + EPS); }
    __syncthreads();
    const float* og = F.in[13] + l * 256; bf16* MX = (bf16*)(F.ws + WS_MIXED) + row0 * D;
    f32x4 og2[2] = {*(const f32x4*)(og + 32 * w + 4 * g4), *(const f32x4*)(og + 32 * w + 16 + 4 * g4)}; PIN4(og2[0], og2[1], og2[0], og2[1]);
#pragma unroll
    for (int tt = 0; tt < S5S; ++tt) { const float rs = RSTD[16 * tt + il];
#pragma unroll
        for (int nt = 0; nt < 2; ++nt) { const int n0 = 32 * w + 16 * nt + 4 * g4; const f32x4 o4 = og2[nt];
            *(GAS unsigned long long*)((char*)(MX + (size_t)16 * tt * D) + (unsigned)(il * D + n0) * 2u) = (unsigned long long)cvtpk(acc[tt][nt][0] * rs * o4[0], acc[tt][nt][1] * rs * o4[1]) | ((unsigned long long)cvtpk(acc[tt][nt][2] * rs * o4[2], acc[tt][nt][3] * rs * o4[3]) << 32); } }
    __syncthreads();
}
constexpr int MOETBL_OFF = SEG_OFF + 2048;
static_assert(MOETBL_OFF % 16 == 0 && MOETBL_OFF + 64 <= LDS_BYTES, "LDS map (MoE table)");
__device__ __forceinline__ void moe_table(Frame& F) {
    if (mk_tid(F.wave_s) == 0) { LAS int* tbl = (LAS int*)(F.lds + MOETBL_OFF); const unsigned* cnt = (const unsigned*)(F.ctl + CW_CNT); int acc = 0;
        for (int e = 0; e < 8; ++e) { tbl[e] = acc; acc += ((int)cnt[e] + 255) >> 8; } tbl[8] = acc; }
    __syncthreads();
}
constexpr int NU_S5 = 2 * NCH5, NU_HG = 520, NU_RT = 1040, NU_ALL = NU_S5 + NU_HG + NU_RT, QSLOT_OFF = MOETBL_OFF + 64;
static_assert(QSLOT_OFF % 16 == 0 && QSLOT_OFF + 16 <= LDS_BYTES, "LDS map (queue slot)");
template <bool IS_MC> __device__ __forceinline__ void p_mixer_units(Frame& F, int l, float* outb, int qidx) {
    LAS int* slot = (LAS int*)(F.lds + QSLOT_OFF); gu32* q = F.ctl + CW_QUEUE + 64 * qidx;
    const bool t0 = mk_tid(F.wave_s) == 0; int nxt = 0;
    if (t0) slot[0] = (int)__hip_atomic_fetch_add(q, 1u, RLX_AGENT);
    __syncthreads();
    for (;;) {
        const int u = __builtin_amdgcn_readfirstlane(slot[0]);
        if (u >= NU_ALL) break;
        if (t0) nxt = (int)__hip_atomic_fetch_add(q, 1u, RLX_AGENT);
        if (u < NU_S5) { const Loc L = make_loc(F.wave_s); if (IS_MC) mc_s5_unit(F, L, l, u / NCH5, u % NCH5, outb); else ma_s5_unit(F, L, l, u / NCH5, u % NCH5, outb); }
        else if (u < NU_S5 + NU_HG) { const Loc L = make_loc(F.wave_s); const int uu = u - NU_S5; if (IS_MC) mc_hg_unit(F, L, l, uu / 260, (uu % 260) >> 2, uu & 3, outb); else ma_hg_unit(F, L, l, uu / 260, (uu % 260) >> 2, uu & 3, outb); }
        else { const Loc L = make_loc(F.wave_s); const int uu = u - NU_S5 - NU_HG; if (IS_MC) mc_ret_unit(F, L, l, uu / 520, (uu % 520) >> 3, uu & 7, outb); else ma_ret_unit(F, L, uu / 520, (uu % 520) >> 3, uu & 7, outb); }
        if (t0) slot[0] = nxt;
        __syncthreads();
    }
}
__device__ __forceinline__ void p_ma(Frame& F, int l, float* outb) { p_mixer_units<false>(F, l, outb, 2 * l); }
__device__ __forceinline__ void p_mb(Frame& F, int l, float* outb) { const Loc L = make_loc(F.wave_s); const int gt = L.vcu * NT + L.tid;
    if (gt < 32768) mb_ret(L, outb, gt); else if (gt < 65536) mb_hg(L, outb, gt - 32768); else if (gt < 67584) mb_s5(F, L, l, outb, gt - 65536); }
__device__ __forceinline__ void p_mc(Frame& F, int l, float* outb) { p_mixer_units<true>(F, l, outb, 2 * l + 1); }
__device__ __forceinline__ void p_w2conv(Frame& F) {
    const Loc L = make_loc(F.wave_s); LAS float* scr = (LAS float*)(F.lds + RING_OFF); constexpr int I_M2 = 56 * 4;
    for (int it = L.vcu; it < 8 * I_M2; it += L.G) { const int e = it / I_M2; tr_item_wg(TrP{F.in[26] + (size_t)e * DFE * D, DFE, D, (bf16*)(F.ws + WS_WM2) + (size_t)e * D * DFE, 0, nullptr, it % I_M2}, scr, L.tid); }
}
__device__ __forceinline__ void p_route(Frame& F) {
    const Loc L = make_loc(F.wave_s);
    const bf16* HB = (const bf16*)(F.ws + WS_HB); const float* gff = F.in[19] + D; const float* R = F.in[23];
    int* POS = (int*)(F.ws + WS_POS); float* GATE = (float*)(F.ws + WS_GATE); int* LIST = (int*)(F.ws + WS_LIST); unsigned* CNT = (unsigned*)(F.ctl + CW_CNT);
    LAS float* RT = (LAS float*)F.lds;
    for (int grp = L.bx; grp < BATCH * SEQ / 64; grp += L.G) {
        for (int j = 0; j < 8; ++j) { const int tk = grp * 64 + L.wave * 8 + j; const size_t m = (size_t)(tk / SEQ) * TB + 128 + (tk % SEQ);
            float ss = 0.f, part[8];
#pragma unroll
            for (int e = 0; e < 8; ++e) part[e] = 0.f;
            v4u hw[2]; hw[0] = ((const GAS v4u*)(HB + m * D))[L.lane]; hw[1] = ((const GAS v4u*)(HB + m * D))[L.lane + 64]; PIN4(hw[0], hw[1], hw[0], hw[1]);
#pragma unroll
            for (int jj = 0; jj < 2; ++jj) { const int d0 = 8 * L.lane + 512 * jj;
#pragma unroll
                for (int q = 0; q < 8; ++q) { const unsigned wq = hw[jj][q >> 1]; const float hx = __uint_as_float((q & 1) ? (wq & 0xffff0000u) : (wq << 16)); ss += hx * hx;
                    const float hv = hx * gff[d0 + q]; const f32x4 r0 = *(const f32x4*)(R + (d0 + q) * 8), r1 = *(const f32x4*)(R + (d0 + q) * 8 + 4);
                    part[0] += hv * r0.x; part[1] += hv * r0.y; part[2] += hv * r0.z; part[3] += hv * r0.w; part[4] += hv * r1.x; part[5] += hv * r1.y; part[6] += hv * r1.z; part[7] += hv * r1.w; } }
            const float rstd = rsqrtf(wave_sum(ss) * (1.0f / 1024.0f) + EPS); float lg[8];
#pragma unroll
            for (int e = 0; e < 8; ++e) lg[e] = wave_sum(part[e]) * rstd;
            int i1 = 0; float l1 = lg[0];
#pragma unroll
            for (int e = 1; e < 8; ++e) if (lg[e] > l1) { l1 = lg[e]; i1 = e; }
            int i2 = -1; float l2 = -3.0e38f;
#pragma unroll
            for (int e = 0; e < 8; ++e) if (e != i1 && lg[e] > l2) { l2 = lg[e]; i2 = e; }
            const float e2 = __expf(l2 - l1), g1 = 1.0f / (1.0f + e2), g2 = e2 * g1;
            if (L.lane == 0) { const int sl = L.wave * 8 + j; RT[sl * 4 + 0] = __int_as_float(i1); RT[sl * 4 + 1] = __int_as_float(i2); RT[sl * 4 + 2] = g1; RT[sl * 4 + 3] = g2; RT[256 + sl] = rstd; } }
        __syncthreads();
        if (L.wave == 0) { const int tk = grp * 64 + L.lane; const int e1 = __float_as_int(RT[L.lane * 4 + 0]), e2 = __float_as_int(RT[L.lane * 4 + 1]); const float g1 = RT[L.lane * 4 + 2], g2 = RT[L.lane * 4 + 3];
            const int row = (tk / SEQ) * TB + 128 + (tk % SEQ); const unsigned long long lt = (1ull << L.lane) - 1ull; int p1 = 0, p2 = 0;
#pragma unroll
            for (int e = 0; e < 8; ++e) { const unsigned long long m1 = __ballot(e1 == e), m2 = __ballot(e2 == e); const int n1 = __popcll(m1), n2 = __popcll(m2);
                unsigned base = 0u; if (L.lane == 0 && n1 + n2 > 0) base = atomicAdd(CNT + e, (unsigned)(n1 + n2)); base = __shfl(base, 0);
                if (e1 == e) p1 = (int)base + __popcll(m1 & lt); if (e2 == e) p2 = (int)base + n1 + __popcll(m2 & lt); }
            LIST[(size_t)e1 * MOE_CAP + p1] = row; LIST[(size_t)e2 * MOE_CAP + p2] = row; { float* RSL = (float*)(F.ws + WS_RSL); const float rs = RT[256 + L.lane]; RSL[(size_t)e1 * MOE_CAP + p1] = rs; RSL[(size_t)e2 * MOE_CAP + p2] = rs; }
            POS[tk * 2] = (e1 << 20) | p1; POS[tk * 2 + 1] = (e2 << 20) | p2; GATE[tk * 2] = g1; GATE[tk * 2 + 1] = g2; }
        __syncthreads();
    }
}
__device__ __forceinline__ void p_final(Frame& F, float* out) {
    const Loc L = make_loc(F.wave_s);
    const int gw = L.vcu * NWAVES + L.wave, NGW = L.G * NWAVES; const bf16* HB = (const bf16*)(F.ws + WS_HB); const float* gf = F.in[27];
    const int* POS = (const int*)(F.ws + WS_POS); const float* GATE = (const float*)(F.ws + WS_GATE); const bf16* YS = (const bf16*)(F.ws + WS_YS); const unsigned* CNT = (const unsigned*)(F.ctl + CW_CNT);
    moe_table(F); const LAS int* tbl = (const LAS int*)(F.lds + MOETBL_OFF);
    f32x4 gfr[4];
#pragma unroll
    for (int j = 0; j < 4; ++j) gfr[j] = ((const GAS f32x4*)gf)[L.lane + 64 * j];
    PIN4(gfr[0], gfr[1], gfr[2], gfr[3]);
    for (int r = gw; r < BATCH * SEQ; r += NGW) { const int b = r / SEQ, t = r % SEQ; const size_t m = (size_t)b * TB + 128 + t;
        const int q1 = POS[r * 2], q2 = POS[r * 2 + 1]; const float g1 = GATE[r * 2], g2 = GATE[r * 2 + 1]; const int t1 = tbl[q1 >> 20], t2 = tbl[q2 >> 20];
        const size_t s1 = (size_t)t1 * 256 + (q1 & 0xfffff), s2 = (size_t)t2 * 256 + (q2 & 0xfffff);
        f32x4 v[4]; float s = 0.f; unsigned long long hh[4], ya[4], yb[4];
#pragma unroll
        for (int j = 0; j < 4; ++j) { hh[j] = ((const GAS unsigned long long*)(HB + m * D))[L.lane + 64 * j]; ya[j] = ((const GAS unsigned long long*)(YS + s1 * D))[L.lane + 64 * j]; yb[j] = ((const GAS unsigned long long*)(YS + s2 * D))[L.lane + 64 * j]; }
        PIN4(hh[0], hh[1], hh[2], hh[3]); PIN8(ya[0], ya[1], ya[2], ya[3], yb[0], yb[1], yb[2], yb[3]);
#pragma unroll
        for (int j = 0; j < 4; ++j) { const unsigned long long y1 = ya[j], y2 = yb[j];
#pragma unroll
            for (int q = 0; q < 4; ++q) v[j][q] = bf2f((bf16)(hh[j] >> (16 * q))) + g1 * bf2f((bf16)(y1 >> (16 * q))) + g2 * bf2f((bf16)(y2 >> (16 * q)));
            s += (v[j].x * v[j].x + v[j].y * v[j].y) + (v[j].z * v[j].z + v[j].w * v[j].w); }
        const float rstd = rsqrtf(wave_sum(s) * (1.0f / 1024.0f) + EPS);
#pragma unroll
        for (int j = 0; j < 4; ++j) ((GAS f32x4*)(out + (size_t)r * D))[L.lane + 64 * j] = v[j] * rstd * gfr[j];
        if (PROBE_TA >= 0 && r == 0 && L.lane == 0) { asm volatile("s_waitcnt vmcnt(0)" ::: "memory"); out[0] = PROBE_SCALE * (float)(__hip_atomic_load(F.ctl + CW_PROBE + (PROBE_TB >= 0 ? PROBE_TB : 0), RLX_AGENT) - __hip_atomic_load(F.ctl + CW_PROBE + (PROBE_TA >= 0 ? PROBE_TA : 0), RLX_AGENT)); }
    }
}

struct Args { const float* in[28]; float* out; unsigned char* ws; int ph_lo, ph_hi, li, pad; };
__global__ void __launch_bounds__(NWAVES * 64, 2) __attribute__((amdgpu_waves_per_eu(2, 2))) mk_fwd(Args args) {
    extern __shared__ __attribute__((aligned(16))) unsigned char lds[];
    Frame F;
    F.lds = (LAS unsigned char*)lds; F.MISC = (volatile LAS unsigned*)(F.lds + MISC_OFF);
    F.ws = args.ws; F.ctl = (gu32*)(args.ws + WS_CTL); F.in = args.in; F.wave_s = __builtin_amdgcn_readfirstlane((int)threadIdx.x >> 6);
    for (int u = mk_tid(F.wave_s); u < (LDS_BYTES - LDSCTL_OFF) / 4; u += NWAVES * 64) ((LAS unsigned*)(F.lds + LDSCTL_OFF))[u] = 0u;
    __syncthreads();
    XcdBarrier bar; bar.bar = (unsigned*)(F.ctl + CW_BAR); bar.x = 0; bar.st = nullptr; bar.wv = F.wave_s;
    if (!MK_PER_PHASE) bar = xcd_barrier_post((unsigned*)(F.ctl + CW_BAR), F.MISC + 8, F.wave_s);
    STAMP(15);
    const int lo = args.ph_lo, hi = args.ph_hi;
#define IN(k) (lo <= (k) && (k) < hi)
#define SEAM(k) do { if (!MK_PER_PHASE && (k) + 1 < hi) xcd_barrier(bar); STAMP(16 + (k)); } while (0)
    unsigned char* ws = args.ws;
    float* SS = (float*)(ws + WS_SSP);
    if (IN(0)) for (int rep = 0; rep < REP(1); ++rep) { p0_prologue(F); SEAM(0); }
    for (int l = 0; l < 2; ++l) {
        { unsigned char* w_ = args.ws; asm volatile("" : "+s"(w_)); ws = w_; F.ws = w_; F.ctl = (gu32*)(w_ + WS_CTL); SS = (float*)(w_ + WS_SSP); }
        const int base = 1 + 30 * l;
        if (IN(base + 0)) for (int rep = 0; rep < REP(2); ++rep) {
            pg8::Gemm g{(const bf16*)(ws + WS_HB), (const bf16*)(ws + WS_WIN) + (size_t)l * NIN * D, M, NIN, D, F.wave_s}; pg8::StaticOrder S; const Loc L = make_loc(F.wave_s); S.init(M, NIN, L.G, L.bx);
            pg8::EpiProj E{(bf16*)(ws + WS_PROJ), NIN, SS + (size_t)(2 * l) * M * 16};
            pg8::gemm_phase<pg8::EpiProj, pg8::StaticOrder, true, true>(F.lds + RING_OFF, g, S, E);
            SEAM(base + 0);
        }
        if (IN(base + 1)) for (int rep = 0; rep < REP(3); ++rep) { p_ma(F, l, args.out); SEAM(base + 1); }
        if (IN(base + 2)) { p_mb(F, l, args.out); SEAM(base + 2); }
        if (IN(base + 3)) for (int rep = 0; rep < REP(4); ++rep) { p_mc(F, l, args.out); SEAM(base + 3); }
        if (IN(base + 6)) {
            pg8::Gemm g{(const bf16*)(ws + WS_MIXED), (const bf16*)(ws + WS_WOUT) + (size_t)l * D * D, M, D, D, F.wave_s}; pg8::StaticOrder S; const Loc L = make_loc(F.wave_s); S.init(M, D, L.G, L.bx);
            pg8::EpiResid E{(bf16*)(ws + WS_HB), SS + (size_t)(2 * l + 1) * M * 16, nullptr, 0, 1};
            pg8::gemm_phase<pg8::EpiResid, pg8::StaticOrder, true, true>(F.lds + RING_OFF, g, S, E);
            SEAM(base + 6);
        }
        if (l == 0) {
            if (IN(base + 8)) for (int rep = 0; rep < REP(5); ++rep) {
                pg8::Gemm g{(const bf16*)(ws + WS_HB), (const bf16*)(ws + WS_WF13), M, 2 * DFF, D, F.wave_s}; pg8::StaticOrder S; const Loc L = make_loc(F.wave_s); S.init(M, 2 * DFF, L.G, L.bx);
                pg8::EpiSwiglu E{(bf16*)(ws + WS_ACT), DFF, SS + (size_t)1 * M * 16};
                pg8::gemm_phase<pg8::EpiSwiglu, pg8::StaticOrder, true, true>(F.lds + RING_OFF, g, S, E);
                SEAM(base + 8);
            }
            if (IN(base + 9)) {
                pg8::Gemm g{(const bf16*)(ws + WS_ACT), (const bf16*)(ws + WS_WF2), M, D, DFF, F.wave_s}; pg8::StaticOrder S; const Loc L = make_loc(F.wave_s); S.init(M, D, L.G, L.bx);
                pg8::EpiResid E{(bf16*)(ws + WS_HB), SS + (size_t)2 * M * 16, nullptr, 0, 1};
                pg8::gemm_phase<pg8::EpiResid, pg8::StaticOrder, true, true>(F.lds + RING_OFF, g, S, E);
                { const Loc L2 = make_loc(F.wave_s); if (L2.bx >= 4) conv_moe13(F, L2.bx - 4, L2.G - 4, 2580, N_M13, L2.tid); }
                SEAM(base + 9);
            }
        } else {
            if (IN(base + 7)) { p_route(F); SEAM(base + 7); }
            if (IN(base + 10)) for (int rep = 0; rep < REP(6); ++rep) {
                pg8::Gemm g{(const bf16*)(ws + WS_HB), (const bf16*)(ws + WS_WM13), MOE_TMAX * 256, NEXP * 2 * DFE, D, F.wave_s}; const Loc L = make_loc(F.wave_s);
                moe_table(F); pg8::MoeOrder<true> S; S.init((const int*)(F.ctl + CW_CNT), (const int*)(ws + WS_LIST), MOE_CAP, 2 * DFE / 256, L.G, L.bx, (const LAS int*)(F.lds + MOETBL_OFF));
                pg8::EpiSwigluMoe E{(bf16*)(ws + WS_ACT), DFE, (const float*)(ws + WS_RSL), MOE_CAP, 2 * DFE / 256};
                pg8::gemm_phase<pg8::EpiSwigluMoe, pg8::MoeOrder<true>, true, true>(F.lds + RING_OFF, g, S, E);
                SEAM(base + 10);
            }
            if (IN(base + 11)) for (int rep = 0; rep < REP(8); ++rep) { p_w2conv(F); SEAM(base + 11); }
            if (IN(base + 12)) for (int rep = 0; rep < REP(7); ++rep) {
                pg8::Gemm g{(const bf16*)(ws + WS_ACT), (const bf16*)(ws + WS_WM2), MOE_TMAX * 256, NEXP * D, DFE, F.wave_s}; const Loc L = make_loc(F.wave_s);
                moe_table(F); pg8::MoeOrder<false> S; S.init((const int*)(F.ctl + CW_CNT), (const int*)(ws + WS_LIST), MOE_CAP, D / 256, L.G, L.bx, (const LAS int*)(F.lds + MOETBL_OFF));
                pg8::EpiYs E{(bf16*)(ws + WS_YS)};
                pg8::gemm_phase<pg8::EpiYs, pg8::MoeOrder<false>, true, true>(F.lds + RING_OFF, g, S, E);
                SEAM(base + 12);
            }
        }
    }
    if (IN(NPH - 1)) p_final(F, args.out);
#undef IN
#undef SEAM
}

extern "C" void kernel_launch(void* const* d_in, const int* in_sizes, int n_in, void* d_out, int out_size, void* d_ws, size_t ws_size, hipStream_t stream) {
    static int grid = 0;
    if (grid == 0) {
        if (n_in != 28 || out_size != BATCH * SEQ * D || ws_size < WS_END) { fprintf(stderr, "kernel_launch: unexpected shapes: n_in %d out %d ws %zu (need %zu)\n", n_in, out_size, ws_size, (size_t)WS_END); grid = -1; return; }
        int dev = 0, cus = 0, per_cu = 0;
        if (hipGetDevice(&dev) != hipSuccess || hipDeviceGetAttribute(&cus, hipDeviceAttributeMultiprocessorCount, dev) != hipSuccess) { grid = -1; return; }
        if (hipFuncSetAttribute((const void*)mk_fwd, hipFuncAttributeMaxDynamicSharedMemorySize, LDS_BYTES) != hipSuccess) { fprintf(stderr, "kernel_launch: hipFuncSetAttribute failed\n"); grid = -1; return; }
        if (hipOccupancyMaxActiveBlocksPerMultiprocessor(&per_cu, (const void*)mk_fwd, NWAVES * 64, LDS_BYTES) != hipSuccess || per_cu < 1) { fprintf(stderr, "kernel_launch: occupancy query says %d\n", per_cu); }
        (void)hipGetLastError();
        grid = cus;
    }
    if (grid < 0) return;
    if (hipMemsetAsync((char*)d_ws + WS_CTL, 0, CTL_ZERO_BYTES, stream) != hipSuccess) return;
    Args a{};
    for (int i = 0; i < 28; ++i) a.in[i] = (const float*)d_in[i];
    a.out = (float*)d_out; a.ws = (unsigned char*)d_ws;
#if MK_PER_PHASE
    for (int k = 0; k < NPH; ++k) { if (!phase_exists(k)) continue; a.ph_lo = k; a.ph_hi = k + 1; a.li = 0; hipLaunchKernelGGL(mk_fwd, dim3(grid), dim3(NWAVES * 64), LDS_BYTES, stream, a); }
#else
    a.ph_lo = 0; a.ph_hi = NPH; a.li = 0;
    hipLaunchKernelGGL(mk_fwd, dim3(grid), dim3(NWAVES * 64), LDS_BYTES, stream, a);
#endif
}
```

```cpp
#include <hip/hip_runtime.h>
#include <cstdio>
#include <cstdint>
#include <cmath>
#define PIN4(a, b, c, d) asm volatile("" : "+v"(a), "+v"(b), "+v"(c), "+v"(d) :: "memory")
#define PIN8(a, b, c, d, e, f, g, h) asm volatile("" : "+v"(a), "+v"(b), "+v"(c), "+v"(d), "+v"(e), "+v"(f), "+v"(g), "+v"(h) :: "memory")
#define PIN16O(A, o) asm volatile("" : "+v"(A[(o) + 0]), "+v"(A[(o) + 1]), "+v"(A[(o) + 2]), "+v"(A[(o) + 3]), "+v"(A[(o) + 4]), "+v"(A[(o) + 5]), "+v"(A[(o) + 6]), "+v"(A[(o) + 7]), "+v"(A[(o) + 8]), "+v"(A[(o) + 9]), "+v"(A[(o) + 10]), "+v"(A[(o) + 11]), "+v"(A[(o) + 12]), "+v"(A[(o) + 13]), "+v"(A[(o) + 14]), "+v"(A[(o) + 15]) :: "memory")
#define PIN16(A) asm volatile("" : "+v"(A[0]), "+v"(A[1]), "+v"(A[2]), "+v"(A[3]), "+v"(A[4]), "+v"(A[5]), "+v"(A[6]), "+v"(A[7]), "+v"(A[8]), "+v"(A[9]), "+v"(A[10]), "+v"(A[11]), "+v"(A[12]), "+v"(A[13]), "+v"(A[14]), "+v"(A[15]) :: "memory")
__device__ __forceinline__ int mk_tid(int wave_s) { int z = 0; asm volatile("" : "+v"(z)); return wave_s * 64 + (int)__builtin_amdgcn_mbcnt_hi(~0u, __builtin_amdgcn_mbcnt_lo(~0u, (unsigned)z)); }
namespace pg8 {
#define PG8_LAS __attribute__((address_space(3)))
typedef unsigned short bf16_t;
typedef short bf16x8 __attribute__((ext_vector_type(8)));
typedef float f32x4 __attribute__((ext_vector_type(4)));
typedef unsigned u32x4 __attribute__((ext_vector_type(4)));
constexpr int BM = 256, BK = 64, HALF = 128, HTB = HALF * BK * 2  , STAGE_BYTES = 8 * HTB, NXCD = 8, WGM = 8;

__host__ __device__ __forceinline__ int lds_byte(int r, int c) { const int st = (r >> 4) * 2 + (c >> 5), rr = r & 15, cc = c & 31, ob = rr * 64 + cc * 2; return st * 1024 + (ob ^ (((ob >> 9) & 1) << 5)); }
__host__ __device__ __forceinline__ void stage_rc(int b, int& R, int& C) { const int st = b / 1024, sb = b % 1024, swz = sb ^ (((sb >> 9) & 1) << 5); R = (st >> 1) * 16 + swz / 64; C = (st & 1) * 32 + (swz % 64) / 2; }
__host__ __device__ __forceinline__ int perm32(int rho) { const int n = rho >> 4, i = rho & 15; return 8 * (i >> 2) + 4 * n + (i & 3); }

struct Unit { int pm, pn, e, r0, ce; };
struct Gemm { const bf16_t* A; const bf16_t* Bt; int M, N, K, wv; };

struct StaticOrder {
    static constexpr bool GATHER = false;
    int nM, nN, nwg, G, c;
    __host__ __device__ void init(int M, int N, int G_, int c_) { nM = M / BM; nN = N / BM; nwg = nM * nN; G = G_; c = c_; }
    __host__ __device__ bool next(int i, Unit& u) const {
        const long L = (long)i * G + c; if (L >= nwg) return false;
        int wgid = (int)L; { const int q = nwg / NXCD, r = nwg % NXCD, xcd = wgid % NXCD, off = wgid / NXCD; wgid = (xcd < r ? xcd * (q + 1) : r * (q + 1) + (xcd - r) * q) + off; }
        const int nig = WGM * nN, gid = wgid / nig, fm = gid * WGM, gsz = (nM - fm) < WGM ? (nM - fm) : WGM;
        u.pm = fm + ((wgid % nig) % gsz); u.pn = (wgid % nig) / gsz; return true;
    }
    __device__ __forceinline__ void a_ready(const Unit&) const {}
    __device__ __forceinline__ void done(const Unit&) const {}
    __device__ __forceinline__ int arow(const Unit&, int) const { return 0; }
};

__device__ __forceinline__ unsigned cvt_pk_bf16(float lo, float hi) { unsigned r; asm volatile("v_cvt_pk_bf16_f32 %0, %1, %2" : "=v"(r) : "v"(lo), "v"(hi)); return r; }
typedef float f32x2 __attribute__((ext_vector_type(2)));
constexpr float RMS_EPS = 1e-6f;
__device__ __forceinline__ float fast_silu(float a) { return a * __builtin_amdgcn_rcpf(1.0f + __expf(-a)); }
__device__ __forceinline__ float rstd_of(const f32x4 a, const f32x4 b, const f32x4 c, const f32x4 d) {
    const float t = (((a[0] + a[1]) + (a[2] + a[3])) + ((b[0] + b[1]) + (b[2] + b[3]))) + (((c[0] + c[1]) + (c[2] + c[3])) + ((d[0] + d[1]) + (d[2] + d[3])));
    return __builtin_amdgcn_rsqf(t * (1.0f / 1024.0f) + RMS_EPS); }
__device__ __forceinline__ float row_rstd(const float* ss, int row) { const f32x4* p = (const f32x4*)(ss + (size_t)row * 16); return rstd_of(p[0], p[1], p[2], p[3]); }
__device__ __forceinline__ void row_rstd4(const float* ss, int row0, float (&sc)[4]) {
    f32x4 v[4][4];
#pragma unroll
    for (int m = 0; m < 4; ++m)
#pragma unroll
        for (int j = 0; j < 4; ++j) v[m][j] = *(const f32x4*)(ss + (size_t)(row0 + 16 * m) * 16 + 4 * j);
    PIN8(v[0][0], v[0][1], v[0][2], v[0][3], v[1][0], v[1][1], v[1][2], v[1][3]); PIN8(v[2][0], v[2][1], v[2][2], v[2][3], v[3][0], v[3][1], v[3][2], v[3][3]);
#pragma unroll
    for (int m = 0; m < 4; ++m) sc[m] = rstd_of(v[m][0], v[m][1], v[m][2], v[m][3]);
}
struct EpiProj {
    static constexpr bool PERM = true, AFTER_DRAIN = false;
    bf16_t* O; int ldc; const float* ss;
    __device__ __forceinline__ void operator()(const f32x4 (&acc)[2][2][4][2], const Unit& u, int wr, int wc, int fr, int fq) const {
        const int row0 = u.pm * BM + wr * 64 + fr, col0 = u.pn * BM + wc * 32 + 8 * fq;
#pragma unroll
        for (int ai = 0; ai < 2; ++ai) { float sc4[4]; row_rstd4(ss, row0 + ai * HALF, sc4);
#pragma unroll
            for (int m = 0; m < 4; ++m) { const int row = row0 + ai * HALF + m * 16; const float sc = sc4[m];
                bf16_t* rowp = O + (size_t)row * ldc + col0;
#pragma unroll
                for (int bj = 0; bj < 2; ++bj) { const f32x4 v0 = acc[ai][bj][m][0] * sc, v1 = acc[ai][bj][m][1] * sc;
                    u32x4 w; w.x = cvt_pk_bf16(v0[0], v0[1]); w.y = cvt_pk_bf16(v0[2], v0[3]); w.z = cvt_pk_bf16(v1[0], v1[1]); w.w = cvt_pk_bf16(v1[2], v1[3]);
                    *(u32x4*)(rowp + bj * HALF) = w; } } }
    }
};
struct EpiSwiglu {
    static constexpr bool PERM = true, AFTER_DRAIN = false;
    bf16_t* O; int ldc; const float* ss;
    __device__ __forceinline__ void operator()(const f32x4 (&acc)[2][2][4][2], const Unit& u, int wr, int wc, int fr, int fq) const {
        const int row0 = u.pm * BM + wr * 64 + fr, col0 = u.pn * HALF + wc * 32 + 8 * fq;
#pragma unroll
        for (int ai = 0; ai < 2; ++ai) { float sc4[4]; row_rstd4(ss, row0 + ai * HALF, sc4);
#pragma unroll
            for (int m = 0; m < 4; ++m) { const int row = row0 + ai * HALF + m * 16; const float sc = sc4[m];
                const f32x4 a0 = acc[ai][0][m][0] * sc, a1 = acc[ai][0][m][1] * sc, b0 = acc[ai][1][m][0] * sc, b1 = acc[ai][1][m][1] * sc;
                u32x4 w; w.x = cvt_pk_bf16(fast_silu(a0[0]) * b0[0], fast_silu(a0[1]) * b0[1]); w.y = cvt_pk_bf16(fast_silu(a0[2]) * b0[2], fast_silu(a0[3]) * b0[3]);
                w.z = cvt_pk_bf16(fast_silu(a1[0]) * b1[0], fast_silu(a1[1]) * b1[1]); w.w = cvt_pk_bf16(fast_silu(a1[2]) * b1[2], fast_silu(a1[3]) * b1[3]);
                *(u32x4*)(O + (size_t)row * ldc + col0) = w; } }
    }
};
struct EpiResid {
    static constexpr bool PERM = false, AFTER_DRAIN = false;
    bf16_t* HB; float* ssout; const float* gate; int gstride; int write_ss;
    __device__ __forceinline__ void operator()(const f32x4 (&acc)[2][2][4][2], const Unit& u, int wr, int wc, int fr, int fq) const {
        const int row0 = u.pm * BM + wr * 64 + fr, col0 = u.pn * BM + wc * 32 + 4 * fq;
#pragma unroll
        for (int ai = 0; ai < 2; ++ai) {
            unsigned long long hv[4][2][2];
#pragma unroll
            for (int m = 0; m < 4; ++m)
#pragma unroll
                for (int bj = 0; bj < 2; ++bj)
#pragma unroll
                    for (int n = 0; n < 2; ++n) hv[m][bj][n] = *(const unsigned long long*)(HB + (size_t)(row0 + ai * HALF + m * 16) * 1024 + col0 + bj * HALF + n * 16);
            PIN8(hv[0][0][0], hv[0][0][1], hv[0][1][0], hv[0][1][1], hv[1][0][0], hv[1][0][1], hv[1][1][0], hv[1][1][1]); PIN8(hv[2][0][0], hv[2][0][1], hv[2][1][0], hv[2][1][1], hv[3][0][0], hv[3][0][1], hv[3][1][0], hv[3][1][1]);
#pragma unroll
            for (int m = 0; m < 4; ++m) { const int row = row0 + ai * HALF + m * 16; const float g = gate ? gate[(size_t)row * gstride] : 1.0f; float s = 0.f;
#pragma unroll
                for (int bj = 0; bj < 2; ++bj)
#pragma unroll
                    for (int n = 0; n < 2; ++n) { const unsigned long long h = hv[m][bj][n]; f32x4 o;
                        o[0] = __uint_as_float((unsigned)h << 16); o[1] = __uint_as_float((unsigned)h & 0xffff0000u); o[2] = __uint_as_float((unsigned)(h >> 32) << 16); o[3] = __uint_as_float((unsigned)(h >> 32) & 0xffff0000u);
                        o = o + acc[ai][bj][m][n] * g; s += (o[0] * o[0] + o[1] * o[1]) + (o[2] * o[2] + o[3] * o[3]);
                        *(unsigned long long*)(HB + (size_t)row * 1024 + col0 + bj * HALF + n * 16) = (unsigned long long)cvt_pk_bf16(o[0], o[1]) | ((unsigned long long)cvt_pk_bf16(o[2], o[3]) << 32); }
                if (write_ss) { s += __shfl_xor(s, 16); s += __shfl_xor(s, 32); if (fq == 0) ssout[(size_t)row * 16 + u.pn * 4 + wc] = s; } } }
    }
};
template <bool GATH> struct MoeOrder {
    static constexpr bool GATHER = GATH;
    int nNe, nT, nwg, G, c, cap; const int* list; const int* cnt; const PG8_LAS int* tbl;
    __device__ __forceinline__ void init(const int* cnt_, const int* list_, int cap_, int nNe_, int G_, int c_, const PG8_LAS int* tbl_) { list = list_; cnt = cnt_; tbl = tbl_; cap = cap_; nNe = nNe_; G = G_; c = c_; nT = tbl_[8]; nwg = nT * nNe; }
    __device__ __forceinline__ bool next(int i, Unit& u) const {
        const long L = (long)i * G + c; if (L >= nwg) return false;
        int wgid = (int)L; { const int q = nwg / NXCD, r = nwg % NXCD, xcd = wgid % NXCD, off = wgid / NXCD; wgid = (xcd < r ? xcd * (q + 1) : r * (q + 1) + (xcd - r) * q) + off; }
        const int nig = WGM * nNe, gid = wgid / nig, fm = gid * WGM, gsz = (nT - fm) < WGM ? (nT - fm) : WGM;
        const int t = fm + ((wgid % nig) % gsz), pnl = (wgid % nig) / gsz;
        int e = 0;
#pragma unroll
        for (int k = 1; k < 8; ++k) e += (t >= tbl[k]) ? 1 : 0;
        e = __builtin_amdgcn_readfirstlane(e);
        u.pm = t; u.pn = e * nNe + pnl; u.e = e; u.r0 = (t - __builtin_amdgcn_readfirstlane(tbl[e])) * BM; u.ce = cnt[e]; return true;
    }
    __device__ __forceinline__ int arow(const Unit& u, int R) const { const int pos = u.r0 + R; return pos < u.ce ? list[(size_t)u.e * cap + pos] : 0; }
    __device__ __forceinline__ void a_ready(const Unit&) const {}
    __device__ __forceinline__ void done(const Unit&) const {}
};
struct EpiSwigluMoe {
    static constexpr bool PERM = true, AFTER_DRAIN = false;
    bf16_t* O; int ldc; const float* rs; int cap, nNe;
    __device__ __forceinline__ void operator()(const f32x4 (&acc)[2][2][4][2], const Unit& u, int wr, int wc, int fr, int fq) const {
        const int r0 = wr * 64 + fr, col0 = (u.pn - u.e * nNe) * HALF + wc * 32 + 8 * fq;
        float sc8[8];
#pragma unroll
        for (int i = 0; i < 8; ++i) { const int pos = u.r0 + r0 + (i >> 2) * HALF + (i & 3) * 16; sc8[i] = pos < u.ce ? rs[(size_t)u.e * cap + pos] : 0.0f; }
        PIN8(sc8[0], sc8[1], sc8[2], sc8[3], sc8[4], sc8[5], sc8[6], sc8[7]);
#pragma unroll
        for (int ai = 0; ai < 2; ++ai)
#pragma unroll
            for (int m = 0; m < 4; ++m) { const int R = r0 + ai * HALF + m * 16; const float sc = sc8[ai * 4 + m];
                const f32x4 a0 = acc[ai][0][m][0] * sc, a1 = acc[ai][0][m][1] * sc, b0 = acc[ai][1][m][0] * sc, b1 = acc[ai][1][m][1] * sc;
                u32x4 w; w.x = cvt_pk_bf16(fast_silu(a0[0]) * b0[0], fast_silu(a0[1]) * b0[1]); w.y = cvt_pk_bf16(fast_silu(a0[2]) * b0[2], fast_silu(a0[3]) * b0[3]);
                w.z = cvt_pk_bf16(fast_silu(a1[0]) * b1[0], fast_silu(a1[1]) * b1[1]); w.w = cvt_pk_bf16(fast_silu(a1[2]) * b1[2], fast_silu(a1[3]) * b1[3]);
                *(u32x4*)(O + (size_t)(u.pm * BM + R) * ldc + col0) = w; }
    }
};
struct EpiYs {
    static constexpr bool PERM = true, AFTER_DRAIN = false;
    bf16_t* O;
    __device__ __forceinline__ void operator()(const f32x4 (&acc)[2][2][4][2], const Unit& u, int wr, int wc, int fr, int fq) const {
        const int row0 = u.pm * BM + wr * 64 + fr, col0 = (u.pn - u.e * 4) * BM + wc * 32 + 8 * fq;
#pragma unroll
        for (int ai = 0; ai < 2; ++ai)
#pragma unroll
            for (int m = 0; m < 4; ++m) { bf16_t* rowp = O + (size_t)(row0 + ai * HALF + m * 16) * 1024 + col0;
#pragma unroll
                for (int bj = 0; bj < 2; ++bj) { const f32x4 v0 = acc[ai][bj][m][0], v1 = acc[ai][bj][m][1];
                    u32x4 w; w.x = cvt_pk_bf16(v0[0], v0[1]); w.y = cvt_pk_bf16(v0[2], v0[3]); w.z = cvt_pk_bf16(v1[0], v1[1]); w.w = cvt_pk_bf16(v1[2], v1[3]);
                    *(u32x4*)(rowp + bj * HALF) = w; } }
    }
};
template <class Epi, class Sched, bool ALIGN_EPI = false, bool SP2 = false>
__device__ __forceinline__ void gemm_phase(PG8_LAS unsigned char* lds, const Gemm g, const Sched& S, const Epi& E) {
    int tid_ = mk_tid(g.wv); asm volatile("" : "+v"(tid_));
    const int tid = tid_, wid = __builtin_amdgcn_readfirstlane(tid >> 6), lane = tid & 63, wr = wid >> 2, wc = wid & 3, fr = lane & 15, fq = lane >> 4;
    const int K = g.K, nt = K / BK;
    unsigned voffA[2], voffB[2];
#pragma unroll
    for (int i = 0; i < 2; ++i) { int R, C; stage_rc(tid * 16 + i * 8192, R, C); const int Rb = Epi::PERM ? ((R & ~31) + perm32(R & 31)) : R;
        voffA[i] = (unsigned)(R * K + C) * 2u; voffB[i] = (unsigned)(Rb * K + C) * 2u; }
    const size_t kstep = (size_t)(BK * 2);
    const size_t hstep = (size_t)HALF * K * 2;
    const size_t tstep = 2 * hstep;
    const unsigned ldsw = (unsigned)wid * 1024u;
    const int aoff = lds_byte(wr * 64 + fr, fq * 8), boff = lds_byte(wc * 32 + fr, fq * 8);
#define PG8_SA(b, h) (((b) * 2 + (h)) * HTB)
#define PG8_SB(b, h) ((4 + (b) * 2 + (h)) * HTB)
#define PG8_STAGE(bufoff, gbase, voff) do { _Pragma("unroll") for (int _i = 0; _i < 2; ++_i) \
        __builtin_amdgcn_global_load_lds((const unsigned*)((const char*)(gbase) + (voff)[_i]), (PG8_LAS unsigned*)(lds + (bufoff) + ldsw + _i * 8192), 16, 0, 0); } while (0)
#define PG8_STAGE_A(bufoff, gbase, hh, NX) do { if constexpr (Sched::GATHER) { const unsigned _o[2] = {((NX) && last) ? ngvo[hh][0] : gvo[hh][0], ((NX) && last) ? ngvo[hh][1] : gvo[hh][1]}; PG8_STAGE(bufoff, gbase, _o); } \
        else { PG8_STAGE(bufoff, (gbase) + ((hh) ? hstep : 0), voffA); } } while (0)
#define PG8_LDA(dst, b, h) do { _Pragma("unroll") for (int m = 0; m < 4; ++m) _Pragma("unroll") for (int k = 0; k < 2; ++k) dst[m][k] = *(const PG8_LAS bf16x8*)(lds + PG8_SA(b, h) + aoff + m * 2048 + k * 1024); } while (0)
#define PG8_LDB(dst, b, h) do { _Pragma("unroll") for (int n = 0; n < 2; ++n) _Pragma("unroll") for (int k = 0; k < 2; ++k) dst[n][k] = *(const PG8_LAS bf16x8*)(lds + PG8_SB(b, h) + boff + n * 2048 + k * 1024); } while (0)
#define PG8_MMA(ai, bj, At, Bt) do { __builtin_amdgcn_s_setprio(1); _Pragma("unroll") for (int m = 0; m < 4; ++m) _Pragma("unroll") for (int n = 0; n < 2; ++n) _Pragma("unroll") for (int k = 0; k < 2; ++k) \
        acc[ai][bj][m][n] = __builtin_amdgcn_mfma_f32_16x16x32_bf16(Bt[n][k], At[m][k], acc[ai][bj][m][n], 0, 0, 0); __builtin_amdgcn_s_setprio(0); } while (0)
#define PG8_WAIT_V(n) asm volatile("s_waitcnt vmcnt(" #n ")" ::: "memory")
#define PG8_WAIT_L(n) asm volatile("s_waitcnt lgkmcnt(" #n ")" ::: "memory")
#define PG8_BAR __builtin_amdgcn_s_barrier()
#define PG8_SCHED __builtin_amdgcn_sched_barrier(0)
    Unit cur, nxt; int ui = 0;
    if (!S.next(0, cur)) return;
    f32x4 acc[2][2][4][2];
#pragma unroll
    for (int a = 0; a < 2; ++a)
#pragma unroll
        for (int b = 0; b < 2; ++b)
#pragma unroll
            for (int m = 0; m < 4; ++m)
#pragma unroll
                for (int n = 0; n < 2; ++n) acc[a][b][m][n] = (f32x4){0.f, 0.f, 0.f, 0.f};
    bf16x8 At[4][2], B0[2][2], B1[2][2];
    const char* cA = (const char*)g.A + (Sched::GATHER ? (size_t)0 : (size_t)cur.pm * tstep); const char* cB = (const char*)g.Bt + (size_t)cur.pn * tstep;
    unsigned gvo[2][2] = {{0u, 0u}, {0u, 0u}}, ngvo[2][2] = {{0u, 0u}, {0u, 0u}}; const bool last = false;
    if constexpr (Sched::GATHER) {
#pragma unroll
        for (int hh = 0; hh < 2; ++hh)
#pragma unroll
            for (int i = 0; i < 2; ++i) { int R, C; stage_rc(tid * 16 + i * 8192, R, C); gvo[hh][i] = (unsigned)(S.arow(cur, hh * HALF + R) * K + C) * 2u; } }
    S.a_ready(cur);
    if constexpr (SP2) {
        PG8_STAGE(PG8_SB(0, 0), cB, voffB); PG8_STAGE(PG8_SB(0, 1), cB + hstep, voffB); PG8_STAGE_A(PG8_SA(0, 0), cA, 0, 0); PG8_STAGE_A(PG8_SA(0, 1), cA, 1, 0);
        if (wr == 1) PG8_BAR;
        PG8_WAIT_V(2); PG8_BAR;
        PG8_STAGE(PG8_SB(1, 0), cB + kstep, voffB); PG8_STAGE_A(PG8_SA(1, 0), cA + kstep, 0, 0); PG8_STAGE(PG8_SB(1, 1), cB + hstep + kstep, voffB);
        PG8_WAIT_V(6); PG8_BAR;
    } else {
        PG8_STAGE(PG8_SB(0, 0), cB, voffB); PG8_STAGE_A(PG8_SA(0, 0), cA, 0, 0); PG8_STAGE(PG8_SB(0, 1), cB + hstep, voffB); PG8_STAGE_A(PG8_SA(0, 1), cA, 1, 0);
        if (wr == 1) PG8_BAR;
        PG8_WAIT_V(4); PG8_BAR;
        PG8_STAGE(PG8_SB(1, 0), cB + kstep, voffB); PG8_STAGE_A(PG8_SA(1, 0), cA + kstep, 0, 0); PG8_STAGE(PG8_SB(1, 1), cB + hstep + kstep, voffB);
        PG8_WAIT_V(6); PG8_BAR;
    }
    for (;;) {
        const bool has_next = S.next(ui + 1, nxt);
        const char* nA = (has_next && !Sched::GATHER) ? (const char*)g.A + (size_t)nxt.pm * tstep : cA; const char* nB = has_next ? (const char*)g.Bt + (size_t)nxt.pn * tstep : cB;
        if constexpr (Sched::GATHER) {
#pragma unroll
            for (int hh = 0; hh < 2; ++hh)
#pragma unroll
                for (int i = 0; i < 2; ++i) { int R, C; stage_rc(tid * 16 + i * 8192, R, C); ngvo[hh][i] = has_next ? (unsigned)(S.arow(nxt, hh * HALF + R) * K + C) * 2u : gvo[hh][i]; } }
        for (int t = 0; t < nt; t += 2) {
            const bool last = (t == nt - 2);
            const char* a1 = cA + (size_t)(t + 1) * kstep;
            const char* a2 = last ? nA : cA + (size_t)(t + 2) * kstep; const char* b2 = last ? nB : cB + (size_t)(t + 2) * kstep;
            const char* a3 = a2 + kstep; const char* b3 = b2 + kstep;
            if (last && has_next) S.a_ready(nxt);
            if constexpr (SP2) {
            PG8_LDB(B0, 0, 0); PG8_LDB(B1, 0, 1); PG8_SCHED; PG8_LDA(At, 0, 0); PG8_STAGE_A(PG8_SA(1, 1), a1, 1, 0);
            PG8_WAIT_V(8); PG8_WAIT_L(0); PG8_BAR; PG8_MMA(0, 0, At, B0); PG8_MMA(0, 1, At, B1); PG8_BAR; PG8_SCHED;
            PG8_LDA(At, 0, 1); PG8_STAGE(PG8_SB(0, 0), b2, voffB); PG8_STAGE(PG8_SB(0, 1), b2 + hstep, voffB); PG8_STAGE_A(PG8_SA(0, 0), a2, 0, 1);
            PG8_WAIT_V(8); PG8_WAIT_L(0); PG8_BAR; PG8_MMA(1, 0, At, B0); PG8_MMA(1, 1, At, B1); PG8_BAR; PG8_SCHED;
            PG8_LDB(B0, 1, 0); PG8_LDB(B1, 1, 1); PG8_SCHED; PG8_LDA(At, 1, 0); PG8_STAGE_A(PG8_SA(0, 1), a2, 1, 1);
            PG8_WAIT_V(8); PG8_WAIT_L(0); PG8_BAR; PG8_MMA(0, 0, At, B0); PG8_MMA(0, 1, At, B1); PG8_BAR; PG8_SCHED;
            PG8_LDA(At, 1, 1); PG8_STAGE(PG8_SB(1, 0), b3, voffB); PG8_STAGE(PG8_SB(1, 1), b3 + hstep, voffB); PG8_STAGE_A(PG8_SA(1, 0), a3, 0, 1);
            PG8_WAIT_V(8); PG8_WAIT_L(0); PG8_BAR; PG8_MMA(1, 0, At, B0); PG8_MMA(1, 1, At, B1); PG8_BAR; PG8_SCHED;
            } else {
            PG8_LDB(B0, 0, 0); PG8_SCHED; PG8_LDA(At, 0, 0); PG8_STAGE_A(PG8_SA(1, 1), a1, 1, 0);
            PG8_WAIT_L(8); PG8_BAR; PG8_WAIT_L(0); PG8_MMA(0, 0, At, B0); PG8_BAR; PG8_SCHED;
            PG8_LDB(B1, 0, 1); PG8_STAGE(PG8_SB(0, 0), b2, voffB);
            PG8_BAR; PG8_WAIT_L(0); PG8_MMA(0, 1, At, B1); PG8_BAR;
            PG8_LDA(At, 0, 1); PG8_STAGE_A(PG8_SA(0, 0), a2, 0, 1);
            PG8_BAR; PG8_WAIT_L(0); PG8_MMA(1, 0, At, B0); PG8_BAR; PG8_SCHED;
            PG8_STAGE(PG8_SB(0, 1), b2 + hstep, voffB);
            PG8_WAIT_V(6); PG8_BAR; PG8_MMA(1, 1, At, B1); PG8_BAR;
            PG8_LDB(B0, 1, 0); PG8_SCHED; PG8_LDA(At, 1, 0); PG8_STAGE_A(PG8_SA(0, 1), a2, 1, 1);
            PG8_WAIT_L(8); PG8_BAR; PG8_WAIT_L(0); PG8_MMA(0, 0, At, B0); PG8_BAR; PG8_SCHED;
            PG8_LDB(B1, 1, 1); PG8_STAGE(PG8_SB(1, 0), b3, voffB);
            PG8_BAR; PG8_WAIT_L(0); PG8_MMA(0, 1, At, B1); PG8_BAR;
            PG8_LDA(At, 1, 1); PG8_STAGE_A(PG8_SA(1, 0), a3, 0, 1);
            PG8_BAR; PG8_WAIT_L(0); PG8_MMA(1, 0, At, B0); PG8_BAR; PG8_SCHED;
            PG8_STAGE(PG8_SB(1, 1), b3 + hstep, voffB);
            PG8_WAIT_V(6); PG8_BAR; PG8_MMA(1, 1, At, B1); PG8_BAR;
            }
        }
        if constexpr (ALIGN_EPI) { if (wr == 0) PG8_BAR; }
        if constexpr (!Epi::AFTER_DRAIN) { E(acc, cur, wr, wc, fr, fq); S.done(cur); }
        if (!has_next) break;
#pragma unroll
        for (int a = 0; a < 2; ++a)
#pragma unroll
            for (int b = 0; b < 2; ++b)
#pragma unroll
                for (int m = 0; m < 4; ++m)
#pragma unroll
                    for (int n = 0; n < 2; ++n) acc[a][b][m][n] = (f32x4){0.f, 0.f, 0.f, 0.f};
        cur = nxt; cA = nA; cB = nB; ++ui;
        if constexpr (Sched::GATHER) { gvo[0][0] = ngvo[0][0]; gvo[0][1] = ngvo[0][1]; gvo[1][0] = ngvo[1][0]; gvo[1][1] = ngvo[1][1]; }
        if constexpr (ALIGN_EPI) { if (wr == 1) PG8_BAR; }
    }
    PG8_WAIT_V(0);
    if constexpr (!ALIGN_EPI) { if (wr == 0) PG8_BAR; }
    PG8_BAR;
    if constexpr (Epi::AFTER_DRAIN) { E.fused(acc, cur, wr, wc, fr, fq, lds, wid, lane); S.done(cur); }
#undef PG8_SA
#undef PG8_SB
#undef PG8_STAGE
#undef PG8_STAGE_A
#undef PG8_LDA
#undef PG8_LDB
#undef PG8_MMA
#undef PG8_WAIT_V
#undef PG8_WAIT_L
#undef PG8_BAR
#undef PG8_SCHED
}
}
#define GAS __attribute__((address_space(1)))
#define LAS __attribute__((address_space(3)))
typedef unsigned short bf16;
typedef unsigned v4u __attribute__((ext_vector_type(4)));
typedef float f32x4 __attribute__((ext_vector_type(4)));
typedef short bf16x8 __attribute__((ext_vector_type(8)));
typedef GAS unsigned gu32;
typedef GAS unsigned long long gu64;
#define RLX_AGENT __ATOMIC_RELAXED, __HIP_MEMORY_SCOPE_AGENT
#define LDS_WAIT() asm volatile("s_waitcnt lgkmcnt(0)" ::: "memory")
#define VM_WAIT() asm volatile("s_waitcnt vmcnt(0)" ::: "memory")
__device__ __forceinline__ unsigned long long rt() { return __builtin_amdgcn_s_memrealtime(); }
__device__ __forceinline__ unsigned f2bf(float f) { unsigned u = __builtin_bit_cast(unsigned, f); return (u + 0x7fffu + ((u >> 16) & 1u)) >> 16; }
__device__ __forceinline__ unsigned pk2(float lo, float hi) { return f2bf(lo) | (f2bf(hi) << 16); }

#define XB_TMO      128
#define XB_XCNT(j)  (256  + 64 * (j))
#define XB_XSUB(j)  (1280 + 64 * (j))
#define XB_XGEN(j)  (2304 + 64 * (j))
#define XB_TOP      3328
#define XB_TOPGEN   3392
#define XCD_BAR_WORDS 3456
#define XB_SPIN_CAP (1u << 18)

__device__ __forceinline__ unsigned xb_ld(unsigned* p)              { return __hip_atomic_load(p, __ATOMIC_RELAXED, __HIP_MEMORY_SCOPE_AGENT); }
__device__ __forceinline__ unsigned xb_add(unsigned* p, unsigned v) { return __hip_atomic_fetch_add(p, v, __ATOMIC_RELAXED, __HIP_MEMORY_SCOPE_AGENT); }
__device__ __forceinline__ unsigned xb_xcc_id() { return (unsigned)__builtin_amdgcn_s_getreg((3 << 11) | 20) & 0xFu; }
#define XB_SPIN(cond, bar) do { unsigned _sp = 0; while (cond) { __builtin_amdgcn_s_sleep(1); \
    if ((++_sp & 255u) == 0u) { if (xb_ld(&(bar)[XB_TMO])) break; if (_sp > XB_SPIN_CAP) { atomicAdd(&(bar)[XB_TMO], 1u); break; } } } } while (0)

struct XcdBarrier {
    int wv;
    unsigned* bar; unsigned x;
    volatile LAS unsigned* st;
};

__device__ __forceinline__ XcdBarrier xcd_barrier_post(unsigned* bar, volatile LAS unsigned* st, int wv) {
    XcdBarrier b; b.bar = bar; b.x = xb_xcc_id(); b.st = st; b.wv = wv;
    if (mk_tid(wv) == 0) (void)xb_add(&bar[XB_XCNT(b.x)], 1u);
    return b;
}
__device__ __forceinline__ void xcd_barrier_complete(unsigned* bar, unsigned x, unsigned& nloc, unsigned& nx) {
    const unsigned G = gridDim.x * gridDim.y * gridDim.z;
    unsigned sum, cnt, mine, sp = 0u;
    for (;;) {
        sum = 0u; cnt = 0u; mine = 0u;
#pragma unroll
        for (unsigned j = 0; j < 16; ++j) { const unsigned c = xb_ld(&bar[XB_XCNT(j)]); sum += c; cnt += (c > 0u) ? 1u : 0u; mine = (j == x) ? c : mine; }
        if (sum == G) break;
        __builtin_amdgcn_s_sleep(1);
        if ((++sp & 255u) == 0u) { if (xb_ld(&bar[XB_TMO])) break; if (sp > XB_SPIN_CAP) { atomicAdd(&bar[XB_TMO], 1u); break; } }
    }
    nloc = mine > 0u ? mine : 1u; nx = cnt > 0u ? cnt : 1u;
}

__device__ __forceinline__ void xcd_barrier(const XcdBarrier& b) {
    asm volatile("s_waitcnt vmcnt(0)" ::: "memory");
    __syncthreads();
    if (mk_tid(b.wv) == 0) {
        unsigned* bar = b.bar;
        __builtin_amdgcn_s_waitcnt(0);
        unsigned nloc = b.st[0], nx = b.st[1];
        if (nloc == 0u) { xcd_barrier_complete(bar, b.x, nloc, nx); b.st[0] = nloc; b.st[1] = nx; }
        const unsigned old = xb_add(&bar[XB_XSUB(b.x)], 1u);
        const unsigned gen = old / nloc;
        if (old + 1u == (gen + 1u) * nloc) {
            __builtin_amdgcn_fence(__ATOMIC_RELEASE, "agent");
            asm volatile("s_waitcnt vmcnt(0)" ::: "memory");
            const unsigned og = xb_add(&bar[XB_TOP], 1u);
            const unsigned tg = og / nx;
            if (og + 1u == (tg + 1u) * nx) xb_add(&bar[XB_TOPGEN], 1u);
            else XB_SPIN(xb_ld(&bar[XB_TOPGEN]) == tg, bar);
            __builtin_amdgcn_fence(__ATOMIC_ACQUIRE, "agent");
            xb_add(&bar[XB_XGEN(b.x)], 1u);
            asm volatile("s_waitcnt vmcnt(0)" ::: "memory");
        } else {
            XB_SPIN(xb_ld(&bar[XB_XGEN(b.x)]) == gen, bar);
            __builtin_amdgcn_fence(__ATOMIC_ACQUIRE, "agent");
            asm volatile("s_waitcnt vmcnt(0)" ::: "memory");
        }
    }
    __syncthreads();
}
constexpr int NWAVES = 8, NT = 512;
constexpr int MT = 16384, MROW0 = MT + 112;
constexpr int BATCH = 2, SEQ = 8192, D = 1024, TB = 8320, M = BATCH * TB, PADR = 112;
constexpr int NIN = 2816, DFF = 2816, NEXP = 8, DFE = 3584;
constexpr int C_U = 0, C_HQ = 256, C_HF = 512, C_HI = 768, C_HG = 1024, C_RQ = 1280, C_RK = 1536, C_RV = 1792, C_RG = 2304;
constexpr float EPS = 1e-6f;
#ifndef PROBE_DUP
#define PROBE_DUP 0
#endif
#define REP(n) ((PROBE_DUP == (n)) ? 2 : 1)
#ifndef PROBE_TA
#define PROBE_TA -1
#define PROBE_TB -1
#endif
#ifndef PROBE_SCALE
#define PROBE_SCALE 0.01f
#endif
#ifndef PROBE_BLK
#define PROBE_BLK 200
#endif
#ifndef MK_PER_PHASE
#define MK_PER_PHASE 0
#endif
constexpr int NPH = 62;
__host__ __device__ inline bool phase_exists(int k) {
    if (k == 0 || k == NPH - 1) return true;
    const int l = (k - 1) / 30, r = (k - 1) % 30;
    if (r <= 3 || r == 6) return true;
    if (l == 0) return r == 8 || r == 9;
    return r == 7 || r == 10 || r == 11 || r == 12;
}
constexpr size_t MiB = 1u << 20;
constexpr size_t WS_CTL = 0, CTL_ZERO_BYTES = 1 * MiB;
constexpr int CW_TMO = 0, CW_CODE = 1, CW_BAR = 4096, CW_CNT = 16384, CW_PROBE = 16448, CW_QUEUE = 16640;
constexpr size_t WS_LB = 1 * MiB, WS_LB128 = 1 * MiB + 16384, WS_BB = 1 * MiB + 65536, WS_BBT = 1 * MiB + 393216, WS_ROT = 1 * MiB + 524288, WS_CCT = 2752512, WS_WGT = 2883584, WS_LBT = 3 * MiB;
constexpr size_t WS_POS = 3 * MiB + 65536, WS_GATE = WS_POS + 131072, WS_LIST = WS_GATE + 131072;
constexpr int MOE_CAP = 16384;
static_assert(WS_BBT + 131072 <= WS_ROT && WS_ROT + (size_t)TB * 32 * 4 <= WS_CCT && WS_CCT + 131072 <= WS_WGT && WS_WGT + 262144 <= WS_LBT && WS_LIST + 8 * MOE_CAP * 4 <= 4 * MiB, "table map");
constexpr size_t WS_WM13 = 4 * MiB, WS_WM2 = 4 * MiB, WS_YS = 60 * MiB, WS_HB = 149 * MiB, WS_SSP = 214 * MiB, WS_PROJ = 220 * MiB, WS_MIXED = 310 * MiB, WS_ACT = 220 * MiB;
constexpr size_t WS_WIN = 343 * MiB, WS_WOUT = 354 * MiB, WS_WF13 = 358 * MiB, WS_WF2 = 369 * MiB, WS_RSL = 458 * MiB, WS_END = 459 * MiB;
constexpr int MOE_TMAX = 136;
static_assert(WS_WM13 + (size_t)NEXP * 2 * DFE * D * 2 <= WS_HB && WS_WM2 + (size_t)NEXP * D * DFE * 2 <= WS_YS && WS_YS + (size_t)MOE_TMAX * 256 * D * 2 <= WS_HB && WS_HB + (size_t)M * D * 2 <= WS_SSP, "ws map 1");
static_assert(WS_SSP + (size_t)5 * M * 16 * 4 <= WS_PROJ && WS_PROJ + (size_t)M * NIN * 2 <= WS_MIXED && WS_MIXED + (size_t)M * D * 2 <= WS_WIN, "ws map 2");
static_assert(WS_WIN + (size_t)2 * NIN * D * 2 <= WS_WOUT && WS_WOUT + (size_t)2 * D * D * 2 <= WS_WF13 && WS_WF13 + (size_t)2 * DFF * D * 2 <= WS_WF2 && WS_WF2 + (size_t)D * DFF * 2 <= WS_END, "ws map 3");
static_assert(WS_ACT + (size_t)M * DFF * 2 <= WS_MIXED && WS_ACT + (size_t)MOE_TMAX * 256 * DFE * 2 <= WS_RSL && WS_RSL + (size_t)8 * MOE_CAP * 4 <= WS_END, "ws map 4");
constexpr int RING_OFF = 0, RING_BYTES = 131072, LDSCTL_OFF = RING_BYTES, MISC_OFF = LDSCTL_OFF + 320, LDS_BYTES = 147456;

struct Frame { LAS unsigned char* lds; volatile LAS unsigned* MISC; gu32* ctl; unsigned char* ws; const float* const* in; int wave_s; };
#define STAMP(k) do { if (PROBE_TA >= 0 && blockIdx.x == PROBE_BLK && mk_tid(F.wave_s) == 0) { gu32* _p = F.ctl + CW_PROBE + (k); if (__hip_atomic_load(_p, RLX_AGENT) == 0u) __hip_atomic_store(_p, (unsigned)__builtin_amdgcn_s_memrealtime(), RLX_AGENT); } } while (0)
struct Loc { int tid, lane, wave, bx, vcu, G; };
__device__ __forceinline__ Loc make_loc(int wave_s) { Loc L; int t = mk_tid(wave_s); asm volatile("" : "+v"(t));   int b = blockIdx.x; asm volatile("" : "+s"(b)); L.tid = t; L.lane = t & 63; L.wave = __builtin_amdgcn_readfirstlane(t >> 6);
    L.bx = b; L.G = gridDim.x; L.vcu = (L.G % 8 == 0) ? (b % 8) * (L.G / 8) + b / 8 : b; return L; }
__device__ __forceinline__ float bf2f(bf16 x) { return __uint_as_float((unsigned)x << 16); }
__device__ __forceinline__ bf16 f2bf_(float f) { return (bf16)f2bf(f); }
__device__ __forceinline__ float wave_sum(float v) {
#pragma unroll
    for (int o = 1; o < 64; o <<= 1) v += __shfl_xor(v, o);
    return v;
}
__device__ __forceinline__ float silu_f(float a) { return a * __builtin_amdgcn_rcpf(1.0f + __expf(-a)); }
__device__ __forceinline__ float sigmoid_f(float a) { return __builtin_amdgcn_rcpf(1.0f + __expf(-a)); }

struct TrP { const float* W; int K, N; bf16* WT; int mode; const float* g; int item; };
constexpr int TR_LD = 257;
static_assert(64 * TR_LD * 4 <= RING_BYTES, "LDS map (transposer)");
__device__ __forceinline__ void tr_item_wg(const TrP& q, LAS float* scr, int tid) {
    const int nblk = q.N / 256, kb = q.item / nblk, nb = q.item % nblk, k0 = 64 * kb, n0 = 256 * nb, wv = tid >> 6, ln = tid & 63;
    f32x4 v[8]; float gk[8];
#pragma unroll
    for (int i = 0; i < 8; ++i) { const int kk = 8 * i + wv; v[i] = *(const GAS f32x4*)(q.W + (size_t)(k0 + kk) * q.N + n0 + 4 * ln); gk[i] = q.g ? q.g[k0 + kk] : 1.0f; }
    PIN8(v[0], v[1], v[2], v[3], v[4], v[5], v[6], v[7]); PIN8(gk[0], gk[1], gk[2], gk[3], gk[4], gk[5], gk[6], gk[7]);
#pragma unroll
    for (int i = 0; i < 8; ++i) { const int kk = 8 * i + wv; LAS float* d = scr + kk * TR_LD + 4 * ln; d[0] = v[i][0] * gk[i]; d[1] = v[i][1] * gk[i]; d[2] = v[i][2] * gk[i]; d[3] = v[i][3] * gk[i]; }
    __syncthreads();
    const int c = tid & 7;
#pragma unroll
    for (int j = 0; j < 4; ++j) { const int n = (tid >> 3) + 64 * j; const LAS float* s = scr + (8 * c) * TR_LD + n;
        v4u o; o.x = pk2(s[0 * TR_LD], s[1 * TR_LD]); o.y = pk2(s[2 * TR_LD], s[3 * TR_LD]); o.z = pk2(s[4 * TR_LD], s[5 * TR_LD]); o.w = pk2(s[6 * TR_LD], s[7 * TR_LD]);
        const int nn = n0 + n, drow = q.mode == 0 ? nn : ((nn >> 7) * 256 + (nn & 127) + (q.mode == 2 ? 128 : 0));
        *(GAS v4u*)(q.WT + (size_t)drow * q.K + k0 + 8 * c) = o; }
    __syncthreads();
}
constexpr int I_M13 = 16 * 14, N_M13 = 16 * I_M13;
__device__ __forceinline__ TrP moe13_item(Frame& F, int it) { constexpr int I_M = I_M13; const int half = it / (8 * I_M), r = it % (8 * I_M), e = r / I_M;
    return TrP{F.in[24 + half] + (size_t)e * D * DFE, D, DFE, (bf16*)(F.ws + WS_WM13) + (size_t)e * 2 * DFE * D, 1 + half, F.in[19] + D, r % I_M}; }
__device__ __forceinline__ void conv_moe13(Frame& F, int rank, int nranks, int i0, int i1, int tid) {
    LAS float* scr = (LAS float*)(F.lds + RING_OFF);
    for (int it = i0 + rank; it < i1; it += nranks) tr_item_wg(moe13_item(F, it), scr, tid);
}
__device__ __forceinline__ int gt0(const Loc& L) { return L.vcu * NT + L.tid; }
__device__ __forceinline__ void p0_prologue(Frame& F) {
    const Loc L = make_loc(F.wave_s);
    LAS float* scr = (LAS float*)(F.lds + RING_OFF);
    const int gw = L.vcu * NWAVES + L.wave, NGW = L.G * NWAVES;
    unsigned char* ws = F.ws; const float* const* in = F.in;
    constexpr int I_IN = 16 * 11, I_OUT = 16 * 4, I_F = 16 * 11, I_F2 = 44 * 4;
    constexpr int NITEMS = 2 * I_IN + 2 * I_OUT + 2 * I_F + I_F2;
    auto small_item = [&](int it) -> TrP { int r = it;
        if (r < 2 * I_IN) { const int l = r / I_IN; return TrP{in[3] + (size_t)l * D * NIN, D, NIN, (bf16*)(ws + WS_WIN) + (size_t)l * NIN * D, 0, in[2] + l * D, r % I_IN}; } r -= 2 * I_IN;
        if (r < 2 * I_OUT) { const int l = r / I_OUT; return TrP{in[18] + (size_t)l * D * D, D, D, (bf16*)(ws + WS_WOUT) + (size_t)l * D * D, 0, nullptr, r % I_OUT}; } r -= 2 * I_OUT;
        if (r < I_F) return TrP{in[20], D, DFF, (bf16*)(ws + WS_WF13), 1, in[19], r}; r -= I_F;
        if (r < I_F) return TrP{in[21], D, DFF, (bf16*)(ws + WS_WF13), 2, in[19], r}; r -= I_F;
        return TrP{in[22], DFF, D, (bf16*)(ws + WS_WF2), 0, nullptr, r}; };
    for (int it = L.vcu; it < NITEMS; it += L.G) tr_item_wg(small_item(it), scr, L.tid);
    conv_moe13(F, L.vcu, L.G, 0, N_M13, L.tid);
    bf16* HB = (bf16*)(ws + WS_HB); float* SS0 = (float*)(ws + WS_SSP);
    for (int m = gw; m < MT + 128; m += NGW) {
        const float* src = m < MT ? in[0] + (size_t)m * D : (m < MROW0 ? nullptr : in[1] + (size_t)(m - MROW0) * D);
        f32x4 v[4]; float s = 0.f;
#pragma unroll
        for (int j = 0; j < 4; ++j) v[j] = src ? ((const GAS f32x4*)src)[L.lane + 64 * j] : (f32x4){0.f, 0.f, 0.f, 0.f};
        PIN4(v[0], v[1], v[2], v[3]);
#pragma unroll
        for (int j = 0; j < 4; ++j) s += (v[j].x * v[j].x + v[j].y * v[j].y) + (v[j].z * v[j].z + v[j].w * v[j].w);
        s = wave_sum(s);
#pragma unroll
        for (int j = 0; j < 4; ++j) ((GAS unsigned long long*)(HB + (size_t)m * D))[L.lane + 64 * j] = (unsigned long long)pk2(v[j].x, v[j].y) | ((unsigned long long)pk2(v[j].z, v[j].w) << 32);
        if (L.lane < 16) SS0[(size_t)m * 16 + L.lane] = L.lane == 0 ? s : 0.0f;
    }
    { unsigned long long* pz = (unsigned long long*)((bf16*)(ws + WS_PROJ) + (size_t)MT * NIN); for (int i = gt0(L); i < 112 * NIN / 4; i += L.G * NT) pz[i] = 0ull; }
    const int gt = L.vcu * NT + L.tid, NGT = L.G * NT;
    float* LB = (float*)(ws + WS_LB); float* BB = (float*)(ws + WS_BB); float* ROT = (float*)(ws + WS_ROT); float* LBT = (float*)(ws + WS_LBT);
    for (int i = gt; i < 2048; i += NGT) {
        const int lg = i >> 6; const float step = expf(in[11][lg]); const float lre = in[4][i], lim = in[5][i];
        const float mag = expf(lre * step); float sn, cs; sincosf(lim * step, &sn, &cs); const float br = mag * cs, bi = mag * sn;
        const float den = 1.0f / (lre * lre + lim * lim), cr = ((br - 1.0f) * lre + bi * lim) * den, ci = (bi * lre - (br - 1.0f) * lim) * den;
        LB[2 * i] = br; LB[2 * i + 1] = bi;
        for (int h = 0; h < 16; ++h) { const float b_r = in[6][i * 16 + h], b_i = in[7][i * 16 + h]; BB[(i * 16 + h) * 2] = cr * b_r - ci * b_i; BB[(i * 16 + h) * 2 + 1] = cr * b_i + ci * b_r; }
    }
    { bf16* BBT = (bf16*)(ws + WS_BBT); bf16* CCT = (bf16*)(ws + WS_CCT); bf16* WGT = (bf16*)(ws + WS_WGT); float* LB128 = (float*)(ws + WS_LB128);
      for (int i = gt; i < 2048; i += NGT) { const int lg = i >> 6, p = i & 63; const float step = expf(in[11][lg]), lre = in[4][i], lim = in[5][i];
          const float mag = expf(64.0f * lre * step); float sn, cs; sincosf(64.0f * (lim * step), &sn, &cs); LB128[2 * i] = mag * cs; LB128[2 * i + 1] = mag * sn;
          const float m1 = expf(lre * step); float s1, c1; sincosf(lim * step, &s1, &c1); const float br = m1 * c1, bi = m1 * s1, den = 1.0f / (lre * lre + lim * lim), cr = ((br - 1.0f) * lre + bi * lim) * den, ci = (bi * lre - (br - 1.0f) * lim) * den;
          for (int h = 0; h < 16; ++h) { const float b_r = in[6][i * 16 + h], b_i = in[7][i * 16 + h]; BBT[((size_t)lg * 128 + p) * 16 + h] = f2bf_(cr * b_r - ci * b_i); BBT[((size_t)lg * 128 + 64 + p) * 16 + h] = f2bf_(cr * b_i + ci * b_r);
              CCT[((size_t)lg * 16 + h) * 128 + 2 * p] = f2bf_(in[8][(lg * 16 + h) * 64 + p]); CCT[((size_t)lg * 16 + h) * 128 + 2 * p + 1] = f2bf_(-in[9][(lg * 16 + h) * 64 + p]); } }
      for (int i = gt; i < 2 * 65536; i += NGT) { const int l = i >> 16, n = (i >> 8) & 255, k = i & 255; WGT[i] = f2bf_(in[12][(size_t)l * 65536 + k * 256 + n]); } }
    for (int i = gt; i < TB * 16; i += NGT) { const int t = i >> 4, f = i & 15; const float pos = (float)(t - PADR), inv = powf(10000.0f, -(float)f / 16.0f); float sn, cs; sincosf(pos * inv, &sn, &cs); ROT[2 * i] = cs; ROT[2 * i + 1] = sn; }
    for (int i = gt; i < 512; i += NGT) { const int l = i >> 8, c = i & 255; float lb = 0.f; if (l == 1) { const float a0 = in[15][c], a1 = in[15][256 + c], mx = fmaxf(a0, a1), e0 = expf(a0 - mx), e1 = expf(a1 - mx); lb = e1 / (e0 + e1); } LBT[i] = lb; }
}

__device__ __forceinline__ float gelu_tanh(float y) { const float x = 0.7978845608028654f * (y + 0.044715f * y * y * y); const float th = 1.0f - 2.0f * __builtin_amdgcn_rcpf(1.0f + __expf(2.0f * x)); return 0.5f * y * (1.0f + th); }
__device__ __forceinline__ int chunk_row0(int b, int c) { return c == 0 ? MT : b * SEQ + (c - 1) * 128; }
__device__ __forceinline__ int s5_row0(int b, int c5) { return c5 < 2 ? MT + 64 * c5 : b * SEQ + (c5 - 2) * 64; }
typedef unsigned u32x4_t __attribute__((ext_vector_type(4)));
__device__ __forceinline__ f32x4 mfma16(bf16x8 a, bf16x8 b, f32x4 c) { return __builtin_amdgcn_mfma_f32_16x16x32_bf16(a, b, c, 0, 0, 0); }
__device__ __forceinline__ unsigned cvtpk(float lo, float hi) { unsigned r; asm volatile("v_cvt_pk_bf16_f32 %0, %1, %2" : "=v"(r) : "v"(lo), "v"(hi)); return r; }
__device__ __forceinline__ bf16x8 pack8(f32x4 a, f32x4 b) { u32x4_t w; w.x = cvtpk(a[0], a[1]); w.y = cvtpk(a[2], a[3]); w.z = cvtpk(b[0], b[1]); w.w = cvtpk(b[2], b[3]); return __builtin_bit_cast(bf16x8, w); }
__device__ __forceinline__ int perm_pos(int j) { return (j & ~31) + 8 * ((j >> 2) & 3) + 4 * ((j >> 4) & 1) + (j & 3); }
constexpr int NCH = TB / 128;
constexpr size_t OUT_RST = 0, OUT_HST = 9 * MiB, OUT_HDK = 18 * MiB, OUT_S5X = 19 * MiB;
__device__ __forceinline__ void ma_ret_unit(Frame& F, const Loc& L, int b, int c, int h, float* outb) {
    LAS bf16* Vt = (LAS bf16*)F.lds; LAS bf16* Kt = Vt + 64 * 136;
    const bf16* P = (const bf16*)(F.ws + WS_PROJ) + (size_t)chunk_row0(b, c) * NIN; const float* ROT = (const float*)(F.ws + WS_ROT) + (size_t)c * 128 * 32;
    const float lg = __log2f(1.0f - exp2f(-5.0f - (float)h));
    STAMP(5);
    { const int ch = L.tid & 63, seg = L.tid >> 6; const bf16* pv = P + (size_t)(16 * seg) * NIN + C_RV + h * 64 + ch; unsigned x[16];
#pragma unroll
      for (int r = 0; r < 16; ++r) x[r] = pv[(size_t)r * NIN];
      PIN16(x);
      u32x4_t w0, w1; w0.x = x[0] | ((unsigned)x[1] << 16); w0.y = x[2] | ((unsigned)x[3] << 16); w0.z = x[4] | ((unsigned)x[5] << 16); w0.w = x[6] | ((unsigned)x[7] << 16);
      w1.x = x[8] | ((unsigned)x[9] << 16); w1.y = x[10] | ((unsigned)x[11] << 16); w1.z = x[12] | ((unsigned)x[13] << 16); w1.w = x[14] | ((unsigned)x[15] << 16);
      *(LAS u32x4_t*)(Vt + ch * 136 + 16 * seg) = w0; *(LAS u32x4_t*)(Vt + ch * 136 + 16 * seg + 8) = w1; }
    if (L.tid < 128) { const int i = L.tid & 15, seg = L.tid >> 4; const bf16* pk = P + (size_t)(16 * seg) * NIN + C_RK + h * 32 + i; const float* rp = ROT + (16 * seg * 16 + i) * 2; float ka[16], kb[16];
      unsigned x1[16], x2[16]; float crc[16], crs[16];
#pragma unroll
      for (int r = 0; r < 16; ++r) { x1[r] = pk[(size_t)r * NIN]; x2[r] = pk[(size_t)r * NIN + 16]; const float2 t = *(const float2*)(rp + r * 32); crc[r] = t.x; crs[r] = t.y; }
      PIN16(x1); PIN16(x2); PIN16(crc); PIN16(crs);
#pragma unroll
      for (int r = 0; r < 16; ++r) { const float k1 = __uint_as_float(x1[r] << 16), k2 = __uint_as_float(x2[r] << 16), cs = crc[r], sn = crs[r], w = __builtin_amdgcn_exp2f((float)(127 - 16 * seg - r) * lg);
          ka[r] = (k1 * cs - k2 * sn) * w; kb[r] = (k1 * sn + k2 * cs) * w; }
      u32x4_t w0, w1; w0.x = cvtpk(ka[0], ka[1]); w0.y = cvtpk(ka[2], ka[3]); w0.z = cvtpk(ka[4], ka[5]); w0.w = cvtpk(ka[6], ka[7]); w1.x = cvtpk(ka[8], ka[9]); w1.y = cvtpk(ka[10], ka[11]); w1.z = cvtpk(ka[12], ka[13]); w1.w = cvtpk(ka[14], ka[15]);
      *(LAS u32x4_t*)(Kt + i * 136 + 16 * seg) = w0; *(LAS u32x4_t*)(Kt + i * 136 + 16 * seg + 8) = w1;
      w0.x = cvtpk(kb[0], kb[1]); w0.y = cvtpk(kb[2], kb[3]); w0.z = cvtpk(kb[4], kb[5]); w0.w = cvtpk(kb[6], kb[7]); w1.x = cvtpk(kb[8], kb[9]); w1.y = cvtpk(kb[10], kb[11]); w1.z = cvtpk(kb[12], kb[13]); w1.w = cvtpk(kb[14], kb[15]);
      *(LAS u32x4_t*)(Kt + (16 + i) * 136 + 16 * seg) = w0; *(LAS u32x4_t*)(Kt + (16 + i) * 136 + 16 * seg + 8) = w1; }
    STAMP(6);
    __syncthreads();
    { const int il = L.lane & 15, g = L.lane >> 4, ft = L.wave & 1, vt = L.wave >> 1; f32x4 acc = {0.f, 0.f, 0.f, 0.f};
#pragma unroll
      for (int ks = 0; ks < 4; ++ks) { const bf16x8 A = *(const LAS bf16x8*)(Kt + (16 * ft + il) * 136 + 32 * ks + 8 * g), B = *(const LAS bf16x8*)(Vt + (16 * vt + il) * 136 + 32 * ks + 8 * g); acc = mfma16(A, B, acc); }
      float* S = (float*)((unsigned char*)outb + OUT_RST) + (size_t)((b * NCH + c) * 8 + h) * 2048;
#pragma unroll
      for (int r = 0; r < 4; ++r) S[(16 * ft + 4 * g + r) * 64 + 16 * vt + il] = acc[r]; }
    __syncthreads();
    STAMP(7);
}
__device__ __forceinline__ void mb_ret(const Loc& L, float* outb, int e) {
    { const int b = e >> 14, h = (e >> 11) & 7, idx = e & 2047; const float d = exp2f(128.0f * __log2f(1.0f - exp2f(-5.0f - (float)h)));
        float* p = (float*)((unsigned char*)outb + OUT_RST) + (size_t)(b * NCH * 8 + h) * 2048 + idx; float s = 0.f;
        float loc[NCH];
#pragma unroll
        for (int c = 0; c < NCH; ++c) loc[c] = p[(size_t)c * 8 * 2048];
        PIN16(loc); PIN16O(loc, 16); PIN16O(loc, 32); PIN16O(loc, 48); asm volatile("" : "+v"(loc[64]) :: "memory");
        asm volatile("" : "+v"(p));
#pragma unroll
        for (int c = 0; c < NCH; ++c) { p[(size_t)c * 8 * 2048] = s; s = d * s + loc[c]; } }
}
__device__ __forceinline__ void mc_ret_unit(Frame& F, const Loc& L, int l, int b, int c, int h, const float* outb) {
    LAS bf16* Qrm = (LAS bf16*)F.lds; LAS bf16* Krm = Qrm + 4096; LAS bf16* Vt = Krm + 4096; LAS bf16* SpT = Vt + 64 * 136;
    const size_t row0 = (size_t)chunk_row0(b, c); const bf16* P = (const bf16*)(F.ws + WS_PROJ) + row0 * NIN; const float* ROT = (const float*)(F.ws + WS_ROT) + (size_t)c * 128 * 32;
    const float gamma = 1.0f - exp2f(-5.0f - (float)h), lg = __log2f(gamma);
    { const int r = L.tid >> 2, pq = L.tid & 3; const bf16* pr = P + (size_t)r * NIN; const f32x4 r0 = *(const f32x4*)(ROT + (r * 16 + 4 * pq) * 2), r1 = *(const f32x4*)(ROT + (r * 16 + 4 * pq) * 2 + 4);
      const float cs[4] = {r0[0], r0[2], r1[0], r1[2]}, sn[4] = {r0[1], r0[3], r1[1], r1[3]};
      const float wq = 0.17677669529663687f * exp2f((float)r * lg), wk = exp2f(-(float)r * lg);
      const unsigned long long q1 = *(const GAS unsigned long long*)(pr + C_RQ + h * 32 + 4 * pq), q2 = *(const GAS unsigned long long*)(pr + C_RQ + h * 32 + 16 + 4 * pq);
      const unsigned long long k1 = *(const GAS unsigned long long*)(pr + C_RK + h * 32 + 4 * pq), k2 = *(const GAS unsigned long long*)(pr + C_RK + h * 32 + 16 + 4 * pq);
      const int vq = 16 * pq, pj = perm_pos(r); v4u va = *(const GAS v4u*)(pr + C_RV + h * 64 + vq), vb = *(const GAS v4u*)(pr + C_RV + h * 64 + vq + 8);
      const int ksp = L.tid >> 4, v4 = (L.tid & 15) * 4; f32x4 sp = *(const f32x4*)((const float*)((const unsigned char*)outb + OUT_RST) + (size_t)((b * NCH + c) * 8 + h) * 2048 + ksp * 64 + v4);
      { unsigned long long q1_ = q1, q2_ = q2, k1_ = k1, k2_ = k2; asm volatile("" : "+v"(q1_), "+v"(q2_), "+v"(k1_), "+v"(k2_), "+v"(va), "+v"(vb), "+v"(sp) :: "memory"); (void)q1_; }
      float qa[4], qb[4], ka[4], kb[4];
#pragma unroll
      for (int e = 0; e < 4; ++e) { const float a1 = bf2f((bf16)(q1 >> (16 * e))), a2 = bf2f((bf16)(q2 >> (16 * e))), b1 = bf2f((bf16)(k1 >> (16 * e))), b2 = bf2f((bf16)(k2 >> (16 * e)));
          qa[e] = (a1 * cs[e] - a2 * sn[e]) * wq; qb[e] = (a1 * sn[e] + a2 * cs[e]) * wq; ka[e] = (b1 * cs[e] - b2 * sn[e]) * wk; kb[e] = (b1 * sn[e] + b2 * cs[e]) * wk; }
      *(LAS unsigned long long*)(Qrm + r * 32 + 4 * pq) = (unsigned long long)cvtpk(qa[0], qa[1]) | ((unsigned long long)cvtpk(qa[2], qa[3]) << 32);
      *(LAS unsigned long long*)(Qrm + r * 32 + 16 + 4 * pq) = (unsigned long long)cvtpk(qb[0], qb[1]) | ((unsigned long long)cvtpk(qb[2], qb[3]) << 32);
      *(LAS unsigned long long*)(Krm + r * 32 + 4 * pq) = (unsigned long long)cvtpk(ka[0], ka[1]) | ((unsigned long long)cvtpk(ka[2], ka[3]) << 32);
      *(LAS unsigned long long*)(Krm + r * 32 + 16 + 4 * pq) = (unsigned long long)cvtpk(kb[0], kb[1]) | ((unsigned long long)cvtpk(kb[2], kb[3]) << 32);
#pragma unroll
      for (int e = 0; e < 4; ++e) { Vt[(vq + 2 * e) * 136 + pj] = (bf16)(va[e] & 0xffffu); Vt[(vq + 2 * e + 1) * 136 + pj] = (bf16)(va[e] >> 16);
          Vt[(vq + 8 + 2 * e) * 136 + pj] = (bf16)(vb[e] & 0xffffu); Vt[(vq + 8 + 2 * e + 1) * 136 + pj] = (bf16)(vb[e] >> 16); }
#pragma unroll
      for (int e = 0; e < 4; ++e) SpT[(v4 + e) * 40 + ksp] = f2bf_(gamma * sp[e]);
    }
    __syncthreads();
    const int w = L.wave, il = L.lane & 15, g = L.lane >> 4;
    const size_t row = row0 + 16 * w + il; const bf16* gp = (const bf16*)(F.ws + WS_PROJ) + row * NIN + C_RG + h * 64; const float* og = F.in[17] + l * 512 + h * 64;
    unsigned long long gg4[4]; f32x4 og4[4];
#pragma unroll
    for (int vt = 0; vt < 4; ++vt) { gg4[vt] = *(const GAS unsigned long long*)(gp + 16 * vt + 4 * g); og4[vt] = *(const f32x4*)(og + 16 * vt + 4 * g); }
    const bf16x8 Bq = *(const LAS bf16x8*)(Qrm + (16 * w + il) * 32 + 8 * g);
    const f32x4 zero = {0.f, 0.f, 0.f, 0.f}; f32x4 O[4] = {zero, zero, zero, zero};
#pragma unroll
    for (int jp = 0; jp < 4; ++jp) if (2 * jp <= w) {
        f32x4 p0, p1 = zero;
        { const bf16x8 A = *(const LAS bf16x8*)(Krm + (32 * jp + il) * 32 + 8 * g); p0 = mfma16(A, Bq, zero);
          if (2 * jp == w) {
#pragma unroll
              for (int r = 0; r < 4; ++r) if (4 * g + r > il) p0[r] = 0.f; } }
        if (2 * jp + 1 <= w) { const bf16x8 A = *(const LAS bf16x8*)(Krm + (32 * jp + 16 + il) * 32 + 8 * g); p1 = mfma16(A, Bq, zero);
          if (2 * jp + 1 == w) {
#pragma unroll
              for (int r = 0; r < 4; ++r) if (4 * g + r > il) p1[r] = 0.f; } }
        const bf16x8 Bp = pack8(p0, p1);
#pragma unroll
        for (int vt = 0; vt < 4; ++vt) { const bf16x8 A = *(const LAS bf16x8*)(Vt + (16 * vt + il) * 136 + 32 * jp + 8 * g); O[vt] = mfma16(A, Bp, O[vt]); }
    }
#pragma unroll
    for (int vt = 0; vt < 4; ++vt) { const bf16x8 A = *(const LAS bf16x8*)(SpT + (16 * vt + il) * 40 + 8 * g); O[vt] = mfma16(A, Bq, O[vt]); }
    float s1 = 0.f;
#pragma unroll
    for (int vt = 0; vt < 4; ++vt) s1 += (O[vt][0] + O[vt][1]) + (O[vt][2] + O[vt][3]);
    s1 += __shfl_xor(s1, 16); s1 += __shfl_xor(s1, 32); const float mean = s1 * (1.0f / 64.0f); float s2 = 0.f;
#pragma unroll
    for (int vt = 0; vt < 4; ++vt) { O[vt] = O[vt] - mean; s2 += (O[vt][0] * O[vt][0] + O[vt][1] * O[vt][1]) + (O[vt][2] * O[vt][2] + O[vt][3] * O[vt][3]); }
    s2 += __shfl_xor(s2, 16); s2 += __shfl_xor(s2, 32); const float rstd = rsqrtf(s2 * (1.0f / 64.0f) + EPS);
    bf16* mo = (bf16*)(F.ws + WS_MIXED) + row * D + 512 + h * 64;
#pragma unroll
    for (int vt = 0; vt < 4; ++vt) { const int v0 = 16 * vt + 4 * g; const unsigned long long gg = gg4[vt]; const f32x4 o4 = og4[vt]; float y[4];
#pragma unroll
        for (int r = 0; r < 4; ++r) y[r] = O[vt][r] * rstd * o4[r] * silu_f(bf2f((bf16)(gg >> (16 * r))));
        *(GAS unsigned long long*)(mo + v0) = (unsigned long long)cvtpk(y[0], y[1]) | ((unsigned long long)cvtpk(y[2], y[3]) << 32); }
    __syncthreads();
}
constexpr int HG_LD = 68;
constexpr int SEG_OFF = MISC_OFF + 192;
static_assert(SEG_OFF % 16 == 0 && SEG_OFF + 2048 <= LDS_BYTES, "LDS map (SEG)");
__device__ __forceinline__ const bf16* hg_hist(const bf16* PROJ, int b, int c, int w) {
    if (w > 0) return PROJ + (size_t)(chunk_row0(b, c) + 16 * w - 3) * NIN;
    if (c == 0) return nullptr;
    return PROJ + (size_t)(chunk_row0(b, c - 1) + 125) * NIN;
}
template <bool NEED_Q> __device__ __forceinline__ void hg_rows(const bf16* Pcur, const bf16* Ph, int ch, const float* cw, float lb, float (&q)[16], float (&kk)[16], float (&vv)[16], float (&gl)[16]) {
    float wq[4], wf[4], wi[4];
#pragma unroll
    for (int j = 0; j < 4; ++j) { wq[j] = cw[j * 768 + ch]; wf[j] = cw[j * 768 + 256 + ch]; wi[j] = cw[j * 768 + 512 + ch]; }
    unsigned hq0[3] = {0u, 0u, 0u}, hf0[3] = {0u, 0u, 0u}, hi0[3] = {0u, 0u, 0u}, rq[16], rf[16], ri[16];
#pragma unroll
    for (int j = 0; j < 3; ++j) { if (Ph) { const bf16* pr = Ph + (size_t)j * NIN; if (NEED_Q) hq0[j] = pr[C_HQ + ch]; hf0[j] = pr[C_HF + ch]; hi0[j] = pr[C_HI + ch]; } }
#pragma unroll
    for (int r = 0; r < 16; ++r) { const bf16* pr = Pcur + (size_t)r * NIN; rq[r] = NEED_Q ? (unsigned)pr[C_HQ + ch] : 0u; rf[r] = pr[C_HF + ch]; ri[r] = pr[C_HI + ch]; }
    if (NEED_Q) { PIN16(rq); PIN4(hq0[0], hq0[1], hq0[2], wq[0]); } PIN16(rf); PIN16(ri); PIN8(hf0[0], hf0[1], hf0[2], hi0[0], hi0[1], hi0[2], wf[0], wi[0]);
    float hq[3], hf[3], hi[3];
#pragma unroll
    for (int j = 0; j < 3; ++j) { hq[j] = __uint_as_float(hq0[j] << 16); hf[j] = __uint_as_float(hf0[j] << 16); hi[j] = __uint_as_float(hi0[j] << 16); }
    float run = 0.f;
#pragma unroll
    for (int r = 0; r < 16; ++r) { const float xq = __uint_as_float(rq[r] << 16), xf = __uint_as_float(rf[r] << 16), xi = __uint_as_float(ri[r] << 16);
        const float cq = (wq[0] * hq[0] + wq[1] * hq[1]) + (wq[2] * hq[2] + wq[3] * xq), cf = (wf[0] * hf[0] + wf[1] * hf[1]) + (wf[2] * hf[2] + wf[3] * xf), ci = (wi[0] * hi[0] + wi[1] * hi[1]) + (wi[2] * hi[2] + wi[3] * xi);
        hq[0] = hq[1]; hq[1] = hq[2]; hq[2] = xq; hf[0] = hf[1]; hf[1] = hf[2]; hf[2] = xf; hi[0] = hi[1]; hi[1] = hi[2]; hi[2] = xi;
        const float f = fmaxf(lb + (1.0f - lb) * sigmoid_f(cf), 1e-30f); run += __logf(f); gl[r] = run; kk[r] = 1.0f - f; vv[r] = ci; q[r] = NEED_Q ? silu_f(cq) : 0.f; }
}
__device__ __forceinline__ void ma_hg_unit(Frame& F, const Loc& L, int l, int b, int c, int h, float* outb) {
    LAS bf16* Vt = (LAS bf16*)F.lds; LAS bf16* Kt = Vt + 64 * 136; LAS float* SEG = (LAS float*)(F.lds + SEG_OFF);
    const bf16* PJ = (const bf16*)(F.ws + WS_PROJ); const int k = L.tid & 63, w = L.tid >> 6;
    float q[16], kk[16], vv[16], gl[16];
    STAMP(0);
    hg_rows<false>(PJ + (size_t)(chunk_row0(b, c) + 16 * w) * NIN, hg_hist(PJ, b, c, w), h * 64 + k, F.in[14] + l * 4 * 768, ((const float*)(F.ws + WS_LBT))[l * 256 + h * 64 + k], q, kk, vv, gl);
    STAMP(1);
    { u32x4_t w0, w1; w0.x = cvtpk(vv[0], vv[1]); w0.y = cvtpk(vv[2], vv[3]); w0.z = cvtpk(vv[4], vv[5]); w0.w = cvtpk(vv[6], vv[7]); w1.x = cvtpk(vv[8], vv[9]); w1.y = cvtpk(vv[10], vv[11]); w1.z = cvtpk(vv[12], vv[13]); w1.w = cvtpk(vv[14], vv[15]);
      *(LAS u32x4_t*)(Vt + k * 136 + 16 * w) = w0; *(LAS u32x4_t*)(Vt + k * 136 + 16 * w + 8) = w1; }
    SEG[w * 64 + k] = gl[15];
    __syncthreads();
    STAMP(2);
    float off = 0.f, tot = 0.f;
#pragma unroll
    for (int ww = 0; ww < 8; ++ww) { const float s = SEG[ww * 64 + k]; if (ww < w) off += s; tot += s; }
    { float e[16];
#pragma unroll
      for (int r = 0; r < 16; ++r) e[r] = kk[r] * __expf(tot - off - gl[r]);
      u32x4_t w0, w1; w0.x = cvtpk(e[0], e[1]); w0.y = cvtpk(e[2], e[3]); w0.z = cvtpk(e[4], e[5]); w0.w = cvtpk(e[6], e[7]); w1.x = cvtpk(e[8], e[9]); w1.y = cvtpk(e[10], e[11]); w1.z = cvtpk(e[12], e[13]); w1.w = cvtpk(e[14], e[15]);
      *(LAS u32x4_t*)(Kt + k * 136 + 16 * w) = w0; *(LAS u32x4_t*)(Kt + k * 136 + 16 * w + 8) = w1; }
    const size_t ui = (size_t)(b * NCH + c) * 4 + h;
    if (w == 0) ((float*)((unsigned char*)outb + OUT_HDK))[ui * 64 + k] = __expf(tot);
    __syncthreads();
    STAMP(3);
    { const int il = L.lane & 15, g = L.lane >> 4, kt = L.wave >> 1, vt0 = 2 * (L.wave & 1); const f32x4 zero = {0.f, 0.f, 0.f, 0.f}; f32x4 acc[2] = {zero, zero};
#pragma unroll
      for (int ks = 0; ks < 4; ++ks) { const bf16x8 A = *(const LAS bf16x8*)(Kt + (16 * kt + il) * 136 + 32 * ks + 8 * g);
#pragma unroll
          for (int t = 0; t < 2; ++t) { const bf16x8 B = *(const LAS bf16x8*)(Vt + (16 * (vt0 + t) + il) * 136 + 32 * ks + 8 * g); acc[t] = mfma16(A, B, acc[t]); } }
      float* S = (float*)((unsigned char*)outb + OUT_HST) + ui * 4096;
#pragma unroll
      for (int t = 0; t < 2; ++t)
#pragma unroll
          for (int r = 0; r < 4; ++r) S[(16 * kt + 4 * g + r) * 64 + 16 * (vt0 + t) + il] = acc[t][r]; }
    __syncthreads();
    STAMP(4);
}
__device__ __forceinline__ void mb_hg(const Loc& L, float* outb, int e) {
    { const int b = e >> 14, h = (e >> 12) & 3, idx = e & 4095;
        float* p = (float*)((unsigned char*)outb + OUT_HST) + (size_t)(b * NCH * 4 + h) * 4096 + idx; const float* dk = (const float*)((unsigned char*)outb + OUT_HDK) + (size_t)(b * NCH * 4 + h) * 64 + (idx >> 6); float s = 0.f;
        float loc[NCH], dd[NCH];
#pragma unroll
        for (int c = 0; c < NCH; ++c) { loc[c] = p[(size_t)c * 4 * 4096]; dd[c] = dk[(size_t)c * 4 * 64]; }
        PIN16(loc); PIN16O(loc, 16); PIN16O(loc, 32); PIN16O(loc, 48); PIN16(dd); PIN16O(dd, 16); PIN16O(dd, 32); PIN16O(dd, 48); asm volatile("" : "+v"(loc[64]), "+v"(dd[64]) :: "memory");
        asm volatile("" : "+v"(p));
#pragma unroll
        for (int c = 0; c < NCH; ++c) { p[(size_t)c * 4 * 4096] = s; s = dd[c] * s + loc[c]; } }
}
__device__ __forceinline__ f32x4 ld4(const LAS float* p) { return *(const LAS f32x4*)p; }
__device__ __forceinline__ void mc_hg_unit(Frame& F, const Loc& L, int l, int b, int c, int h, const float* outb) {
    LAS float* Qf = (LAS float*)F.lds; LAS float* Kf = Qf + 128 * HG_LD; LAS float* G = Kf + 128 * HG_LD; LAS bf16* Vt = (LAS bf16*)(G + 128 * HG_LD); LAS bf16* SpT = Vt + 64 * 136; LAS float* SEG = (LAS float*)(F.lds + SEG_OFF);
    static_assert(3 * 128 * HG_LD * 4 + 64 * 136 * 2 + 64 * 72 * 2 <= RING_BYTES, "LDS map (HGRN2 MC)");
    const size_t row0 = (size_t)chunk_row0(b, c); const bf16* PJ = (const bf16*)(F.ws + WS_PROJ);
    { const int k = L.tid & 63, w = L.tid >> 6; float q[16], kk[16], vv[16], gl[16];
      hg_rows<true>(PJ + (size_t)(row0 + 16 * w) * NIN, hg_hist(PJ, b, c, w), h * 64 + k, F.in[14] + l * 4 * 768, ((const float*)(F.ws + WS_LBT))[l * 256 + h * 64 + k], q, kk, vv, gl);
#pragma unroll
      for (int r = 0; r < 16; ++r) { const int t = 16 * w + r; Qf[t * HG_LD + k] = q[r]; Kf[t * HG_LD + k] = kk[r]; Vt[k * 136 + perm_pos(t)] = f2bf_(vv[r]); }
      SEG[w * 64 + k] = gl[15];
      { const int kr = L.tid >> 3, v8 = (L.tid & 7) * 8; const float* sp = (const float*)((const unsigned char*)outb + OUT_HST) + ((size_t)(b * NCH + c) * 4 + h) * 4096 + kr * 64 + v8; const f32x4 s0 = *(const f32x4*)sp, s1 = *(const f32x4*)(sp + 4);
#pragma unroll
        for (int e = 0; e < 4; ++e) { SpT[(v8 + e) * 72 + kr] = f2bf_(s0[e]); SpT[(v8 + 4 + e) * 72 + kr] = f2bf_(s1[e]); } }
      __syncthreads();
      float off = 0.f;
#pragma unroll
      for (int ww = 0; ww < 8; ++ww) { const float s = SEG[ww * 64 + k]; if (ww < w) off += s; }
#pragma unroll
      for (int r = 0; r < 16; ++r) G[(16 * w + r) * HG_LD + k] = gl[r] + off;
    }
    __syncthreads();
    const int w = L.wave, il = L.lane & 15, g = L.lane >> 4; const f32x4 zero = {0.f, 0.f, 0.f, 0.f};
    const size_t row = row0 + 16 * w + il; const bf16* gp = (const bf16*)(F.ws + WS_PROJ) + row * NIN + C_HG + h * 64; const float* og = F.in[16] + l * 256 + h * 64;
    unsigned long long gg4[4]; f32x4 og4[4];
#pragma unroll
    for (int vt = 0; vt < 4; ++vt) { gg4[vt] = *(const GAS unsigned long long*)(gp + 16 * vt + 4 * g); og4[vt] = *(const f32x4*)(og + 16 * vt + 4 * g); }
    f32x4 gr[2][2]; bf16x8 Bq[2], Bqi[2];
#pragma unroll
    for (int ks = 0; ks < 2; ++ks) { const int ko = 32 * ks + 8 * g;
        if (w > 0) { gr[ks][0] = ld4(G + (16 * w - 1) * HG_LD + ko); gr[ks][1] = ld4(G + (16 * w - 1) * HG_LD + ko + 4); } else { gr[ks][0] = zero; gr[ks][1] = zero; }
        const f32x4 q0 = ld4(Qf + (16 * w + il) * HG_LD + ko), q1 = ld4(Qf + (16 * w + il) * HG_LD + ko + 4), g0 = ld4(G + (16 * w + il) * HG_LD + ko), g1 = ld4(G + (16 * w + il) * HG_LD + ko + 4);
        f32x4 a0, a1, b0, b1;
#pragma unroll
        for (int e = 0; e < 4; ++e) { a0[e] = q0[e] * __expf(g0[e] - gr[ks][0][e]); a1[e] = q1[e] * __expf(g1[e] - gr[ks][1][e]); b0[e] = q0[e] * __expf(g0[e]); b1[e] = q1[e] * __expf(g1[e]); }
        Bq[ks] = pack8(a0, a1); Bqi[ks] = pack8(b0, b1); }
    f32x4 O[4] = {zero, zero, zero, zero};
#pragma unroll
    for (int jp = 0; jp < 4; ++jp) if (2 * jp <= w) {
        f32x4 pt[2] = {zero, zero};
#pragma unroll
        for (int hh = 0; hh < 2; ++hh) if (2 * jp + hh <= w) { const int J = 2 * jp + hh;
#pragma unroll
            for (int ks = 0; ks < 2; ++ks) { const int ko = 32 * ks + 8 * g; const f32x4 k0 = ld4(Kf + (16 * J + il) * HG_LD + ko), k1 = ld4(Kf + (16 * J + il) * HG_LD + ko + 4), g0 = ld4(G + (16 * J + il) * HG_LD + ko), g1 = ld4(G + (16 * J + il) * HG_LD + ko + 4);
                f32x4 a0, a1;
#pragma unroll
                for (int e = 0; e < 4; ++e) { a0[e] = k0[e] * __expf(fminf(gr[ks][0][e] - g0[e], 80.0f)); a1[e] = k1[e] * __expf(fminf(gr[ks][1][e] - g1[e], 80.0f)); }
                pt[hh] = mfma16(pack8(a0, a1), Bq[ks], pt[hh]); }
            if (J == w) {
#pragma unroll
                for (int r = 0; r < 4; ++r) if (4 * g + r > il) pt[hh][r] = 0.f; } }
        const bf16x8 Bp = pack8(pt[0], pt[1]);
#pragma unroll
        for (int vt = 0; vt < 4; ++vt) { const bf16x8 A = *(const LAS bf16x8*)(Vt + (16 * vt + il) * 136 + 32 * jp + 8 * g); O[vt] = mfma16(A, Bp, O[vt]); }
    }
#pragma unroll
    for (int vt = 0; vt < 4; ++vt)
#pragma unroll
        for (int ks = 0; ks < 2; ++ks) { const bf16x8 A = *(const LAS bf16x8*)(SpT + (16 * vt + il) * 72 + 32 * ks + 8 * g); O[vt] = mfma16(A, Bqi[ks], O[vt]); }
    float s2 = 0.f;
#pragma unroll
    for (int vt = 0; vt < 4; ++vt) s2 += (O[vt][0] * O[vt][0] + O[vt][1] * O[vt][1]) + (O[vt][2] * O[vt][2] + O[vt][3] * O[vt][3]);
    s2 += __shfl_xor(s2, 16); s2 += __shfl_xor(s2, 32); const float rstd = rsqrtf(s2 * (1.0f / 64.0f) + EPS);
    bf16* mo = (bf16*)(F.ws + WS_MIXED) + row * D + 256 + h * 64;
#pragma unroll
    for (int vt = 0; vt < 4; ++vt) { const int v0 = 16 * vt + 4 * g; const unsigned long long gg = gg4[vt]; const f32x4 o4 = og4[vt]; float y[4];
#pragma unroll
        for (int r = 0; r < 4; ++r) y[r] = O[vt][r] * rstd * o4[r] * silu_f(bf2f((bf16)(gg >> (16 * r))));
        *(GAS unsigned long long*)(mo + v0) = (unsigned long long)cvtpk(y[0], y[1]) | ((unsigned long long)cvtpk(y[2], y[3]) << 32); }
    __syncthreads();
}
constexpr int NCH5 = TB / 64, S5R = 64, S5S = 4;
constexpr int S5_WREG = 14592, BU_LD = 20, XS_LD = 136, GY_LD = 264;
static_assert(8 * S5_WREG <= RING_BYTES && S5R * GY_LD * 2 + 4096 + 512 <= RING_BYTES, "LDS map (S5)");
template <bool FULL> __device__ __forceinline__ void s5_group(Frame& F, const Loc& L, int l, int gidx, const bf16* Pc  , float& xr, float& xi, unsigned (&gy)[S5S][2]) {
    LAS float* BUt = (LAS float*)(F.lds + L.wave * S5_WREG); LAS bf16* Xs = (LAS bf16*)(F.lds + L.wave * S5_WREG + 128 * BU_LD * 4);
    const int il = L.lane & 15, g4 = L.lane >> 4, lg = l * 16 + gidx; const f32x4 zero = {0.f, 0.f, 0.f, 0.f}; const bf16x8 bz = {0, 0, 0, 0, 0, 0, 0, 0};
    bf16x8 Bb[8];
#pragma unroll
    for (int ct = 0; ct < 8; ++ct) Bb[ct] = g4 < 2 ? *(const bf16x8*)((const bf16*)(F.ws + WS_BBT) + ((size_t)lg * 128 + 16 * ct + il) * 16 + 8 * g4) : bz;
    bf16x8 Cb[4], Db = bz;
    if (FULL) {
#pragma unroll
        for (int ks = 0; ks < 4; ++ks) Cb[ks] = *(const bf16x8*)((const bf16*)(F.ws + WS_CCT) + ((size_t)lg * 16 + il) * 128 + 32 * ks + 8 * g4);
        const short dsk = (short)f2bf_(F.in[10][lg * 16 + il]);
#pragma unroll
        for (int jj = 0; jj < 8; ++jj) Db[jj] = (8 * g4 + jj == il) ? dsk : (short)0; }
    const float* LB = (const float*)(F.ws + WS_LB) + (size_t)(lg * 64 + L.lane) * 2; const float lr = LB[0], li = LB[1];
    const unsigned avoff = (unsigned)(il * NIN + C_U + 16 * gidx + 8 * g4) * 2u;
    bf16x8 Aall[S5S];
#pragma unroll
    for (int s = 0; s < S5S; ++s) Aall[s] = g4 < 2 ? *(const bf16x8*)((const char*)(Pc + (size_t)16 * s * NIN) + avoff) : bz;
#pragma unroll
    for (int s = 0; s < S5S; ++s) {
        const bf16x8 A = Aall[s];
#pragma unroll
        for (int ct = 0; ct < 8; ++ct) { const f32x4 d = mfma16(A, Bb[ct], zero); *(LAS f32x4*)(BUt + (16 * ct + il) * BU_LD + 4 * g4) = d; }
#pragma unroll
        for (int q = 0; q < 4; ++q) { const f32x4 br = *(const LAS f32x4*)(BUt + L.lane * BU_LD + 4 * q), bi = *(const LAS f32x4*)(BUt + (64 + L.lane) * BU_LD + 4 * q);
#pragma unroll
            for (int e = 0; e < 4; ++e) { const float nr = fmaf(lr, xr, fmaf(-li, xi, br[e])), ni = fmaf(lr, xi, fmaf(li, xr, bi[e])); xr = nr; xi = ni;
                if (FULL) *(LAS unsigned*)(Xs + (4 * q + e) * XS_LD + 2 * L.lane) = cvtpk(xr, xi); } }
        if (FULL) { f32x4 y = mfma16(A, Db, zero);
#pragma unroll
            for (int ks = 0; ks < 4; ++ks) { const bf16x8 Ax = *(const LAS bf16x8*)(Xs + il * XS_LD + 32 * ks + 8 * g4); y = mfma16(Ax, Cb[ks], y); }
            gy[s][0] = cvtpk(gelu_tanh(y[0]), gelu_tanh(y[1])); gy[s][1] = cvtpk(gelu_tanh(y[2]), gelu_tanh(y[3])); }
        asm volatile("" : "+v"(xr), "+v"(xi) :: "memory");
    }
}
__device__ __forceinline__ void ma_s5_unit(Frame& F, const Loc& L, int l, int b, int c, float* outb) {
    const bf16* Pc = (const bf16*)(F.ws + WS_PROJ) + (size_t)s5_row0(b, c) * NIN; unsigned gy[S5S][2];
#pragma unroll
    for (int gi = 0; gi < 2; ++gi) { const int gidx = 2 * L.wave + gi; float xr = 0.f, xi = 0.f; s5_group<false>(F, L, l, gidx, Pc, xr, xi, gy);
        float* xo = (float*)((unsigned char*)outb + OUT_S5X) + (((size_t)(b * NCH5 + c) * 16 + gidx) * 64 + L.lane) * 2; xo[0] = xr; xo[1] = xi; }
    __syncthreads();
}
__device__ __forceinline__ void mb_s5(Frame& F, const Loc& L, int l, float* outb, int e) {
    { const int b = e >> 10, gp = e & 1023; const float* lb = (const float*)(F.ws + WS_LB128) + (size_t)(l * 1024 + gp) * 2; const float dr = lb[0], di = lb[1];
        float* p = (float*)((unsigned char*)outb + OUT_S5X) + ((size_t)b * NCH5 * 1024 + gp) * 2; float sr = 0.f, si = 0.f; asm volatile("" : "+v"(sr), "+v"(si));
#pragma unroll
        for (int hf = 0; hf < 2; ++hf) {
            float la[65], lbv[65];
#pragma unroll
            for (int c = 0; c < 65; ++c) { const float2 t = *(const float2*)(p + (size_t)c * 2048); la[c] = t.x; lbv[c] = t.y; }
            PIN16(la); PIN16O(la, 16); PIN16O(la, 32); PIN16O(la, 48); PIN16(lbv); PIN16O(lbv, 16); PIN16O(lbv, 32); PIN16O(lbv, 48); asm volatile("" : "+v"(la[64]), "+v"(lbv[64]) :: "memory");
            asm volatile("" : "+v"(p));
#pragma unroll
            for (int c = 0; c < 65; ++c) { *(float2*)(p + (size_t)c * 2048) = make_float2(sr, si); const float nr = dr * sr - di * si + la[c], ni = dr * si + di * sr + lbv[c]; sr = nr; si = ni; }
            p += (size_t)65 * 2048; } }
}
__device__ __forceinline__ void mc_s5_unit(Frame& F, const Loc& L, int l, int b, int c, const float* outb) {
    const size_t row0 = (size_t)s5_row0(b, c); const bf16* Pc = (const bf16*)(F.ws + WS_PROJ) + row0 * NIN;
    const int il = L.lane & 15, g4 = L.lane >> 4, w = L.wave;
    unsigned gy[2][S5S][2];
    STAMP(40);
#pragma unroll
    for (int gi = 0; gi < 2; ++gi) { const int gidx = 2 * w + gi; const float* xo = (const float*)((const unsigned char*)outb + OUT_S5X) + (((size_t)(b * NCH5 + c) * 16 + gidx) * 64 + L.lane) * 2; float xr = xo[0], xi = xo[1];
        s5_group<true>(F, L, l, gidx, Pc, xr, xi, gy[gi]); if (gi == 0) STAMP(41); }
    STAMP(42);
    __syncthreads();
    LAS bf16* GYs = (LAS bf16*)F.lds; LAS float* RED = (LAS float*)(F.lds + S5R * GY_LD * 2); LAS float* RSTD = RED + S5R * 8;
#pragma unroll
    for (int gi = 0; gi < 2; ++gi)
#pragma unroll
        for (int s = 0; s < S5S; ++s)
#pragma unroll
            for (int r = 0; r < 4; ++r) GYs[(16 * s + 4 * g4 + r) * GY_LD + 16 * (2 * w + gi) + il] = (bf16)(gy[gi][s][r >> 1] >> (16 * (r & 1)));
    __syncthreads();
    STAMP(43);
    const f32x4 zero = {0.f, 0.f, 0.f, 0.f}; f32x4 acc[S5S][2];
#pragma unroll
    for (int tt = 0; tt < S5S; ++tt) { acc[tt][0] = zero; acc[tt][1] = zero; }
    const bf16* WG = (const bf16*)(F.ws + WS_WGT) + (size_t)l * 65536;
    bf16x8 Wf[8][2];
#pragma unroll
    for (int ks = 0; ks < 8; ++ks) { Wf[ks][0] = *(const bf16x8*)(WG + (size_t)(32 * w + il) * 256 + 32 * ks + 8 * g4); Wf[ks][1] = *(const bf16x8*)(WG + (size_t)(32 * w + 16 + il) * 256 + 32 * ks + 8 * g4); }
#pragma unroll
    for (int ks = 0; ks < 8; ++ks) {
#pragma unroll
        for (int tt = 0; tt < S5S; ++tt) { const bf16x8 Ag = *(const LAS bf16x8*)(GYs + (16 * tt + il) * GY_LD + 32 * ks + 8 * g4); acc[tt][0] = mfma16(Wf[ks][0], Ag, acc[tt][0]); acc[tt][1] = mfma16(Wf[ks][1], Ag, acc[tt][1]); } }
#pragma unroll
    for (int tt = 0; tt < S5S; ++tt) { float ss = 0.f;
#pragma unroll
        for (int nt = 0; nt < 2; ++nt) { const unsigned long long gq = *(const LAS unsigned long long*)(GYs + (16 * tt + il) * GY_LD + 32 * w + 16 * nt + 4 * g4);
#pragma unroll
            for (int r = 0; r < 4; ++r) { const float v = bf2f((bf16)(gq >> (16 * r))) * sigmoid_f(acc[tt][nt][r]); acc[tt][nt][r] = v; ss += v * v; } }
        ss += __shfl_xor(ss, 16); ss += __shfl_xor(ss, 32); if (g4 == 0) RED[(16 * tt + il) * 8 + w] = ss; }
    STAMP(44);
    __syncthreads();
    if (L.tid < S5R) { const f32x4 a = *(const LAS f32x4*)(RED + L.tid * 8), bq = *(const LAS f32x4*)(RED + L.tid * 8 + 4); RSTD[L.tid] = rsqrtf((((a[0] + a[1]) + (a[2] + a[3])) + ((bq[0] + bq[1]) + (bq[2] + bq[3]))) * (1.0f / 256.0f) + EPS); }
    __syncthreads();
    const float* og = F.in[13] + l * 256; bf16* MX = (bf16*)(F.ws + WS_MIXED) + row0 * D;
    f32x4 og2[2] = {*(const f32x4*)(og + 32 * w + 4 * g4), *(const f32x4*)(og + 32 * w + 16 + 4 * g4)}; PIN4(og2[0], og2[1], og2[0], og2[1]);
#pragma unroll
    for (int tt = 0; tt < S5S; ++tt) { const float rs = RSTD[16 * tt + il];
#pragma unroll
        for (int nt = 0; nt < 2; ++nt) { const int n0 = 32 * w + 16 * nt + 4 * g4; const f32x4 o4 = og2[nt];
            *(GAS unsigned long long*)((char*)(MX + (size_t)16 * tt * D) + (unsigned)(il * D + n0) * 2u) = (unsigned long long)cvtpk(acc[tt][nt][0] * rs * o4[0], acc[tt][nt][1] * rs * o4[1]) | ((unsigned long long)cvtpk(acc[tt][nt][2] * rs * o4[2], acc[tt][nt][3] * rs * o4[3]) << 32); } }
    __syncthreads();
}
constexpr int MOETBL_OFF = SEG_OFF + 2048;
static_assert(MOETBL_OFF % 16 == 0 && MOETBL_OFF + 64 <= LDS_BYTES, "LDS map (MoE table)");
__device__ __forceinline__ void moe_table(Frame& F) {
    if (mk_tid(F.wave_s) == 0) { LAS int* tbl = (LAS int*)(F.lds + MOETBL_OFF); const unsigned* cnt = (const unsigned*)(F.ctl + CW_CNT); int acc = 0;
        for (int e = 0; e < 8; ++e) { tbl[e] = acc; acc += ((int)cnt[e] + 255) >> 8; } tbl[8] = acc; }
    __syncthreads();
}
constexpr int NU_S5 = 2 * NCH5, NU_HG = 520, NU_RT = 1040, NU_ALL = NU_S5 + NU_HG + NU_RT, QSLOT_OFF = MOETBL_OFF + 64;
static_assert(QSLOT_OFF % 16 == 0 && QSLOT_OFF + 16 <= LDS_BYTES, "LDS map (queue slot)");
template <bool IS_MC> __device__ __forceinline__ void p_mixer_units(Frame& F, int l, float* outb, int qidx) {
    LAS int* slot = (LAS int*)(F.lds + QSLOT_OFF); gu32* q = F.ctl + CW_QUEUE + 64 * qidx;
    const bool t0 = mk_tid(F.wave_s) == 0; int nxt = 0;
    if (t0) slot[0] = (int)__hip_atomic_fetch_add(q, 1u, RLX_AGENT);
    __syncthreads();
    for (;;) {
        const int u = __builtin_amdgcn_readfirstlane(slot[0]);
        if (u >= NU_ALL) break;
        if (t0) nxt = (int)__hip_atomic_fetch_add(q, 1u, RLX_AGENT);
        if (u < NU_S5) { const Loc L = make_loc(F.wave_s); if (IS_MC) { if (!(u / NCH5 == 1 && u % NCH5 < 2)) mc_s5_unit(F, L, l, u / NCH5, u % NCH5, outb); } else ma_s5_unit(F, L, l, u / NCH5, u % NCH5, outb); }
        else if (u < NU_S5 + NU_HG) { const Loc L = make_loc(F.wave_s); const int uu = u - NU_S5; if (IS_MC) { if (!(uu / 260 == 1 && ((uu % 260) >> 2) == 0)) mc_hg_unit(F, L, l, uu / 260, (uu % 260) >> 2, uu & 3, outb); } else ma_hg_unit(F, L, l, uu / 260, (uu % 260) >> 2, uu & 3, outb); }
        else { const Loc L = make_loc(F.wave_s); const int uu = u - NU_S5 - NU_HG; if (IS_MC) { if (!(uu / 520 == 1 && ((uu % 520) >> 3) == 0)) mc_ret_unit(F, L, l, uu / 520, (uu % 520) >> 3, uu & 7, outb); } else ma_ret_unit(F, L, uu / 520, (uu % 520) >> 3, uu & 7, outb); }
        if (t0) slot[0] = nxt;
        __syncthreads();
    }
}
__device__ __forceinline__ void p_ma(Frame& F, int l, float* outb) { p_mixer_units<false>(F, l, outb, 2 * l); }
__device__ __forceinline__ void p_mb(Frame& F, int l, float* outb) { const Loc L = make_loc(F.wave_s); const int gt = L.vcu * NT + L.tid;
    if (gt < 32768) mb_ret(L, outb, gt); else if (gt < 65536) mb_hg(L, outb, gt - 32768); else if (gt < 67584) mb_s5(F, L, l, outb, gt - 65536); }
__device__ __forceinline__ void p_mc(Frame& F, int l, float* outb) { p_mixer_units<true>(F, l, outb, 2 * l + 1); }
__device__ __forceinline__ void p_w2conv(Frame& F) {
    const Loc L = make_loc(F.wave_s); LAS float* scr = (LAS float*)(F.lds + RING_OFF); constexpr int I_M2 = 56 * 4;
    for (int it = L.vcu; it < 8 * I_M2; it += L.G) { const int e = it / I_M2; tr_item_wg(TrP{F.in[26] + (size_t)e * DFE * D, DFE, D, (bf16*)(F.ws + WS_WM2) + (size_t)e * D * DFE, 0, nullptr, it % I_M2}, scr, L.tid); }
}
__device__ __forceinline__ void p_route(Frame& F) {
    const Loc L = make_loc(F.wave_s);
    const bf16* HB = (const bf16*)(F.ws + WS_HB); const float* gff = F.in[19] + D; const float* R = F.in[23];
    int* POS = (int*)(F.ws + WS_POS); float* GATE = (float*)(F.ws + WS_GATE); int* LIST = (int*)(F.ws + WS_LIST); unsigned* CNT = (unsigned*)(F.ctl + CW_CNT);
    LAS float* RT = (LAS float*)F.lds;
    float gr[2][8][8];
#pragma unroll
    for (int jj = 0; jj < 2; ++jj) { const int d0 = 8 * L.lane + 512 * jj; const f32x4 g0 = *(const f32x4*)(gff + d0), g1 = *(const f32x4*)(gff + d0 + 4); f32x4 rr[8][2];
#pragma unroll
        for (int q = 0; q < 8; ++q) { rr[q][0] = *(const f32x4*)(R + (d0 + q) * 8); rr[q][1] = *(const f32x4*)(R + (d0 + q) * 8 + 4); }
        PIN8(rr[0][0], rr[0][1], rr[1][0], rr[1][1], rr[2][0], rr[2][1], rr[3][0], rr[3][1]); PIN8(rr[4][0], rr[4][1], rr[5][0], rr[5][1], rr[6][0], rr[6][1], rr[7][0], rr[7][1]);
#pragma unroll
        for (int q = 0; q < 8; ++q) { const float gq = q < 4 ? g0[q] : g1[q - 4];
#pragma unroll
            for (int e = 0; e < 8; ++e) gr[jj][q][e] = gq * (e < 4 ? rr[q][0][e] : rr[q][1][e - 4]); } }
    for (int grp = L.bx; grp < BATCH * SEQ / 64; grp += L.G) {
        v4u hw8[8][2];
#pragma unroll
        for (int j = 0; j < 8; ++j) { const size_t m = (size_t)(grp * 64 + L.wave * 8 + j); hw8[j][0] = ((const GAS v4u*)(HB + m * D))[L.lane]; hw8[j][1] = ((const GAS v4u*)(HB + m * D))[L.lane + 64]; }
        PIN8(hw8[0][0], hw8[0][1], hw8[1][0], hw8[1][1], hw8[2][0], hw8[2][1], hw8[3][0], hw8[3][1]); PIN8(hw8[4][0], hw8[4][1], hw8[5][0], hw8[5][1], hw8[6][0], hw8[6][1], hw8[7][0], hw8[7][1]);
        float val[72];
#pragma unroll
        for (int j = 0; j < 8; ++j) {
#pragma unroll
            for (int e = 0; e < 9; ++e) val[9 * j + e] = 0.f;
#pragma unroll
            for (int jj = 0; jj < 2; ++jj)
#pragma unroll
                for (int q = 0; q < 8; ++q) { const unsigned wq = hw8[j][jj][q >> 1]; const float hx = __uint_as_float((q & 1) ? (wq & 0xffff0000u) : (wq << 16)); val[9 * j + 8] += hx * hx;
#pragma unroll
                    for (int e = 0; e < 8; ++e) val[9 * j + e] += hx * gr[jj][q][e]; } }
#pragma unroll
        for (int i = 0; i < 36; ++i) { const bool up = (L.lane & 32) != 0; const float send = up ? val[i] : val[i + 36], keep = up ? val[i + 36] : val[i]; val[i] = keep + __shfl_xor(send, 32); }
#pragma unroll
        for (int i = 0; i < 18; ++i) { const bool up = (L.lane & 16) != 0; const float send = up ? val[i] : val[i + 18], keep = up ? val[i + 18] : val[i]; val[i] = keep + __shfl_xor(send, 16); }
#pragma unroll
        for (int i = 0; i < 9; ++i) { const bool up = (L.lane & 8) != 0; const float send = up ? val[i] : val[i + 9], keep = up ? val[i + 9] : val[i]; val[i] = keep + __shfl_xor(send, 8); }
#pragma unroll
        for (int i = 0; i < 9; ++i) { val[i] += __shfl_xor(val[i], 4); val[i] += __shfl_xor(val[i], 2); val[i] += __shfl_xor(val[i], 1); }
        if ((L.lane & 7) == 0) { const int j = L.lane >> 3;
            const float rstd = rsqrtf(val[8] * (1.0f / 1024.0f) + EPS); float lg[8];
#pragma unroll
            for (int e = 0; e < 8; ++e) lg[e] = val[e] * rstd;
            int i1 = 0; float l1 = lg[0];
#pragma unroll
            for (int e = 1; e < 8; ++e) if (lg[e] > l1) { l1 = lg[e]; i1 = e; }
            int i2 = -1; float l2 = -3.0e38f;
#pragma unroll
            for (int e = 0; e < 8; ++e) if (e != i1 && lg[e] > l2) { l2 = lg[e]; i2 = e; }
            const float e2 = __expf(l2 - l1), g1 = 1.0f / (1.0f + e2), g2 = e2 * g1;
            const int sl = L.wave * 8 + j; RT[sl * 4 + 0] = __int_as_float(i1); RT[sl * 4 + 1] = __int_as_float(i2); RT[sl * 4 + 2] = g1; RT[sl * 4 + 3] = g2; RT[256 + sl] = rstd; }
        __syncthreads();
        if (L.wave == 0) { const int tk = grp * 64 + L.lane; const int e1 = __float_as_int(RT[L.lane * 4 + 0]), e2 = __float_as_int(RT[L.lane * 4 + 1]); const float g1 = RT[L.lane * 4 + 2], g2 = RT[L.lane * 4 + 3];
            const int row = tk; const unsigned long long lt = (1ull << L.lane) - 1ull; int p1 = 0, p2 = 0, off2 = 0; unsigned mine = 0u;
#pragma unroll
            for (int e = 0; e < 8; ++e) { const unsigned long long m1 = __ballot(e1 == e), m2 = __ballot(e2 == e); const int n1 = __popcll(m1), n2 = __popcll(m2);
                if (L.lane == e) mine = (unsigned)(n1 + n2); if (e1 == e) p1 = __popcll(m1 & lt); if (e2 == e) { p2 = __popcll(m2 & lt); off2 = n1; } }
            unsigned base = 0u; if (L.lane < 8 && mine > 0u) base = atomicAdd(CNT + L.lane, mine);
            p1 += (int)__shfl(base, e1); p2 += (int)__shfl(base, e2) + off2;
            LIST[(size_t)e1 * MOE_CAP + p1] = row; LIST[(size_t)e2 * MOE_CAP + p2] = row; { float* RSL = (float*)(F.ws + WS_RSL); const float rs = RT[256 + L.lane]; RSL[(size_t)e1 * MOE_CAP + p1] = rs; RSL[(size_t)e2 * MOE_CAP + p2] = rs; }
            POS[tk * 2] = (e1 << 20) | p1; POS[tk * 2 + 1] = (e2 << 20) | p2; GATE[tk * 2] = g1; GATE[tk * 2 + 1] = g2; }
        __syncthreads();
    }
}
__device__ __forceinline__ void p_final(Frame& F, float* out) {
    const Loc L = make_loc(F.wave_s);
    const int gw = L.vcu * NWAVES + L.wave, NGW = L.G * NWAVES; const bf16* HB = (const bf16*)(F.ws + WS_HB); const float* gf = F.in[27];
    const int* POS = (const int*)(F.ws + WS_POS); const float* GATE = (const float*)(F.ws + WS_GATE); const bf16* YS = (const bf16*)(F.ws + WS_YS); const unsigned* CNT = (const unsigned*)(F.ctl + CW_CNT);
    moe_table(F); const LAS int* tbl = (const LAS int*)(F.lds + MOETBL_OFF);
    f32x4 gfr[4];
#pragma unroll
    for (int j = 0; j < 4; ++j) gfr[j] = ((const GAS f32x4*)gf)[L.lane + 64 * j];
    PIN4(gfr[0], gfr[1], gfr[2], gfr[3]);
    for (int r = gw; r < BATCH * SEQ; r += NGW) { const size_t m = (size_t)r;
        const int q1 = POS[r * 2], q2 = POS[r * 2 + 1]; const float g1 = GATE[r * 2], g2 = GATE[r * 2 + 1]; const int t1 = tbl[q1 >> 20], t2 = tbl[q2 >> 20];
        const size_t s1 = (size_t)t1 * 256 + (q1 & 0xfffff), s2 = (size_t)t2 * 256 + (q2 & 0xfffff);
        f32x4 v[4]; float s = 0.f; unsigned long long hh[4], ya[4], yb[4];
#pragma unroll
        for (int j = 0; j < 4; ++j) { hh[j] = ((const GAS unsigned long long*)(HB + m * D))[L.lane + 64 * j]; ya[j] = ((const GAS unsigned long long*)(YS + s1 * D))[L.lane + 64 * j]; yb[j] = ((const GAS unsigned long long*)(YS + s2 * D))[L.lane + 64 * j]; }
        PIN4(hh[0], hh[1], hh[2], hh[3]); PIN8(ya[0], ya[1], ya[2], ya[3], yb[0], yb[1], yb[2], yb[3]);
#pragma unroll
        for (int j = 0; j < 4; ++j) { const unsigned long long y1 = ya[j], y2 = yb[j];
#pragma unroll
            for (int q = 0; q < 4; ++q) v[j][q] = bf2f((bf16)(hh[j] >> (16 * q))) + g1 * bf2f((bf16)(y1 >> (16 * q))) + g2 * bf2f((bf16)(y2 >> (16 * q)));
            s += (v[j].x * v[j].x + v[j].y * v[j].y) + (v[j].z * v[j].z + v[j].w * v[j].w); }
        const float rstd = rsqrtf(wave_sum(s) * (1.0f / 1024.0f) + EPS);
#pragma unroll
        for (int j = 0; j < 4; ++j) ((GAS f32x4*)(out + (size_t)r * D))[L.lane + 64 * j] = v[j] * rstd * gfr[j];
        if (PROBE_TA >= 0 && r == 0 && L.lane == 0) { asm volatile("s_waitcnt vmcnt(0)" ::: "memory"); out[0] = PROBE_SCALE * (float)(__hip_atomic_load(F.ctl + CW_PROBE + (PROBE_TB >= 0 ? PROBE_TB : 0), RLX_AGENT) - __hip_atomic_load(F.ctl + CW_PROBE + (PROBE_TA >= 0 ? PROBE_TA : 0), RLX_AGENT)); }
    }
}

template <int KIND> __device__ __forceinline__ void meta_side(Frame& F, const bf16* A, int K, const bf16* Wt, int ntiles, bf16* OUT, int ldo) {
    const Loc L = make_loc(F.wave_s);
    if (L.bx < ntiles) {
        LAS float* red = (LAS float*)F.lds; LAS float* rs = red + 8 * 64 * 8;
        const int il = L.lane & 15, g = L.lane >> 4, w = L.wave;
        if (KIND != 1) { const bf16* HB = (const bf16*)(F.ws + WS_HB);
#pragma unroll
            for (int rr = 0; rr < 2; ++rr) { const int r = 2 * w + rr; const v4u x0 = ((const GAS v4u*)(HB + (size_t)(MROW0 + r) * D))[L.lane], x1 = ((const GAS v4u*)(HB + (size_t)(MROW0 + r) * D))[L.lane + 64]; float ss = 0.f;
#pragma unroll
                for (int q = 0; q < 4; ++q) { const float a = __uint_as_float(x0[q] << 16), bq = __uint_as_float(x0[q] & 0xffff0000u), c = __uint_as_float(x1[q] << 16), d = __uint_as_float(x1[q] & 0xffff0000u); ss += (a * a + bq * bq) + (c * c + d * d); }
                ss = wave_sum(ss); if (L.lane == 0) rs[r] = rsqrtf(ss * (1.0f / 1024.0f) + EPS); } }
        const int kw = K / 8, nks = kw / 32;
        const int n0 = KIND == 2 ? ((16 * L.bx) >> 7) * 256 + ((16 * L.bx) & 127) : 16 * L.bx;
        const bf16* ap = A + (size_t)(MROW0 + il) * K + w * kw + 8 * g; const bf16* bp = Wt + (size_t)(n0 + il) * K + w * kw + 8 * g;
        const f32x4 zero = {0.f, 0.f, 0.f, 0.f}; f32x4 a0 = zero, a1 = zero;
        for (int ks = 0; ks < nks; ++ks) { const bf16x8 Af = *(const bf16x8*)(ap + 32 * ks), B0 = *(const bf16x8*)(bp + 32 * ks); a0 = mfma16(Af, B0, a0);
            if (KIND == 2) { const bf16x8 B1 = *(const bf16x8*)(bp + (size_t)128 * K + 32 * ks); a1 = mfma16(Af, B1, a1); } }
        *(LAS f32x4*)(red + (w * 64 + L.lane) * 8) = a0; if (KIND == 2) *(LAS f32x4*)(red + (w * 64 + L.lane) * 8 + 4) = a1;
        __syncthreads();
        if (w == 0) { f32x4 s0 = zero, s1 = zero;
#pragma unroll
            for (int ww = 0; ww < 8; ++ww) { s0 = s0 + *(const LAS f32x4*)(red + (ww * 64 + L.lane) * 8); if (KIND == 2) s1 = s1 + *(const LAS f32x4*)(red + (ww * 64 + L.lane) * 8 + 4); }
#pragma unroll
            for (int r = 0; r < 4; ++r) { const int mr = 4 * g + r; bf16* o = OUT + (size_t)(MROW0 + mr) * ldo + 16 * L.bx + il;
                if (KIND == 0) *o = f2bf_(s0[r] * rs[mr]);
                else if (KIND == 1) *o = f2bf_(bf2f(*o) + s0[r]);
                else { const float av = s0[r] * rs[mr], bv = s1[r] * rs[mr]; *o = f2bf_(silu_f(av) * bv); } } }
        __syncthreads();
    }
}
struct Args { const float* in[28]; float* out; unsigned char* ws; int ph_lo, ph_hi, li, pad; };
__global__ void __launch_bounds__(NWAVES * 64, 2) __attribute__((amdgpu_waves_per_eu(2, 2))) mk_fwd(Args args) {
    extern __shared__ __attribute__((aligned(16))) unsigned char lds[];
    Frame F;
    F.lds = (LAS unsigned char*)lds; F.MISC = (volatile LAS unsigned*)(F.lds + MISC_OFF);
    F.ws = args.ws; F.ctl = (gu32*)(args.ws + WS_CTL); F.in = args.in; F.wave_s = __builtin_amdgcn_readfirstlane((int)threadIdx.x >> 6);
    for (int u = mk_tid(F.wave_s); u < (LDS_BYTES - LDSCTL_OFF) / 4; u += NWAVES * 64) ((LAS unsigned*)(F.lds + LDSCTL_OFF))[u] = 0u;
    __syncthreads();
    XcdBarrier bar; bar.bar = (unsigned*)(F.ctl + CW_BAR); bar.x = 0; bar.st = nullptr; bar.wv = F.wave_s;
    if (!MK_PER_PHASE) bar = xcd_barrier_post((unsigned*)(F.ctl + CW_BAR), F.MISC + 8, F.wave_s);
    STAMP(15);
    const int lo = args.ph_lo, hi = args.ph_hi;
#define IN(k) (lo <= (k) && (k) < hi)
#define SEAM(k) do { if (!MK_PER_PHASE && (k) + 1 < hi) xcd_barrier(bar); STAMP(16 + (k)); } while (0)
    unsigned char* ws = args.ws;
    float* SS = (float*)(ws + WS_SSP);
    if (IN(0)) for (int rep = 0; rep < REP(1); ++rep) { p0_prologue(F); SEAM(0); }
    for (int l = 0; l < 2; ++l) {
        { unsigned char* w_ = args.ws; asm volatile("" : "+s"(w_)); ws = w_; F.ws = w_; F.ctl = (gu32*)(w_ + WS_CTL); SS = (float*)(w_ + WS_SSP); }
        const int base = 1 + 30 * l;
        if (IN(base + 0)) for (int rep = 0; rep < REP(2); ++rep) {
            pg8::Gemm g{(const bf16*)(ws + WS_HB), (const bf16*)(ws + WS_WIN) + (size_t)l * NIN * D, MT, NIN, D, F.wave_s}; pg8::StaticOrder S; const Loc L = make_loc(F.wave_s); S.init(MT, NIN, L.G, L.bx);
            pg8::EpiProj E{(bf16*)(ws + WS_PROJ), NIN, SS + (size_t)(2 * l) * M * 16};
            pg8::gemm_phase<pg8::EpiProj, pg8::StaticOrder, true, true>(F.lds + RING_OFF, g, S, E);
            meta_side<0>(F, (const bf16*)(ws + WS_HB), D, (const bf16*)(ws + WS_WIN) + (size_t)l * NIN * D, NIN / 16, (bf16*)(ws + WS_PROJ), NIN);
            SEAM(base + 0);
        }
        if (IN(base + 1)) for (int rep = 0; rep < REP(3); ++rep) { p_ma(F, l, args.out); SEAM(base + 1); }
        if (IN(base + 2)) { p_mb(F, l, args.out); SEAM(base + 2); }
        if (IN(base + 3)) for (int rep = 0; rep < REP(4); ++rep) { p_mc(F, l, args.out); SEAM(base + 3); }
        if (IN(base + 6)) {
            pg8::Gemm g{(const bf16*)(ws + WS_MIXED), (const bf16*)(ws + WS_WOUT) + (size_t)l * D * D, MT, D, D, F.wave_s}; pg8::StaticOrder S; const Loc L = make_loc(F.wave_s); S.init(MT, D, L.G, L.bx);
            pg8::EpiResid E{(bf16*)(ws + WS_HB), SS + (size_t)(2 * l + 1) * M * 16, nullptr, 0, 1};
            pg8::gemm_phase<pg8::EpiResid, pg8::StaticOrder, true, true>(F.lds + RING_OFF, g, S, E);
            if (l == 0) meta_side<1>(F, (const bf16*)(ws + WS_MIXED), D, (const bf16*)(ws + WS_WOUT), D / 16, (bf16*)(ws + WS_HB), D);
            SEAM(base + 6);
        }
        if (l == 0) {
            if (IN(base + 8)) for (int rep = 0; rep < REP(5); ++rep) {
                pg8::Gemm g{(const bf16*)(ws + WS_HB), (const bf16*)(ws + WS_WF13), MT, 2 * DFF, D, F.wave_s}; pg8::StaticOrder S; const Loc L = make_loc(F.wave_s); S.init(MT, 2 * DFF, L.G, L.bx);
                pg8::EpiSwiglu E{(bf16*)(ws + WS_ACT), DFF, SS + (size_t)1 * M * 16};
                pg8::gemm_phase<pg8::EpiSwiglu, pg8::StaticOrder, true, true>(F.lds + RING_OFF, g, S, E);
                meta_side<2>(F, (const bf16*)(ws + WS_HB), D, (const bf16*)(ws + WS_WF13), DFF / 16, (bf16*)(ws + WS_ACT), DFF);
                SEAM(base + 8);
            }
            if (IN(base + 9)) {
                pg8::Gemm g{(const bf16*)(ws + WS_ACT), (const bf16*)(ws + WS_WF2), MT, D, DFF, F.wave_s}; pg8::StaticOrder S; const Loc L = make_loc(F.wave_s); S.init(MT, D, L.G, L.bx);
                pg8::EpiResid E{(bf16*)(ws + WS_HB), SS + (size_t)2 * M * 16, nullptr, 0, 1};
                pg8::gemm_phase<pg8::EpiResid, pg8::StaticOrder, true, true>(F.lds + RING_OFF, g, S, E);
                meta_side<1>(F, (const bf16*)(ws + WS_ACT), DFF, (const bf16*)(ws + WS_WF2), D / 16, (bf16*)(ws + WS_HB), D);
                SEAM(base + 9);
            }
        } else {
            if (IN(base + 7)) { p_route(F); SEAM(base + 7); }
            if (IN(base + 10)) for (int rep = 0; rep < REP(6); ++rep) {
                pg8::Gemm g{(const bf16*)(ws + WS_HB), (const bf16*)(ws + WS_WM13), MOE_TMAX * 256, NEXP * 2 * DFE, D, F.wave_s}; const Loc L = make_loc(F.wave_s);
                moe_table(F); pg8::MoeOrder<true> S; S.init((const int*)(F.ctl + CW_CNT), (const int*)(ws + WS_LIST), MOE_CAP, 2 * DFE / 256, L.G, L.bx, (const LAS int*)(F.lds + MOETBL_OFF));
                pg8::EpiSwigluMoe E{(bf16*)(ws + WS_ACT), DFE, (const float*)(ws + WS_RSL), MOE_CAP, 2 * DFE / 256};
                pg8::gemm_phase<pg8::EpiSwigluMoe, pg8::MoeOrder<true>, true, true>(F.lds + RING_OFF, g, S, E);
                SEAM(base + 10);
            }
            if (IN(base + 11)) for (int rep = 0; rep < REP(8); ++rep) { p_w2conv(F); SEAM(base + 11); }
            if (IN(base + 12)) for (int rep = 0; rep < REP(7); ++rep) {
                pg8::Gemm g{(const bf16*)(ws + WS_ACT), (const bf16*)(ws + WS_WM2), MOE_TMAX * 256, NEXP * D, DFE, F.wave_s}; const Loc L = make_loc(F.wave_s);
                moe_table(F); pg8::MoeOrder<false> S; S.init((const int*)(F.ctl + CW_CNT), (const int*)(ws + WS_LIST), MOE_CAP, D / 256, L.G, L.bx, (const LAS int*)(F.lds + MOETBL_OFF));
                pg8::EpiYs E{(bf16*)(ws + WS_YS)};
                pg8::gemm_phase<pg8::EpiYs, pg8::MoeOrder<false>, true, true>(F.lds + RING_OFF, g, S, E);
                SEAM(base + 12);
            }
        }
    }
    if (IN(NPH - 1)) p_final(F, args.out);
#undef IN
#undef SEAM
}

extern "C" void kernel_launch(void* const* d_in, const int* in_sizes, int n_in, void* d_out, int out_size, void* d_ws, size_t ws_size, hipStream_t stream) {
    static int grid = 0;
    if (grid == 0) {
        if (n_in != 28 || out_size != BATCH * SEQ * D || ws_size < WS_END) { fprintf(stderr, "kernel_launch: unexpected shapes: n_in %d out %d ws %zu (need %zu)\n", n_in, out_size, ws_size, (size_t)WS_END); grid = -1; return; }
        int dev = 0, cus = 0, per_cu = 0;
        if (hipGetDevice(&dev) != hipSuccess || hipDeviceGetAttribute(&cus, hipDeviceAttributeMultiprocessorCount, dev) != hipSuccess) { grid = -1; return; }
        if (hipFuncSetAttribute((const void*)mk_fwd, hipFuncAttributeMaxDynamicSharedMemorySize, LDS_BYTES) != hipSuccess) { fprintf(stderr, "kernel_launch: hipFuncSetAttribute failed\n"); grid = -1; return; }
        if (hipOccupancyMaxActiveBlocksPerMultiprocessor(&per_cu, (const void*)mk_fwd, NWAVES * 64, LDS_BYTES) != hipSuccess || per_cu < 1) { fprintf(stderr, "kernel_launch: occupancy query says %d\n", per_cu); }
        (void)hipGetLastError();
        grid = cus;
    }
    if (grid < 0) return;
    if (hipMemsetAsync((char*)d_ws + WS_CTL, 0, CTL_ZERO_BYTES, stream) != hipSuccess) return;
    Args a{};
    for (int i = 0; i < 28; ++i) a.in[i] = (const float*)d_in[i];
    a.out = (float*)d_out; a.ws = (unsigned char*)d_ws;
#if MK_PER_PHASE
    for (int k = 0; k < NPH; ++k) { if (!phase_exists(k)) continue; a.ph_lo = k; a.ph_hi = k + 1; a.li = 0; hipLaunchKernelGGL(mk_fwd, dim3(grid), dim3(NWAVES * 64), LDS_BYTES, stream, a); }
#else
    a.ph_lo = 0; a.ph_hi = NPH; a.li = 0;
    hipLaunchKernelGGL(mk_fwd, dim3(grid), dim3(NWAVES * 64), LDS_BYTES, stream, a);
#endif
}
```

```cpp
#include <hip/hip_runtime.h>
#include <cstdio>
#include <cstdint>
#include <cmath>
#define PIN4(a, b, c, d) asm volatile("" : "+v"(a), "+v"(b), "+v"(c), "+v"(d) :: "memory")
#define PIN8(a, b, c, d, e, f, g, h) asm volatile("" : "+v"(a), "+v"(b), "+v"(c), "+v"(d), "+v"(e), "+v"(f), "+v"(g), "+v"(h) :: "memory")
#define PIN16O(A, o) asm volatile("" : "+v"(A[(o) + 0]), "+v"(A[(o) + 1]), "+v"(A[(o) + 2]), "+v"(A[(o) + 3]), "+v"(A[(o) + 4]), "+v"(A[(o) + 5]), "+v"(A[(o) + 6]), "+v"(A[(o) + 7]), "+v"(A[(o) + 8]), "+v"(A[(o) + 9]), "+v"(A[(o) + 10]), "+v"(A[(o) + 11]), "+v"(A[(o) + 12]), "+v"(A[(o) + 13]), "+v"(A[(o) + 14]), "+v"(A[(o) + 15]) :: "memory")
#define PIN16(A) asm volatile("" : "+v"(A[0]), "+v"(A[1]), "+v"(A[2]), "+v"(A[3]), "+v"(A[4]), "+v"(A[5]), "+v"(A[6]), "+v"(A[7]), "+v"(A[8]), "+v"(A[9]), "+v"(A[10]), "+v"(A[11]), "+v"(A[12]), "+v"(A[13]), "+v"(A[14]), "+v"(A[15]) :: "memory")
__device__ __forceinline__ int mk_tid(int wave_s) { int z = 0; asm volatile("" : "+v"(z)); return wave_s * 64 + (int)__builtin_amdgcn_mbcnt_hi(~0u, __builtin_amdgcn_mbcnt_lo(~0u, (unsigned)z)); }
namespace pg8 {
#define PG8_LAS __attribute__((address_space(3)))
typedef unsigned short bf16_t;
typedef short bf16x8 __attribute__((ext_vector_type(8)));
typedef float f32x4 __attribute__((ext_vector_type(4)));
typedef unsigned u32x4 __attribute__((ext_vector_type(4)));
constexpr int BM = 256, BK = 64, HALF = 128, HTB = HALF * BK * 2  , STAGE_BYTES = 8 * HTB, NXCD = 8, WGM = 8;

__host__ __device__ __forceinline__ int lds_byte(int r, int c) { const int st = (r >> 4) * 2 + (c >> 5), rr = r & 15, cc = c & 31, ob = rr * 64 + cc * 2; return st * 1024 + (ob ^ (((ob >> 9) & 1) << 5)); }
__host__ __device__ __forceinline__ void stage_rc(int b, int& R, int& C) { const int st = b / 1024, sb = b % 1024, swz = sb ^ (((sb >> 9) & 1) << 5); R = (st >> 1) * 16 + swz / 64; C = (st & 1) * 32 + (swz % 64) / 2; }
__host__ __device__ __forceinline__ int perm32(int rho) { const int n = rho >> 4, i = rho & 15; return 8 * (i >> 2) + 4 * n + (i & 3); }

struct Unit { int pm, pn, e, r0, ce; };
struct Gemm { const bf16_t* A; const bf16_t* Bt; int M, N, K, wv; };

struct StaticOrder {
    static constexpr bool GATHER = false;
    int nM, nN, nwg, G, c;
    __host__ __device__ void init(int M, int N, int G_, int c_) { nM = M / BM; nN = N / BM; nwg = nM * nN; G = G_; c = c_; }
    __host__ __device__ bool next(int i, Unit& u) const {
        const long L = (long)i * G + c; if (L >= nwg) return false;
        int wgid = (int)L; { const int q = nwg / NXCD, r = nwg % NXCD, xcd = wgid % NXCD, off = wgid / NXCD; wgid = (xcd < r ? xcd * (q + 1) : r * (q + 1) + (xcd - r) * q) + off; }
        const int nig = WGM * nN, gid = wgid / nig, fm = gid * WGM, gsz = (nM - fm) < WGM ? (nM - fm) : WGM;
        u.pm = fm + ((wgid % nig) % gsz); u.pn = (wgid % nig) / gsz; return true;
    }
    __device__ __forceinline__ void a_ready(const Unit&) const {}
    __device__ __forceinline__ void done(const Unit&) const {}
    __device__ __forceinline__ int arow(const Unit&, int) const { return 0; }
    __device__ __forceinline__ long boff(const Unit&) const { return 0; }
};

__device__ __forceinline__ unsigned cvt_pk_bf16(float lo, float hi) { unsigned r; asm volatile("v_cvt_pk_bf16_f32 %0, %1, %2" : "=v"(r) : "v"(lo), "v"(hi)); return r; }
typedef float f32x2 __attribute__((ext_vector_type(2)));
constexpr float RMS_EPS = 1e-6f;
__device__ __forceinline__ float fast_silu(float a) { return a * __builtin_amdgcn_rcpf(1.0f + __expf(-a)); }
__device__ __forceinline__ float rstd_of(const f32x4 a, const f32x4 b, const f32x4 c, const f32x4 d) {
    const float t = (((a[0] + a[1]) + (a[2] + a[3])) + ((b[0] + b[1]) + (b[2] + b[3]))) + (((c[0] + c[1]) + (c[2] + c[3])) + ((d[0] + d[1]) + (d[2] + d[3])));
    return __builtin_amdgcn_rsqf(t * (1.0f / 1024.0f) + RMS_EPS); }
__device__ __forceinline__ float row_rstd(const float* ss, int row) { const f32x4* p = (const f32x4*)(ss + (size_t)row * 16); return rstd_of(p[0], p[1], p[2], p[3]); }
__device__ __forceinline__ void row_rstd4(const float* ss, int row0, float (&sc)[4]) {
    f32x4 v[4][4];
#pragma unroll
    for (int m = 0; m < 4; ++m)
#pragma unroll
        for (int j = 0; j < 4; ++j) v[m][j] = *(const f32x4*)(ss + (size_t)(row0 + 16 * m) * 16 + 4 * j);
    PIN8(v[0][0], v[0][1], v[0][2], v[0][3], v[1][0], v[1][1], v[1][2], v[1][3]); PIN8(v[2][0], v[2][1], v[2][2], v[2][3], v[3][0], v[3][1], v[3][2], v[3][3]);
#pragma unroll
    for (int m = 0; m < 4; ++m) sc[m] = rstd_of(v[m][0], v[m][1], v[m][2], v[m][3]);
}
struct EpiProj {
    static constexpr bool PERM = true, AFTER_DRAIN = false;
    bf16_t* O; int ldc; const float* ss;
    __device__ __forceinline__ void operator()(const f32x4 (&acc)[2][2][4][2], const Unit& u, int wr, int wc, int fr, int fq) const {
        const int row0 = u.pm * BM + wr * 64 + fr, col0 = u.pn * BM + wc * 32 + 8 * fq;
#pragma unroll
        for (int ai = 0; ai < 2; ++ai) { float sc4[4]; row_rstd4(ss, row0 + ai * HALF, sc4);
#pragma unroll
            for (int m = 0; m < 4; ++m) { const int row = row0 + ai * HALF + m * 16; const float sc = sc4[m];
                bf16_t* rowp = O + (size_t)row * ldc + col0;
#pragma unroll
                for (int bj = 0; bj < 2; ++bj) { const f32x4 v0 = acc[ai][bj][m][0] * sc, v1 = acc[ai][bj][m][1] * sc;
                    u32x4 w; w.x = cvt_pk_bf16(v0[0], v0[1]); w.y = cvt_pk_bf16(v0[2], v0[3]); w.z = cvt_pk_bf16(v1[0], v1[1]); w.w = cvt_pk_bf16(v1[2], v1[3]);
                    *(u32x4*)(rowp + bj * HALF) = w; } } }
    }
};
struct EpiSwiglu {
    static constexpr bool PERM = true, AFTER_DRAIN = false;
    bf16_t* O; int ldc; const float* ss;
    __device__ __forceinline__ void operator()(const f32x4 (&acc)[2][2][4][2], const Unit& u, int wr, int wc, int fr, int fq) const {
        const int row0 = u.pm * BM + wr * 64 + fr, col0 = u.pn * HALF + wc * 32 + 8 * fq;
#pragma unroll
        for (int ai = 0; ai < 2; ++ai) { float sc4[4]; row_rstd4(ss, row0 + ai * HALF, sc4);
#pragma unroll
            for (int m = 0; m < 4; ++m) { const int row = row0 + ai * HALF + m * 16; const float sc = sc4[m];
                const f32x4 a0 = acc[ai][0][m][0] * sc, a1 = acc[ai][0][m][1] * sc, b0 = acc[ai][1][m][0] * sc, b1 = acc[ai][1][m][1] * sc;
                u32x4 w; w.x = cvt_pk_bf16(fast_silu(a0[0]) * b0[0], fast_silu(a0[1]) * b0[1]); w.y = cvt_pk_bf16(fast_silu(a0[2]) * b0[2], fast_silu(a0[3]) * b0[3]);
                w.z = cvt_pk_bf16(fast_silu(a1[0]) * b1[0], fast_silu(a1[1]) * b1[1]); w.w = cvt_pk_bf16(fast_silu(a1[2]) * b1[2], fast_silu(a1[3]) * b1[3]);
                *(u32x4*)(O + (size_t)row * ldc + col0) = w; } }
    }
};
struct EpiResid {
    static constexpr bool PERM = false, AFTER_DRAIN = false;
    bf16_t* HB; float* ssout; const float* gate; int gstride; int write_ss;
    __device__ __forceinline__ void operator()(const f32x4 (&acc)[2][2][4][2], const Unit& u, int wr, int wc, int fr, int fq) const {
        const int row0 = u.pm * BM + wr * 64 + fr, col0 = u.pn * BM + wc * 32 + 4 * fq;
#pragma unroll
        for (int ai = 0; ai < 2; ++ai) {
            unsigned long long hv[4][2][2];
#pragma unroll
            for (int m = 0; m < 4; ++m)
#pragma unroll
                for (int bj = 0; bj < 2; ++bj)
#pragma unroll
                    for (int n = 0; n < 2; ++n) hv[m][bj][n] = *(const unsigned long long*)(HB + (size_t)(row0 + ai * HALF + m * 16) * 1024 + col0 + bj * HALF + n * 16);
            PIN8(hv[0][0][0], hv[0][0][1], hv[0][1][0], hv[0][1][1], hv[1][0][0], hv[1][0][1], hv[1][1][0], hv[1][1][1]); PIN8(hv[2][0][0], hv[2][0][1], hv[2][1][0], hv[2][1][1], hv[3][0][0], hv[3][0][1], hv[3][1][0], hv[3][1][1]);
#pragma unroll
            for (int m = 0; m < 4; ++m) { const int row = row0 + ai * HALF + m * 16; const float g = gate ? gate[(size_t)row * gstride] : 1.0f; float s = 0.f;
#pragma unroll
                for (int bj = 0; bj < 2; ++bj)
#pragma unroll
                    for (int n = 0; n < 2; ++n) { const unsigned long long h = hv[m][bj][n]; f32x4 o;
                        o[0] = __uint_as_float((unsigned)h << 16); o[1] = __uint_as_float((unsigned)h & 0xffff0000u); o[2] = __uint_as_float((unsigned)(h >> 32) << 16); o[3] = __uint_as_float((unsigned)(h >> 32) & 0xffff0000u);
                        o = o + acc[ai][bj][m][n] * g; s += (o[0] * o[0] + o[1] * o[1]) + (o[2] * o[2] + o[3] * o[3]);
                        *(unsigned long long*)(HB + (size_t)row * 1024 + col0 + bj * HALF + n * 16) = (unsigned long long)cvt_pk_bf16(o[0], o[1]) | ((unsigned long long)cvt_pk_bf16(o[2], o[3]) << 32); }
                if (write_ss) { s += __shfl_xor(s, 16); s += __shfl_xor(s, 32); if (fq == 0) ssout[(size_t)row * 16 + u.pn * 4 + wc] = s; } } }
    }
};
template <bool GATH> struct MoeOrder {
    static constexpr bool GATHER = GATH;
    int nNe, nT, nwg, G, c, cap; long hi_off; const int* list; const int* cnt; const PG8_LAS int* tbl;
    __device__ __forceinline__ void init(const int* cnt_, const int* list_, int cap_, int nNe_, int G_, int c_, const PG8_LAS int* tbl_) { list = list_; cnt = cnt_; tbl = tbl_; cap = cap_; nNe = nNe_; G = G_; c = c_; nT = tbl_[8]; nwg = nT * nNe; hi_off = 0; }
    __device__ __forceinline__ long boff(const Unit& u) const { return u.e >= 4 ? hi_off : 0; }
    __device__ __forceinline__ bool next(int i, Unit& u) const {
        const long L = (long)i * G + c; if (L >= nwg) return false;
        int wgid = (int)L; { const int q = nwg / NXCD, r = nwg % NXCD, xcd = wgid % NXCD, off = wgid / NXCD; wgid = (xcd < r ? xcd * (q + 1) : r * (q + 1) + (xcd - r) * q) + off; }
        const int nig = WGM * nNe, gid = wgid / nig, fm = gid * WGM, gsz = (nT - fm) < WGM ? (nT - fm) : WGM;
        const int t = fm + ((wgid % nig) % gsz), pnl = (wgid % nig) / gsz;
        int e = 0;
#pragma unroll
        for (int k = 1; k < 8; ++k) e += (t >= tbl[k]) ? 1 : 0;
        e = __builtin_amdgcn_readfirstlane(e);
        u.pm = t; u.pn = e * nNe + pnl; u.e = e; u.r0 = (t - __builtin_amdgcn_readfirstlane(tbl[e])) * BM; u.ce = cnt[e]; return true;
    }
    __device__ __forceinline__ int arow(const Unit& u, int R) const { const int pos = u.r0 + R; return pos < u.ce ? list[(size_t)u.e * cap + pos] : 0; }
    __device__ __forceinline__ void a_ready(const Unit&) const {}
    __device__ __forceinline__ void done(const Unit&) const {}
};
struct EpiSwigluMoe {
    static constexpr bool PERM = true, AFTER_DRAIN = false;
    bf16_t* O; int ldc; const float* rs; int cap, nNe;
    __device__ __forceinline__ void operator()(const f32x4 (&acc)[2][2][4][2], const Unit& u, int wr, int wc, int fr, int fq) const {
        const int r0 = wr * 64 + fr, col0 = (u.pn - u.e * nNe) * HALF + wc * 32 + 8 * fq;
        float sc8[8];
#pragma unroll
        for (int i = 0; i < 8; ++i) { const int pos = u.r0 + r0 + (i >> 2) * HALF + (i & 3) * 16; sc8[i] = pos < u.ce ? rs[(size_t)u.e * cap + pos] : 0.0f; }
        PIN8(sc8[0], sc8[1], sc8[2], sc8[3], sc8[4], sc8[5], sc8[6], sc8[7]);
#pragma unroll
        for (int ai = 0; ai < 2; ++ai)
#pragma unroll
            for (int m = 0; m < 4; ++m) { const int R = r0 + ai * HALF + m * 16; const float sc = sc8[ai * 4 + m];
                const f32x4 a0 = acc[ai][0][m][0] * sc, a1 = acc[ai][0][m][1] * sc, b0 = acc[ai][1][m][0] * sc, b1 = acc[ai][1][m][1] * sc;
                u32x4 w; w.x = cvt_pk_bf16(fast_silu(a0[0]) * b0[0], fast_silu(a0[1]) * b0[1]); w.y = cvt_pk_bf16(fast_silu(a0[2]) * b0[2], fast_silu(a0[3]) * b0[3]);
                w.z = cvt_pk_bf16(fast_silu(a1[0]) * b1[0], fast_silu(a1[1]) * b1[1]); w.w = cvt_pk_bf16(fast_silu(a1[2]) * b1[2], fast_silu(a1[3]) * b1[3]);
                *(u32x4*)(O + (size_t)(u.pm * BM + R) * ldc + col0) = w; }
    }
};
struct EpiYs {
    static constexpr bool PERM = true, AFTER_DRAIN = false;
    bf16_t* O;
    __device__ __forceinline__ void operator()(const f32x4 (&acc)[2][2][4][2], const Unit& u, int wr, int wc, int fr, int fq) const {
        const int row0 = u.pm * BM + wr * 64 + fr, col0 = (u.pn - u.e * 4) * BM + wc * 32 + 8 * fq;
#pragma unroll
        for (int ai = 0; ai < 2; ++ai)
#pragma unroll
            for (int m = 0; m < 4; ++m) { bf16_t* rowp = O + (size_t)(row0 + ai * HALF + m * 16) * 1024 + col0;
#pragma unroll
                for (int bj = 0; bj < 2; ++bj) { const f32x4 v0 = acc[ai][bj][m][0], v1 = acc[ai][bj][m][1];
                    u32x4 w; w.x = cvt_pk_bf16(v0[0], v0[1]); w.y = cvt_pk_bf16(v0[2], v0[3]); w.z = cvt_pk_bf16(v1[0], v1[1]); w.w = cvt_pk_bf16(v1[2], v1[3]);
                    *(u32x4*)(rowp + bj * HALF) = w; } }
    }
};
template <class Epi, class Sched, bool ALIGN_EPI = false, bool SP2 = false>
__device__ __forceinline__ void gemm_phase(PG8_LAS unsigned char* lds, const Gemm g, const Sched& S, const Epi& E) {
    int tid_ = mk_tid(g.wv); asm volatile("" : "+v"(tid_));
    const int tid = tid_, wid = __builtin_amdgcn_readfirstlane(tid >> 6), lane = tid & 63, wr = wid >> 2, wc = wid & 3, fr = lane & 15, fq = lane >> 4;
    const int K = g.K, nt = K / BK;
    unsigned voffA[2], voffB[2];
#pragma unroll
    for (int i = 0; i < 2; ++i) { int R, C; stage_rc(tid * 16 + i * 8192, R, C); const int Rb = Epi::PERM ? ((R & ~31) + perm32(R & 31)) : R;
        voffA[i] = (unsigned)(R * K + C) * 2u; voffB[i] = (unsigned)(Rb * K + C) * 2u; }
    const size_t kstep = (size_t)(BK * 2);
    const size_t hstep = (size_t)HALF * K * 2;
    const size_t tstep = 2 * hstep;
    const unsigned ldsw = (unsigned)wid * 1024u;
    const int aoff = lds_byte(wr * 64 + fr, fq * 8), boff = lds_byte(wc * 32 + fr, fq * 8);
#define PG8_SA(b, h) (((b) * 2 + (h)) * HTB)
#define PG8_SB(b, h) ((4 + (b) * 2 + (h)) * HTB)
#define PG8_STAGE(bufoff, gbase, voff) do { _Pragma("unroll") for (int _i = 0; _i < 2; ++_i) \
        __builtin_amdgcn_global_load_lds((const unsigned*)((const char*)(gbase) + (voff)[_i]), (PG8_LAS unsigned*)(lds + (bufoff) + ldsw + _i * 8192), 16, 0, 0); } while (0)
#define PG8_STAGE_A(bufoff, gbase, hh, NX) do { if constexpr (Sched::GATHER) { const unsigned _o[2] = {((NX) && last) ? ngvo[hh][0] : gvo[hh][0], ((NX) && last) ? ngvo[hh][1] : gvo[hh][1]}; PG8_STAGE(bufoff, gbase, _o); } \
        else { PG8_STAGE(bufoff, (gbase) + ((hh) ? hstep : 0), voffA); } } while (0)
#define PG8_LDA(dst, b, h) do { _Pragma("unroll") for (int m = 0; m < 4; ++m) _Pragma("unroll") for (int k = 0; k < 2; ++k) dst[m][k] = *(const PG8_LAS bf16x8*)(lds + PG8_SA(b, h) + aoff + m * 2048 + k * 1024); } while (0)
#define PG8_LDB(dst, b, h) do { _Pragma("unroll") for (int n = 0; n < 2; ++n) _Pragma("unroll") for (int k = 0; k < 2; ++k) dst[n][k] = *(const PG8_LAS bf16x8*)(lds + PG8_SB(b, h) + boff + n * 2048 + k * 1024); } while (0)
#define PG8_MMA(ai, bj, At, Bt) do { __builtin_amdgcn_s_setprio(1); _Pragma("unroll") for (int m = 0; m < 4; ++m) _Pragma("unroll") for (int n = 0; n < 2; ++n) _Pragma("unroll") for (int k = 0; k < 2; ++k) \
        acc[ai][bj][m][n] = __builtin_amdgcn_mfma_f32_16x16x32_bf16(Bt[n][k], At[m][k], acc[ai][bj][m][n], 0, 0, 0); __builtin_amdgcn_s_setprio(0); } while (0)
#define PG8_WAIT_V(n) asm volatile("s_waitcnt vmcnt(" #n ")" ::: "memory")
#define PG8_WAIT_L(n) asm volatile("s_waitcnt lgkmcnt(" #n ")" ::: "memory")
#define PG8_BAR __builtin_amdgcn_s_barrier()
#define PG8_SCHED __builtin_amdgcn_sched_barrier(0)
    Unit cur, nxt; int ui = 0;
    if (!S.next(0, cur)) return;
    f32x4 acc[2][2][4][2];
#pragma unroll
    for (int a = 0; a < 2; ++a)
#pragma unroll
        for (int b = 0; b < 2; ++b)
#pragma unroll
            for (int m = 0; m < 4; ++m)
#pragma unroll
                for (int n = 0; n < 2; ++n) acc[a][b][m][n] = (f32x4){0.f, 0.f, 0.f, 0.f};
    bf16x8 At[4][2], B0[2][2], B1[2][2];
    const char* cA = (const char*)g.A + (Sched::GATHER ? (size_t)0 : (size_t)cur.pm * tstep); const char* cB = (const char*)g.Bt + (size_t)cur.pn * tstep + S.boff(cur);
    unsigned gvo[2][2] = {{0u, 0u}, {0u, 0u}}, ngvo[2][2] = {{0u, 0u}, {0u, 0u}}; const bool last = false;
    if constexpr (Sched::GATHER) {
#pragma unroll
        for (int hh = 0; hh < 2; ++hh)
#pragma unroll
            for (int i = 0; i < 2; ++i) { int R, C; stage_rc(tid * 16 + i * 8192, R, C); gvo[hh][i] = (unsigned)(S.arow(cur, hh * HALF + R) * K + C) * 2u; } }
    S.a_ready(cur);
    if constexpr (SP2) {
        PG8_STAGE(PG8_SB(0, 0), cB, voffB); PG8_STAGE(PG8_SB(0, 1), cB + hstep, voffB); PG8_STAGE_A(PG8_SA(0, 0), cA, 0, 0); PG8_STAGE_A(PG8_SA(0, 1), cA, 1, 0);
        if (wr == 1) PG8_BAR;
        PG8_WAIT_V(2); PG8_BAR;
        PG8_STAGE(PG8_SB(1, 0), cB + kstep, voffB); PG8_STAGE_A(PG8_SA(1, 0), cA + kstep, 0, 0); PG8_STAGE(PG8_SB(1, 1), cB + hstep + kstep, voffB);
        PG8_WAIT_V(6); PG8_BAR;
    } else {
        PG8_STAGE(PG8_SB(0, 0), cB, voffB); PG8_STAGE_A(PG8_SA(0, 0), cA, 0, 0); PG8_STAGE(PG8_SB(0, 1), cB + hstep, voffB); PG8_STAGE_A(PG8_SA(0, 1), cA, 1, 0);
        if (wr == 1) PG8_BAR;
        PG8_WAIT_V(4); PG8_BAR;
        PG8_STAGE(PG8_SB(1, 0), cB + kstep, voffB); PG8_STAGE_A(PG8_SA(1, 0), cA + kstep, 0, 0); PG8_STAGE(PG8_SB(1, 1), cB + hstep + kstep, voffB);
        PG8_WAIT_V(6); PG8_BAR;
    }
    for (;;) {
        const bool has_next = S.next(ui + 1, nxt);
        const char* nA = (has_next && !Sched::GATHER) ? (const char*)g.A + (size_t)nxt.pm * tstep : cA; const char* nB = has_next ? (const char*)g.Bt + (size_t)nxt.pn * tstep + S.boff(nxt) : cB;
        if constexpr (Sched::GATHER) {
#pragma unroll
            for (int hh = 0; hh < 2; ++hh)
#pragma unroll
                for (int i = 0; i < 2; ++i) { int R, C; stage_rc(tid * 16 + i * 8192, R, C); ngvo[hh][i] = has_next ? (unsigned)(S.arow(nxt, hh * HALF + R) * K + C) * 2u : gvo[hh][i]; } }
        for (int t = 0; t < nt; t += 2) {
            const bool last = (t == nt - 2);
            const char* a1 = cA + (size_t)(t + 1) * kstep;
            const char* a2 = last ? nA : cA + (size_t)(t + 2) * kstep; const char* b2 = last ? nB : cB + (size_t)(t + 2) * kstep;
            const char* a3 = a2 + kstep; const char* b3 = b2 + kstep;
            if (last && has_next) S.a_ready(nxt);
            if constexpr (SP2) {
            PG8_LDB(B0, 0, 0); PG8_LDB(B1, 0, 1); PG8_SCHED; PG8_LDA(At, 0, 0); PG8_STAGE_A(PG8_SA(1, 1), a1, 1, 0);
            PG8_WAIT_V(8); PG8_WAIT_L(0); PG8_BAR; PG8_MMA(0, 0, At, B0); PG8_MMA(0, 1, At, B1); PG8_BAR; PG8_SCHED;
            PG8_LDA(At, 0, 1); PG8_STAGE(PG8_SB(0, 0), b2, voffB); PG8_STAGE(PG8_SB(0, 1), b2 + hstep, voffB); PG8_STAGE_A(PG8_SA(0, 0), a2, 0, 1);
            PG8_WAIT_V(8); PG8_WAIT_L(0); PG8_BAR; PG8_MMA(1, 0, At, B0); PG8_MMA(1, 1, At, B1); PG8_BAR; PG8_SCHED;
            PG8_LDB(B0, 1, 0); PG8_LDB(B1, 1, 1); PG8_SCHED; PG8_LDA(At, 1, 0); PG8_STAGE_A(PG8_SA(0, 1), a2, 1, 1);
            PG8_WAIT_V(8); PG8_WAIT_L(0); PG8_BAR; PG8_MMA(0, 0, At, B0); PG8_MMA(0, 1, At, B1); PG8_BAR; PG8_SCHED;
            PG8_LDA(At, 1, 1); PG8_STAGE(PG8_SB(1, 0), b3, voffB); PG8_STAGE(PG8_SB(1, 1), b3 + hstep, voffB); PG8_STAGE_A(PG8_SA(1, 0), a3, 0, 1);
            PG8_WAIT_V(8); PG8_WAIT_L(0); PG8_BAR; PG8_MMA(1, 0, At, B0); PG8_MMA(1, 1, At, B1); PG8_BAR; PG8_SCHED;
            } else {
            PG8_LDB(B0, 0, 0); PG8_SCHED; PG8_LDA(At, 0, 0); PG8_STAGE_A(PG8_SA(1, 1), a1, 1, 0);
            PG8_WAIT_L(8); PG8_BAR; PG8_WAIT_L(0); PG8_MMA(0, 0, At, B0); PG8_BAR; PG8_SCHED;
            PG8_LDB(B1, 0, 1); PG8_STAGE(PG8_SB(0, 0), b2, voffB);
            PG8_BAR; PG8_WAIT_L(0); PG8_MMA(0, 1, At, B1); PG8_BAR;
            PG8_LDA(At, 0, 1); PG8_STAGE_A(PG8_SA(0, 0), a2, 0, 1);
            PG8_BAR; PG8_WAIT_L(0); PG8_MMA(1, 0, At, B0); PG8_BAR; PG8_SCHED;
            PG8_STAGE(PG8_SB(0, 1), b2 + hstep, voffB);
            PG8_WAIT_V(6); PG8_BAR; PG8_MMA(1, 1, At, B1); PG8_BAR;
            PG8_LDB(B0, 1, 0); PG8_SCHED; PG8_LDA(At, 1, 0); PG8_STAGE_A(PG8_SA(0, 1), a2, 1, 1);
            PG8_WAIT_L(8); PG8_BAR; PG8_WAIT_L(0); PG8_MMA(0, 0, At, B0); PG8_BAR; PG8_SCHED;
            PG8_LDB(B1, 1, 1); PG8_STAGE(PG8_SB(1, 0), b3, voffB);
            PG8_BAR; PG8_WAIT_L(0); PG8_MMA(0, 1, At, B1); PG8_BAR;
            PG8_LDA(At, 1, 1); PG8_STAGE_A(PG8_SA(1, 0), a3, 0, 1);
            PG8_BAR; PG8_WAIT_L(0); PG8_MMA(1, 0, At, B0); PG8_BAR; PG8_SCHED;
            PG8_STAGE(PG8_SB(1, 1), b3 + hstep, voffB);
            PG8_WAIT_V(6); PG8_BAR; PG8_MMA(1, 1, At, B1); PG8_BAR;
            }
        }
        if constexpr (ALIGN_EPI) { if (wr == 0) PG8_BAR; }
        if constexpr (!Epi::AFTER_DRAIN) { E(acc, cur, wr, wc, fr, fq); S.done(cur); }
        if (!has_next) break;
#pragma unroll
        for (int a = 0; a < 2; ++a)
#pragma unroll
            for (int b = 0; b < 2; ++b)
#pragma unroll
                for (int m = 0; m < 4; ++m)
#pragma unroll
                    for (int n = 0; n < 2; ++n) acc[a][b][m][n] = (f32x4){0.f, 0.f, 0.f, 0.f};
        cur = nxt; cA = nA; cB = nB; ++ui;
        if constexpr (Sched::GATHER) { gvo[0][0] = ngvo[0][0]; gvo[0][1] = ngvo[0][1]; gvo[1][0] = ngvo[1][0]; gvo[1][1] = ngvo[1][1]; }
        if constexpr (ALIGN_EPI) { if (wr == 1) PG8_BAR; }
    }
    PG8_WAIT_V(0);
    if constexpr (!ALIGN_EPI) { if (wr == 0) PG8_BAR; }
    PG8_BAR;
    if constexpr (Epi::AFTER_DRAIN) { E.fused(acc, cur, wr, wc, fr, fq, lds, wid, lane); S.done(cur); }
#undef PG8_SA
#undef PG8_SB
#undef PG8_STAGE
#undef PG8_STAGE_A
#undef PG8_LDA
#undef PG8_LDB
#undef PG8_MMA
#undef PG8_WAIT_V
#undef PG8_WAIT_L
#undef PG8_BAR
#undef PG8_SCHED
}
}
#define GAS __attribute__((address_space(1)))
#define LAS __attribute__((address_space(3)))
typedef unsigned short bf16;
typedef unsigned v4u __attribute__((ext_vector_type(4)));
typedef float f32x4 __attribute__((ext_vector_type(4)));
typedef short bf16x8 __attribute__((ext_vector_type(8)));
typedef GAS unsigned gu32;
typedef GAS unsigned long long gu64;
#define RLX_AGENT __ATOMIC_RELAXED, __HIP_MEMORY_SCOPE_AGENT
#define LDS_WAIT() asm volatile("s_waitcnt lgkmcnt(0)" ::: "memory")
#define VM_WAIT() asm volatile("s_waitcnt vmcnt(0)" ::: "memory")
__device__ __forceinline__ unsigned long long rt() { return __builtin_amdgcn_s_memrealtime(); }
__device__ __forceinline__ unsigned f2bf(float f) { unsigned u = __builtin_bit_cast(unsigned, f); return (u + 0x7fffu + ((u >> 16) & 1u)) >> 16; }
__device__ __forceinline__ unsigned pk2(float lo, float hi) { return f2bf(lo) | (f2bf(hi) << 16); }

#define XB_TMO      128
#define XB_XCNT(j)  (256  + 64 * (j))
#define XB_XSUB(j)  (1280 + 64 * (j))
#define XB_XGEN(j)  (2304 + 64 * (j))
#define XB_TOP      3328
#define XB_TOPGEN   3392
#define XCD_BAR_WORDS 3456
#define XB_SPIN_CAP (1u << 18)

__device__ __forceinline__ unsigned xb_ld(unsigned* p)              { return __hip_atomic_load(p, __ATOMIC_RELAXED, __HIP_MEMORY_SCOPE_AGENT); }
__device__ __forceinline__ unsigned xb_add(unsigned* p, unsigned v) { return __hip_atomic_fetch_add(p, v, __ATOMIC_RELAXED, __HIP_MEMORY_SCOPE_AGENT); }
__device__ __forceinline__ unsigned xb_xcc_id() { return (unsigned)__builtin_amdgcn_s_getreg((3 << 11) | 20) & 0xFu; }
#define XB_SPIN(cond, bar) do { unsigned _sp = 0; while (cond) { __builtin_amdgcn_s_sleep(1); \
    if ((++_sp & 255u) == 0u) { if (xb_ld(&(bar)[XB_TMO])) break; if (_sp > XB_SPIN_CAP) { atomicAdd(&(bar)[XB_TMO], 1u); break; } } } } while (0)

struct XcdBarrier {
    int wv;
    unsigned* bar; unsigned x;
    volatile LAS unsigned* st;
};

__device__ __forceinline__ XcdBarrier xcd_barrier_post(unsigned* bar, volatile LAS unsigned* st, int wv) {
    XcdBarrier b; b.bar = bar; b.x = xb_xcc_id(); b.st = st; b.wv = wv;
    if (mk_tid(wv) == 0) (void)xb_add(&bar[XB_XCNT(b.x)], 1u);
    return b;
}
__device__ __forceinline__ void xcd_barrier_complete(unsigned* bar, unsigned x, unsigned& nloc, unsigned& nx) {
    const unsigned G = gridDim.x * gridDim.y * gridDim.z;
    unsigned sum, cnt, mine, sp = 0u;
    for (;;) {
        sum = 0u; cnt = 0u; mine = 0u;
#pragma unroll
        for (unsigned j = 0; j < 16; ++j) { const unsigned c = xb_ld(&bar[XB_XCNT(j)]); sum += c; cnt += (c > 0u) ? 1u : 0u; mine = (j == x) ? c : mine; }
        if (sum == G) break;
        __builtin_amdgcn_s_sleep(1);
        if ((++sp & 255u) == 0u) { if (xb_ld(&bar[XB_TMO])) break; if (sp > XB_SPIN_CAP) { atomicAdd(&bar[XB_TMO], 1u); break; } }
    }
    nloc = mine > 0u ? mine : 1u; nx = cnt > 0u ? cnt : 1u;
}

__device__ __forceinline__ void xcd_barrier(const XcdBarrier& b) {
    asm volatile("s_waitcnt vmcnt(0)" ::: "memory");
    __syncthreads();
    if (mk_tid(b.wv) == 0) {
        unsigned* bar = b.bar;
        __builtin_amdgcn_s_waitcnt(0);
        unsigned nloc = b.st[0], nx = b.st[1];
        if (nloc == 0u) { xcd_barrier_complete(bar, b.x, nloc, nx); b.st[0] = nloc; b.st[1] = nx; }
        const unsigned old = xb_add(&bar[XB_XSUB(b.x)], 1u);
        const unsigned gen = old / nloc;
        if (old + 1u == (gen + 1u) * nloc) {
            __builtin_amdgcn_fence(__ATOMIC_RELEASE, "agent");
            asm volatile("s_waitcnt vmcnt(0)" ::: "memory");
            const unsigned og = xb_add(&bar[XB_TOP], 1u);
            const unsigned tg = og / nx;
            if (og + 1u == (tg + 1u) * nx) xb_add(&bar[XB_TOPGEN], 1u);
            else XB_SPIN(xb_ld(&bar[XB_TOPGEN]) == tg, bar);
            __builtin_amdgcn_fence(__ATOMIC_ACQUIRE, "agent");
            xb_add(&bar[XB_XGEN(b.x)], 1u);
            asm volatile("s_waitcnt vmcnt(0)" ::: "memory");
        } else {
            XB_SPIN(xb_ld(&bar[XB_XGEN(b.x)]) == gen, bar);
            __builtin_amdgcn_fence(__ATOMIC_ACQUIRE, "agent");
            asm volatile("s_waitcnt vmcnt(0)" ::: "memory");
        }
    }
    __syncthreads();
}
constexpr int NWAVES = 8, NT = 512;
constexpr int MT = 16384, MROW0 = MT + 112;
constexpr int BATCH = 2, SEQ = 8192, D = 1024, TB = 8320, M = BATCH * TB, PADR = 112;
constexpr int NIN = 2816, DFF = 2816, NEXP = 8, DFE = 3584;
constexpr int C_U = 0, C_HQ = 256, C_HF = 512, C_HI = 768, C_HG = 1024, C_RQ = 1280, C_RK = 1536, C_RV = 1792, C_RG = 2304;
constexpr float EPS = 1e-6f;
#ifndef PROBE_DUP
#define PROBE_DUP 0
#endif
#define REP(n) ((PROBE_DUP == (n)) ? 2 : 1)
#ifndef PROBE_TA
#define PROBE_TA -1
#define PROBE_TB -1
#endif
#ifndef PROBE_SCALE
#define PROBE_SCALE 0.01f
#endif
#ifndef PROBE_BLK
#define PROBE_BLK 200
#endif
#ifndef MK_PER_PHASE
#define MK_PER_PHASE 0
#endif
constexpr int NPH = 62;
__host__ __device__ inline bool phase_exists(int k) {
    if (k == 0 || k == NPH - 1) return true;
    const int l = (k - 1) / 30, r = (k - 1) % 30;
    if (r <= 3 || r == 6) return true;
    if (l == 0) return r == 8 || r == 9;
    return r == 7 || r == 10 || r == 12;
}
constexpr size_t MiB = 1u << 20;
constexpr size_t WS_CTL = 0, CTL_ZERO_BYTES = 1 * MiB;
constexpr int CW_TMO = 0, CW_CODE = 1, CW_BAR = 4096, CW_CNT = 16384, CW_PROBE = 16448, CW_QUEUE = 16640;
constexpr size_t WS_LB = 1 * MiB, WS_LB128 = 1 * MiB + 16384, WS_BB = 1 * MiB + 65536, WS_BBT = 1 * MiB + 393216, WS_ROT = 1 * MiB + 524288, WS_CCT = 2752512, WS_WGT = 2883584, WS_LBT = 3 * MiB;
constexpr size_t WS_POS = 3 * MiB + 65536, WS_GATE = WS_POS + 131072, WS_LIST = WS_GATE + 131072;
constexpr int MOE_CAP = 16384;
static_assert(WS_BBT + 131072 <= WS_ROT && WS_ROT + (size_t)TB * 32 * 4 <= WS_CCT && WS_CCT + 131072 <= WS_WGT && WS_WGT + 262144 <= WS_LBT && WS_LIST + 8 * MOE_CAP * 4 <= 4 * MiB, "table map");
constexpr size_t WS_WM13 = 4 * MiB, WS_YS = 4 * MiB, WS_WM2A = 116 * MiB, WS_WM2B = 182 * MiB, WS_HB = 149 * MiB, WS_SSP = 214 * MiB, WS_PROJ = 220 * MiB, WS_MIXED = 310 * MiB, WS_ACT = 220 * MiB;
constexpr size_t WS_WIN = 343 * MiB, WS_WOUT = 354 * MiB, WS_WF13 = 358 * MiB, WS_WF2 = 369 * MiB, WS_RSL = 458 * MiB, WS_END = 459 * MiB;
constexpr int MOE_TMAX = 136;
static_assert(WS_WM13 + (size_t)NEXP * 2 * DFE * D * 2 <= WS_WM2A && WS_YS + (size_t)MOE_TMAX * 256 * D * 2 <= WS_WM2A && WS_WM2A + (size_t)4 * D * DFE * 2 <= WS_HB && WS_HB + (size_t)M * D * 2 <= WS_WM2B && WS_WM2B + (size_t)4 * D * DFE * 2 <= WS_SSP, "ws map 1");
static_assert(WS_SSP + (size_t)5 * M * 16 * 4 <= WS_PROJ && WS_PROJ + (size_t)M * NIN * 2 <= WS_MIXED && WS_MIXED + (size_t)M * D * 2 <= WS_WIN, "ws map 2");
static_assert(WS_WIN + (size_t)2 * NIN * D * 2 <= WS_WOUT && WS_WOUT + (size_t)2 * D * D * 2 <= WS_WF13 && WS_WF13 + (size_t)2 * DFF * D * 2 <= WS_WF2 && WS_WF2 + (size_t)D * DFF * 2 <= WS_END, "ws map 3");
static_assert(WS_ACT + (size_t)M * DFF * 2 <= WS_MIXED && WS_ACT + (size_t)MOE_TMAX * 256 * DFE * 2 <= WS_RSL && WS_RSL + (size_t)8 * MOE_CAP * 4 <= WS_END, "ws map 4");
constexpr int RING_OFF = 0, RING_BYTES = 131072, LDSCTL_OFF = RING_BYTES, MISC_OFF = LDSCTL_OFF + 320, LDS_BYTES = 147456;

struct Frame { LAS unsigned char* lds; volatile LAS unsigned* MISC; gu32* ctl; unsigned char* ws; const float* const* in; int wave_s; };
#define STAMP(k) do { if (PROBE_TA >= 0 && blockIdx.x == PROBE_BLK && mk_tid(F.wave_s) == 0) { gu32* _p = F.ctl + CW_PROBE + (k); if (__hip_atomic_load(_p, RLX_AGENT) == 0u) __hip_atomic_store(_p, (unsigned)__builtin_amdgcn_s_memrealtime(), RLX_AGENT); } } while (0)
struct Loc { int tid, lane, wave, bx, vcu, G; };
__device__ __forceinline__ Loc make_loc(int wave_s) { Loc L; int t = mk_tid(wave_s); asm volatile("" : "+v"(t));   int b = blockIdx.x; asm volatile("" : "+s"(b)); L.tid = t; L.lane = t & 63; L.wave = __builtin_amdgcn_readfirstlane(t >> 6);
    L.bx = b; L.G = gridDim.x; L.vcu = (L.G % 8 == 0) ? (b % 8) * (L.G / 8) + b / 8 : b; return L; }
__device__ __forceinline__ float bf2f(bf16 x) { return __uint_as_float((unsigned)x << 16); }
__device__ __forceinline__ bf16 f2bf_(float f) { return (bf16)f2bf(f); }
__device__ __forceinline__ float wave_sum(float v) {
#pragma unroll
    for (int o = 1; o < 64; o <<= 1) v += __shfl_xor(v, o);
    return v;
}
__device__ __forceinline__ float silu_f(float a) { return a * __builtin_amdgcn_rcpf(1.0f + __expf(-a)); }
__device__ __forceinline__ float sigmoid_f(float a) { return __builtin_amdgcn_rcpf(1.0f + __expf(-a)); }

struct TrP { const float* W; int K, N; bf16* WT; int mode; const float* g; int item; };
constexpr int TR_LD = 257;
static_assert(64 * TR_LD * 4 <= RING_BYTES, "LDS map (transposer)");
struct TrRegs { f32x4 v[8]; float gk[8]; };
__device__ __forceinline__ void tr_wg_load(const TrP& q, int tid, TrRegs& r) {
    const int nblk = q.N / 256, kb = q.item / nblk, nb = q.item % nblk, k0 = 64 * kb, n0 = 256 * nb, wv = tid >> 6, ln = tid & 63;
#pragma unroll
    for (int i = 0; i < 8; ++i) { const int kk = 8 * i + wv; r.v[i] = *(const GAS f32x4*)(q.W + (size_t)(k0 + kk) * q.N + n0 + 4 * ln); r.gk[i] = q.g ? q.g[k0 + kk] : 1.0f; }
}
__device__ __forceinline__ void tr_wg_store(const TrP& q, LAS float* scr, int tid, TrRegs& r) {
    const int nblk = q.N / 256, kb = q.item / nblk, nb = q.item % nblk, k0 = 64 * kb, n0 = 256 * nb, wv = tid >> 6, ln = tid & 63;
    PIN8(r.v[0], r.v[1], r.v[2], r.v[3], r.v[4], r.v[5], r.v[6], r.v[7]); PIN8(r.gk[0], r.gk[1], r.gk[2], r.gk[3], r.gk[4], r.gk[5], r.gk[6], r.gk[7]);
#pragma unroll
    for (int i = 0; i < 8; ++i) { const int kk = 8 * i + wv; LAS float* d = scr + kk * TR_LD + 4 * ln; d[0] = r.v[i][0] * r.gk[i]; d[1] = r.v[i][1] * r.gk[i]; d[2] = r.v[i][2] * r.gk[i]; d[3] = r.v[i][3] * r.gk[i]; }
    __syncthreads();
    const int c = tid & 7;
#pragma unroll
    for (int j = 0; j < 4; ++j) { const int n = (tid >> 3) + 64 * j; const LAS float* s = scr + (8 * c) * TR_LD + n;
        v4u o; o.x = pk2(s[0 * TR_LD], s[1 * TR_LD]); o.y = pk2(s[2 * TR_LD], s[3 * TR_LD]); o.z = pk2(s[4 * TR_LD], s[5 * TR_LD]); o.w = pk2(s[6 * TR_LD], s[7 * TR_LD]);
        const int nn = n0 + n, drow = q.mode == 0 ? nn : ((nn >> 7) * 256 + (nn & 127) + (q.mode == 2 ? 128 : 0));
        *(GAS v4u*)(q.WT + (size_t)drow * q.K + k0 + 8 * c) = o; }
    __syncthreads();
}
__device__ __forceinline__ void tr_item_wg(const TrP& q, LAS float* scr, int tid) { TrRegs r; tr_wg_load(q, tid, r); tr_wg_store(q, scr, tid, r); }
template <class ItemFn> __device__ __forceinline__ void tr_stream(ItemFn item, int first, int last, int step, LAS float* scr, int tid) {
    if (first >= last) return;
    TrRegs ra, rb; TrP qa = item(first), qb = qa; tr_wg_load(qa, tid, ra);
    for (int it = first; it < last; it += 2 * step) {
        const bool h1 = it + step < last, h2 = it + 2 * step < last;
        if (h1) { qb = item(it + step); tr_wg_load(qb, tid, rb); }
        tr_wg_store(qa, scr, tid, ra);
        if (h2) { qa = item(it + 2 * step); tr_wg_load(qa, tid, ra); }
        if (h1) tr_wg_store(qb, scr, tid, rb);
    }
}
constexpr int I_M13 = 16 * 14, N_M13 = 16 * I_M13;
__device__ __forceinline__ TrP moe13_item(Frame& F, int it) { constexpr int I_M = I_M13; const int half = it / (8 * I_M), r = it % (8 * I_M), e = r / I_M;
    return TrP{F.in[24 + half] + (size_t)e * D * DFE, D, DFE, (bf16*)(F.ws + WS_WM13) + (size_t)e * 2 * DFE * D, 1 + half, F.in[19] + D, r % I_M}; }
__device__ __forceinline__ void conv_moe13(Frame& F, int rank, int nranks, int i0, int i1, int tid) {
    LAS float* scr = (LAS float*)(F.lds + RING_OFF);
    tr_stream([&](int it) { return moe13_item(F, it); }, i0 + rank, i1, nranks, scr, tid);
}
__device__ __forceinline__ void conv_w2(Frame& F, int rank, int nranks, int i0, int i1, int tid) {
    LAS float* scr = (LAS float*)(F.lds + RING_OFF); constexpr int I_M2 = 56 * 4;
    tr_stream([&](int it) { const int e = it / I_M2; bf16* dst = (bf16*)(F.ws + (e < 4 ? WS_WM2A : WS_WM2B)) + (size_t)(e & 3) * D * DFE;
        return TrP{F.in[26] + (size_t)e * DFE * D, DFE, D, dst, 0, nullptr, it % I_M2}; }, i0 + rank, i1, nranks, scr, tid);
}
__device__ __forceinline__ int gt0(const Loc& L) { return L.vcu * NT + L.tid; }
__device__ __forceinline__ void p0_prologue(Frame& F) {
    const Loc L = make_loc(F.wave_s);
    LAS float* scr = (LAS float*)(F.lds + RING_OFF);
    const int gw = L.vcu * NWAVES + L.wave, NGW = L.G * NWAVES;
    unsigned char* ws = F.ws; const float* const* in = F.in;
    constexpr int I_IN = 16 * 11, I_OUT = 16 * 4, I_F = 16 * 11, I_F2 = 44 * 4;
    constexpr int NITEMS = 2 * I_IN + 2 * I_OUT + 2 * I_F + I_F2;
    auto small_item = [&](int it) -> TrP { int r = it;
        if (r < 2 * I_IN) { const int l = r / I_IN; return TrP{in[3] + (size_t)l * D * NIN, D, NIN, (bf16*)(ws + WS_WIN) + (size_t)l * NIN * D, 0, in[2] + l * D, r % I_IN}; } r -= 2 * I_IN;
        if (r < 2 * I_OUT) { const int l = r / I_OUT; return TrP{in[18] + (size_t)l * D * D, D, D, (bf16*)(ws + WS_WOUT) + (size_t)l * D * D, 0, nullptr, r % I_OUT}; } r -= 2 * I_OUT;
        if (r < I_F) return TrP{in[20], D, DFF, (bf16*)(ws + WS_WF13), 1, in[19], r}; r -= I_F;
        if (r < I_F) return TrP{in[21], D, DFF, (bf16*)(ws + WS_WF13), 2, in[19], r}; r -= I_F;
        return TrP{in[22], DFF, D, (bf16*)(ws + WS_WF2), 0, nullptr, r}; };
    tr_stream(small_item, L.vcu, NITEMS, L.G, scr, L.tid);
    conv_moe13(F, L.vcu, L.G, 0, 1408, L.tid); conv_w2(F, L.vcu, L.G, 0, 792, L.tid);
    bf16* HB = (bf16*)(ws + WS_HB); float* SS0 = (float*)(ws + WS_SSP);
    for (int m = gw; m < MT + 128; m += NGW) {
        const float* src = m < MT ? in[0] + (size_t)m * D : (m < MROW0 ? nullptr : in[1] + (size_t)(m - MROW0) * D);
        f32x4 v[4]; float s = 0.f;
#pragma unroll
        for (int j = 0; j < 4; ++j) v[j] = src ? ((const GAS f32x4*)src)[L.lane + 64 * j] : (f32x4){0.f, 0.f, 0.f, 0.f};
        PIN4(v[0], v[1], v[2], v[3]);
#pragma unroll
        for (int j = 0; j < 4; ++j) s += (v[j].x * v[j].x + v[j].y * v[j].y) + (v[j].z * v[j].z + v[j].w * v[j].w);
        s = wave_sum(s);
#pragma unroll
        for (int j = 0; j < 4; ++j) ((GAS unsigned long long*)(HB + (size_t)m * D))[L.lane + 64 * j] = (unsigned long long)pk2(v[j].x, v[j].y) | ((unsigned long long)pk2(v[j].z, v[j].w) << 32);
        if (L.lane < 16) SS0[(size_t)m * 16 + L.lane] = L.lane == 0 ? s : 0.0f;
    }
    { unsigned long long* pz = (unsigned long long*)((bf16*)(ws + WS_PROJ) + (size_t)MT * NIN); for (int i = gt0(L); i < 112 * NIN / 4; i += L.G * NT) pz[i] = 0ull; }
    const int gt = L.vcu * NT + L.tid, NGT = L.G * NT;
    float* LB = (float*)(ws + WS_LB); float* BB = (float*)(ws + WS_BB); float* ROT = (float*)(ws + WS_ROT); float* LBT = (float*)(ws + WS_LBT);
    for (int i = gt; i < 2048; i += NGT) {
        const int lg = i >> 6; const float step = expf(in[11][lg]); const float lre = in[4][i], lim = in[5][i];
        const float mag = expf(lre * step); float sn, cs; sincosf(lim * step, &sn, &cs); const float br = mag * cs, bi = mag * sn;
        const float den = 1.0f / (lre * lre + lim * lim), cr = ((br - 1.0f) * lre + bi * lim) * den, ci = (bi * lre - (br - 1.0f) * lim) * den;
        LB[2 * i] = br; LB[2 * i + 1] = bi;
        for (int h = 0; h < 16; ++h) { const float b_r = in[6][i * 16 + h], b_i = in[7][i * 16 + h]; BB[(i * 16 + h) * 2] = cr * b_r - ci * b_i; BB[(i * 16 + h) * 2 + 1] = cr * b_i + ci * b_r; }
    }
    { bf16* BBT = (bf16*)(ws + WS_BBT); bf16* CCT = (bf16*)(ws + WS_CCT); bf16* WGT = (bf16*)(ws + WS_WGT); float* LB128 = (float*)(ws + WS_LB128);
      for (int i = gt; i < 2048; i += NGT) { const int lg = i >> 6, p = i & 63; const float step = expf(in[11][lg]), lre = in[4][i], lim = in[5][i];
          const float mag = expf(64.0f * lre * step); float sn, cs; sincosf(64.0f * (lim * step), &sn, &cs); LB128[2 * i] = mag * cs; LB128[2 * i + 1] = mag * sn;
          const float m1 = expf(lre * step); float s1, c1; sincosf(lim * step, &s1, &c1); const float br = m1 * c1, bi = m1 * s1, den = 1.0f / (lre * lre + lim * lim), cr = ((br - 1.0f) * lre + bi * lim) * den, ci = (bi * lre - (br - 1.0f) * lim) * den;
          for (int h = 0; h < 16; ++h) { const float b_r = in[6][i * 16 + h], b_i = in[7][i * 16 + h]; BBT[((size_t)lg * 128 + p) * 16 + h] = f2bf_(cr * b_r - ci * b_i); BBT[((size_t)lg * 128 + 64 + p) * 16 + h] = f2bf_(cr * b_i + ci * b_r);
              CCT[((size_t)lg * 16 + h) * 128 + 2 * p] = f2bf_(in[8][(lg * 16 + h) * 64 + p]); CCT[((size_t)lg * 16 + h) * 128 + 2 * p + 1] = f2bf_(-in[9][(lg * 16 + h) * 64 + p]); } }
      for (int i = gt; i < 2 * 65536; i += NGT) { const int l = i >> 16, n = (i >> 8) & 255, k = i & 255; WGT[i] = f2bf_(in[12][(size_t)l * 65536 + k * 256 + n]); } }
    for (int i = gt; i < TB * 16; i += NGT) { const int t = i >> 4, f = i & 15; const float pos = (float)(t - PADR), inv = powf(10000.0f, -(float)f / 16.0f); float sn, cs; sincosf(pos * inv, &sn, &cs); ROT[2 * i] = cs; ROT[2 * i + 1] = sn; }
    for (int i = gt; i < 512; i += NGT) { const int l = i >> 8, c = i & 255; float lb = 0.f; if (l == 1) { const float a0 = in[15][c], a1 = in[15][256 + c], mx = fmaxf(a0, a1), e0 = expf(a0 - mx), e1 = expf(a1 - mx); lb = e1 / (e0 + e1); } LBT[i] = lb; }
}

__device__ __forceinline__ float gelu_tanh(float y) { const float x = 0.7978845608028654f * (y + 0.044715f * y * y * y); const float th = 1.0f - 2.0f * __builtin_amdgcn_rcpf(1.0f + __expf(2.0f * x)); return 0.5f * y * (1.0f + th); }
__device__ __forceinline__ int chunk_row0(int b, int c) { return c == 0 ? MT : b * SEQ + (c - 1) * 128; }
__device__ __forceinline__ int s5_row0(int b, int c5) { return c5 < 2 ? MT + 64 * c5 : b * SEQ + (c5 - 2) * 64; }
typedef unsigned u32x4_t __attribute__((ext_vector_type(4)));
__device__ __forceinline__ f32x4 mfma16(bf16x8 a, bf16x8 b, f32x4 c) { return __builtin_amdgcn_mfma_f32_16x16x32_bf16(a, b, c, 0, 0, 0); }
__device__ __forceinline__ unsigned cvtpk(float lo, float hi) { unsigned r; asm volatile("v_cvt_pk_bf16_f32 %0, %1, %2" : "=v"(r) : "v"(lo), "v"(hi)); return r; }
__device__ __forceinline__ bf16x8 pack8(f32x4 a, f32x4 b) { u32x4_t w; w.x = cvtpk(a[0], a[1]); w.y = cvtpk(a[2], a[3]); w.z = cvtpk(b[0], b[1]); w.w = cvtpk(b[2], b[3]); return __builtin_bit_cast(bf16x8, w); }
__device__ __forceinline__ int perm_pos(int j) { return (j & ~31) + 8 * ((j >> 2) & 3) + 4 * ((j >> 4) & 1) + (j & 3); }
constexpr int NCH = TB / 128;
constexpr size_t OUT_RST = 0, OUT_HST = 9 * MiB, OUT_HDK = 18 * MiB, OUT_S5X = 19 * MiB;
__device__ __forceinline__ void ma_ret_unit(Frame& F, const Loc& L, int b, int c, int h, float* outb) {
    LAS bf16* Vt = (LAS bf16*)F.lds; LAS bf16* Kt = Vt + 64 * 136;
    const bf16* P = (const bf16*)(F.ws + WS_PROJ) + (size_t)chunk_row0(b, c) * NIN; const float* ROT = (const float*)(F.ws + WS_ROT) + (size_t)c * 128 * 32;
    const float lg = __log2f(1.0f - exp2f(-5.0f - (float)h));
    STAMP(5);
    { const int ch = L.tid & 63, seg = L.tid >> 6; const bf16* pv = P + (size_t)(16 * seg) * NIN + C_RV + h * 64 + ch; unsigned x[16];
#pragma unroll
      for (int r = 0; r < 16; ++r) x[r] = pv[(size_t)r * NIN];
      PIN16(x);
      u32x4_t w0, w1; w0.x = x[0] | ((unsigned)x[1] << 16); w0.y = x[2] | ((unsigned)x[3] << 16); w0.z = x[4] | ((unsigned)x[5] << 16); w0.w = x[6] | ((unsigned)x[7] << 16);
      w1.x = x[8] | ((unsigned)x[9] << 16); w1.y = x[10] | ((unsigned)x[11] << 16); w1.z = x[12] | ((unsigned)x[13] << 16); w1.w = x[14] | ((unsigned)x[15] << 16);
      *(LAS u32x4_t*)(Vt + ch * 136 + 16 * seg) = w0; *(LAS u32x4_t*)(Vt + ch * 136 + 16 * seg + 8) = w1; }
    if (L.tid < 128) { const int i = L.tid & 15, seg = L.tid >> 4; const bf16* pk = P + (size_t)(16 * seg) * NIN + C_RK + h * 32 + i; const float* rp = ROT + (16 * seg * 16 + i) * 2; float ka[16], kb[16];
      unsigned x1[16], x2[16]; float crc[16], crs[16];
#pragma unroll
      for (int r = 0; r < 16; ++r) { x1[r] = pk[(size_t)r * NIN]; x2[r] = pk[(size_t)r * NIN + 16]; const float2 t = *(const float2*)(rp + r * 32); crc[r] = t.x; crs[r] = t.y; }
      PIN16(x1); PIN16(x2); PIN16(crc); PIN16(crs);
#pragma unroll
      for (int r = 0; r < 16; ++r) { const float k1 = __uint_as_float(x1[r] << 16), k2 = __uint_as_float(x2[r] << 16), cs = crc[r], sn = crs[r], w = __builtin_amdgcn_exp2f((float)(127 - 16 * seg - r) * lg);
          ka[r] = (k1 * cs - k2 * sn) * w; kb[r] = (k1 * sn + k2 * cs) * w; }
      u32x4_t w0, w1; w0.x = cvtpk(ka[0], ka[1]); w0.y = cvtpk(ka[2], ka[3]); w0.z = cvtpk(ka[4], ka[5]); w0.w = cvtpk(ka[6], ka[7]); w1.x = cvtpk(ka[8], ka[9]); w1.y = cvtpk(ka[10], ka[11]); w1.z = cvtpk(ka[12], ka[13]); w1.w = cvtpk(ka[14], ka[15]);
      *(LAS u32x4_t*)(Kt + i * 136 + 16 * seg) = w0; *(LAS u32x4_t*)(Kt + i * 136 + 16 * seg + 8) = w1;
      w0.x = cvtpk(kb[0], kb[1]); w0.y = cvtpk(kb[2], kb[3]); w0.z = cvtpk(kb[4], kb[5]); w0.w = cvtpk(kb[6], kb[7]); w1.x = cvtpk(kb[8], kb[9]); w1.y = cvtpk(kb[10], kb[11]); w1.z = cvtpk(kb[12], kb[13]); w1.w = cvtpk(kb[14], kb[15]);
      *(LAS u32x4_t*)(Kt + (16 + i) * 136 + 16 * seg) = w0; *(LAS u32x4_t*)(Kt + (16 + i) * 136 + 16 * seg + 8) = w1; }
    STAMP(6);
    __syncthreads();
    { const int il = L.lane & 15, g = L.lane >> 4, ft = L.wave & 1, vt = L.wave >> 1; f32x4 acc = {0.f, 0.f, 0.f, 0.f};
#pragma unroll
      for (int ks = 0; ks < 4; ++ks) { const bf16x8 A = *(const LAS bf16x8*)(Kt + (16 * ft + il) * 136 + 32 * ks + 8 * g), B = *(const LAS bf16x8*)(Vt + (16 * vt + il) * 136 + 32 * ks + 8 * g); acc = mfma16(A, B, acc); }
      float* S = (float*)((unsigned char*)outb + OUT_RST) + (size_t)((b * NCH + c) * 8 + h) * 2048;
#pragma unroll
      for (int r = 0; r < 4; ++r) S[(16 * ft + 4 * g + r) * 64 + 16 * vt + il] = acc[r]; }
    __syncthreads();
    STAMP(7);
}
__device__ __forceinline__ void mb_ret(const Loc& L, float* outb, int e) {
    { const int b = e >> 14, h = (e >> 11) & 7, idx = e & 2047; const float d = exp2f(128.0f * __log2f(1.0f - exp2f(-5.0f - (float)h)));
        float* p = (float*)((unsigned char*)outb + OUT_RST) + (size_t)(b * NCH * 8 + h) * 2048 + idx; float s = 0.f;
        float loc[NCH];
#pragma unroll
        for (int c = 0; c < NCH; ++c) loc[c] = p[(size_t)c * 8 * 2048];
        PIN16(loc); PIN16O(loc, 16); PIN16O(loc, 32); PIN16O(loc, 48); asm volatile("" : "+v"(loc[64]) :: "memory");
        asm volatile("" : "+v"(p));
#pragma unroll
        for (int c = 0; c < NCH; ++c) { p[(size_t)c * 8 * 2048] = s; s = d * s + loc[c]; } }
}
__device__ __forceinline__ void mc_ret_unit(Frame& F, const Loc& L, int l, int b, int c, int h, const float* outb) {
    LAS bf16* Qrm = (LAS bf16*)F.lds; LAS bf16* Krm = Qrm + 4096; LAS bf16* Vt = Krm + 4096; LAS bf16* SpT = Vt + 64 * 136;
    const size_t row0 = (size_t)chunk_row0(b, c); const bf16* P = (const bf16*)(F.ws + WS_PROJ) + row0 * NIN; const float* ROT = (const float*)(F.ws + WS_ROT) + (size_t)c * 128 * 32;
    const float gamma = 1.0f - exp2f(-5.0f - (float)h), lg = __log2f(gamma);
    { const int r = L.tid >> 2, pq = L.tid & 3; const bf16* pr = P + (size_t)r * NIN; const f32x4 r0 = *(const f32x4*)(ROT + (r * 16 + 4 * pq) * 2), r1 = *(const f32x4*)(ROT + (r * 16 + 4 * pq) * 2 + 4);
      const float cs[4] = {r0[0], r0[2], r1[0], r1[2]}, sn[4] = {r0[1], r0[3], r1[1], r1[3]};
      const float wq = 0.17677669529663687f * exp2f((float)r * lg), wk = exp2f(-(float)r * lg);
      const unsigned long long q1 = *(const GAS unsigned long long*)(pr + C_RQ + h * 32 + 4 * pq), q2 = *(const GAS unsigned long long*)(pr + C_RQ + h * 32 + 16 + 4 * pq);
      const unsigned long long k1 = *(const GAS unsigned long long*)(pr + C_RK + h * 32 + 4 * pq), k2 = *(const GAS unsigned long long*)(pr + C_RK + h * 32 + 16 + 4 * pq);
      const int vq = 16 * pq, pj = perm_pos(r); v4u va = *(const GAS v4u*)(pr + C_RV + h * 64 + vq), vb = *(const GAS v4u*)(pr + C_RV + h * 64 + vq + 8);
      const int ksp = L.tid >> 4, v4 = (L.tid & 15) * 4; f32x4 sp = *(const f32x4*)((const float*)((const unsigned char*)outb + OUT_RST) + (size_t)((b * NCH + c) * 8 + h) * 2048 + ksp * 64 + v4);
      { unsigned long long q1_ = q1, q2_ = q2, k1_ = k1, k2_ = k2; asm volatile("" : "+v"(q1_), "+v"(q2_), "+v"(k1_), "+v"(k2_), "+v"(va), "+v"(vb), "+v"(sp) :: "memory"); (void)q1_; }
      float qa[4], qb[4], ka[4], kb[4];
#pragma unroll
      for (int e = 0; e < 4; ++e) { const float a1 = bf2f((bf16)(q1 >> (16 * e))), a2 = bf2f((bf16)(q2 >> (16 * e))), b1 = bf2f((bf16)(k1 >> (16 * e))), b2 = bf2f((bf16)(k2 >> (16 * e)));
          qa[e] = (a1 * cs[e] - a2 * sn[e]) * wq; qb[e] = (a1 * sn[e] + a2 * cs[e]) * wq; ka[e] = (b1 * cs[e] - b2 * sn[e]) * wk; kb[e] = (b1 * sn[e] + b2 * cs[e]) * wk; }
      *(LAS unsigned long long*)(Qrm + r * 32 + 4 * pq) = (unsigned long long)cvtpk(qa[0], qa[1]) | ((unsigned long long)cvtpk(qa[2], qa[3]) << 32);
      *(LAS unsigned long long*)(Qrm + r * 32 + 16 + 4 * pq) = (unsigned long long)cvtpk(qb[0], qb[1]) | ((unsigned long long)cvtpk(qb[2], qb[3]) << 32);
      *(LAS unsigned long long*)(Krm + r * 32 + 4 * pq) = (unsigned long long)cvtpk(ka[0], ka[1]) | ((unsigned long long)cvtpk(ka[2], ka[3]) << 32);
      *(LAS unsigned long long*)(Krm + r * 32 + 16 + 4 * pq) = (unsigned long long)cvtpk(kb[0], kb[1]) | ((unsigned long long)cvtpk(kb[2], kb[3]) << 32);
#pragma unroll
      for (int e = 0; e < 4; ++e) { Vt[(vq + 2 * e) * 136 + pj] = (bf16)(va[e] & 0xffffu); Vt[(vq + 2 * e + 1) * 136 + pj] = (bf16)(va[e] >> 16);
          Vt[(vq + 8 + 2 * e) * 136 + pj] = (bf16)(vb[e] & 0xffffu); Vt[(vq + 8 + 2 * e + 1) * 136 + pj] = (bf16)(vb[e] >> 16); }
#pragma unroll
      for (int e = 0; e < 4; ++e) SpT[(v4 + e) * 40 + ksp] = f2bf_(gamma * sp[e]);
    }
    __syncthreads();
    const int w = L.wave, il = L.lane & 15, g = L.lane >> 4;
    const size_t row = row0 + 16 * w + il; const bf16* gp = (const bf16*)(F.ws + WS_PROJ) + row * NIN + C_RG + h * 64; const float* og = F.in[17] + l * 512 + h * 64;
    unsigned long long gg4[4]; f32x4 og4[4];
#pragma unroll
    for (int vt = 0; vt < 4; ++vt) { gg4[vt] = *(const GAS unsigned long long*)(gp + 16 * vt + 4 * g); og4[vt] = *(const f32x4*)(og + 16 * vt + 4 * g); }
    const bf16x8 Bq = *(const LAS bf16x8*)(Qrm + (16 * w + il) * 32 + 8 * g);
    const f32x4 zero = {0.f, 0.f, 0.f, 0.f}; f32x4 O[4] = {zero, zero, zero, zero};
#pragma unroll
    for (int jp = 0; jp < 4; ++jp) if (2 * jp <= w) {
        f32x4 p0, p1 = zero;
        { const bf16x8 A = *(const LAS bf16x8*)(Krm + (32 * jp + il) * 32 + 8 * g); p0 = mfma16(A, Bq, zero);
          if (2 * jp == w) {
#pragma unroll
              for (int r = 0; r < 4; ++r) if (4 * g + r > il) p0[r] = 0.f; } }
        if (2 * jp + 1 <= w) { const bf16x8 A = *(const LAS bf16x8*)(Krm + (32 * jp + 16 + il) * 32 + 8 * g); p1 = mfma16(A, Bq, zero);
          if (2 * jp + 1 == w) {
#pragma unroll
              for (int r = 0; r < 4; ++r) if (4 * g + r > il) p1[r] = 0.f; } }
        const bf16x8 Bp = pack8(p0, p1);
#pragma unroll
        for (int vt = 0; vt < 4; ++vt) { const bf16x8 A = *(const LAS bf16x8*)(Vt + (16 * vt + il) * 136 + 32 * jp + 8 * g); O[vt] = mfma16(A, Bp, O[vt]); }
    }
#pragma unroll
    for (int vt = 0; vt < 4; ++vt) { const bf16x8 A = *(const LAS bf16x8*)(SpT + (16 * vt + il) * 40 + 8 * g); O[vt] = mfma16(A, Bq, O[vt]); }
    float s1 = 0.f;
#pragma unroll
    for (int vt = 0; vt < 4; ++vt) s1 += (O[vt][0] + O[vt][1]) + (O[vt][2] + O[vt][3]);
    s1 += __shfl_xor(s1, 16); s1 += __shfl_xor(s1, 32); const float mean = s1 * (1.0f / 64.0f); float s2 = 0.f;
#pragma unroll
    for (int vt = 0; vt < 4; ++vt) { O[vt] = O[vt] - mean; s2 += (O[vt][0] * O[vt][0] + O[vt][1] * O[vt][1]) + (O[vt][2] * O[vt][2] + O[vt][3] * O[vt][3]); }
    s2 += __shfl_xor(s2, 16); s2 += __shfl_xor(s2, 32); const float rstd = rsqrtf(s2 * (1.0f / 64.0f) + EPS);
    bf16* mo = (bf16*)(F.ws + WS_MIXED) + row * D + 512 + h * 64;
#pragma unroll
    for (int vt = 0; vt < 4; ++vt) { const int v0 = 16 * vt + 4 * g; const unsigned long long gg = gg4[vt]; const f32x4 o4 = og4[vt]; float y[4];
#pragma unroll
        for (int r = 0; r < 4; ++r) y[r] = O[vt][r] * rstd * o4[r] * silu_f(bf2f((bf16)(gg >> (16 * r))));
        *(GAS unsigned long long*)(mo + v0) = (unsigned long long)cvtpk(y[0], y[1]) | ((unsigned long long)cvtpk(y[2], y[3]) << 32); }
    __syncthreads();
}
constexpr int HG_LD = 68;
constexpr int SEG_OFF = MISC_OFF + 192;
static_assert(SEG_OFF % 16 == 0 && SEG_OFF + 2048 <= LDS_BYTES, "LDS map (SEG)");
__device__ __forceinline__ const bf16* hg_hist(const bf16* PROJ, int b, int c, int w) {
    if (w > 0) return PROJ + (size_t)(chunk_row0(b, c) + 16 * w - 3) * NIN;
    if (c == 0) return nullptr;
    return PROJ + (size_t)(chunk_row0(b, c - 1) + 125) * NIN;
}
template <bool NEED_Q> __device__ __forceinline__ void hg_rows(const bf16* Pcur, const bf16* Ph, int ch, const float* cw, float lb, float (&q)[16], float (&kk)[16], float (&vv)[16], float (&gl)[16]) {
    float wq[4], wf[4], wi[4];
#pragma unroll
    for (int j = 0; j < 4; ++j) { wq[j] = cw[j * 768 + ch]; wf[j] = cw[j * 768 + 256 + ch]; wi[j] = cw[j * 768 + 512 + ch]; }
    unsigned hq0[3] = {0u, 0u, 0u}, hf0[3] = {0u, 0u, 0u}, hi0[3] = {0u, 0u, 0u}, rq[16], rf[16], ri[16];
#pragma unroll
    for (int j = 0; j < 3; ++j) { if (Ph) { const bf16* pr = Ph + (size_t)j * NIN; if (NEED_Q) hq0[j] = pr[C_HQ + ch]; hf0[j] = pr[C_HF + ch]; hi0[j] = pr[C_HI + ch]; } }
#pragma unroll
    for (int r = 0; r < 16; ++r) { const bf16* pr = Pcur + (size_t)r * NIN; rq[r] = NEED_Q ? (unsigned)pr[C_HQ + ch] : 0u; rf[r] = pr[C_HF + ch]; ri[r] = pr[C_HI + ch]; }
    if (NEED_Q) { PIN16(rq); PIN4(hq0[0], hq0[1], hq0[2], wq[0]); } PIN16(rf); PIN16(ri); PIN8(hf0[0], hf0[1], hf0[2], hi0[0], hi0[1], hi0[2], wf[0], wi[0]);
    float hq[3], hf[3], hi[3];
#pragma unroll
    for (int j = 0; j < 3; ++j) { hq[j] = __uint_as_float(hq0[j] << 16); hf[j] = __uint_as_float(hf0[j] << 16); hi[j] = __uint_as_float(hi0[j] << 16); }
    float run = 0.f;
#pragma unroll
    for (int r = 0; r < 16; ++r) { const float xq = __uint_as_float(rq[r] << 16), xf = __uint_as_float(rf[r] << 16), xi = __uint_as_float(ri[r] << 16);
        const float cq = (wq[0] * hq[0] + wq[1] * hq[1]) + (wq[2] * hq[2] + wq[3] * xq), cf = (wf[0] * hf[0] + wf[1] * hf[1]) + (wf[2] * hf[2] + wf[3] * xf), ci = (wi[0] * hi[0] + wi[1] * hi[1]) + (wi[2] * hi[2] + wi[3] * xi);
        hq[0] = hq[1]; hq[1] = hq[2]; hq[2] = xq; hf[0] = hf[1]; hf[1] = hf[2]; hf[2] = xf; hi[0] = hi[1]; hi[1] = hi[2]; hi[2] = xi;
        const float f = fmaxf(lb + (1.0f - lb) * sigmoid_f(cf), 1e-30f); run += __logf(f); gl[r] = run; kk[r] = 1.0f - f; vv[r] = ci; q[r] = NEED_Q ? silu_f(cq) : 0.f; }
}
__device__ __forceinline__ void ma_hg_unit(Frame& F, const Loc& L, int l, int b, int c, int h, float* outb) {
    LAS bf16* Vt = (LAS bf16*)F.lds; LAS bf16* Kt = Vt + 64 * 136; LAS float* SEG = (LAS float*)(F.lds + SEG_OFF);
    const bf16* PJ = (const bf16*)(F.ws + WS_PROJ); const int k = L.tid & 63, w = L.tid >> 6;
    float q[16], kk[16], vv[16], gl[16];
    STAMP(0);
    hg_rows<false>(PJ + (size_t)(chunk_row0(b, c) + 16 * w) * NIN, hg_hist(PJ, b, c, w), h * 64 + k, F.in[14] + l * 4 * 768, ((const float*)(F.ws + WS_LBT))[l * 256 + h * 64 + k], q, kk, vv, gl);
    STAMP(1);
    { u32x4_t w0, w1; w0.x = cvtpk(vv[0], vv[1]); w0.y = cvtpk(vv[2], vv[3]); w0.z = cvtpk(vv[4], vv[5]); w0.w = cvtpk(vv[6], vv[7]); w1.x = cvtpk(vv[8], vv[9]); w1.y = cvtpk(vv[10], vv[11]); w1.z = cvtpk(vv[12], vv[13]); w1.w = cvtpk(vv[14], vv[15]);
      *(LAS u32x4_t*)(Vt + k * 136 + 16 * w) = w0; *(LAS u32x4_t*)(Vt + k * 136 + 16 * w + 8) = w1; }
    SEG[w * 64 + k] = gl[15];
    __syncthreads();
    STAMP(2);
    float off = 0.f, tot = 0.f;
#pragma unroll
    for (int ww = 0; ww < 8; ++ww) { const float s = SEG[ww * 64 + k]; if (ww < w) off += s; tot += s; }
    { float e[16];
#pragma unroll
      for (int r = 0; r < 16; ++r) e[r] = kk[r] * __expf(tot - off - gl[r]);
      u32x4_t w0, w1; w0.x = cvtpk(e[0], e[1]); w0.y = cvtpk(e[2], e[3]); w0.z = cvtpk(e[4], e[5]); w0.w = cvtpk(e[6], e[7]); w1.x = cvtpk(e[8], e[9]); w1.y = cvtpk(e[10], e[11]); w1.z = cvtpk(e[12], e[13]); w1.w = cvtpk(e[14], e[15]);
      *(LAS u32x4_t*)(Kt + k * 136 + 16 * w) = w0; *(LAS u32x4_t*)(Kt + k * 136 + 16 * w + 8) = w1; }
    const size_t ui = (size_t)(b * NCH + c) * 4 + h;
    if (w == 0) ((float*)((unsigned char*)outb + OUT_HDK))[ui * 64 + k] = __expf(tot);
    __syncthreads();
    STAMP(3);
    { const int il = L.lane & 15, g = L.lane >> 4, kt = L.wave >> 1, vt0 = 2 * (L.wave & 1); const f32x4 zero = {0.f, 0.f, 0.f, 0.f}; f32x4 acc[2] = {zero, zero};
#pragma unroll
      for (int ks = 0; ks < 4; ++ks) { const bf16x8 A = *(const LAS bf16x8*)(Kt + (16 * kt + il) * 136 + 32 * ks + 8 * g);
#pragma unroll
          for (int t = 0; t < 2; ++t) { const bf16x8 B = *(const LAS bf16x8*)(Vt + (16 * (vt0 + t) + il) * 136 + 32 * ks + 8 * g); acc[t] = mfma16(A, B, acc[t]); } }
      float* S = (float*)((unsigned char*)outb + OUT_HST) + ui * 4096;
#pragma unroll
      for (int t = 0; t < 2; ++t)
#pragma unroll
          for (int r = 0; r < 4; ++r) S[(16 * kt + 4 * g + r) * 64 + 16 * (vt0 + t) + il] = acc[t][r]; }
    __syncthreads();
    STAMP(4);
}
__device__ __forceinline__ void mb_hg(const Loc& L, float* outb, int e) {
    { const int b = e >> 14, h = (e >> 12) & 3, idx = e & 4095;
        float* p = (float*)((unsigned char*)outb + OUT_HST) + (size_t)(b * NCH * 4 + h) * 4096 + idx; const float* dk = (const float*)((unsigned char*)outb + OUT_HDK) + (size_t)(b * NCH * 4 + h) * 64 + (idx >> 6); float s = 0.f;
        float loc[NCH], dd[NCH];
#pragma unroll
        for (int c = 0; c < NCH; ++c) { loc[c] = p[(size_t)c * 4 * 4096]; dd[c] = dk[(size_t)c * 4 * 64]; }
        PIN16(loc); PIN16O(loc, 16); PIN16O(loc, 32); PIN16O(loc, 48); PIN16(dd); PIN16O(dd, 16); PIN16O(dd, 32); PIN16O(dd, 48); asm volatile("" : "+v"(loc[64]), "+v"(dd[64]) :: "memory");
        asm volatile("" : "+v"(p));
#pragma unroll
        for (int c = 0; c < NCH; ++c) { p[(size_t)c * 4 * 4096] = s; s = dd[c] * s + loc[c]; } }
}
__device__ __forceinline__ f32x4 ld4(const LAS float* p) { return *(const LAS f32x4*)p; }
__device__ __forceinline__ void mc_hg_unit(Frame& F, const Loc& L, int l, int b, int c, int h, const float* outb) {
    LAS float* Qf = (LAS float*)F.lds; LAS float* Kf = Qf + 128 * HG_LD; LAS float* G = Kf + 128 * HG_LD; LAS bf16* Vt = (LAS bf16*)(G + 128 * HG_LD); LAS bf16* SpT = Vt + 64 * 136; LAS float* SEG = (LAS float*)(F.lds + SEG_OFF);
    static_assert(3 * 128 * HG_LD * 4 + 64 * 136 * 2 + 64 * 72 * 2 <= RING_BYTES, "LDS map (HGRN2 MC)");
    const size_t row0 = (size_t)chunk_row0(b, c); const bf16* PJ = (const bf16*)(F.ws + WS_PROJ);
    { const int k = L.tid & 63, w = L.tid >> 6; float q[16], kk[16], vv[16], gl[16];
      hg_rows<true>(PJ + (size_t)(row0 + 16 * w) * NIN, hg_hist(PJ, b, c, w), h * 64 + k, F.in[14] + l * 4 * 768, ((const float*)(F.ws + WS_LBT))[l * 256 + h * 64 + k], q, kk, vv, gl);
#pragma unroll
      for (int r = 0; r < 16; ++r) { const int t = 16 * w + r; Qf[t * HG_LD + k] = q[r]; Kf[t * HG_LD + k] = kk[r]; Vt[k * 136 + perm_pos(t)] = f2bf_(vv[r]); }
      SEG[w * 64 + k] = gl[15];
      { const int kr = L.tid >> 3, v8 = (L.tid & 7) * 8; const float* sp = (const float*)((const unsigned char*)outb + OUT_HST) + ((size_t)(b * NCH + c) * 4 + h) * 4096 + kr * 64 + v8; const f32x4 s0 = *(const f32x4*)sp, s1 = *(const f32x4*)(sp + 4);
#pragma unroll
        for (int e = 0; e < 4; ++e) { SpT[(v8 + e) * 72 + kr] = f2bf_(s0[e]); SpT[(v8 + 4 + e) * 72 + kr] = f2bf_(s1[e]); } }
      __syncthreads();
      float off = 0.f;
#pragma unroll
      for (int ww = 0; ww < 8; ++ww) { const float s = SEG[ww * 64 + k]; if (ww < w) off += s; }
#pragma unroll
      for (int r = 0; r < 16; ++r) G[(16 * w + r) * HG_LD + k] = gl[r] + off;
    }
    __syncthreads();
    const int w = L.wave, il = L.lane & 15, g = L.lane >> 4; const f32x4 zero = {0.f, 0.f, 0.f, 0.f};
    const size_t row = row0 + 16 * w + il; const bf16* gp = (const bf16*)(F.ws + WS_PROJ) + row * NIN + C_HG + h * 64; const float* og = F.in[16] + l * 256 + h * 64;
    unsigned long long gg4[4]; f32x4 og4[4];
#pragma unroll
    for (int vt = 0; vt < 4; ++vt) { gg4[vt] = *(const GAS unsigned long long*)(gp + 16 * vt + 4 * g); og4[vt] = *(const f32x4*)(og + 16 * vt + 4 * g); }
    f32x4 gr[2][2]; bf16x8 Bq[2], Bqi[2];
#pragma unroll
    for (int ks = 0; ks < 2; ++ks) { const int ko = 32 * ks + 8 * g;
        if (w > 0) { gr[ks][0] = ld4(G + (16 * w - 1) * HG_LD + ko); gr[ks][1] = ld4(G + (16 * w - 1) * HG_LD + ko + 4); } else { gr[ks][0] = zero; gr[ks][1] = zero; }
        const f32x4 q0 = ld4(Qf + (16 * w + il) * HG_LD + ko), q1 = ld4(Qf + (16 * w + il) * HG_LD + ko + 4), g0 = ld4(G + (16 * w + il) * HG_LD + ko), g1 = ld4(G + (16 * w + il) * HG_LD + ko + 4);
        f32x4 a0, a1, b0, b1;
#pragma unroll
        for (int e = 0; e < 4; ++e) { a0[e] = q0[e] * __expf(g0[e] - gr[ks][0][e]); a1[e] = q1[e] * __expf(g1[e] - gr[ks][1][e]); b0[e] = q0[e] * __expf(g0[e]); b1[e] = q1[e] * __expf(g1[e]); }
        Bq[ks] = pack8(a0, a1); Bqi[ks] = pack8(b0, b1); }
    f32x4 O[4] = {zero, zero, zero, zero};
#pragma unroll
    for (int jp = 0; jp < 4; ++jp) if (2 * jp <= w) {
        f32x4 pt[2] = {zero, zero};
#pragma unroll
        for (int hh = 0; hh < 2; ++hh) if (2 * jp + hh <= w) { const int J = 2 * jp + hh;
#pragma unroll
            for (int ks = 0; ks < 2; ++ks) { const int ko = 32 * ks + 8 * g; const f32x4 k0 = ld4(Kf + (16 * J + il) * HG_LD + ko), k1 = ld4(Kf + (16 * J + il) * HG_LD + ko + 4), g0 = ld4(G + (16 * J + il) * HG_LD + ko), g1 = ld4(G + (16 * J + il) * HG_LD + ko + 4);
                f32x4 a0, a1;
#pragma unroll
                for (int e = 0; e < 4; ++e) { a0[e] = k0[e] * __expf(fminf(gr[ks][0][e] - g0[e], 80.0f)); a1[e] = k1[e] * __expf(fminf(gr[ks][1][e] - g1[e], 80.0f)); }
                pt[hh] = mfma16(pack8(a0, a1), Bq[ks], pt[hh]); }
            if (J == w) {
#pragma unroll
                for (int r = 0; r < 4; ++r) if (4 * g + r > il) pt[hh][r] = 0.f; } }
        const bf16x8 Bp = pack8(pt[0], pt[1]);
#pragma unroll
        for (int vt = 0; vt < 4; ++vt) { const bf16x8 A = *(const LAS bf16x8*)(Vt + (16 * vt + il) * 136 + 32 * jp + 8 * g); O[vt] = mfma16(A, Bp, O[vt]); }
    }
#pragma unroll
    for (int vt = 0; vt < 4; ++vt)
#pragma unroll
        for (int ks = 0; ks < 2; ++ks) { const bf16x8 A = *(const LAS bf16x8*)(SpT + (16 * vt + il) * 72 + 32 * ks + 8 * g); O[vt] = mfma16(A, Bqi[ks], O[vt]); }
    float s2 = 0.f;
#pragma unroll
    for (int vt = 0; vt < 4; ++vt) s2 += (O[vt][0] * O[vt][0] + O[vt][1] * O[vt][1]) + (O[vt][2] * O[vt][2] + O[vt][3] * O[vt][3]);
    s2 += __shfl_xor(s2, 16); s2 += __shfl_xor(s2, 32); const float rstd = rsqrtf(s2 * (1.0f / 64.0f) + EPS);
    bf16* mo = (bf16*)(F.ws + WS_MIXED) + row * D + 256 + h * 64;
#pragma unroll
    for (int vt = 0; vt < 4; ++vt) { const int v0 = 16 * vt + 4 * g; const unsigned long long gg = gg4[vt]; const f32x4 o4 = og4[vt]; float y[4];
#pragma unroll
        for (int r = 0; r < 4; ++r) y[r] = O[vt][r] * rstd * o4[r] * silu_f(bf2f((bf16)(gg >> (16 * r))));
        *(GAS unsigned long long*)(mo + v0) = (unsigned long long)cvtpk(y[0], y[1]) | ((unsigned long long)cvtpk(y[2], y[3]) << 32); }
    __syncthreads();
}
constexpr int NCH5 = TB / 64, S5R = 64, S5S = 4;
constexpr int S5_WREG = 14592, BU_LD = 20, XS_LD = 136, GY_LD = 264;
static_assert(8 * S5_WREG <= RING_BYTES && S5R * GY_LD * 2 + 4096 + 512 <= RING_BYTES, "LDS map (S5)");
template <bool FULL> __device__ __forceinline__ void s5_group(Frame& F, const Loc& L, int l, int gidx, const bf16* Pc  , float& xr, float& xi, unsigned (&gy)[S5S][2]) {
    LAS float* BUt = (LAS float*)(F.lds + L.wave * S5_WREG); LAS bf16* Xs = (LAS bf16*)(F.lds + L.wave * S5_WREG + 128 * BU_LD * 4);
    const int il = L.lane & 15, g4 = L.lane >> 4, lg = l * 16 + gidx; const f32x4 zero = {0.f, 0.f, 0.f, 0.f}; const bf16x8 bz = {0, 0, 0, 0, 0, 0, 0, 0};
    bf16x8 Bb[8];
#pragma unroll
    for (int ct = 0; ct < 8; ++ct) Bb[ct] = g4 < 2 ? *(const bf16x8*)((const bf16*)(F.ws + WS_BBT) + ((size_t)lg * 128 + 16 * ct + il) * 16 + 8 * g4) : bz;
    bf16x8 Cb[4], Db = bz;
    if (FULL) {
#pragma unroll
        for (int ks = 0; ks < 4; ++ks) Cb[ks] = *(const bf16x8*)((const bf16*)(F.ws + WS_CCT) + ((size_t)lg * 16 + il) * 128 + 32 * ks + 8 * g4);
        const short dsk = (short)f2bf_(F.in[10][lg * 16 + il]);
#pragma unroll
        for (int jj = 0; jj < 8; ++jj) Db[jj] = (8 * g4 + jj == il) ? dsk : (short)0; }
    const float* LB = (const float*)(F.ws + WS_LB) + (size_t)(lg * 64 + L.lane) * 2; const float lr = LB[0], li = LB[1];
    const unsigned avoff = (unsigned)(il * NIN + C_U + 16 * gidx + 8 * g4) * 2u;
    bf16x8 Aall[S5S];
#pragma unroll
    for (int s = 0; s < S5S; ++s) Aall[s] = g4 < 2 ? *(const bf16x8*)((const char*)(Pc + (size_t)16 * s * NIN) + avoff) : bz;
#pragma unroll
    for (int s = 0; s < S5S; ++s) {
        const bf16x8 A = Aall[s];
#pragma unroll
        for (int ct = 0; ct < 8; ++ct) { const f32x4 d = mfma16(A, Bb[ct], zero); *(LAS f32x4*)(BUt + (16 * ct + il) * BU_LD + 4 * g4) = d; }
#pragma unroll
        for (int q = 0; q < 4; ++q) { const f32x4 br = *(const LAS f32x4*)(BUt + L.lane * BU_LD + 4 * q), bi = *(const LAS f32x4*)(BUt + (64 + L.lane) * BU_LD + 4 * q);
#pragma unroll
            for (int e = 0; e < 4; ++e) { const float nr = fmaf(lr, xr, fmaf(-li, xi, br[e])), ni = fmaf(lr, xi, fmaf(li, xr, bi[e])); xr = nr; xi = ni;
                if (FULL) *(LAS unsigned*)(Xs + (4 * q + e) * XS_LD + 2 * L.lane) = cvtpk(xr, xi); } }
        if (FULL) { f32x4 y = mfma16(A, Db, zero);
#pragma unroll
            for (int ks = 0; ks < 4; ++ks) { const bf16x8 Ax = *(const LAS bf16x8*)(Xs + il * XS_LD + 32 * ks + 8 * g4); y = mfma16(Ax, Cb[ks], y); }
            gy[s][0] = cvtpk(gelu_tanh(y[0]), gelu_tanh(y[1])); gy[s][1] = cvtpk(gelu_tanh(y[2]), gelu_tanh(y[3])); }
        asm volatile("" : "+v"(xr), "+v"(xi) :: "memory");
    }
}
__device__ __forceinline__ void ma_s5_unit(Frame& F, const Loc& L, int l, int b, int c, float* outb) {
    const bf16* Pc = (const bf16*)(F.ws + WS_PROJ) + (size_t)s5_row0(b, c) * NIN; unsigned gy[S5S][2];
#pragma unroll
    for (int gi = 0; gi < 2; ++gi) { const int gidx = 2 * L.wave + gi; float xr = 0.f, xi = 0.f; s5_group<false>(F, L, l, gidx, Pc, xr, xi, gy);
        float* xo = (float*)((unsigned char*)outb + OUT_S5X) + (((size_t)(b * NCH5 + c) * 16 + gidx) * 64 + L.lane) * 2; xo[0] = xr; xo[1] = xi; }
    __syncthreads();
}
__device__ __forceinline__ void mb_s5(Frame& F, const Loc& L, int l, float* outb, int e) {
    { const int b = e >> 10, gp = e & 1023; const float* lb = (const float*)(F.ws + WS_LB128) + (size_t)(l * 1024 + gp) * 2; const float dr = lb[0], di = lb[1];
        float* p = (float*)((unsigned char*)outb + OUT_S5X) + ((size_t)b * NCH5 * 1024 + gp) * 2; float sr = 0.f, si = 0.f; asm volatile("" : "+v"(sr), "+v"(si));
#pragma unroll
        for (int hf = 0; hf < 2; ++hf) {
            float la[65], lbv[65];
#pragma unroll
            for (int c = 0; c < 65; ++c) { const float2 t = *(const float2*)(p + (size_t)c * 2048); la[c] = t.x; lbv[c] = t.y; }
            PIN16(la); PIN16O(la, 16); PIN16O(la, 32); PIN16O(la, 48); PIN16(lbv); PIN16O(lbv, 16); PIN16O(lbv, 32); PIN16O(lbv, 48); asm volatile("" : "+v"(la[64]), "+v"(lbv[64]) :: "memory");
            asm volatile("" : "+v"(p));
#pragma unroll
            for (int c = 0; c < 65; ++c) { *(float2*)(p + (size_t)c * 2048) = make_float2(sr, si); const float nr = dr * sr - di * si + la[c], ni = dr * si + di * sr + lbv[c]; sr = nr; si = ni; }
            p += (size_t)65 * 2048; } }
}
__device__ __forceinline__ void mc_s5_unit(Frame& F, const Loc& L, int l, int b, int c, const float* outb) {
    const size_t row0 = (size_t)s5_row0(b, c); const bf16* Pc = (const bf16*)(F.ws + WS_PROJ) + row0 * NIN;
    const int il = L.lane & 15, g4 = L.lane >> 4, w = L.wave;
    unsigned gy[2][S5S][2];
    STAMP(40);
#pragma unroll
    for (int gi = 0; gi < 2; ++gi) { const int gidx = 2 * w + gi; const float* xo = (const float*)((const unsigned char*)outb + OUT_S5X) + (((size_t)(b * NCH5 + c) * 16 + gidx) * 64 + L.lane) * 2; float xr = xo[0], xi = xo[1];
        s5_group<true>(F, L, l, gidx, Pc, xr, xi, gy[gi]); if (gi == 0) STAMP(41); }
    STAMP(42);
    __syncthreads();
    LAS bf16* GYs = (LAS bf16*)F.lds; LAS float* RED = (LAS float*)(F.lds + S5R * GY_LD * 2); LAS float* RSTD = RED + S5R * 8;
#pragma unroll
    for (int gi = 0; gi < 2; ++gi)
#pragma unroll
        for (int s = 0; s < S5S; ++s)
#pragma unroll
            for (int r = 0; r < 4; ++r) GYs[(16 * s + 4 * g4 + r) * GY_LD + 16 * (2 * w + gi) + il] = (bf16)(gy[gi][s][r >> 1] >> (16 * (r & 1)));
    __syncthreads();
    STAMP(43);
    const f32x4 zero = {0.f, 0.f, 0.f, 0.f}; f32x4 acc[S5S][2];
#pragma unroll
    for (int tt = 0; tt < S5S; ++tt) { acc[tt][0] = zero; acc[tt][1] = zero; }
    const bf16* WG = (const bf16*)(F.ws + WS_WGT) + (size_t)l * 65536;
    bf16x8 Wf[8][2];
#pragma unroll
    for (int ks = 0; ks < 8; ++ks) { Wf[ks][0] = *(const bf16x8*)(WG + (size_t)(32 * w + il) * 256 + 32 * ks + 8 * g4); Wf[ks][1] = *(const bf16x8*)(WG + (size_t)(32 * w + 16 + il) * 256 + 32 * ks + 8 * g4); }
#pragma unroll
    for (int ks = 0; ks < 8; ++ks) {
#pragma unroll
        for (int tt = 0; tt < S5S; ++tt) { const bf16x8 Ag = *(const LAS bf16x8*)(GYs + (16 * tt + il) * GY_LD + 32 * ks + 8 * g4); acc[tt][0] = mfma16(Wf[ks][0], Ag, acc[tt][0]); acc[tt][1] = mfma16(Wf[ks][1], Ag, acc[tt][1]); } }
#pragma unroll
    for (int tt = 0; tt < S5S; ++tt) { float ss = 0.f;
#pragma unroll
        for (int nt = 0; nt < 2; ++nt) { const unsigned long long gq = *(const LAS unsigned long long*)(GYs + (16 * tt + il) * GY_LD + 32 * w + 16 * nt + 4 * g4);
#pragma unroll
            for (int r = 0; r < 4; ++r) { const float v = bf2f((bf16)(gq >> (16 * r))) * sigmoid_f(acc[tt][nt][r]); acc[tt][nt][r] = v; ss += v * v; } }
        ss += __shfl_xor(ss, 16); ss += __shfl_xor(ss, 32); if (g4 == 0) RED[(16 * tt + il) * 8 + w] = ss; }
    STAMP(44);
    __syncthreads();
    if (L.tid < S5R) { const f32x4 a = *(const LAS f32x4*)(RED + L.tid * 8), bq = *(const LAS f32x4*)(RED + L.tid * 8 + 4); RSTD[L.tid] = rsqrtf((((a[0] + a[1]) + (a[2] + a[3])) + ((bq[0] + bq[1]) + (bq[2] + bq[3]))) * (1.0f / 256.0f) + EPS); }
    __syncthreads();
    const float* og = F.in[13] + l * 256; bf16* MX = (bf16*)(F.ws + WS_MIXED) + row0 * D;
    f32x4 og2[2] = {*(const f32x4*)(og + 32 * w + 4 * g4), *(const f32x4*)(og + 32 * w + 16 + 4 * g4)}; PIN4(og2[0], og2[1], og2[0], og2[1]);
#pragma unroll
    for (int tt = 0; tt < S5S; ++tt) { const float rs = RSTD[16 * tt + il];
#pragma unroll
        for (int nt = 0; nt < 2; ++nt) { const int n0 = 32 * w + 16 * nt + 4 * g4; const f32x4 o4 = og2[nt];
            *(GAS unsigned long long*)((char*)(MX + (size_t)16 * tt * D) + (unsigned)(il * D + n0) * 2u) = (unsigned long long)cvtpk(acc[tt][nt][0] * rs * o4[0], acc[tt][nt][1] * rs * o4[1]) | ((unsigned long long)cvtpk(acc[tt][nt][2] * rs * o4[2], acc[tt][nt][3] * rs * o4[3]) << 32); } }
    __syncthreads();
}
constexpr int MOETBL_OFF = SEG_OFF + 2048;
static_assert(MOETBL_OFF % 16 == 0 && MOETBL_OFF + 64 <= LDS_BYTES, "LDS map (MoE table)");
__device__ __forceinline__ void moe_table(Frame& F) {
    if (mk_tid(F.wave_s) == 0) { LAS int* tbl = (LAS int*)(F.lds + MOETBL_OFF); const unsigned* cnt = (const unsigned*)(F.ctl + CW_CNT); int acc = 0;
        for (int e = 0; e < 8; ++e) { tbl[e] = acc; acc += ((int)cnt[e] + 255) >> 8; } tbl[8] = acc; }
    __syncthreads();
}
constexpr int NU_S5 = 2 * NCH5, NU_HG = 520, NU_RT = 1040, NU_ALL = NU_S5 + NU_HG + NU_RT, QSLOT_OFF = MOETBL_OFF + 64;
static_assert(QSLOT_OFF % 16 == 0 && QSLOT_OFF + 16 <= LDS_BYTES, "LDS map (queue slot)");
template <bool IS_MC> __device__ __forceinline__ void p_mixer_units(Frame& F, int l, float* outb, int qidx) {
    LAS int* slot = (LAS int*)(F.lds + QSLOT_OFF); gu32* q = F.ctl + CW_QUEUE + 64 * qidx;
    const bool t0 = mk_tid(F.wave_s) == 0; int nxt = 0;
    if (t0) slot[0] = (int)__hip_atomic_fetch_add(q, 1u, RLX_AGENT);
    __syncthreads();
    for (;;) {
        const int u = __builtin_amdgcn_readfirstlane(slot[0]);
        if (u >= NU_ALL) break;
        if (t0) nxt = (int)__hip_atomic_fetch_add(q, 1u, RLX_AGENT);
        if (u < NU_S5) { const Loc L = make_loc(F.wave_s); if (IS_MC) { if (!(u / NCH5 == 1 && u % NCH5 < 2)) mc_s5_unit(F, L, l, u / NCH5, u % NCH5, outb); } else ma_s5_unit(F, L, l, u / NCH5, u % NCH5, outb); }
        else if (u < NU_S5 + NU_HG) { const Loc L = make_loc(F.wave_s); const int uu = u - NU_S5; if (IS_MC) { if (!(uu / 260 == 1 && ((uu % 260) >> 2) == 0)) mc_hg_unit(F, L, l, uu / 260, (uu % 260) >> 2, uu & 3, outb); } else ma_hg_unit(F, L, l, uu / 260, (uu % 260) >> 2, uu & 3, outb); }
        else { const Loc L = make_loc(F.wave_s); const int uu = u - NU_S5 - NU_HG; if (IS_MC) { if (!(uu / 520 == 1 && ((uu % 520) >> 3) == 0)) mc_ret_unit(F, L, l, uu / 520, (uu % 520) >> 3, uu & 7, outb); } else ma_ret_unit(F, L, uu / 520, (uu % 520) >> 3, uu & 7, outb); }
        if (t0) slot[0] = nxt;
        __syncthreads();
    }
}
__device__ __forceinline__ void p_ma(Frame& F, int l, float* outb) { p_mixer_units<false>(F, l, outb, 2 * l); }
__device__ __forceinline__ void p_mb(Frame& F, int l, float* outb) { const Loc L = make_loc(F.wave_s); const int gt = L.vcu * NT + L.tid;
    if (gt < 32768) mb_ret(L, outb, gt); else if (gt < 65536) mb_hg(L, outb, gt - 32768); else if (gt < 67584) mb_s5(F, L, l, outb, gt - 65536); }
__device__ __forceinline__ void p_mc(Frame& F, int l, float* outb) { p_mixer_units<true>(F, l, outb, 2 * l + 1); }
__device__ __forceinline__ void p_route(Frame& F) {
    const Loc L = make_loc(F.wave_s);
    const bf16* HB = (const bf16*)(F.ws + WS_HB); const float* gff = F.in[19] + D; const float* R = F.in[23];
    int* POS = (int*)(F.ws + WS_POS); float* GATE = (float*)(F.ws + WS_GATE); int* LIST = (int*)(F.ws + WS_LIST); unsigned* CNT = (unsigned*)(F.ctl + CW_CNT);
    LAS float* RT = (LAS float*)F.lds;
    float gr[2][8][8];
#pragma unroll
    for (int jj = 0; jj < 2; ++jj) { const int d0 = 8 * L.lane + 512 * jj; const f32x4 g0 = *(const f32x4*)(gff + d0), g1 = *(const f32x4*)(gff + d0 + 4); f32x4 rr[8][2];
#pragma unroll
        for (int q = 0; q < 8; ++q) { rr[q][0] = *(const f32x4*)(R + (d0 + q) * 8); rr[q][1] = *(const f32x4*)(R + (d0 + q) * 8 + 4); }
        PIN8(rr[0][0], rr[0][1], rr[1][0], rr[1][1], rr[2][0], rr[2][1], rr[3][0], rr[3][1]); PIN8(rr[4][0], rr[4][1], rr[5][0], rr[5][1], rr[6][0], rr[6][1], rr[7][0], rr[7][1]);
#pragma unroll
        for (int q = 0; q < 8; ++q) { const float gq = q < 4 ? g0[q] : g1[q - 4];
#pragma unroll
            for (int e = 0; e < 8; ++e) gr[jj][q][e] = gq * (e < 4 ? rr[q][0][e] : rr[q][1][e - 4]); } }
    for (int grp = L.bx; grp < BATCH * SEQ / 64; grp += L.G) {
        v4u hw8[8][2];
#pragma unroll
        for (int j = 0; j < 8; ++j) { const size_t m = (size_t)(grp * 64 + L.wave * 8 + j); hw8[j][0] = ((const GAS v4u*)(HB + m * D))[L.lane]; hw8[j][1] = ((const GAS v4u*)(HB + m * D))[L.lane + 64]; }
        PIN8(hw8[0][0], hw8[0][1], hw8[1][0], hw8[1][1], hw8[2][0], hw8[2][1], hw8[3][0], hw8[3][1]); PIN8(hw8[4][0], hw8[4][1], hw8[5][0], hw8[5][1], hw8[6][0], hw8[6][1], hw8[7][0], hw8[7][1]);
        float val[72];
#pragma unroll
        for (int j = 0; j < 8; ++j) {
#pragma unroll
            for (int e = 0; e < 9; ++e) val[9 * j + e] = 0.f;
#pragma unroll
            for (int jj = 0; jj < 2; ++jj)
#pragma unroll
                for (int q = 0; q < 8; ++q) { const unsigned wq = hw8[j][jj][q >> 1]; const float hx = __uint_as_float((q & 1) ? (wq & 0xffff0000u) : (wq << 16)); val[9 * j + 8] += hx * hx;
#pragma unroll
                    for (int e = 0; e < 8; ++e) val[9 * j + e] += hx * gr[jj][q][e]; } }
#pragma unroll
        for (int i = 0; i < 36; ++i) { const bool up = (L.lane & 32) != 0; const float send = up ? val[i] : val[i + 36], keep = up ? val[i + 36] : val[i]; val[i] = keep + __shfl_xor(send, 32); }
#pragma unroll
        for (int i = 0; i < 18; ++i) { const bool up = (L.lane & 16) != 0; const float send = up ? val[i] : val[i + 18], keep = up ? val[i + 18] : val[i]; val[i] = keep + __shfl_xor(send, 16); }
#pragma unroll
        for (int i = 0; i < 9; ++i) { const bool up = (L.lane & 8) != 0; const float send = up ? val[i] : val[i + 9], keep = up ? val[i + 9] : val[i]; val[i] = keep + __shfl_xor(send, 8); }
#pragma unroll
        for (int i = 0; i < 9; ++i) { val[i] += __shfl_xor(val[i], 4); val[i] += __shfl_xor(val[i], 2); val[i] += __shfl_xor(val[i], 1); }
        if ((L.lane & 7) == 0) { const int j = L.lane >> 3;
            const float rstd = rsqrtf(val[8] * (1.0f / 1024.0f) + EPS); float lg[8];
#pragma unroll
            for (int e = 0; e < 8; ++e) lg[e] = val[e] * rstd;
            int i1 = 0; float l1 = lg[0];
#pragma unroll
            for (int e = 1; e < 8; ++e) if (lg[e] > l1) { l1 = lg[e]; i1 = e; }
            int i2 = -1; float l2 = -3.0e38f;
#pragma unroll
            for (int e = 0; e < 8; ++e) if (e != i1 && lg[e] > l2) { l2 = lg[e]; i2 = e; }
            const float e2 = __expf(l2 - l1), g1 = 1.0f / (1.0f + e2), g2 = e2 * g1;
            const int sl = L.wave * 8 + j; RT[sl * 4 + 0] = __int_as_float(i1); RT[sl * 4 + 1] = __int_as_float(i2); RT[sl * 4 + 2] = g1; RT[sl * 4 + 3] = g2; RT[256 + sl] = rstd; }
        __syncthreads();
        if (L.wave == 0) { const int tk = grp * 64 + L.lane; const int e1 = __float_as_int(RT[L.lane * 4 + 0]), e2 = __float_as_int(RT[L.lane * 4 + 1]); const float g1 = RT[L.lane * 4 + 2], g2 = RT[L.lane * 4 + 3];
            const int row = tk; const unsigned long long lt = (1ull << L.lane) - 1ull; int p1 = 0, p2 = 0, off2 = 0; unsigned mine = 0u;
#pragma unroll
            for (int e = 0; e < 8; ++e) { const unsigned long long m1 = __ballot(e1 == e), m2 = __ballot(e2 == e); const int n1 = __popcll(m1), n2 = __popcll(m2);
                if (L.lane == e) mine = (unsigned)(n1 + n2); if (e1 == e) p1 = __popcll(m1 & lt); if (e2 == e) { p2 = __popcll(m2 & lt); off2 = n1; } }
            unsigned base = 0u; if (L.lane < 8 && mine > 0u) base = atomicAdd(CNT + L.lane, mine);
            p1 += (int)__shfl(base, e1); p2 += (int)__shfl(base, e2) + off2;
            LIST[(size_t)e1 * MOE_CAP + p1] = row; LIST[(size_t)e2 * MOE_CAP + p2] = row; { float* RSL = (float*)(F.ws + WS_RSL); const float rs = RT[256 + L.lane]; RSL[(size_t)e1 * MOE_CAP + p1] = rs; RSL[(size_t)e2 * MOE_CAP + p2] = rs; }
            POS[tk * 2] = (e1 << 20) | p1; POS[tk * 2 + 1] = (e2 << 20) | p2; GATE[tk * 2] = g1; GATE[tk * 2 + 1] = g2; }
        __syncthreads();
    }
}
__device__ __forceinline__ void p_final(Frame& F, float* out) {
    const Loc L = make_loc(F.wave_s);
    const int gw = L.vcu * NWAVES + L.wave, NGW = L.G * NWAVES; const bf16* HB = (const bf16*)(F.ws + WS_HB); const float* gf = F.in[27];
    const int* POS = (const int*)(F.ws + WS_POS); const float* GATE = (const float*)(F.ws + WS_GATE); const bf16* YS = (const bf16*)(F.ws + WS_YS); const unsigned* CNT = (const unsigned*)(F.ctl + CW_CNT);
    moe_table(F); const LAS int* tbl = (const LAS int*)(F.lds + MOETBL_OFF);
    f32x4 gfr[4];
#pragma unroll
    for (int j = 0; j < 4; ++j) gfr[j] = ((const GAS f32x4*)gf)[L.lane + 64 * j];
    PIN4(gfr[0], gfr[1], gfr[2], gfr[3]);
    for (int r = gw; r < BATCH * SEQ; r += NGW) { const size_t m = (size_t)r;
        const int q1 = POS[r * 2], q2 = POS[r * 2 + 1]; const float g1 = GATE[r * 2], g2 = GATE[r * 2 + 1]; const int t1 = tbl[q1 >> 20], t2 = tbl[q2 >> 20];
        const size_t s1 = (size_t)t1 * 256 + (q1 & 0xfffff), s2 = (size_t)t2 * 256 + (q2 & 0xfffff);
        f32x4 v[4]; float s = 0.f; unsigned long long hh[4], ya[4], yb[4];
#pragma unroll
        for (int j = 0; j < 4; ++j) { hh[j] = ((const GAS unsigned long long*)(HB + m * D))[L.lane + 64 * j]; ya[j] = ((const GAS unsigned long long*)(YS + s1 * D))[L.lane + 64 * j]; yb[j] = ((const GAS unsigned long long*)(YS + s2 * D))[L.lane + 64 * j]; }
        PIN4(hh[0], hh[1], hh[2], hh[3]); PIN8(ya[0], ya[1], ya[2], ya[3], yb[0], yb[1], yb[2], yb[3]);
#pragma unroll
        for (int j = 0; j < 4; ++j) { const unsigned long long y1 = ya[j], y2 = yb[j];
#pragma unroll
            for (int q = 0; q < 4; ++q) v[j][q] = bf2f((bf16)(hh[j] >> (16 * q))) + g1 * bf2f((bf16)(y1 >> (16 * q))) + g2 * bf2f((bf16)(y2 >> (16 * q)));
            s += (v[j].x * v[j].x + v[j].y * v[j].y) + (v[j].z * v[j].z + v[j].w * v[j].w); }
        const float rstd = rsqrtf(wave_sum(s) * (1.0f / 1024.0f) + EPS);
#pragma unroll
        for (int j = 0; j < 4; ++j) ((GAS f32x4*)(out + (size_t)r * D))[L.lane + 64 * j] = v[j] * rstd * gfr[j];
        if (PROBE_TA >= 0 && r == 0 && L.lane == 0) { asm volatile("s_waitcnt vmcnt(0)" ::: "memory"); out[0] = PROBE_SCALE * (float)(__hip_atomic_load(F.ctl + CW_PROBE + (PROBE_TB >= 0 ? PROBE_TB : 0), RLX_AGENT) - __hip_atomic_load(F.ctl + CW_PROBE + (PROBE_TA >= 0 ? PROBE_TA : 0), RLX_AGENT)); }
    }
}

template <int KIND> __device__ __forceinline__ void meta_side(Frame& F, const bf16* A, int K, const bf16* Wt, int ntiles, bf16* OUT, int ldo) {
    const Loc L = make_loc(F.wave_s);
    if (L.bx < ntiles) {
        LAS float* red = (LAS float*)F.lds; LAS float* rs = red + 8 * 64 * 8;
        const int il = L.lane & 15, g = L.lane >> 4, w = L.wave;
        if (KIND != 1) { const bf16* HB = (const bf16*)(F.ws + WS_HB);
#pragma unroll
            for (int rr = 0; rr < 2; ++rr) { const int r = 2 * w + rr; const v4u x0 = ((const GAS v4u*)(HB + (size_t)(MROW0 + r) * D))[L.lane], x1 = ((const GAS v4u*)(HB + (size_t)(MROW0 + r) * D))[L.lane + 64]; float ss = 0.f;
#pragma unroll
                for (int q = 0; q < 4; ++q) { const float a = __uint_as_float(x0[q] << 16), bq = __uint_as_float(x0[q] & 0xffff0000u), c = __uint_as_float(x1[q] << 16), d = __uint_as_float(x1[q] & 0xffff0000u); ss += (a * a + bq * bq) + (c * c + d * d); }
                ss = wave_sum(ss); if (L.lane == 0) rs[r] = rsqrtf(ss * (1.0f / 1024.0f) + EPS); } }
        const int kw = K / 8, nks = kw / 32;
        const int n0 = KIND == 2 ? ((16 * L.bx) >> 7) * 256 + ((16 * L.bx) & 127) : 16 * L.bx;
        const bf16* ap = A + (size_t)(MROW0 + il) * K + w * kw + 8 * g; const bf16* bp = Wt + (size_t)(n0 + il) * K + w * kw + 8 * g;
        const f32x4 zero = {0.f, 0.f, 0.f, 0.f}; f32x4 a0 = zero, a1 = zero;
        for (int ks = 0; ks < nks; ++ks) { const bf16x8 Af = *(const bf16x8*)(ap + 32 * ks), B0 = *(const bf16x8*)(bp + 32 * ks); a0 = mfma16(Af, B0, a0);
            if (KIND == 2) { const bf16x8 B1 = *(const bf16x8*)(bp + (size_t)128 * K + 32 * ks); a1 = mfma16(Af, B1, a1); } }
        *(LAS f32x4*)(red + (w * 64 + L.lane) * 8) = a0; if (KIND == 2) *(LAS f32x4*)(red + (w * 64 + L.lane) * 8 + 4) = a1;
        __syncthreads();
        if (w == 0) { f32x4 s0 = zero, s1 = zero;
#pragma unroll
            for (int ww = 0; ww < 8; ++ww) { s0 = s0 + *(const LAS f32x4*)(red + (ww * 64 + L.lane) * 8); if (KIND == 2) s1 = s1 + *(const LAS f32x4*)(red + (ww * 64 + L.lane) * 8 + 4); }
#pragma unroll
            for (int r = 0; r < 4; ++r) { const int mr = 4 * g + r; bf16* o = OUT + (size_t)(MROW0 + mr) * ldo + 16 * L.bx + il;
                if (KIND == 0) *o = f2bf_(s0[r] * rs[mr]);
                else if (KIND == 1) *o = f2bf_(bf2f(*o) + s0[r]);
                else { const float av = s0[r] * rs[mr], bv = s1[r] * rs[mr]; *o = f2bf_(silu_f(av) * bv); } } }
        __syncthreads();
    }
}
struct Args { const float* in[28]; float* out; unsigned char* ws; int ph_lo, ph_hi, li, pad; };
__global__ void __launch_bounds__(NWAVES * 64, 2) __attribute__((amdgpu_waves_per_eu(2, 2))) mk_fwd(Args args) {
    extern __shared__ __attribute__((aligned(16))) unsigned char lds[];
    Frame F;
    F.lds = (LAS unsigned char*)lds; F.MISC = (volatile LAS unsigned*)(F.lds + MISC_OFF);
    F.ws = args.ws; F.ctl = (gu32*)(args.ws + WS_CTL); F.in = args.in; F.wave_s = __builtin_amdgcn_readfirstlane((int)threadIdx.x >> 6);
    for (int u = mk_tid(F.wave_s); u < (LDS_BYTES - LDSCTL_OFF) / 4; u += NWAVES * 64) ((LAS unsigned*)(F.lds + LDSCTL_OFF))[u] = 0u;
    __syncthreads();
    XcdBarrier bar; bar.bar = (unsigned*)(F.ctl + CW_BAR); bar.x = 0; bar.st = nullptr; bar.wv = F.wave_s;
    if (!MK_PER_PHASE) bar = xcd_barrier_post((unsigned*)(F.ctl + CW_BAR), F.MISC + 8, F.wave_s);
    STAMP(15);
    const int lo = args.ph_lo, hi = args.ph_hi;
#define IN(k) (lo <= (k) && (k) < hi)
#define SEAM(k) do { if (!MK_PER_PHASE && (k) + 1 < hi) xcd_barrier(bar); STAMP(16 + (k)); } while (0)
    unsigned char* ws = args.ws;
    float* SS = (float*)(ws + WS_SSP);
    if (IN(0)) for (int rep = 0; rep < REP(1); ++rep) { p0_prologue(F); SEAM(0); }
    for (int l = 0; l < 2; ++l) {
        { unsigned char* w_ = args.ws; asm volatile("" : "+s"(w_)); ws = w_; F.ws = w_; F.ctl = (gu32*)(w_ + WS_CTL); SS = (float*)(w_ + WS_SSP); }
        const int base = 1 + 30 * l;
        if (IN(base + 0)) for (int rep = 0; rep < REP(2); ++rep) {
            pg8::Gemm g{(const bf16*)(ws + WS_HB), (const bf16*)(ws + WS_WIN) + (size_t)l * NIN * D, MT, NIN, D, F.wave_s}; pg8::StaticOrder S; const Loc L = make_loc(F.wave_s); S.init(MT, NIN, L.G, L.bx);
            pg8::EpiProj E{(bf16*)(ws + WS_PROJ), NIN, SS + (size_t)(2 * l) * M * 16};
            pg8::gemm_phase<pg8::EpiProj, pg8::StaticOrder, true, true>(F.lds + RING_OFF, g, S, E);
            meta_side<0>(F, (const bf16*)(ws + WS_HB), D, (const bf16*)(ws + WS_WIN) + (size_t)l * NIN * D, NIN / 16, (bf16*)(ws + WS_PROJ), NIN);
            { const Loc L2 = make_loc(F.wave_s); if (L2.bx >= 192) conv_moe13(F, L2.bx - 192, 64, l == 0 ? 1408 : 3008, l == 0 ? 1984 : N_M13, L2.tid); }
            SEAM(base + 0);
        }
        if (IN(base + 1)) for (int rep = 0; rep < REP(3); ++rep) { p_ma(F, l, args.out); SEAM(base + 1); }
        if (IN(base + 2)) { p_mb(F, l, args.out); SEAM(base + 2); }
        if (IN(base + 3)) for (int rep = 0; rep < REP(4); ++rep) { p_mc(F, l, args.out); SEAM(base + 3); }
        if (IN(base + 6)) {
            pg8::Gemm g{(const bf16*)(ws + WS_MIXED), (const bf16*)(ws + WS_WOUT) + (size_t)l * D * D, MT, D, D, F.wave_s}; pg8::StaticOrder S; const Loc L = make_loc(F.wave_s); S.init(MT, D, L.G, L.bx);
            pg8::EpiResid E{(bf16*)(ws + WS_HB), SS + (size_t)(2 * l + 1) * M * 16, nullptr, 0, 1};
            pg8::gemm_phase<pg8::EpiResid, pg8::StaticOrder, true, true>(F.lds + RING_OFF, g, S, E);
            if (l == 0) meta_side<1>(F, (const bf16*)(ws + WS_MIXED), D, (const bf16*)(ws + WS_WOUT), D / 16, (bf16*)(ws + WS_HB), D);
            SEAM(base + 6);
        }
        if (l == 0) {
            if (IN(base + 8)) for (int rep = 0; rep < REP(5); ++rep) {
                pg8::Gemm g{(const bf16*)(ws + WS_HB), (const bf16*)(ws + WS_WF13), MT, 2 * DFF, D, F.wave_s}; pg8::StaticOrder S; const Loc L = make_loc(F.wave_s); S.init(MT, 2 * DFF, L.G, L.bx);
                pg8::EpiSwiglu E{(bf16*)(ws + WS_ACT), DFF, SS + (size_t)1 * M * 16};
                pg8::gemm_phase<pg8::EpiSwiglu, pg8::StaticOrder, true, true>(F.lds + RING_OFF, g, S, E);
                meta_side<2>(F, (const bf16*)(ws + WS_HB), D, (const bf16*)(ws + WS_WF13), DFF / 16, (bf16*)(ws + WS_ACT), DFF);
                { const Loc L2 = make_loc(F.wave_s); if (L2.bx >= 128) conv_moe13(F, L2.bx - 128, 128, 1984, 3008, L2.tid); }
                SEAM(base + 8);
            }
            if (IN(base + 9)) {
                pg8::Gemm g{(const bf16*)(ws + WS_ACT), (const bf16*)(ws + WS_WF2), MT, D, DFF, F.wave_s}; pg8::StaticOrder S; const Loc L = make_loc(F.wave_s); S.init(MT, D, L.G, L.bx);
                pg8::EpiResid E{(bf16*)(ws + WS_HB), SS + (size_t)2 * M * 16, nullptr, 0, 1};
                pg8::gemm_phase<pg8::EpiResid, pg8::StaticOrder, true, true>(F.lds + RING_OFF, g, S, E);
                meta_side<1>(F, (const bf16*)(ws + WS_ACT), DFF, (const bf16*)(ws + WS_WF2), D / 16, (bf16*)(ws + WS_HB), D);
                SEAM(base + 9);
            }
        } else {
            if (IN(base + 7)) { p_route(F); SEAM(base + 7); }
            if (IN(base + 10)) for (int rep = 0; rep < REP(6); ++rep) {
                pg8::Gemm g{(const bf16*)(ws + WS_HB), (const bf16*)(ws + WS_WM13), MOE_TMAX * 256, NEXP * 2 * DFE, D, F.wave_s}; const Loc L = make_loc(F.wave_s);
                moe_table(F); pg8::MoeOrder<true> S; S.init((const int*)(F.ctl + CW_CNT), (const int*)(ws + WS_LIST), MOE_CAP, 2 * DFE / 256, L.G, L.bx, (const LAS int*)(F.lds + MOETBL_OFF));
                pg8::EpiSwigluMoe E{(bf16*)(ws + WS_ACT), DFE, (const float*)(ws + WS_RSL), MOE_CAP, 2 * DFE / 256};
                pg8::gemm_phase<pg8::EpiSwigluMoe, pg8::MoeOrder<true>, true, true>(F.lds + RING_OFF, g, S, E);
                { const Loc L2 = make_loc(F.wave_s); const int rem = S.nwg % L2.G; if (rem == 0) conv_w2(F, L2.bx, L2.G, 792, 1792, L2.tid); else if (L2.bx >= rem) conv_w2(F, L2.bx - rem, L2.G - rem, 792, 1792, L2.tid); }
                SEAM(base + 10);
            }
            if (IN(base + 12)) for (int rep = 0; rep < REP(7); ++rep) {
                pg8::Gemm g{(const bf16*)(ws + WS_ACT), (const bf16*)(ws + WS_WM2A), MOE_TMAX * 256, NEXP * D, DFE, F.wave_s}; const Loc L = make_loc(F.wave_s);
                moe_table(F); pg8::MoeOrder<false> S; S.init((const int*)(F.ctl + CW_CNT), (const int*)(ws + WS_LIST), MOE_CAP, D / 256, L.G, L.bx, (const LAS int*)(F.lds + MOETBL_OFF)); S.hi_off = (long)WS_WM2B - (long)WS_WM2A - (long)4 * D * DFE * 2;
                pg8::EpiYs E{(bf16*)(ws + WS_YS)};
                pg8::gemm_phase<pg8::EpiYs, pg8::MoeOrder<false>, true, true>(F.lds + RING_OFF, g, S, E);
                SEAM(base + 12);
            }
        }
    }
    if (IN(NPH - 1)) for (int rep = 0; rep < REP(9); ++rep) p_final(F, args.out);
#undef IN
#undef SEAM
}

extern "C" void kernel_launch(void* const* d_in, const int* in_sizes, int n_in, void* d_out, int out_size, void* d_ws, size_t ws_size, hipStream_t stream) {
    static int grid = 0;
    if (grid == 0) {
        if (n_in != 28 || out_size != BATCH * SEQ * D || ws_size < WS_END) { fprintf(stderr, "kernel_launch: unexpected shapes: n_in %d out %d ws %zu (need %zu)\n", n_in, out_size, ws_size, (size_t)WS_END); grid = -1; return; }
        int dev = 0, cus = 0, per_cu = 0;
        if (hipGetDevice(&dev) != hipSuccess || hipDeviceGetAttribute(&cus, hipDeviceAttributeMultiprocessorCount, dev) != hipSuccess) { grid = -1; return; }
        if (hipFuncSetAttribute((const void*)mk_fwd, hipFuncAttributeMaxDynamicSharedMemorySize, LDS_BYTES) != hipSuccess) { fprintf(stderr, "kernel_launch: hipFuncSetAttribute failed\n"); grid = -1; return; }
        if (hipOccupancyMaxActiveBlocksPerMultiprocessor(&per_cu, (const void*)mk_fwd, NWAVES * 64, LDS_BYTES) != hipSuccess || per_cu < 1) { fprintf(stderr, "kernel_launch: occupancy query says %d\n", per_cu); }
        (void)hipGetLastError();
        grid = cus;
    }
    if (grid < 0) return;
    if (hipMemsetAsync((char*)d_ws + WS_CTL, 0, CTL_ZERO_BYTES, stream) != hipSuccess) return;
    Args a{};
    for (int i = 0; i < 28; ++i) a.in[i] = (const float*)d_in[i];
    a.out = (float*)d_out; a.ws = (unsigned char*)d_ws;
#if MK_PER_PHASE
    for (int k = 0; k < NPH; ++k) { if (!phase_exists(k)) continue; a.ph_lo = k; a.ph_hi = k + 1; a.li = 0; hipLaunchKernelGGL(mk_fwd, dim3(grid), dim3(NWAVES * 64), LDS_BYTES, stream, a); }
#else
    a.ph_lo = 0; a.ph_hi = NPH; a.li = 0;
    hipLaunchKernelGGL(mk_fwd, dim3(grid), dim3(NWAVES * 64), LDS_BYTES, stream, a);
#endif
}
```

```cpp
#include <hip/hip_runtime.h>
#include <cstdio>
#include <cstdint>
#include <cmath>
#define PIN4(a, b, c, d) asm volatile("" : "+v"(a), "+v"(b), "+v"(c), "+v"(d) :: "memory")
#define PIN8(a, b, c, d, e, f, g, h) asm volatile("" : "+v"(a), "+v"(b), "+v"(c), "+v"(d), "+v"(e), "+v"(f), "+v"(g), "+v"(h) :: "memory")
#define PIN16O(A, o) asm volatile("" : "+v"(A[(o) + 0]), "+v"(A[(o) + 1]), "+v"(A[(o) + 2]), "+v"(A[(o) + 3]), "+v"(A[(o) + 4]), "+v"(A[(o) + 5]), "+v"(A[(o) + 6]), "+v"(A[(o) + 7]), "+v"(A[(o) + 8]), "+v"(A[(o) + 9]), "+v"(A[(o) + 10]), "+v"(A[(o) + 11]), "+v"(A[(o) + 12]), "+v"(A[(o) + 13]), "+v"(A[(o) + 14]), "+v"(A[(o) + 15]) :: "memory")
#define PIN16(A) asm volatile("" : "+v"(A[0]), "+v"(A[1]), "+v"(A[2]), "+v"(A[3]), "+v"(A[4]), "+v"(A[5]), "+v"(A[6]), "+v"(A[7]), "+v"(A[8]), "+v"(A[9]), "+v"(A[10]), "+v"(A[11]), "+v"(A[12]), "+v"(A[13]), "+v"(A[14]), "+v"(A[15]) :: "memory")
__device__ __forceinline__ int mk_tid(int wave_s) { int z = 0; asm volatile("" : "+v"(z)); return wave_s * 64 + (int)__builtin_amdgcn_mbcnt_hi(~0u, __builtin_amdgcn_mbcnt_lo(~0u, (unsigned)z)); }
namespace pg8 {
#define PG8_LAS __attribute__((address_space(3)))
typedef unsigned short bf16_t;
typedef short bf16x8 __attribute__((ext_vector_type(8)));
typedef float f32x4 __attribute__((ext_vector_type(4)));
typedef unsigned u32x4 __attribute__((ext_vector_type(4)));
constexpr int BM = 256, BK = 64, HALF = 128, HTB = HALF * BK * 2  , STAGE_BYTES = 8 * HTB, NXCD = 8, WGM = 8;

__host__ __device__ __forceinline__ int lds_byte(int r, int c) { const int st = (r >> 4) * 2 + (c >> 5), rr = r & 15, cc = c & 31, ob = rr * 64 + cc * 2; return st * 1024 + (ob ^ (((ob >> 9) & 1) << 5)); }
__host__ __device__ __forceinline__ void stage_rc(int b, int& R, int& C) { const int st = b / 1024, sb = b % 1024, swz = sb ^ (((sb >> 9) & 1) << 5); R = (st >> 1) * 16 + swz / 64; C = (st & 1) * 32 + (swz % 64) / 2; }
__host__ __device__ __forceinline__ int perm32(int rho) { const int n = rho >> 4, i = rho & 15; return 8 * (i >> 2) + 4 * n + (i & 3); }

struct Unit { int pm, pn, e, r0, ce, ks; };
struct Gemm { const bf16_t* A; const bf16_t* Bt; int M, N, K, wv, ld; };

struct StaticOrder {
    static constexpr bool GATHER = false;
    int nM, nN, nwg, G, c;
    __host__ __device__ void init(int M, int N, int G_, int c_) { nM = M / BM; nN = N / BM; nwg = nM * nN; G = G_; c = c_; }
    __host__ __device__ bool next(int i, Unit& u) const {
        const long L = (long)i * G + c; if (L >= nwg) return false;
        int wgid = (int)L; { const int q = nwg / NXCD, r = nwg % NXCD, xcd = wgid % NXCD, off = wgid / NXCD; wgid = (xcd < r ? xcd * (q + 1) : r * (q + 1) + (xcd - r) * q) + off; }
        const int nig = WGM * nN, gid = wgid / nig, fm = gid * WGM, gsz = (nM - fm) < WGM ? (nM - fm) : WGM;
        u.pm = fm + ((wgid % nig) % gsz); u.pn = (wgid % nig) / gsz; return true;
    }
    __device__ __forceinline__ void a_ready(const Unit&) const {}
    __device__ __forceinline__ void done(const Unit&) const {}
    __device__ __forceinline__ int arow(const Unit&, int) const { return 0; }
    __device__ __forceinline__ long boff(const Unit&) const { return 0; }
    __device__ __forceinline__ long aoff(const Unit&) const { return 0; }
};

__device__ __forceinline__ unsigned cvt_pk_bf16(float lo, float hi) { unsigned r; asm volatile("v_cvt_pk_bf16_f32 %0, %1, %2" : "=v"(r) : "v"(lo), "v"(hi)); return r; }
typedef float f32x2 __attribute__((ext_vector_type(2)));
constexpr float RMS_EPS = 1e-6f;
__device__ __forceinline__ float fast_silu(float a) { return a * __builtin_amdgcn_rcpf(1.0f + __expf(-a)); }
__device__ __forceinline__ float rstd_of(const f32x4 a, const f32x4 b, const f32x4 c, const f32x4 d) {
    const float t = (((a[0] + a[1]) + (a[2] + a[3])) + ((b[0] + b[1]) + (b[2] + b[3]))) + (((c[0] + c[1]) + (c[2] + c[3])) + ((d[0] + d[1]) + (d[2] + d[3])));
    return __builtin_amdgcn_rsqf(t * (1.0f / 1024.0f) + RMS_EPS); }
__device__ __forceinline__ float row_rstd(const float* ss, int row) { const f32x4* p = (const f32x4*)(ss + (size_t)row * 16); return rstd_of(p[0], p[1], p[2], p[3]); }
__device__ __forceinline__ void row_rstd4(const float* ss, int row0, float (&sc)[4]) {
    f32x4 v[4][4];
#pragma unroll
    for (int m = 0; m < 4; ++m)
#pragma unroll
        for (int j = 0; j < 4; ++j) v[m][j] = *(const f32x4*)(ss + (size_t)(row0 + 16 * m) * 16 + 4 * j);
    PIN8(v[0][0], v[0][1], v[0][2], v[0][3], v[1][0], v[1][1], v[1][2], v[1][3]); PIN8(v[2][0], v[2][1], v[2][2], v[2][3], v[3][0], v[3][1], v[3][2], v[3][3]);
#pragma unroll
    for (int m = 0; m < 4; ++m) sc[m] = rstd_of(v[m][0], v[m][1], v[m][2], v[m][3]);
}
struct EpiProj {
    static constexpr bool PERM = true, AFTER_DRAIN = false;
    bf16_t* O; int ldc; const float* ss;
    __device__ __forceinline__ void operator()(const f32x4 (&acc)[2][2][4][2], const Unit& u, int wr, int wc, int fr, int fq) const {
        const int row0 = u.pm * BM + wr * 64 + fr, col0 = u.pn * BM + wc * 32 + 8 * fq;
#pragma unroll
        for (int ai = 0; ai < 2; ++ai) { float sc4[4]; row_rstd4(ss, row0 + ai * HALF, sc4);
#pragma unroll
            for (int m = 0; m < 4; ++m) { const int row = row0 + ai * HALF + m * 16; const float sc = sc4[m];
                bf16_t* rowp = O + (size_t)row * ldc + col0;
#pragma unroll
                for (int bj = 0; bj < 2; ++bj) { const f32x4 v0 = acc[ai][bj][m][0] * sc, v1 = acc[ai][bj][m][1] * sc;
                    u32x4 w; w.x = cvt_pk_bf16(v0[0], v0[1]); w.y = cvt_pk_bf16(v0[2], v0[3]); w.z = cvt_pk_bf16(v1[0], v1[1]); w.w = cvt_pk_bf16(v1[2], v1[3]);
                    *(u32x4*)(rowp + bj * HALF) = w; } } }
    }
};
struct EpiSwiglu {
    static constexpr bool PERM = true, AFTER_DRAIN = false;
    bf16_t* O; int ldc; const float* ss;
    __device__ __forceinline__ void operator()(const f32x4 (&acc)[2][2][4][2], const Unit& u, int wr, int wc, int fr, int fq) const {
        const int row0 = u.pm * BM + wr * 64 + fr, col0 = u.pn * HALF + wc * 32 + 8 * fq;
#pragma unroll
        for (int ai = 0; ai < 2; ++ai) { float sc4[4]; row_rstd4(ss, row0 + ai * HALF, sc4);
#pragma unroll
            for (int m = 0; m < 4; ++m) { const int row = row0 + ai * HALF + m * 16; const float sc = sc4[m];
                const f32x4 a0 = acc[ai][0][m][0] * sc, a1 = acc[ai][0][m][1] * sc, b0 = acc[ai][1][m][0] * sc, b1 = acc[ai][1][m][1] * sc;
                u32x4 w; w.x = cvt_pk_bf16(fast_silu(a0[0]) * b0[0], fast_silu(a0[1]) * b0[1]); w.y = cvt_pk_bf16(fast_silu(a0[2]) * b0[2], fast_silu(a0[3]) * b0[3]);
                w.z = cvt_pk_bf16(fast_silu(a1[0]) * b1[0], fast_silu(a1[1]) * b1[1]); w.w = cvt_pk_bf16(fast_silu(a1[2]) * b1[2], fast_silu(a1[3]) * b1[3]);
                *(u32x4*)(O + (size_t)row * ldc + col0) = w; } }
    }
};
struct EpiResid {
    static constexpr bool PERM = false, AFTER_DRAIN = false;
    bf16_t* HB; float* ssout; const float* gate; int gstride; int write_ss;
    __device__ __forceinline__ void operator()(const f32x4 (&acc)[2][2][4][2], const Unit& u, int wr, int wc, int fr, int fq) const {
        const int row0 = u.pm * BM + wr * 64 + fr, col0 = u.pn * BM + wc * 32 + 4 * fq;
#pragma unroll
        for (int ai = 0; ai < 2; ++ai) {
            unsigned long long hv[4][2][2];
#pragma unroll
            for (int m = 0; m < 4; ++m)
#pragma unroll
                for (int bj = 0; bj < 2; ++bj)
#pragma unroll
                    for (int n = 0; n < 2; ++n) hv[m][bj][n] = *(const unsigned long long*)(HB + (size_t)(row0 + ai * HALF + m * 16) * 1024 + col0 + bj * HALF + n * 16);
            PIN8(hv[0][0][0], hv[0][0][1], hv[0][1][0], hv[0][1][1], hv[1][0][0], hv[1][0][1], hv[1][1][0], hv[1][1][1]); PIN8(hv[2][0][0], hv[2][0][1], hv[2][1][0], hv[2][1][1], hv[3][0][0], hv[3][0][1], hv[3][1][0], hv[3][1][1]);
#pragma unroll
            for (int m = 0; m < 4; ++m) { const int row = row0 + ai * HALF + m * 16; const float g = gate ? gate[(size_t)row * gstride] : 1.0f; float s = 0.f;
#pragma unroll
                for (int bj = 0; bj < 2; ++bj)
#pragma unroll
                    for (int n = 0; n < 2; ++n) { const unsigned long long h = hv[m][bj][n]; f32x4 o;
                        o[0] = __uint_as_float((unsigned)h << 16); o[1] = __uint_as_float((unsigned)h & 0xffff0000u); o[2] = __uint_as_float((unsigned)(h >> 32) << 16); o[3] = __uint_as_float((unsigned)(h >> 32) & 0xffff0000u);
                        o = o + acc[ai][bj][m][n] * g; s += (o[0] * o[0] + o[1] * o[1]) + (o[2] * o[2] + o[3] * o[3]);
                        *(unsigned long long*)(HB + (size_t)row * 1024 + col0 + bj * HALF + n * 16) = (unsigned long long)cvt_pk_bf16(o[0], o[1]) | ((unsigned long long)cvt_pk_bf16(o[2], o[3]) << 32); }
                if (write_ss) { s += __shfl_xor(s, 16); s += __shfl_xor(s, 32); if (fq == 0) ssout[(size_t)row * 16 + u.pn * 4 + wc] = s; } } }
    }
};
template <bool GATH> struct MoeOrder {
    static constexpr bool GATHER = GATH;
    int nNe, nT, nwg, G, c, cap; long hi_off; const int* list; const int* cnt; const PG8_LAS int* tbl;
    __device__ __forceinline__ void init(const int* cnt_, const int* list_, int cap_, int nNe_, int G_, int c_, const PG8_LAS int* tbl_) { list = list_; cnt = cnt_; tbl = tbl_; cap = cap_; nNe = nNe_; G = G_; c = c_; nT = tbl_[8]; nwg = nT * nNe; hi_off = 0; }
    __device__ __forceinline__ long boff(const Unit& u) const { return u.e >= 4 ? hi_off : 0; }
    __device__ __forceinline__ long aoff(const Unit&) const { return 0; }
    __device__ __forceinline__ bool next(int i, Unit& u) const {
        const long L = (long)i * G + c; if (L >= nwg) return false;
        int wgid = (int)L; { const int q = nwg / NXCD, r = nwg % NXCD, xcd = wgid % NXCD, off = wgid / NXCD; wgid = (xcd < r ? xcd * (q + 1) : r * (q + 1) + (xcd - r) * q) + off; }
        const int nig = WGM * nNe, gid = wgid / nig, fm = gid * WGM, gsz = (nT - fm) < WGM ? (nT - fm) : WGM;
        const int t = fm + ((wgid % nig) % gsz), pnl = (wgid % nig) / gsz;
        int e = 0;
#pragma unroll
        for (int k = 1; k < 8; ++k) e += (t >= tbl[k]) ? 1 : 0;
        e = __builtin_amdgcn_readfirstlane(e);
        u.pm = t; u.pn = e * nNe + pnl; u.e = e; u.r0 = (t - __builtin_amdgcn_readfirstlane(tbl[e])) * BM; u.ce = cnt[e]; return true;
    }
    __device__ __forceinline__ int arow(const Unit& u, int R) const { const int pos = u.r0 + R; return pos < u.ce ? list[(size_t)u.e * cap + pos] : 0; }
    __device__ __forceinline__ void a_ready(const Unit&) const {}
    __device__ __forceinline__ void done(const Unit&) const {}
};
struct EpiSwigluMoe {
    static constexpr bool PERM = true, AFTER_DRAIN = false;
    bf16_t* O; int ldc; const float* rs; int cap, nNe;
    __device__ __forceinline__ void operator()(const f32x4 (&acc)[2][2][4][2], const Unit& u, int wr, int wc, int fr, int fq) const {
        const int r0 = wr * 64 + fr, col0 = (u.pn - u.e * nNe) * HALF + wc * 32 + 8 * fq;
        float sc8[8];
#pragma unroll
        for (int i = 0; i < 8; ++i) { const int pos = u.r0 + r0 + (i >> 2) * HALF + (i & 3) * 16; sc8[i] = pos < u.ce ? rs[(size_t)u.e * cap + pos] : 0.0f; }
        PIN8(sc8[0], sc8[1], sc8[2], sc8[3], sc8[4], sc8[5], sc8[6], sc8[7]);
#pragma unroll
        for (int ai = 0; ai < 2; ++ai)
#pragma unroll
            for (int m = 0; m < 4; ++m) { const int R = r0 + ai * HALF + m * 16; const float sc = sc8[ai * 4 + m];
                const f32x4 a0 = acc[ai][0][m][0] * sc, a1 = acc[ai][0][m][1] * sc, b0 = acc[ai][1][m][0] * sc, b1 = acc[ai][1][m][1] * sc;
                u32x4 w; w.x = cvt_pk_bf16(fast_silu(a0[0]) * b0[0], fast_silu(a0[1]) * b0[1]); w.y = cvt_pk_bf16(fast_silu(a0[2]) * b0[2], fast_silu(a0[3]) * b0[3]);
                w.z = cvt_pk_bf16(fast_silu(a1[0]) * b1[0], fast_silu(a1[1]) * b1[1]); w.w = cvt_pk_bf16(fast_silu(a1[2]) * b1[2], fast_silu(a1[3]) * b1[3]);
                *(u32x4*)(O + (size_t)(u.pm * BM + R) * ldc + col0) = w; }
    }
};
struct EpiYs {
    static constexpr bool PERM = true, AFTER_DRAIN = false;
    bf16_t* O;
    __device__ __forceinline__ void operator()(const f32x4 (&acc)[2][2][4][2], const Unit& u, int wr, int wc, int fr, int fq) const {
        const int row0 = u.pm * BM + wr * 64 + fr, col0 = (u.pn - u.e * 4) * BM + wc * 32 + 8 * fq;
#pragma unroll
        for (int ai = 0; ai < 2; ++ai)
#pragma unroll
            for (int m = 0; m < 4; ++m) { bf16_t* rowp = O + (size_t)(row0 + ai * HALF + m * 16) * 1024 + col0;
#pragma unroll
                for (int bj = 0; bj < 2; ++bj) { const f32x4 v0 = acc[ai][bj][m][0], v1 = acc[ai][bj][m][1];
                    u32x4 w; w.x = cvt_pk_bf16(v0[0], v0[1]); w.y = cvt_pk_bf16(v0[2], v0[3]); w.z = cvt_pk_bf16(v1[0], v1[1]); w.w = cvt_pk_bf16(v1[2], v1[3]);
                    *(u32x4*)(rowp + bj * HALF) = w; } }
    }
};
struct MoeTailOrder {
    static constexpr bool GATHER = false;
    int nsub, G, c, Tm, S, kslice; long hi_off; const PG8_LAS int* tbl;
    __device__ __forceinline__ void init(const PG8_LAS int* tbl_, int G_, int c_, int Ktot) { tbl = tbl_; G = G_; c = c_; Tm = tbl_[9]; S = tbl_[10]; kslice = Ktot / S; nsub = (tbl_[8] - Tm) * 4 * S; hi_off = 0; }
    __device__ __forceinline__ bool next(int i, Unit& u) const {
        const long L = (long)i * G + c; if (L >= nsub) return false;
        const int sub = (int)L, ks = sub % S, uq = sub / S, t = Tm + (uq >> 2), pnl = uq & 3; int e = 0;
#pragma unroll
        for (int k = 1; k < 8; ++k) e += (t >= tbl[k]) ? 1 : 0;
        e = __builtin_amdgcn_readfirstlane(e);
        u.pm = t; u.pn = e * 4 + pnl; u.e = e; u.r0 = uq; u.ce = 0; u.ks = ks; return true;
    }
    __device__ __forceinline__ int arow(const Unit&, int) const { return 0; }
    __device__ __forceinline__ long aoff(const Unit& u) const { return (long)u.ks * kslice * 2; }
    __device__ __forceinline__ long boff(const Unit& u) const { return (u.e >= 4 ? hi_off : 0) + (long)u.ks * kslice * 2; }
    __device__ __forceinline__ void a_ready(const Unit&) const {}
    __device__ __forceinline__ void done(const Unit&) const {}
};
struct EpiPart {
    static constexpr bool PERM = true, AFTER_DRAIN = false;
    bf16_t* O; int S;
    __device__ __forceinline__ void operator()(const f32x4 (&acc)[2][2][4][2], const Unit& u, int wr, int wc, int fr, int fq) const {
        bf16_t* base = O + ((size_t)u.r0 * S + u.ks) * 65536; const int r0 = wr * 64 + fr, col0 = wc * 32 + 8 * fq;
#pragma unroll
        for (int ai = 0; ai < 2; ++ai)
#pragma unroll
            for (int m = 0; m < 4; ++m) { bf16_t* rowp = base + (size_t)(r0 + ai * HALF + m * 16) * 256 + col0;
#pragma unroll
                for (int bj = 0; bj < 2; ++bj) { const f32x4 v0 = acc[ai][bj][m][0], v1 = acc[ai][bj][m][1];
                    u32x4 w; w.x = cvt_pk_bf16(v0[0], v0[1]); w.y = cvt_pk_bf16(v0[2], v0[3]); w.z = cvt_pk_bf16(v1[0], v1[1]); w.w = cvt_pk_bf16(v1[2], v1[3]);
                    *(u32x4*)(rowp + bj * HALF) = w; } }
    }
};
template <class Epi, class Sched, bool ALIGN_EPI = false, bool SP2 = false>
__device__ __forceinline__ void gemm_phase(PG8_LAS unsigned char* lds, const Gemm g, const Sched& S, const Epi& E) {
    int tid_ = mk_tid(g.wv); asm volatile("" : "+v"(tid_));
    const int tid = tid_, wid = __builtin_amdgcn_readfirstlane(tid >> 6), lane = tid & 63, wr = wid >> 2, wc = wid & 3, fr = lane & 15, fq = lane >> 4;
    const int K = g.K, nt = K / BK, ld = g.ld ? g.ld : K;
    unsigned voffA[2], voffB[2];
#pragma unroll
    for (int i = 0; i < 2; ++i) { int R, C; stage_rc(tid * 16 + i * 8192, R, C); const int Rb = Epi::PERM ? ((R & ~31) + perm32(R & 31)) : R;
        voffA[i] = (unsigned)(R * ld + C) * 2u; voffB[i] = (unsigned)(Rb * ld + C) * 2u; }
    const size_t kstep = (size_t)(BK * 2);
    const size_t hstep = (size_t)HALF * ld * 2;
    const size_t tstep = 2 * hstep;
    const unsigned ldsw = (unsigned)wid * 1024u;
    const int aoff = lds_byte(wr * 64 + fr, fq * 8), boff = lds_byte(wc * 32 + fr, fq * 8);
#define PG8_SA(b, h) (((b) * 2 + (h)) * HTB)
#define PG8_SB(b, h) ((4 + (b) * 2 + (h)) * HTB)
#define PG8_STAGE(bufoff, gbase, voff) do { _Pragma("unroll") for (int _i = 0; _i < 2; ++_i) \
        __builtin_amdgcn_global_load_lds((const unsigned*)((const char*)(gbase) + (voff)[_i]), (PG8_LAS unsigned*)(lds + (bufoff) + ldsw + _i * 8192), 16, 0, 0); } while (0)
#define PG8_STAGE_A(bufoff, gbase, hh, NX) do { if constexpr (Sched::GATHER) { const unsigned _o[2] = {((NX) && last) ? ngvo[hh][0] : gvo[hh][0], ((NX) && last) ? ngvo[hh][1] : gvo[hh][1]}; PG8_STAGE(bufoff, gbase, _o); } \
        else { PG8_STAGE(bufoff, (gbase) + ((hh) ? hstep : 0), voffA); } } while (0)
#define PG8_LDA(dst, b, h) do { _Pragma("unroll") for (int m = 0; m < 4; ++m) _Pragma("unroll") for (int k = 0; k < 2; ++k) dst[m][k] = *(const PG8_LAS bf16x8*)(lds + PG8_SA(b, h) + aoff + m * 2048 + k * 1024); } while (0)
#define PG8_LDB(dst, b, h) do { _Pragma("unroll") for (int n = 0; n < 2; ++n) _Pragma("unroll") for (int k = 0; k < 2; ++k) dst[n][k] = *(const PG8_LAS bf16x8*)(lds + PG8_SB(b, h) + boff + n * 2048 + k * 1024); } while (0)
#define PG8_MMA(ai, bj, At, Bt) do { __builtin_amdgcn_s_setprio(1); _Pragma("unroll") for (int m = 0; m < 4; ++m) _Pragma("unroll") for (int n = 0; n < 2; ++n) _Pragma("unroll") for (int k = 0; k < 2; ++k) \
        acc[ai][bj][m][n] = __builtin_amdgcn_mfma_f32_16x16x32_bf16(Bt[n][k], At[m][k], acc[ai][bj][m][n], 0, 0, 0); __builtin_amdgcn_s_setprio(0); } while (0)
#define PG8_WAIT_V(n) asm volatile("s_waitcnt vmcnt(" #n ")" ::: "memory")
#define PG8_WAIT_L(n) asm volatile("s_waitcnt lgkmcnt(" #n ")" ::: "memory")
#define PG8_BAR __builtin_amdgcn_s_barrier()
#define PG8_SCHED __builtin_amdgcn_sched_barrier(0)
    Unit cur, nxt; int ui = 0;
    if (!S.next(0, cur)) return;
    f32x4 acc[2][2][4][2];
#pragma unroll
    for (int a = 0; a < 2; ++a)
#pragma unroll
        for (int b = 0; b < 2; ++b)
#pragma unroll
            for (int m = 0; m < 4; ++m)
#pragma unroll
                for (int n = 0; n < 2; ++n) acc[a][b][m][n] = (f32x4){0.f, 0.f, 0.f, 0.f};
    bf16x8 At[4][2], B0[2][2], B1[2][2];
    const char* cA = (const char*)g.A + (Sched::GATHER ? (size_t)0 : (size_t)cur.pm * tstep) + S.aoff(cur); const char* cB = (const char*)g.Bt + (size_t)cur.pn * tstep + S.boff(cur);
    unsigned gvo[2][2] = {{0u, 0u}, {0u, 0u}}, ngvo[2][2] = {{0u, 0u}, {0u, 0u}}; const bool last = false;
    if constexpr (Sched::GATHER) {
#pragma unroll
        for (int hh = 0; hh < 2; ++hh)
#pragma unroll
            for (int i = 0; i < 2; ++i) { int R, C; stage_rc(tid * 16 + i * 8192, R, C); gvo[hh][i] = (unsigned)(S.arow(cur, hh * HALF + R) * ld + C) * 2u; } }
    S.a_ready(cur);
    if constexpr (SP2) {
        PG8_STAGE(PG8_SB(0, 0), cB, voffB); PG8_STAGE(PG8_SB(0, 1), cB + hstep, voffB); PG8_STAGE_A(PG8_SA(0, 0), cA, 0, 0); PG8_STAGE_A(PG8_SA(0, 1), cA, 1, 0);
        if (wr == 1) PG8_BAR;
        PG8_WAIT_V(2); PG8_BAR;
        PG8_STAGE(PG8_SB(1, 0), cB + kstep, voffB); PG8_STAGE_A(PG8_SA(1, 0), cA + kstep, 0, 0); PG8_STAGE(PG8_SB(1, 1), cB + hstep + kstep, voffB);
        PG8_WAIT_V(6); PG8_BAR;
    } else {
        PG8_STAGE(PG8_SB(0, 0), cB, voffB); PG8_STAGE_A(PG8_SA(0, 0), cA, 0, 0); PG8_STAGE(PG8_SB(0, 1), cB + hstep, voffB); PG8_STAGE_A(PG8_SA(0, 1), cA, 1, 0);
        if (wr == 1) PG8_BAR;
        PG8_WAIT_V(4); PG8_BAR;
        PG8_STAGE(PG8_SB(1, 0), cB + kstep, voffB); PG8_STAGE_A(PG8_SA(1, 0), cA + kstep, 0, 0); PG8_STAGE(PG8_SB(1, 1), cB + hstep + kstep, voffB);
        PG8_WAIT_V(6); PG8_BAR;
    }
    for (;;) {
        const bool has_next = S.next(ui + 1, nxt);
        const char* nA = has_next ? (const char*)g.A + (Sched::GATHER ? (size_t)0 : (size_t)nxt.pm * tstep) + S.aoff(nxt) : cA; const char* nB = has_next ? (const char*)g.Bt + (size_t)nxt.pn * tstep + S.boff(nxt) : cB;
        if constexpr (Sched::GATHER) {
#pragma unroll
            for (int hh = 0; hh < 2; ++hh)
#pragma unroll
                for (int i = 0; i < 2; ++i) { int R, C; stage_rc(tid * 16 + i * 8192, R, C); ngvo[hh][i] = has_next ? (unsigned)(S.arow(nxt, hh * HALF + R) * ld + C) * 2u : gvo[hh][i]; } }
        for (int t = 0; t < nt; t += 2) {
            const bool last = (t == nt - 2);
            const char* a1 = cA + (size_t)(t + 1) * kstep;
            const char* a2 = last ? nA : cA + (size_t)(t + 2) * kstep; const char* b2 = last ? nB : cB + (size_t)(t + 2) * kstep;
            const char* a3 = a2 + kstep; const char* b3 = b2 + kstep;
            if (last && has_next) S.a_ready(nxt);
            if constexpr (SP2) {
            PG8_LDB(B0, 0, 0); PG8_LDB(B1, 0, 1); PG8_SCHED; PG8_LDA(At, 0, 0); PG8_STAGE_A(PG8_SA(1, 1), a1, 1, 0);
            PG8_WAIT_V(8); PG8_WAIT_L(0); PG8_BAR; PG8_MMA(0, 0, At, B0); PG8_MMA(0, 1, At, B1); PG8_BAR; PG8_SCHED;
            PG8_LDA(At, 0, 1); PG8_STAGE(PG8_SB(0, 0), b2, voffB); PG8_STAGE(PG8_SB(0, 1), b2 + hstep, voffB); PG8_STAGE_A(PG8_SA(0, 0), a2, 0, 1);
            PG8_WAIT_V(8); PG8_WAIT_L(0); PG8_BAR; PG8_MMA(1, 0, At, B0); PG8_MMA(1, 1, At, B1); PG8_BAR; PG8_SCHED;
            PG8_LDB(B0, 1, 0); PG8_LDB(B1, 1, 1); PG8_SCHED; PG8_LDA(At, 1, 0); PG8_STAGE_A(PG8_SA(0, 1), a2, 1, 1);
            PG8_WAIT_V(8); PG8_WAIT_L(0); PG8_BAR; PG8_MMA(0, 0, At, B0); PG8_MMA(0, 1, At, B1); PG8_BAR; PG8_SCHED;
            PG8_LDA(At, 1, 1); PG8_STAGE(PG8_SB(1, 0), b3, voffB); PG8_STAGE(PG8_SB(1, 1), b3 + hstep, voffB); PG8_STAGE_A(PG8_SA(1, 0), a3, 0, 1);
            PG8_WAIT_V(8); PG8_WAIT_L(0); PG8_BAR; PG8_MMA(1, 0, At, B0); PG8_MMA(1, 1, At, B1); PG8_BAR; PG8_SCHED;
            } else {
            PG8_LDB(B0, 0, 0); PG8_SCHED; PG8_LDA(At, 0, 0); PG8_STAGE_A(PG8_SA(1, 1), a1, 1, 0);
            PG8_WAIT_L(8); PG8_BAR; PG8_WAIT_L(0); PG8_MMA(0, 0, At, B0); PG8_BAR; PG8_SCHED;
            PG8_LDB(B1, 0, 1); PG8_STAGE(PG8_SB(0, 0), b2, voffB);
            PG8_BAR; PG8_WAIT_L(0); PG8_MMA(0, 1, At, B1); PG8_BAR;
            PG8_LDA(At, 0, 1); PG8_STAGE_A(PG8_SA(0, 0), a2, 0, 1);
            PG8_BAR; PG8_WAIT_L(0); PG8_MMA(1, 0, At, B0); PG8_BAR; PG8_SCHED;
            PG8_STAGE(PG8_SB(0, 1), b2 + hstep, voffB);
            PG8_WAIT_V(6); PG8_BAR; PG8_MMA(1, 1, At, B1); PG8_BAR;
            PG8_LDB(B0, 1, 0); PG8_SCHED; PG8_LDA(At, 1, 0); PG8_STAGE_A(PG8_SA(0, 1), a2, 1, 1);
            PG8_WAIT_L(8); PG8_BAR; PG8_WAIT_L(0); PG8_MMA(0, 0, At, B0); PG8_BAR; PG8_SCHED;
            PG8_LDB(B1, 1, 1); PG8_STAGE(PG8_SB(1, 0), b3, voffB);
            PG8_BAR; PG8_WAIT_L(0); PG8_MMA(0, 1, At, B1); PG8_BAR;
            PG8_LDA(At, 1, 1); PG8_STAGE_A(PG8_SA(1, 0), a3, 0, 1);
            PG8_BAR; PG8_WAIT_L(0); PG8_MMA(1, 0, At, B0); PG8_BAR; PG8_SCHED;
            PG8_STAGE(PG8_SB(1, 1), b3 + hstep, voffB);
            PG8_WAIT_V(6); PG8_BAR; PG8_MMA(1, 1, At, B1); PG8_BAR;
            }
        }
        if constexpr (ALIGN_EPI) { if (wr == 0) PG8_BAR; }
        if constexpr (!Epi::AFTER_DRAIN) { E(acc, cur, wr, wc, fr, fq); S.done(cur); }
        if (!has_next) break;
#pragma unroll
        for (int a = 0; a < 2; ++a)
#pragma unroll
            for (int b = 0; b < 2; ++b)
#pragma unroll
                for (int m = 0; m < 4; ++m)
#pragma unroll
                    for (int n = 0; n < 2; ++n) acc[a][b][m][n] = (f32x4){0.f, 0.f, 0.f, 0.f};
        cur = nxt; cA = nA; cB = nB; ++ui;
        if constexpr (Sched::GATHER) { gvo[0][0] = ngvo[0][0]; gvo[0][1] = ngvo[0][1]; gvo[1][0] = ngvo[1][0]; gvo[1][1] = ngvo[1][1]; }
        if constexpr (ALIGN_EPI) { if (wr == 1) PG8_BAR; }
    }
    PG8_WAIT_V(0);
    if constexpr (!ALIGN_EPI) { if (wr == 0) PG8_BAR; }
    PG8_BAR;
    if constexpr (Epi::AFTER_DRAIN) { E.fused(acc, cur, wr, wc, fr, fq, lds, wid, lane); S.done(cur); }
#undef PG8_SA
#undef PG8_SB
#undef PG8_STAGE
#undef PG8_STAGE_A
#undef PG8_LDA
#undef PG8_LDB
#undef PG8_MMA
#undef PG8_WAIT_V
#undef PG8_WAIT_L
#undef PG8_BAR
#undef PG8_SCHED
}
}
#define GAS __attribute__((address_space(1)))
#define LAS __attribute__((address_space(3)))
typedef unsigned short bf16;
typedef unsigned v4u __attribute__((ext_vector_type(4)));
typedef float f32x4 __attribute__((ext_vector_type(4)));
typedef short bf16x8 __attribute__((ext_vector_type(8)));
typedef GAS unsigned gu32;
typedef GAS unsigned long long gu64;
#define RLX_AGENT __ATOMIC_RELAXED, __HIP_MEMORY_SCOPE_AGENT
#define LDS_WAIT() asm volatile("s_waitcnt lgkmcnt(0)" ::: "memory")
#define VM_WAIT() asm volatile("s_waitcnt vmcnt(0)" ::: "memory")
__device__ __forceinline__ unsigned long long rt() { return __builtin_amdgcn_s_memrealtime(); }
__device__ __forceinline__ unsigned f2bf(float f) { unsigned u = __builtin_bit_cast(unsigned, f); return (u + 0x7fffu + ((u >> 16) & 1u)) >> 16; }
__device__ __forceinline__ unsigned pk2(float lo, float hi) { return f2bf(lo) | (f2bf(hi) << 16); }

#define XB_TMO      128
#define XB_XCNT(j)  (256  + 64 * (j))
#define XB_XSUB(j)  (1280 + 64 * (j))
#define XB_XGEN(j)  (2304 + 64 * (j))
#define XB_TOP      3328
#define XB_TOPGEN   3392
#define XCD_BAR_WORDS 3456
#define XB_SPIN_CAP (1u << 18)

__device__ __forceinline__ unsigned xb_ld(unsigned* p)              { return __hip_atomic_load(p, __ATOMIC_RELAXED, __HIP_MEMORY_SCOPE_AGENT); }
__device__ __forceinline__ unsigned xb_add(unsigned* p, unsigned v) { return __hip_atomic_fetch_add(p, v, __ATOMIC_RELAXED, __HIP_MEMORY_SCOPE_AGENT); }
__device__ __forceinline__ unsigned xb_xcc_id() { return (unsigned)__builtin_amdgcn_s_getreg((3 << 11) | 20) & 0xFu; }
#define XB_SPIN(cond, bar) do { unsigned _sp = 0; while (cond) { __builtin_amdgcn_s_sleep(1); \
    if ((++_sp & 255u) == 0u) { if (xb_ld(&(bar)[XB_TMO])) break; if (_sp > XB_SPIN_CAP) { atomicAdd(&(bar)[XB_TMO], 1u); break; } } } } while (0)

struct XcdBarrier {
    int wv;
    unsigned* bar; unsigned x;
    volatile LAS unsigned* st;
};

__device__ __forceinline__ XcdBarrier xcd_barrier_post(unsigned* bar, volatile LAS unsigned* st, int wv) {
    XcdBarrier b; b.bar = bar; b.x = xb_xcc_id(); b.st = st; b.wv = wv;
    if (mk_tid(wv) == 0) (void)xb_add(&bar[XB_XCNT(b.x)], 1u);
    return b;
}
__device__ __forceinline__ void xcd_barrier_complete(unsigned* bar, unsigned x, unsigned& nloc, unsigned& nx) {
    const unsigned G = gridDim.x * gridDim.y * gridDim.z;
    unsigned sum, cnt, mine, sp = 0u;
    for (;;) {
        sum = 0u; cnt = 0u; mine = 0u;
#pragma unroll
        for (unsigned j = 0; j < 16; ++j) { const unsigned c = xb_ld(&bar[XB_XCNT(j)]); sum += c; cnt += (c > 0u) ? 1u : 0u; mine = (j == x) ? c : mine; }
        if (sum == G) break;
        __builtin_amdgcn_s_sleep(1);
        if ((++sp & 255u) == 0u) { if (xb_ld(&bar[XB_TMO])) break; if (sp > XB_SPIN_CAP) { atomicAdd(&bar[XB_TMO], 1u); break; } }
    }
    nloc = mine > 0u ? mine : 1u; nx = cnt > 0u ? cnt : 1u;
}

__device__ __forceinline__ void xcd_barrier(const XcdBarrier& b) {
    asm volatile("s_waitcnt vmcnt(0)" ::: "memory");
    __syncthreads();
    if (mk_tid(b.wv) == 0) {
        unsigned* bar = b.bar;
        __builtin_amdgcn_s_waitcnt(0);
        unsigned nloc = b.st[0], nx = b.st[1];
        if (nloc == 0u) { xcd_barrier_complete(bar, b.x, nloc, nx); b.st[0] = nloc; b.st[1] = nx; }
        const unsigned old = xb_add(&bar[XB_XSUB(b.x)], 1u);
        const unsigned gen = old / nloc;
        if (old + 1u == (gen + 1u) * nloc) {
            __builtin_amdgcn_fence(__ATOMIC_RELEASE, "agent");
            asm volatile("s_waitcnt vmcnt(0)" ::: "memory");
            const unsigned og = xb_add(&bar[XB_TOP], 1u);
            const unsigned tg = og / nx;
            if (og + 1u == (tg + 1u) * nx) xb_add(&bar[XB_TOPGEN], 1u);
            else XB_SPIN(xb_ld(&bar[XB_TOPGEN]) == tg, bar);
            __builtin_amdgcn_fence(__ATOMIC_ACQUIRE, "agent");
            xb_add(&bar[XB_XGEN(b.x)], 1u);
            asm volatile("s_waitcnt vmcnt(0)" ::: "memory");
        } else {
            XB_SPIN(xb_ld(&bar[XB_XGEN(b.x)]) == gen, bar);
            __builtin_amdgcn_fence(__ATOMIC_ACQUIRE, "agent");
            asm volatile("s_waitcnt vmcnt(0)" ::: "memory");
        }
    }
    __syncthreads();
}
constexpr int NWAVES = 8, NT = 512;
constexpr int MT = 16384, MROW0 = MT + 112;
constexpr int BATCH = 2, SEQ = 8192, D = 1024, TB = 8320, M = BATCH * TB, PADR = 112;
constexpr int NIN = 2816, DFF = 2816, NEXP = 8, DFE = 3584;
constexpr int C_U = 0, C_HQ = 256, C_HF = 512, C_HI = 768, C_HG = 1024, C_RQ = 1280, C_RK = 1536, C_RV = 1792, C_RG = 2304;
constexpr float EPS = 1e-6f;
#ifndef PROBE_DUP
#define PROBE_DUP 0
#endif
#define REP(n) ((PROBE_DUP == (n)) ? 2 : 1)
#ifndef PROBE_TA
#define PROBE_TA -1
#define PROBE_TB -1
#endif
#ifndef PROBE_SCALE
#define PROBE_SCALE 0.01f
#endif
#ifndef PROBE_BLK
#define PROBE_BLK 200
#endif
#ifndef MK_PER_PHASE
#define MK_PER_PHASE 0
#endif
constexpr int NPH = 62;
__host__ __device__ inline bool phase_exists(int k) {
    if (k == 0 || k == NPH - 1) return true;
    const int l = (k - 1) / 30, r = (k - 1) % 30;
    if (r <= 3 || r == 6) return true;
    if (l == 0) return r == 8 || r == 9;
    return r == 7 || r == 10 || r == 12;
}
constexpr size_t MiB = 1u << 20;
constexpr size_t WS_CTL = 0, CTL_ZERO_BYTES = 1 * MiB;
constexpr int CW_TMO = 0, CW_CODE = 1, CW_BAR = 4096, CW_CNT = 16384, CW_PROBE = 16448, CW_QUEUE = 16640;
constexpr size_t WS_LB = 1 * MiB, WS_LB128 = 1 * MiB + 16384, WS_BB = 1 * MiB + 65536, WS_BBT = 1 * MiB + 393216, WS_ROT = 1 * MiB + 524288, WS_CCT = 2752512, WS_WGT = 2883584, WS_LBT = 3 * MiB;
constexpr size_t WS_POS = 3 * MiB + 65536, WS_GATE = WS_POS + 131072, WS_LIST = WS_GATE + 131072;
constexpr int MOE_CAP = 16384;
static_assert(WS_BBT + 131072 <= WS_ROT && WS_ROT + (size_t)TB * 32 * 4 <= WS_CCT && WS_CCT + 131072 <= WS_WGT && WS_WGT + 262144 <= WS_LBT && WS_LIST + 8 * MOE_CAP * 4 <= 4 * MiB, "table map");
constexpr size_t WS_WM13 = 4 * MiB, WS_YS = 4 * MiB, WS_PART = 72 * MiB, WS_WM2A = 116 * MiB, WS_WM2B = 182 * MiB, WS_HB = 149 * MiB, WS_SSP = 214 * MiB, WS_PROJ = 220 * MiB, WS_MIXED = 310 * MiB, WS_ACT = 220 * MiB;
constexpr size_t WS_WIN = 343 * MiB, WS_WOUT = 354 * MiB, WS_WF13 = 358 * MiB, WS_WF2 = 369 * MiB, WS_RSL = 458 * MiB, WS_END = 459 * MiB;
constexpr int MOE_TMAX = 136;
static_assert(WS_WM13 + (size_t)NEXP * 2 * DFE * D * 2 <= WS_WM2A && WS_YS + (size_t)MOE_TMAX * 256 * D * 2 <= WS_PART && WS_PART + (size_t)352 * 65536 * 2 <= WS_WM2A && WS_WM2A + (size_t)4 * D * DFE * 2 <= WS_HB && WS_HB + (size_t)M * D * 2 <= WS_WM2B && WS_WM2B + (size_t)4 * D * DFE * 2 <= WS_SSP, "ws map 1");
static_assert(WS_SSP + (size_t)5 * M * 16 * 4 <= WS_PROJ && WS_PROJ + (size_t)M * NIN * 2 <= WS_MIXED && WS_MIXED + (size_t)M * D * 2 <= WS_WIN, "ws map 2");
static_assert(WS_WIN + (size_t)2 * NIN * D * 2 <= WS_WOUT && WS_WOUT + (size_t)2 * D * D * 2 <= WS_WF13 && WS_WF13 + (size_t)2 * DFF * D * 2 <= WS_WF2 && WS_WF2 + (size_t)D * DFF * 2 <= WS_END, "ws map 3");
static_assert(WS_ACT + (size_t)M * DFF * 2 <= WS_MIXED && WS_ACT + (size_t)MOE_TMAX * 256 * DFE * 2 <= WS_RSL && WS_RSL + (size_t)8 * MOE_CAP * 4 <= WS_END, "ws map 4");
constexpr int RING_OFF = 0, RING_BYTES = 131072, LDSCTL_OFF = RING_BYTES, MISC_OFF = LDSCTL_OFF + 320, LDS_BYTES = 147456;

struct Frame { LAS unsigned char* lds; volatile LAS unsigned* MISC; gu32* ctl; unsigned char* ws; const float* const* in; int wave_s; };
#define STAMP(k) do { if (PROBE_TA >= 0 && blockIdx.x == PROBE_BLK && mk_tid(F.wave_s) == 0) { gu32* _p = F.ctl + CW_PROBE + (k); if (__hip_atomic_load(_p, RLX_AGENT) == 0u) __hip_atomic_store(_p, (unsigned)__builtin_amdgcn_s_memrealtime(), RLX_AGENT); } } while (0)
struct Loc { int tid, lane, wave, bx, vcu, G; };
__device__ __forceinline__ Loc make_loc(int wave_s) { Loc L; int t = mk_tid(wave_s); asm volatile("" : "+v"(t));   int b = blockIdx.x; asm volatile("" : "+s"(b)); L.tid = t; L.lane = t & 63; L.wave = __builtin_amdgcn_readfirstlane(t >> 6);
    L.bx = b; L.G = gridDim.x; L.vcu = (L.G % 8 == 0) ? (b % 8) * (L.G / 8) + b / 8 : b; return L; }
__device__ __forceinline__ float bf2f(bf16 x) { return __uint_as_float((unsigned)x << 16); }
__device__ __forceinline__ bf16 f2bf_(float f) { return (bf16)f2bf(f); }
__device__ __forceinline__ float wave_sum(float v) {
#pragma unroll
    for (int o = 1; o < 64; o <<= 1) v += __shfl_xor(v, o);
    return v;
}
__device__ __forceinline__ float silu_f(float a) { return a * __builtin_amdgcn_rcpf(1.0f + __expf(-a)); }
__device__ __forceinline__ float sigmoid_f(float a) { return __builtin_amdgcn_rcpf(1.0f + __expf(-a)); }

struct TrP { const float* W; int K, N; bf16* WT; int mode; const float* g; int item; };
constexpr int TR_LD = 257;
static_assert(64 * TR_LD * 4 <= RING_BYTES, "LDS map (transposer)");
struct TrRegs { f32x4 v[8]; float gk[8]; };
__device__ __forceinline__ void tr_wg_load(const TrP& q, int tid, TrRegs& r) {
    const int nblk = q.N / 256, kb = q.item / nblk, nb = q.item % nblk, k0 = 64 * kb, n0 = 256 * nb, wv = tid >> 6, ln = tid & 63;
#pragma unroll
    for (int i = 0; i < 8; ++i) { const int kk = 8 * i + wv; r.v[i] = *(const GAS f32x4*)(q.W + (size_t)(k0 + kk) * q.N + n0 + 4 * ln); r.gk[i] = q.g ? q.g[k0 + kk] : 1.0f; }
}
__device__ __forceinline__ void tr_wg_store(const TrP& q, LAS float* scr, int tid, TrRegs& r) {
    const int nblk = q.N / 256, kb = q.item / nblk, nb = q.item % nblk, k0 = 64 * kb, n0 = 256 * nb, wv = tid >> 6, ln = tid & 63;
    PIN8(r.v[0], r.v[1], r.v[2], r.v[3], r.v[4], r.v[5], r.v[6], r.v[7]); PIN8(r.gk[0], r.gk[1], r.gk[2], r.gk[3], r.gk[4], r.gk[5], r.gk[6], r.gk[7]);
#pragma unroll
    for (int i = 0; i < 8; ++i) { const int kk = 8 * i + wv; LAS float* d = scr + kk * TR_LD + 4 * ln; d[0] = r.v[i][0] * r.gk[i]; d[1] = r.v[i][1] * r.gk[i]; d[2] = r.v[i][2] * r.gk[i]; d[3] = r.v[i][3] * r.gk[i]; }
    __syncthreads();
    const int c = tid & 7;
#pragma unroll
    for (int j = 0; j < 4; ++j) { const int n = (tid >> 3) + 64 * j; const LAS float* s = scr + (8 * c) * TR_LD + n;
        v4u o; o.x = pk2(s[0 * TR_LD], s[1 * TR_LD]); o.y = pk2(s[2 * TR_LD], s[3 * TR_LD]); o.z = pk2(s[4 * TR_LD], s[5 * TR_LD]); o.w = pk2(s[6 * TR_LD], s[7 * TR_LD]);
        const int nn = n0 + n, drow = q.mode == 0 ? nn : ((nn >> 7) * 256 + (nn & 127) + (q.mode == 2 ? 128 : 0));
        *(GAS v4u*)(q.WT + (size_t)drow * q.K + k0 + 8 * c) = o; }
    __syncthreads();
}
__device__ __forceinline__ void tr_item_wg(const TrP& q, LAS float* scr, int tid) { TrRegs r; tr_wg_load(q, tid, r); tr_wg_store(q, scr, tid, r); }
template <class ItemFn> __device__ __forceinline__ void tr_stream(ItemFn item, int first, int last, int step, LAS float* scr, int tid) {
    if (first >= last) return;
    TrRegs ra, rb; TrP qa = item(first), qb = qa; tr_wg_load(qa, tid, ra);
    for (int it = first; it < last; it += 2 * step) {
        const bool h1 = it + step < last, h2 = it + 2 * step < last;
        if (h1) { qb = item(it + step); tr_wg_load(qb, tid, rb); }
        tr_wg_store(qa, scr, tid, ra);
        if (h2) { qa = item(it + 2 * step); tr_wg_load(qa, tid, ra); }
        if (h1) tr_wg_store(qb, scr, tid, rb);
    }
}
constexpr int I_M13 = 16 * 14, N_M13 = 16 * I_M13;
__device__ __forceinline__ TrP moe13_item(Frame& F, int it) { constexpr int I_M = I_M13; const int half = it / (8 * I_M), r = it % (8 * I_M), e = r / I_M;
    return TrP{F.in[24 + half] + (size_t)e * D * DFE, D, DFE, (bf16*)(F.ws + WS_WM13) + (size_t)e * 2 * DFE * D, 1 + half, F.in[19] + D, r % I_M}; }
__device__ __forceinline__ void conv_moe13(Frame& F, int rank, int nranks, int i0, int i1, int tid) {
    LAS float* scr = (LAS float*)(F.lds + RING_OFF);
    tr_stream([&](int it) { return moe13_item(F, it); }, i0 + rank, i1, nranks, scr, tid);
}
__device__ __forceinline__ void conv_w2(Frame& F, int rank, int nranks, int i0, int i1, int tid) {
    LAS float* scr = (LAS float*)(F.lds + RING_OFF); constexpr int I_M2 = 56 * 4;
    tr_stream([&](int it) { const int e = it / I_M2; bf16* dst = (bf16*)(F.ws + (e < 4 ? WS_WM2A : WS_WM2B)) + (size_t)(e & 3) * D * DFE;
        return TrP{F.in[26] + (size_t)e * DFE * D, DFE, D, dst, 0, nullptr, it % I_M2}; }, i0 + rank, i1, nranks, scr, tid);
}
__device__ __forceinline__ int gt0(const Loc& L) { return L.vcu * NT + L.tid; }
__device__ __forceinline__ void p0_prologue(Frame& F) {
    const Loc L = make_loc(F.wave_s);
    LAS float* scr = (LAS float*)(F.lds + RING_OFF);
    const int gw = L.vcu * NWAVES + L.wave, NGW = L.G * NWAVES;
    unsigned char* ws = F.ws; const float* const* in = F.in;
    constexpr int I_IN = 16 * 11, I_OUT = 16 * 4, I_F = 16 * 11, I_F2 = 44 * 4;
    constexpr int NITEMS = 2 * I_IN + 2 * I_OUT + 2 * I_F + I_F2;
    auto small_item = [&](int it) -> TrP { int r = it;
        if (r < 2 * I_IN) { const int l = r / I_IN; return TrP{in[3] + (size_t)l * D * NIN, D, NIN, (bf16*)(ws + WS_WIN) + (size_t)l * NIN * D, 0, in[2] + l * D, r % I_IN}; } r -= 2 * I_IN;
        if (r < 2 * I_OUT) { const int l = r / I_OUT; return TrP{in[18] + (size_t)l * D * D, D, D, (bf16*)(ws + WS_WOUT) + (size_t)l * D * D, 0, nullptr, r % I_OUT}; } r -= 2 * I_OUT;
        if (r < I_F) return TrP{in[20], D, DFF, (bf16*)(ws + WS_WF13), 1, in[19], r}; r -= I_F;
        if (r < I_F) return TrP{in[21], D, DFF, (bf16*)(ws + WS_WF13), 2, in[19], r}; r -= I_F;
        return TrP{in[22], DFF, D, (bf16*)(ws + WS_WF2), 0, nullptr, r}; };
    tr_stream(small_item, L.vcu, NITEMS, L.G, scr, L.tid);
    conv_moe13(F, L.vcu, L.G, 0, 1408, L.tid); conv_w2(F, L.vcu, L.G, 0, 792, L.tid);
    bf16* HB = (bf16*)(ws + WS_HB); float* SS0 = (float*)(ws + WS_SSP);
    for (int m = gw; m < MT + 128; m += NGW) {
        const float* src = m < MT ? in[0] + (size_t)m * D : (m < MROW0 ? nullptr : in[1] + (size_t)(m - MROW0) * D);
        f32x4 v[4]; float s = 0.f;
#pragma unroll
        for (int j = 0; j < 4; ++j) v[j] = src ? ((const GAS f32x4*)src)[L.lane + 64 * j] : (f32x4){0.f, 0.f, 0.f, 0.f};
        PIN4(v[0], v[1], v[2], v[3]);
#pragma unroll
        for (int j = 0; j < 4; ++j) s += (v[j].x * v[j].x + v[j].y * v[j].y) + (v[j].z * v[j].z + v[j].w * v[j].w);
        s = wave_sum(s);
#pragma unroll
        for (int j = 0; j < 4; ++j) ((GAS unsigned long long*)(HB + (size_t)m * D))[L.lane + 64 * j] = (unsigned long long)pk2(v[j].x, v[j].y) | ((unsigned long long)pk2(v[j].z, v[j].w) << 32);
        if (L.lane < 16) SS0[(size_t)m * 16 + L.lane] = L.lane == 0 ? s : 0.0f;
    }
    { unsigned long long* pz = (unsigned long long*)((bf16*)(ws + WS_PROJ) + (size_t)MT * NIN); for (int i = gt0(L); i < 112 * NIN / 4; i += L.G * NT) pz[i] = 0ull; }
    const int gt = L.vcu * NT + L.tid, NGT = L.G * NT;
    float* LB = (float*)(ws + WS_LB); float* BB = (float*)(ws + WS_BB); float* ROT = (float*)(ws + WS_ROT); float* LBT = (float*)(ws + WS_LBT);
    for (int i = gt; i < 2048; i += NGT) {
        const int lg = i >> 6; const float step = expf(in[11][lg]); const float lre = in[4][i], lim = in[5][i];
        const float mag = expf(lre * step); float sn, cs; sincosf(lim * step, &sn, &cs); const float br = mag * cs, bi = mag * sn;
        const float den = 1.0f / (lre * lre + lim * lim), cr = ((br - 1.0f) * lre + bi * lim) * den, ci = (bi * lre - (br - 1.0f) * lim) * den;
        LB[2 * i] = br; LB[2 * i + 1] = bi;
        for (int h = 0; h < 16; ++h) { const float b_r = in[6][i * 16 + h], b_i = in[7][i * 16 + h]; BB[(i * 16 + h) * 2] = cr * b_r - ci * b_i; BB[(i * 16 + h) * 2 + 1] = cr * b_i + ci * b_r; }
    }
    { bf16* BBT = (bf16*)(ws + WS_BBT); bf16* CCT = (bf16*)(ws + WS_CCT); bf16* WGT = (bf16*)(ws + WS_WGT); float* LB128 = (float*)(ws + WS_LB128);
      for (int i = gt; i < 2048; i += NGT) { const int lg = i >> 6, p = i & 63; const float step = expf(in[11][lg]), lre = in[4][i], lim = in[5][i];
          const float mag = expf(64.0f * lre * step); float sn, cs; sincosf(64.0f * (lim * step), &sn, &cs); LB128[2 * i] = mag * cs; LB128[2 * i + 1] = mag * sn;
          const float m1 = expf(lre * step); float s1, c1; sincosf(lim * step, &s1, &c1); const float br = m1 * c1, bi = m1 * s1, den = 1.0f / (lre * lre + lim * lim), cr = ((br - 1.0f) * lre + bi * lim) * den, ci = (bi * lre - (br - 1.0f) * lim) * den;
          for (int h = 0; h < 16; ++h) { const float b_r = in[6][i * 16 + h], b_i = in[7][i * 16 + h]; BBT[((size_t)lg * 128 + p) * 16 + h] = f2bf_(cr * b_r - ci * b_i); BBT[((size_t)lg * 128 + 64 + p) * 16 + h] = f2bf_(cr * b_i + ci * b_r);
              CCT[((size_t)lg * 16 + h) * 128 + 2 * p] = f2bf_(in[8][(lg * 16 + h) * 64 + p]); CCT[((size_t)lg * 16 + h) * 128 + 2 * p + 1] = f2bf_(-in[9][(lg * 16 + h) * 64 + p]); } }
      for (int i = gt; i < 2 * 65536; i += NGT) { const int l = i >> 16, n = (i >> 8) & 255, k = i & 255; WGT[i] = f2bf_(in[12][(size_t)l * 65536 + k * 256 + n]); } }
    for (int i = gt; i < TB * 16; i += NGT) { const int t = i >> 4, f = i & 15; const float pos = (float)(t - PADR), inv = powf(10000.0f, -(float)f / 16.0f); float sn, cs; sincosf(pos * inv, &sn, &cs); ROT[2 * i] = cs; ROT[2 * i + 1] = sn; }
    for (int i = gt; i < 512; i += NGT) { const int l = i >> 8, c = i & 255; float lb = 0.f; if (l == 1) { const float a0 = in[15][c], a1 = in[15][256 + c], mx = fmaxf(a0, a1), e0 = expf(a0 - mx), e1 = expf(a1 - mx); lb = e1 / (e0 + e1); } LBT[i] = lb; }
}

__device__ __forceinline__ float gelu_tanh(float y) { const float x = 0.7978845608028654f * (y + 0.044715f * y * y * y); const float th = 1.0f - 2.0f * __builtin_amdgcn_rcpf(1.0f + __expf(2.0f * x)); return 0.5f * y * (1.0f + th); }
__device__ __forceinline__ int chunk_row0(int b, int c) { return c == 0 ? MT : b * SEQ + (c - 1) * 128; }
__device__ __forceinline__ int s5_row0(int b, int c5) { return c5 < 2 ? MT + 64 * c5 : b * SEQ + (c5 - 2) * 64; }
typedef unsigned u32x4_t __attribute__((ext_vector_type(4)));
__device__ __forceinline__ f32x4 mfma16(bf16x8 a, bf16x8 b, f32x4 c) { return __builtin_amdgcn_mfma_f32_16x16x32_bf16(a, b, c, 0, 0, 0); }
__device__ __forceinline__ unsigned cvtpk(float lo, float hi) { unsigned r; asm volatile("v_cvt_pk_bf16_f32 %0, %1, %2" : "=v"(r) : "v"(lo), "v"(hi)); return r; }
__device__ __forceinline__ bf16x8 pack8(f32x4 a, f32x4 b) { u32x4_t w; w.x = cvtpk(a[0], a[1]); w.y = cvtpk(a[2], a[3]); w.z = cvtpk(b[0], b[1]); w.w = cvtpk(b[2], b[3]); return __builtin_bit_cast(bf16x8, w); }
__device__ __forceinline__ int perm_pos(int j) { return (j & ~31) + 8 * ((j >> 2) & 3) + 4 * ((j >> 4) & 1) + (j & 3); }
constexpr int NCH = TB / 128;
constexpr size_t OUT_RST = 0, OUT_HST = 9 * MiB, OUT_HDK = 18 * MiB, OUT_S5X = 19 * MiB;
__device__ __forceinline__ void ma_ret_unit(Frame& F, const Loc& L, int b, int c, int h, float* outb) {
    LAS bf16* Vt = (LAS bf16*)F.lds; LAS bf16* Kt = Vt + 64 * 136;
    const bf16* P = (const bf16*)(F.ws + WS_PROJ) + (size_t)chunk_row0(b, c) * NIN; const float* ROT = (const float*)(F.ws + WS_ROT) + (size_t)c * 128 * 32;
    const float lg = __log2f(1.0f - exp2f(-5.0f - (float)h));
    STAMP(5);
    { const int ch = L.tid & 63, seg = L.tid >> 6; const bf16* pv = P + (size_t)(16 * seg) * NIN + C_RV + h * 64 + ch; unsigned x[16];
#pragma unroll
      for (int r = 0; r < 16; ++r) x[r] = pv[(size_t)r * NIN];
      PIN16(x);
      u32x4_t w0, w1; w0.x = x[0] | ((unsigned)x[1] << 16); w0.y = x[2] | ((unsigned)x[3] << 16); w0.z = x[4] | ((unsigned)x[5] << 16); w0.w = x[6] | ((unsigned)x[7] << 16);
      w1.x = x[8] | ((unsigned)x[9] << 16); w1.y = x[10] | ((unsigned)x[11] << 16); w1.z = x[12] | ((unsigned)x[13] << 16); w1.w = x[14] | ((unsigned)x[15] << 16);
      *(LAS u32x4_t*)(Vt + ch * 136 + 16 * seg) = w0; *(LAS u32x4_t*)(Vt + ch * 136 + 16 * seg + 8) = w1; }
    if (L.tid < 128) { const int i = L.tid & 15, seg = L.tid >> 4; const bf16* pk = P + (size_t)(16 * seg) * NIN + C_RK + h * 32 + i; const float* rp = ROT + (16 * seg * 16 + i) * 2; float ka[16], kb[16];
      unsigned x1[16], x2[16]; float crc[16], crs[16];
#pragma unroll
      for (int r = 0; r < 16; ++r) { x1[r] = pk[(size_t)r * NIN]; x2[r] = pk[(size_t)r * NIN + 16]; const float2 t = *(const float2*)(rp + r * 32); crc[r] = t.x; crs[r] = t.y; }
      PIN16(x1); PIN16(x2); PIN16(crc); PIN16(crs);
#pragma unroll
      for (int r = 0; r < 16; ++r) { const float k1 = __uint_as_float(x1[r] << 16), k2 = __uint_as_float(x2[r] << 16), cs = crc[r], sn = crs[r], w = __builtin_amdgcn_exp2f((float)(127 - 16 * seg - r) * lg);
          ka[r] = (k1 * cs - k2 * sn) * w; kb[r] = (k1 * sn + k2 * cs) * w; }
      u32x4_t w0, w1; w0.x = cvtpk(ka[0], ka[1]); w0.y = cvtpk(ka[2], ka[3]); w0.z = cvtpk(ka[4], ka[5]); w0.w = cvtpk(ka[6], ka[7]); w1.x = cvtpk(ka[8], ka[9]); w1.y = cvtpk(ka[10], ka[11]); w1.z = cvtpk(ka[12], ka[13]); w1.w = cvtpk(ka[14], ka[15]);
      *(LAS u32x4_t*)(Kt + i * 136 + 16 * seg) = w0; *(LAS u32x4_t*)(Kt + i * 136 + 16 * seg + 8) = w1;
      w0.x = cvtpk(kb[0], kb[1]); w0.y = cvtpk(kb[2], kb[3]); w0.z = cvtpk(kb[4], kb[5]); w0.w = cvtpk(kb[6], kb[7]); w1.x = cvtpk(kb[8], kb[9]); w1.y = cvtpk(kb[10], kb[11]); w1.z = cvtpk(kb[12], kb[13]); w1.w = cvtpk(kb[14], kb[15]);
      *(LAS u32x4_t*)(Kt + (16 + i) * 136 + 16 * seg) = w0; *(LAS u32x4_t*)(Kt + (16 + i) * 136 + 16 * seg + 8) = w1; }
    STAMP(6);
    __syncthreads();
    { const int il = L.lane & 15, g = L.lane >> 4, ft = L.wave & 1, vt = L.wave >> 1; f32x4 acc = {0.f, 0.f, 0.f, 0.f};
#pragma unroll
      for (int ks = 0; ks < 4; ++ks) { const bf16x8 A = *(const LAS bf16x8*)(Kt + (16 * ft + il) * 136 + 32 * ks + 8 * g), B = *(const LAS bf16x8*)(Vt + (16 * vt + il) * 136 + 32 * ks + 8 * g); acc = mfma16(A, B, acc); }
      float* S = (float*)((unsigned char*)outb + OUT_RST) + (size_t)((b * NCH + c) * 8 + h) * 2048;
#pragma unroll
      for (int r = 0; r < 4; ++r) S[(16 * ft + 4 * g + r) * 64 + 16 * vt + il] = acc[r]; }
    __syncthreads();
    STAMP(7);
}
__device__ __forceinline__ void mb_ret(const Loc& L, float* outb, int e) {
    { const int b = e >> 14, h = (e >> 11) & 7, idx = e & 2047; const float d = exp2f(128.0f * __log2f(1.0f - exp2f(-5.0f - (float)h)));
        float* p = (float*)((unsigned char*)outb + OUT_RST) + (size_t)(b * NCH * 8 + h) * 2048 + idx; float s = 0.f;
        float loc[NCH];
#pragma unroll
        for (int c = 0; c < NCH; ++c) loc[c] = p[(size_t)c * 8 * 2048];
        PIN16(loc); PIN16O(loc, 16); PIN16O(loc, 32); PIN16O(loc, 48); asm volatile("" : "+v"(loc[64]) :: "memory");
        asm volatile("" : "+v"(p));
#pragma unroll
        for (int c = 0; c < NCH; ++c) { p[(size_t)c * 8 * 2048] = s; s = d * s + loc[c]; } }
}
__device__ __forceinline__ void mc_ret_unit(Frame& F, const Loc& L, int l, int b, int c, int h, const float* outb) {
    LAS bf16* Qrm = (LAS bf16*)F.lds; LAS bf16* Krm = Qrm + 4096; LAS bf16* Vt = Krm + 4096; LAS bf16* SpT = Vt + 64 * 136;
    const size_t row0 = (size_t)chunk_row0(b, c); const bf16* P = (const bf16*)(F.ws + WS_PROJ) + row0 * NIN; const float* ROT = (const float*)(F.ws + WS_ROT) + (size_t)c * 128 * 32;
    const float gamma = 1.0f - exp2f(-5.0f - (float)h), lg = __log2f(gamma);
    { const int r = L.tid >> 2, pq = L.tid & 3; const bf16* pr = P + (size_t)r * NIN; const f32x4 r0 = *(const f32x4*)(ROT + (r * 16 + 4 * pq) * 2), r1 = *(const f32x4*)(ROT + (r * 16 + 4 * pq) * 2 + 4);
      const float cs[4] = {r0[0], r0[2], r1[0], r1[2]}, sn[4] = {r0[1], r0[3], r1[1], r1[3]};
      const float wq = 0.17677669529663687f * exp2f((float)r * lg), wk = exp2f(-(float)r * lg);
      const unsigned long long q1 = *(const GAS unsigned long long*)(pr + C_RQ + h * 32 + 4 * pq), q2 = *(const GAS unsigned long long*)(pr + C_RQ + h * 32 + 16 + 4 * pq);
      const unsigned long long k1 = *(const GAS unsigned long long*)(pr + C_RK + h * 32 + 4 * pq), k2 = *(const GAS unsigned long long*)(pr + C_RK + h * 32 + 16 + 4 * pq);
      const int vq = 16 * pq, pj = perm_pos(r); v4u va = *(const GAS v4u*)(pr + C_RV + h * 64 + vq), vb = *(const GAS v4u*)(pr + C_RV + h * 64 + vq + 8);
      const int ksp = L.tid >> 4, v4 = (L.tid & 15) * 4; f32x4 sp = *(const f32x4*)((const float*)((const unsigned char*)outb + OUT_RST) + (size_t)((b * NCH + c) * 8 + h) * 2048 + ksp * 64 + v4);
      { unsigned long long q1_ = q1, q2_ = q2, k1_ = k1, k2_ = k2; asm volatile("" : "+v"(q1_), "+v"(q2_), "+v"(k1_), "+v"(k2_), "+v"(va), "+v"(vb), "+v"(sp) :: "memory"); (void)q1_; }
      float qa[4], qb[4], ka[4], kb[4];
#pragma unroll
      for (int e = 0; e < 4; ++e) { const float a1 = bf2f((bf16)(q1 >> (16 * e))), a2 = bf2f((bf16)(q2 >> (16 * e))), b1 = bf2f((bf16)(k1 >> (16 * e))), b2 = bf2f((bf16)(k2 >> (16 * e)));
          qa[e] = (a1 * cs[e] - a2 * sn[e]) * wq; qb[e] = (a1 * sn[e] + a2 * cs[e]) * wq; ka[e] = (b1 * cs[e] - b2 * sn[e]) * wk; kb[e] = (b1 * sn[e] + b2 * cs[e]) * wk; }
      *(LAS unsigned long long*)(Qrm + r * 32 + 4 * pq) = (unsigned long long)cvtpk(qa[0], qa[1]) | ((unsigned long long)cvtpk(qa[2], qa[3]) << 32);
      *(LAS unsigned long long*)(Qrm + r * 32 + 16 + 4 * pq) = (unsigned long long)cvtpk(qb[0], qb[1]) | ((unsigned long long)cvtpk(qb[2], qb[3]) << 32);
      *(LAS unsigned long long*)(Krm + r * 32 + 4 * pq) = (unsigned long long)cvtpk(ka[0], ka[1]) | ((unsigned long long)cvtpk(ka[2], ka[3]) << 32);
      *(LAS unsigned long long*)(Krm + r * 32 + 16 + 4 * pq) = (unsigned long long)cvtpk(kb[0], kb[1]) | ((unsigned long long)cvtpk(kb[2], kb[3]) << 32);
#pragma unroll
      for (int e = 0; e < 4; ++e) { Vt[(vq + 2 * e) * 136 + pj] = (bf16)(va[e] & 0xffffu); Vt[(vq + 2 * e + 1) * 136 + pj] = (bf16)(va[e] >> 16);
          Vt[(vq + 8 + 2 * e) * 136 + pj] = (bf16)(vb[e] & 0xffffu); Vt[(vq + 8 + 2 * e + 1) * 136 + pj] = (bf16)(vb[e] >> 16); }
#pragma unroll
      for (int e = 0; e < 4; ++e) SpT[(v4 + e) * 40 + ksp] = f2bf_(gamma * sp[e]);
    }
    __syncthreads();
    const int w = L.wave, il = L.lane & 15, g = L.lane >> 4;
    const size_t row = row0 + 16 * w + il; const bf16* gp = (const bf16*)(F.ws + WS_PROJ) + row * NIN + C_RG + h * 64; const float* og = F.in[17] + l * 512 + h * 64;
    unsigned long long gg4[4]; f32x4 og4[4];
#pragma unroll
    for (int vt = 0; vt < 4; ++vt) { gg4[vt] = *(const GAS unsigned long long*)(gp + 16 * vt + 4 * g); og4[vt] = *(const f32x4*)(og + 16 * vt + 4 * g); }
    const bf16x8 Bq = *(const LAS bf16x8*)(Qrm + (16 * w + il) * 32 + 8 * g);
    const f32x4 zero = {0.f, 0.f, 0.f, 0.f}; f32x4 O[4] = {zero, zero, zero, zero};
#pragma unroll
    for (int jp = 0; jp < 4; ++jp) if (2 * jp <= w) {
        f32x4 p0, p1 = zero;
        { const bf16x8 A = *(const LAS bf16x8*)(Krm + (32 * jp + il) * 32 + 8 * g); p0 = mfma16(A, Bq, zero);
          if (2 * jp == w) {
#pragma unroll
              for (int r = 0; r < 4; ++r) if (4 * g + r > il) p0[r] = 0.f; } }
        if (2 * jp + 1 <= w) { const bf16x8 A = *(const LAS bf16x8*)(Krm + (32 * jp + 16 + il) * 32 + 8 * g); p1 = mfma16(A, Bq, zero);
          if (2 * jp + 1 == w) {
#pragma unroll
              for (int r = 0; r < 4; ++r) if (4 * g + r > il) p1[r] = 0.f; } }
        const bf16x8 Bp = pack8(p0, p1);
#pragma unroll
        for (int vt = 0; vt < 4; ++vt) { const bf16x8 A = *(const LAS bf16x8*)(Vt + (16 * vt + il) * 136 + 32 * jp + 8 * g); O[vt] = mfma16(A, Bp, O[vt]); }
    }
#pragma unroll
    for (int vt = 0; vt < 4; ++vt) { const bf16x8 A = *(const LAS bf16x8*)(SpT + (16 * vt + il) * 40 + 8 * g); O[vt] = mfma16(A, Bq, O[vt]); }
    float s1 = 0.f;
#pragma unroll
    for (int vt = 0; vt < 4; ++vt) s1 += (O[vt][0] + O[vt][1]) + (O[vt][2] + O[vt][3]);
    s1 += __shfl_xor(s1, 16); s1 += __shfl_xor(s1, 32); const float mean = s1 * (1.0f / 64.0f); float s2 = 0.f;
#pragma unroll
    for (int vt = 0; vt < 4; ++vt) { O[vt] = O[vt] - mean; s2 += (O[vt][0] * O[vt][0] + O[vt][1] * O[vt][1]) + (O[vt][2] * O[vt][2] + O[vt][3] * O[vt][3]); }
    s2 += __shfl_xor(s2, 16); s2 += __shfl_xor(s2, 32); const float rstd = rsqrtf(s2 * (1.0f / 64.0f) + EPS);
    bf16* mo = (bf16*)(F.ws + WS_MIXED) + row * D + 512 + h * 64;
#pragma unroll
    for (int vt = 0; vt < 4; ++vt) { const int v0 = 16 * vt + 4 * g; const unsigned long long gg = gg4[vt]; const f32x4 o4 = og4[vt]; float y[4];
#pragma unroll
        for (int r = 0; r < 4; ++r) y[r] = O[vt][r] * rstd * o4[r] * silu_f(bf2f((bf16)(gg >> (16 * r))));
        *(GAS unsigned long long*)(mo + v0) = (unsigned long long)cvtpk(y[0], y[1]) | ((unsigned long long)cvtpk(y[2], y[3]) << 32); }
    __syncthreads();
}
constexpr int HG_LD = 68;
constexpr int SEG_OFF = MISC_OFF + 192;
static_assert(SEG_OFF % 16 == 0 && SEG_OFF + 2048 <= LDS_BYTES, "LDS map (SEG)");
__device__ __forceinline__ const bf16* hg_hist(const bf16* PROJ, int b, int c, int w) {
    if (w > 0) return PROJ + (size_t)(chunk_row0(b, c) + 16 * w - 3) * NIN;
    if (c == 0) return nullptr;
    return PROJ + (size_t)(chunk_row0(b, c - 1) + 125) * NIN;
}
template <bool NEED_Q> __device__ __forceinline__ void hg_rows(const bf16* Pcur, const bf16* Ph, int ch, const float* cw, float lb, float (&q)[16], float (&kk)[16], float (&vv)[16], float (&gl)[16]) {
    float wq[4], wf[4], wi[4];
#pragma unroll
    for (int j = 0; j < 4; ++j) { wq[j] = cw[j * 768 + ch]; wf[j] = cw[j * 768 + 256 + ch]; wi[j] = cw[j * 768 + 512 + ch]; }
    unsigned hq0[3] = {0u, 0u, 0u}, hf0[3] = {0u, 0u, 0u}, hi0[3] = {0u, 0u, 0u}, rq[16], rf[16], ri[16];
#pragma unroll
    for (int j = 0; j < 3; ++j) { if (Ph) { const bf16* pr = Ph + (size_t)j * NIN; if (NEED_Q) hq0[j] = pr[C_HQ + ch]; hf0[j] = pr[C_HF + ch]; hi0[j] = pr[C_HI + ch]; } }
#pragma unroll
    for (int r = 0; r < 16; ++r) { const bf16* pr = Pcur + (size_t)r * NIN; rq[r] = NEED_Q ? (unsigned)pr[C_HQ + ch] : 0u; rf[r] = pr[C_HF + ch]; ri[r] = pr[C_HI + ch]; }
    if (NEED_Q) { PIN16(rq); PIN4(hq0[0], hq0[1], hq0[2], wq[0]); } PIN16(rf); PIN16(ri); PIN8(hf0[0], hf0[1], hf0[2], hi0[0], hi0[1], hi0[2], wf[0], wi[0]);
    float hq[3], hf[3], hi[3];
#pragma unroll
    for (int j = 0; j < 3; ++j) { hq[j] = __uint_as_float(hq0[j] << 16); hf[j] = __uint_as_float(hf0[j] << 16); hi[j] = __uint_as_float(hi0[j] << 16); }
    float run = 0.f;
#pragma unroll
    for (int r = 0; r < 16; ++r) { const float xq = __uint_as_float(rq[r] << 16), xf = __uint_as_float(rf[r] << 16), xi = __uint_as_float(ri[r] << 16);
        const float cq = (wq[0] * hq[0] + wq[1] * hq[1]) + (wq[2] * hq[2] + wq[3] * xq), cf = (wf[0] * hf[0] + wf[1] * hf[1]) + (wf[2] * hf[2] + wf[3] * xf), ci = (wi[0] * hi[0] + wi[1] * hi[1]) + (wi[2] * hi[2] + wi[3] * xi);
        hq[0] = hq[1]; hq[1] = hq[2]; hq[2] = xq; hf[0] = hf[1]; hf[1] = hf[2]; hf[2] = xf; hi[0] = hi[1]; hi[1] = hi[2]; hi[2] = xi;
        const float f = fmaxf(lb + (1.0f - lb) * sigmoid_f(cf), 1e-30f); run += __logf(f); gl[r] = run; kk[r] = 1.0f - f; vv[r] = ci; q[r] = NEED_Q ? silu_f(cq) : 0.f; }
}
__device__ __forceinline__ void ma_hg_unit(Frame& F, const Loc& L, int l, int b, int c, int h, float* outb) {
    LAS bf16* Vt = (LAS bf16*)F.lds; LAS bf16* Kt = Vt + 64 * 136; LAS float* SEG = (LAS float*)(F.lds + SEG_OFF);
    const bf16* PJ = (const bf16*)(F.ws + WS_PROJ); const int k = L.tid & 63, w = L.tid >> 6;
    float q[16], kk[16], vv[16], gl[16];
    STAMP(0);
    hg_rows<false>(PJ + (size_t)(chunk_row0(b, c) + 16 * w) * NIN, hg_hist(PJ, b, c, w), h * 64 + k, F.in[14] + l * 4 * 768, ((const float*)(F.ws + WS_LBT))[l * 256 + h * 64 + k], q, kk, vv, gl);
    STAMP(1);
    { u32x4_t w0, w1; w0.x = cvtpk(vv[0], vv[1]); w0.y = cvtpk(vv[2], vv[3]); w0.z = cvtpk(vv[4], vv[5]); w0.w = cvtpk(vv[6], vv[7]); w1.x = cvtpk(vv[8], vv[9]); w1.y = cvtpk(vv[10], vv[11]); w1.z = cvtpk(vv[12], vv[13]); w1.w = cvtpk(vv[14], vv[15]);
      *(LAS u32x4_t*)(Vt + k * 136 + 16 * w) = w0; *(LAS u32x4_t*)(Vt + k * 136 + 16 * w + 8) = w1; }
    SEG[w * 64 + k] = gl[15];
    __syncthreads();
    STAMP(2);
    float off = 0.f, tot = 0.f;
#pragma unroll
    for (int ww = 0; ww < 8; ++ww) { const float s = SEG[ww * 64 + k]; if (ww < w) off += s; tot += s; }
    { float e[16];
#pragma unroll
      for (int r = 0; r < 16; ++r) e[r] = kk[r] * __expf(tot - off - gl[r]);
      u32x4_t w0, w1; w0.x = cvtpk(e[0], e[1]); w0.y = cvtpk(e[2], e[3]); w0.z = cvtpk(e[4], e[5]); w0.w = cvtpk(e[6], e[7]); w1.x = cvtpk(e[8], e[9]); w1.y = cvtpk(e[10], e[11]); w1.z = cvtpk(e[12], e[13]); w1.w = cvtpk(e[14], e[15]);
      *(LAS u32x4_t*)(Kt + k * 136 + 16 * w) = w0; *(LAS u32x4_t*)(Kt + k * 136 + 16 * w + 8) = w1; }
    const size_t ui = (size_t)(b * NCH + c) * 4 + h;
    if (w == 0) ((float*)((unsigned char*)outb + OUT_HDK))[ui * 64 + k] = __expf(tot);
    __syncthreads();
    STAMP(3);
    { const int il = L.lane & 15, g = L.lane >> 4, kt = L.wave >> 1, vt0 = 2 * (L.wave & 1); const f32x4 zero = {0.f, 0.f, 0.f, 0.f}; f32x4 acc[2] = {zero, zero};
#pragma unroll
      for (int ks = 0; ks < 4; ++ks) { const bf16x8 A = *(const LAS bf16x8*)(Kt + (16 * kt + il) * 136 + 32 * ks + 8 * g);
#pragma unroll
          for (int t = 0; t < 2; ++t) { const bf16x8 B = *(const LAS bf16x8*)(Vt + (16 * (vt0 + t) + il) * 136 + 32 * ks + 8 * g); acc[t] = mfma16(A, B, acc[t]); } }
      float* S = (float*)((unsigned char*)outb + OUT_HST) + ui * 4096;
#pragma unroll
      for (int t = 0; t < 2; ++t)
#pragma unroll
          for (int r = 0; r < 4; ++r) S[(16 * kt + 4 * g + r) * 64 + 16 * (vt0 + t) + il] = acc[t][r]; }
    __syncthreads();
    STAMP(4);
}
__device__ __forceinline__ void mb_hg(const Loc& L, float* outb, int e) {
    { const int b = e >> 14, h = (e >> 12) & 3, idx = e & 4095;
        float* p = (float*)((unsigned char*)outb + OUT_HST) + (size_t)(b * NCH * 4 + h) * 4096 + idx; const float* dk = (const float*)((unsigned char*)outb + OUT_HDK) + (size_t)(b * NCH * 4 + h) * 64 + (idx >> 6); float s = 0.f;
        float loc[NCH], dd[NCH];
#pragma unroll
        for (int c = 0; c < NCH; ++c) { loc[c] = p[(size_t)c * 4 * 4096]; dd[c] = dk[(size_t)c * 4 * 64]; }
        PIN16(loc); PIN16O(loc, 16); PIN16O(loc, 32); PIN16O(loc, 48); PIN16(dd); PIN16O(dd, 16); PIN16O(dd, 32); PIN16O(dd, 48); asm volatile("" : "+v"(loc[64]), "+v"(dd[64]) :: "memory");
        asm volatile("" : "+v"(p));
#pragma unroll
        for (int c = 0; c < NCH; ++c) { p[(size_t)c * 4 * 4096] = s; s = dd[c] * s + loc[c]; } }
}
__device__ __forceinline__ f32x4 ld4(const LAS float* p) { return *(const LAS f32x4*)p; }
__device__ __forceinline__ void mc_hg_unit(Frame& F, const Loc& L, int l, int b, int c, int h, const float* outb) {
    LAS float* Qf = (LAS float*)F.lds; LAS float* Kf = Qf + 128 * HG_LD; LAS float* G = Kf + 128 * HG_LD; LAS bf16* Vt = (LAS bf16*)(G + 128 * HG_LD); LAS bf16* SpT = Vt + 64 * 136; LAS float* SEG = (LAS float*)(F.lds + SEG_OFF);
    static_assert(3 * 128 * HG_LD * 4 + 64 * 136 * 2 + 64 * 72 * 2 <= RING_BYTES, "LDS map (HGRN2 MC)");
    const size_t row0 = (size_t)chunk_row0(b, c); const bf16* PJ = (const bf16*)(F.ws + WS_PROJ);
    { const int k = L.tid & 63, w = L.tid >> 6; float q[16], kk[16], vv[16], gl[16];
      hg_rows<true>(PJ + (size_t)(row0 + 16 * w) * NIN, hg_hist(PJ, b, c, w), h * 64 + k, F.in[14] + l * 4 * 768, ((const float*)(F.ws + WS_LBT))[l * 256 + h * 64 + k], q, kk, vv, gl);
#pragma unroll
      for (int r = 0; r < 16; ++r) { const int t = 16 * w + r; Qf[t * HG_LD + k] = q[r]; Kf[t * HG_LD + k] = kk[r]; Vt[k * 136 + perm_pos(t)] = f2bf_(vv[r]); }
      SEG[w * 64 + k] = gl[15];
      { const int kr = L.tid >> 3, v8 = (L.tid & 7) * 8; const float* sp = (const float*)((const unsigned char*)outb + OUT_HST) + ((size_t)(b * NCH + c) * 4 + h) * 4096 + kr * 64 + v8; const f32x4 s0 = *(const f32x4*)sp, s1 = *(const f32x4*)(sp + 4);
#pragma unroll
        for (int e = 0; e < 4; ++e) { SpT[(v8 + e) * 72 + kr] = f2bf_(s0[e]); SpT[(v8 + 4 + e) * 72 + kr] = f2bf_(s1[e]); } }
      __syncthreads();
      float off = 0.f;
#pragma unroll
      for (int ww = 0; ww < 8; ++ww) { const float s = SEG[ww * 64 + k]; if (ww < w) off += s; }
#pragma unroll
      for (int r = 0; r < 16; ++r) G[(16 * w + r) * HG_LD + k] = gl[r] + off;
    }
    __syncthreads();
    const int w = L.wave, il = L.lane & 15, g = L.lane >> 4; const f32x4 zero = {0.f, 0.f, 0.f, 0.f};
    const size_t row = row0 + 16 * w + il; const bf16* gp = (const bf16*)(F.ws + WS_PROJ) + row * NIN + C_HG + h * 64; const float* og = F.in[16] + l * 256 + h * 64;
    unsigned long long gg4[4]; f32x4 og4[4];
#pragma unroll
    for (int vt = 0; vt < 4; ++vt) { gg4[vt] = *(const GAS unsigned long long*)(gp + 16 * vt + 4 * g); og4[vt] = *(const f32x4*)(og + 16 * vt + 4 * g); }
    f32x4 gr[2][2]; bf16x8 Bq[2], Bqi[2];
#pragma unroll
    for (int ks = 0; ks < 2; ++ks) { const int ko = 32 * ks + 8 * g;
        if (w > 0) { gr[ks][0] = ld4(G + (16 * w - 1) * HG_LD + ko); gr[ks][1] = ld4(G + (16 * w - 1) * HG_LD + ko + 4); } else { gr[ks][0] = zero; gr[ks][1] = zero; }
        const f32x4 q0 = ld4(Qf + (16 * w + il) * HG_LD + ko), q1 = ld4(Qf + (16 * w + il) * HG_LD + ko + 4), g0 = ld4(G + (16 * w + il) * HG_LD + ko), g1 = ld4(G + (16 * w + il) * HG_LD + ko + 4);
        f32x4 a0, a1, b0, b1;
#pragma unroll
        for (int e = 0; e < 4; ++e) { a0[e] = q0[e] * __expf(g0[e] - gr[ks][0][e]); a1[e] = q1[e] * __expf(g1[e] - gr[ks][1][e]); b0[e] = q0[e] * __expf(g0[e]); b1[e] = q1[e] * __expf(g1[e]); }
        Bq[ks] = pack8(a0, a1); Bqi[ks] = pack8(b0, b1); }
    f32x4 O[4] = {zero, zero, zero, zero};
#pragma unroll
    for (int jp = 0; jp < 4; ++jp) if (2 * jp <= w) {
        f32x4 pt[2] = {zero, zero};
#pragma unroll
        for (int hh = 0; hh < 2; ++hh) if (2 * jp + hh <= w) { const int J = 2 * jp + hh;
#pragma unroll
            for (int ks = 0; ks < 2; ++ks) { const int ko = 32 * ks + 8 * g; const f32x4 k0 = ld4(Kf + (16 * J + il) * HG_LD + ko), k1 = ld4(Kf + (16 * J + il) * HG_LD + ko + 4), g0 = ld4(G + (16 * J + il) * HG_LD + ko), g1 = ld4(G + (16 * J + il) * HG_LD + ko + 4);
                f32x4 a0, a1;
#pragma unroll
                for (int e = 0; e < 4; ++e) { a0[e] = k0[e] * __expf(fminf(gr[ks][0][e] - g0[e], 80.0f)); a1[e] = k1[e] * __expf(fminf(gr[ks][1][e] - g1[e], 80.0f)); }
                pt[hh] = mfma16(pack8(a0, a1), Bq[ks], pt[hh]); }
            if (J == w) {
#pragma unroll
                for (int r = 0; r < 4; ++r) if (4 * g + r > il) pt[hh][r] = 0.f; } }
        const bf16x8 Bp = pack8(pt[0], pt[1]);
#pragma unroll
        for (int vt = 0; vt < 4; ++vt) { const bf16x8 A = *(const LAS bf16x8*)(Vt + (16 * vt + il) * 136 + 32 * jp + 8 * g); O[vt] = mfma16(A, Bp, O[vt]); }
    }
#pragma unroll
    for (int vt = 0; vt < 4; ++vt)
#pragma unroll
        for (int ks = 0; ks < 2; ++ks) { const bf16x8 A = *(const LAS bf16x8*)(SpT + (16 * vt + il) * 72 + 32 * ks + 8 * g); O[vt] = mfma16(A, Bqi[ks], O[vt]); }
    float s2 = 0.f;
#pragma unroll
    for (int vt = 0; vt < 4; ++vt) s2 += (O[vt][0] * O[vt][0] + O[vt][1] * O[vt][1]) + (O[vt][2] * O[vt][2] + O[vt][3] * O[vt][3]);
    s2 += __shfl_xor(s2, 16); s2 += __shfl_xor(s2, 32); const float rstd = rsqrtf(s2 * (1.0f / 64.0f) + EPS);
    bf16* mo = (bf16*)(F.ws + WS_MIXED) + row * D + 256 + h * 64;
#pragma unroll
    for (int vt = 0; vt < 4; ++vt) { const int v0 = 16 * vt + 4 * g; const unsigned long long gg = gg4[vt]; const f32x4 o4 = og4[vt]; float y[4];
#pragma unroll
        for (int r = 0; r < 4; ++r) y[r] = O[vt][r] * rstd * o4[r] * silu_f(bf2f((bf16)(gg >> (16 * r))));
        *(GAS unsigned long long*)(mo + v0) = (unsigned long long)cvtpk(y[0], y[1]) | ((unsigned long long)cvtpk(y[2], y[3]) << 32); }
    __syncthreads();
}
constexpr int NCH5 = TB / 64, S5R = 64, S5S = 4;
constexpr int S5_WREG = 14592, BU_LD = 20, XS_LD = 136, GY_LD = 264;
static_assert(8 * S5_WREG <= RING_BYTES && S5R * GY_LD * 2 + 4096 + 512 <= RING_BYTES, "LDS map (S5)");
template <bool FULL> __device__ __forceinline__ void s5_group(Frame& F, const Loc& L, int l, int gidx, const bf16* Pc  , float& xr, float& xi, unsigned (&gy)[S5S][2]) {
    LAS float* BUt = (LAS float*)(F.lds + L.wave * S5_WREG); LAS bf16* Xs = (LAS bf16*)(F.lds + L.wave * S5_WREG + 128 * BU_LD * 4);
    const int il = L.lane & 15, g4 = L.lane >> 4, lg = l * 16 + gidx; const f32x4 zero = {0.f, 0.f, 0.f, 0.f}; const bf16x8 bz = {0, 0, 0, 0, 0, 0, 0, 0};
    bf16x8 Bb[8];
#pragma unroll
    for (int ct = 0; ct < 8; ++ct) Bb[ct] = g4 < 2 ? *(const bf16x8*)((const bf16*)(F.ws + WS_BBT) + ((size_t)lg * 128 + 16 * ct + il) * 16 + 8 * g4) : bz;
    bf16x8 Cb[4], Db = bz;
    if (FULL) {
#pragma unroll
        for (int ks = 0; ks < 4; ++ks) Cb[ks] = *(const bf16x8*)((const bf16*)(F.ws + WS_CCT) + ((size_t)lg * 16 + il) * 128 + 32 * ks + 8 * g4);
        const short dsk = (short)f2bf_(F.in[10][lg * 16 + il]);
#pragma unroll
        for (int jj = 0; jj < 8; ++jj) Db[jj] = (8 * g4 + jj == il) ? dsk : (short)0; }
    const float* LB = (const float*)(F.ws + WS_LB) + (size_t)(lg * 64 + L.lane) * 2; const float lr = LB[0], li = LB[1];
    const unsigned avoff = (unsigned)(il * NIN + C_U + 16 * gidx + 8 * g4) * 2u;
    bf16x8 Aall[S5S];
#pragma unroll
    for (int s = 0; s < S5S; ++s) Aall[s] = g4 < 2 ? *(const bf16x8*)((const char*)(Pc + (size_t)16 * s * NIN) + avoff) : bz;
#pragma unroll
    for (int s = 0; s < S5S; ++s) {
        const bf16x8 A = Aall[s];
#pragma unroll
        for (int ct = 0; ct < 8; ++ct) { const f32x4 d = mfma16(A, Bb[ct], zero); *(LAS f32x4*)(BUt + (16 * ct + il) * BU_LD + 4 * g4) = d; }
#pragma unroll
        for (int q = 0; q < 4; ++q) { const f32x4 br = *(const LAS f32x4*)(BUt + L.lane * BU_LD + 4 * q), bi = *(const LAS f32x4*)(BUt + (64 + L.lane) * BU_LD + 4 * q);
#pragma unroll
            for (int e = 0; e < 4; ++e) { const float nr = fmaf(lr, xr, fmaf(-li, xi, br[e])), ni = fmaf(lr, xi, fmaf(li, xr, bi[e])); xr = nr; xi = ni;
                if (FULL) *(LAS unsigned*)(Xs + (4 * q + e) * XS_LD + 2 * L.lane) = cvtpk(xr, xi); } }
        if (FULL) { f32x4 y = mfma16(A, Db, zero);
#pragma unroll
            for (int ks = 0; ks < 4; ++ks) { const bf16x8 Ax = *(const LAS bf16x8*)(Xs + il * XS_LD + 32 * ks + 8 * g4); y = mfma16(Ax, Cb[ks], y); }
            gy[s][0] = cvtpk(gelu_tanh(y[0]), gelu_tanh(y[1])); gy[s][1] = cvtpk(gelu_tanh(y[2]), gelu_tanh(y[3])); }
        asm volatile("" : "+v"(xr), "+v"(xi) :: "memory");
    }
}
__device__ __forceinline__ void ma_s5_unit(Frame& F, const Loc& L, int l, int b, int c, float* outb) {
    const bf16* Pc = (const bf16*)(F.ws + WS_PROJ) + (size_t)s5_row0(b, c) * NIN; unsigned gy[S5S][2];
#pragma unroll
    for (int gi = 0; gi < 2; ++gi) { const int gidx = 2 * L.wave + gi; float xr = 0.f, xi = 0.f; s5_group<false>(F, L, l, gidx, Pc, xr, xi, gy);
        float* xo = (float*)((unsigned char*)outb + OUT_S5X) + (((size_t)(b * NCH5 + c) * 16 + gidx) * 64 + L.lane) * 2; xo[0] = xr; xo[1] = xi; }
    __syncthreads();
}
__device__ __forceinline__ void mb_s5(Frame& F, const Loc& L, int l, float* outb, int e) {
    { const int b = e >> 10, gp = e & 1023; const float* lb = (const float*)(F.ws + WS_LB128) + (size_t)(l * 1024 + gp) * 2; const float dr = lb[0], di = lb[1];
        float* p = (float*)((unsigned char*)outb + OUT_S5X) + ((size_t)b * NCH5 * 1024 + gp) * 2; float sr = 0.f, si = 0.f; asm volatile("" : "+v"(sr), "+v"(si));
#pragma unroll
        for (int hf = 0; hf < 2; ++hf) {
            float la[65], lbv[65];
#pragma unroll
            for (int c = 0; c < 65; ++c) { const float2 t = *(const float2*)(p + (size_t)c * 2048); la[c] = t.x; lbv[c] = t.y; }
            PIN16(la); PIN16O(la, 16); PIN16O(la, 32); PIN16O(la, 48); PIN16(lbv); PIN16O(lbv, 16); PIN16O(lbv, 32); PIN16O(lbv, 48); asm volatile("" : "+v"(la[64]), "+v"(lbv[64]) :: "memory");
            asm volatile("" : "+v"(p));
#pragma unroll
            for (int c = 0; c < 65; ++c) { *(float2*)(p + (size_t)c * 2048) = make_float2(sr, si); const float nr = dr * sr - di * si + la[c], ni = dr * si + di * sr + lbv[c]; sr = nr; si = ni; }
            p += (size_t)65 * 2048; } }
}
__device__ __forceinline__ void mc_s5_unit(Frame& F, const Loc& L, int l, int b, int c, const float* outb) {
    const size_t row0 = (size_t)s5_row0(b, c); const bf16* Pc = (const bf16*)(F.ws + WS_PROJ) + row0 * NIN;
    const int il = L.lane & 15, g4 = L.lane >> 4, w = L.wave;
    unsigned gy[2][S5S][2];
    STAMP(40);
#pragma unroll
    for (int gi = 0; gi < 2; ++gi) { const int gidx = 2 * w + gi; const float* xo = (const float*)((const unsigned char*)outb + OUT_S5X) + (((size_t)(b * NCH5 + c) * 16 + gidx) * 64 + L.lane) * 2; float xr = xo[0], xi = xo[1];
        s5_group<true>(F, L, l, gidx, Pc, xr, xi, gy[gi]); if (gi == 0) STAMP(41); }
    STAMP(42);
    __syncthreads();
    LAS bf16* GYs = (LAS bf16*)F.lds; LAS float* RED = (LAS float*)(F.lds + S5R * GY_LD * 2); LAS float* RSTD = RED + S5R * 8;
#pragma unroll
    for (int gi = 0; gi < 2; ++gi)
#pragma unroll
        for (int s = 0; s < S5S; ++s)
#pragma unroll
            for (int r = 0; r < 4; ++r) GYs[(16 * s + 4 * g4 + r) * GY_LD + 16 * (2 * w + gi) + il] = (bf16)(gy[gi][s][r >> 1] >> (16 * (r & 1)));
    __syncthreads();
    STAMP(43);
    const f32x4 zero = {0.f, 0.f, 0.f, 0.f}; f32x4 acc[S5S][2];
#pragma unroll
    for (int tt = 0; tt < S5S; ++tt) { acc[tt][0] = zero; acc[tt][1] = zero; }
    const bf16* WG = (const bf16*)(F.ws + WS_WGT) + (size_t)l * 65536;
    bf16x8 Wf[8][2];
#pragma unroll
    for (int ks = 0; ks < 8; ++ks) { Wf[ks][0] = *(const bf16x8*)(WG + (size_t)(32 * w + il) * 256 + 32 * ks + 8 * g4); Wf[ks][1] = *(const bf16x8*)(WG + (size_t)(32 * w + 16 + il) * 256 + 32 * ks + 8 * g4); }
#pragma unroll
    for (int ks = 0; ks < 8; ++ks) {
#pragma unroll
        for (int tt = 0; tt < S5S; ++tt) { const bf16x8 Ag = *(const LAS bf16x8*)(GYs + (16 * tt + il) * GY_LD + 32 * ks + 8 * g4); acc[tt][0] = mfma16(Wf[ks][0], Ag, acc[tt][0]); acc[tt][1] = mfma16(Wf[ks][1], Ag, acc[tt][1]); } }
#pragma unroll
    for (int tt = 0; tt < S5S; ++tt) { float ss = 0.f;
#pragma unroll
        for (int nt = 0; nt < 2; ++nt) { const unsigned long long gq = *(const LAS unsigned long long*)(GYs + (16 * tt + il) * GY_LD + 32 * w + 16 * nt + 4 * g4);
#pragma unroll
            for (int r = 0; r < 4; ++r) { const float v = bf2f((bf16)(gq >> (16 * r))) * sigmoid_f(acc[tt][nt][r]); acc[tt][nt][r] = v; ss += v * v; } }
        ss += __shfl_xor(ss, 16); ss += __shfl_xor(ss, 32); if (g4 == 0) RED[(16 * tt + il) * 8 + w] = ss; }
    STAMP(44);
    __syncthreads();
    if (L.tid < S5R) { const f32x4 a = *(const LAS f32x4*)(RED + L.tid * 8), bq = *(const LAS f32x4*)(RED + L.tid * 8 + 4); RSTD[L.tid] = rsqrtf((((a[0] + a[1]) + (a[2] + a[3])) + ((bq[0] + bq[1]) + (bq[2] + bq[3]))) * (1.0f / 256.0f) + EPS); }
    __syncthreads();
    const float* og = F.in[13] + l * 256; bf16* MX = (bf16*)(F.ws + WS_MIXED) + row0 * D;
    f32x4 og2[2] = {*(const f32x4*)(og + 32 * w + 4 * g4), *(const f32x4*)(og + 32 * w + 16 + 4 * g4)}; PIN4(og2[0], og2[1], og2[0], og2[1]);
#pragma unroll
    for (int tt = 0; tt < S5S; ++tt) { const float rs = RSTD[16 * tt + il];
#pragma unroll
        for (int nt = 0; nt < 2; ++nt) { const int n0 = 32 * w + 16 * nt + 4 * g4; const f32x4 o4 = og2[nt];
            *(GAS unsigned long long*)((char*)(MX + (size_t)16 * tt * D) + (unsigned)(il * D + n0) * 2u) = (unsigned long long)cvtpk(acc[tt][nt][0] * rs * o4[0], acc[tt][nt][1] * rs * o4[1]) | ((unsigned long long)cvtpk(acc[tt][nt][2] * rs * o4[2], acc[tt][nt][3] * rs * o4[3]) << 32); } }
    __syncthreads();
}
constexpr int MOETBL_OFF = SEG_OFF + 2048;
static_assert(MOETBL_OFF % 16 == 0 && MOETBL_OFF + 64 <= LDS_BYTES, "LDS map (MoE table)");
__device__ __forceinline__ void moe_table(Frame& F) {
    if (mk_tid(F.wave_s) == 0) { LAS int* tbl = (LAS int*)(F.lds + MOETBL_OFF); const unsigned* cnt = (const unsigned*)(F.ctl + CW_CNT); int acc = 0;
        for (int e = 0; e < 8; ++e) { tbl[e] = acc; acc += ((int)cnt[e] + 255) >> 8; } tbl[8] = acc;
        const int rem = 4 * (acc % 64), S = rem == 0 ? 1 : (rem <= 24 ? 14 : (rem <= 48 ? 7 : (rem <= 176 ? 2 : 1)));
        tbl[9] = S == 1 ? acc : acc - acc % 64; tbl[10] = S; }
    __syncthreads();
}
constexpr int NU_S5 = 2 * NCH5, NU_HG = 520, NU_RT = 1040, NU_ALL = NU_S5 + NU_HG + NU_RT, QSLOT_OFF = MOETBL_OFF + 64;
static_assert(QSLOT_OFF % 16 == 0 && QSLOT_OFF + 16 <= LDS_BYTES, "LDS map (queue slot)");
template <bool IS_MC> __device__ __forceinline__ void p_mixer_units(Frame& F, int l, float* outb, int qidx) {
    LAS int* slot = (LAS int*)(F.lds + QSLOT_OFF); gu32* q = F.ctl + CW_QUEUE + 64 * qidx;
    const bool t0 = mk_tid(F.wave_s) == 0; int nxt = 0;
    if (t0) slot[0] = (int)__hip_atomic_fetch_add(q, 1u, RLX_AGENT);
    __syncthreads();
    for (;;) {
        const int u = __builtin_amdgcn_readfirstlane(slot[0]);
        if (u >= NU_ALL) break;
        if (t0) nxt = (int)__hip_atomic_fetch_add(q, 1u, RLX_AGENT);
        if (u < NU_S5) { const Loc L = make_loc(F.wave_s); if (IS_MC) { if (!(u / NCH5 == 1 && u % NCH5 < 2)) mc_s5_unit(F, L, l, u / NCH5, u % NCH5, outb); } else ma_s5_unit(F, L, l, u / NCH5, u % NCH5, outb); }
        else if (u < NU_S5 + NU_HG) { const Loc L = make_loc(F.wave_s); const int uu = u - NU_S5; if (IS_MC) { if (!(uu / 260 == 1 && ((uu % 260) >> 2) == 0)) mc_hg_unit(F, L, l, uu / 260, (uu % 260) >> 2, uu & 3, outb); } else ma_hg_unit(F, L, l, uu / 260, (uu % 260) >> 2, uu & 3, outb); }
        else { const Loc L = make_loc(F.wave_s); const int uu = u - NU_S5 - NU_HG; if (IS_MC) { if (!(uu / 520 == 1 && ((uu % 520) >> 3) == 0)) mc_ret_unit(F, L, l, uu / 520, (uu % 520) >> 3, uu & 7, outb); } else ma_ret_unit(F, L, uu / 520, (uu % 520) >> 3, uu & 7, outb); }
        if (t0) slot[0] = nxt;
        __syncthreads();
    }
}
__device__ __forceinline__ void p_ma(Frame& F, int l, float* outb) { p_mixer_units<false>(F, l, outb, 2 * l); }
__device__ __forceinline__ void p_mb(Frame& F, int l, float* outb) { const Loc L = make_loc(F.wave_s); const int gt = L.vcu * NT + L.tid;
    if (gt < 32768) mb_ret(L, outb, gt); else if (gt < 65536) mb_hg(L, outb, gt - 32768); else if (gt < 67584) mb_s5(F, L, l, outb, gt - 65536); }
__device__ __forceinline__ void p_mc(Frame& F, int l, float* outb) { p_mixer_units<true>(F, l, outb, 2 * l + 1); }
__device__ __forceinline__ void p_route(Frame& F) {
    const Loc L = make_loc(F.wave_s);
    const bf16* HB = (const bf16*)(F.ws + WS_HB); const float* gff = F.in[19] + D; const float* R = F.in[23];
    int* POS = (int*)(F.ws + WS_POS); float* GATE = (float*)(F.ws + WS_GATE); int* LIST = (int*)(F.ws + WS_LIST); unsigned* CNT = (unsigned*)(F.ctl + CW_CNT);
    LAS float* RT = (LAS float*)F.lds;
    float gr[2][8][8];
#pragma unroll
    for (int jj = 0; jj < 2; ++jj) { const int d0 = 8 * L.lane + 512 * jj; const f32x4 g0 = *(const f32x4*)(gff + d0), g1 = *(const f32x4*)(gff + d0 + 4); f32x4 rr[8][2];
#pragma unroll
        for (int q = 0; q < 8; ++q) { rr[q][0] = *(const f32x4*)(R + (d0 + q) * 8); rr[q][1] = *(const f32x4*)(R + (d0 + q) * 8 + 4); }
        PIN8(rr[0][0], rr[0][1], rr[1][0], rr[1][1], rr[2][0], rr[2][1], rr[3][0], rr[3][1]); PIN8(rr[4][0], rr[4][1], rr[5][0], rr[5][1], rr[6][0], rr[6][1], rr[7][0], rr[7][1]);
#pragma unroll
        for (int q = 0; q < 8; ++q) { const float gq = q < 4 ? g0[q] : g1[q - 4];
#pragma unroll
            for (int e = 0; e < 8; ++e) gr[jj][q][e] = gq * (e < 4 ? rr[q][0][e] : rr[q][1][e - 4]); } }
    for (int grp = L.bx; grp < BATCH * SEQ / 64; grp += L.G) {
        v4u hw8[8][2];
#pragma unroll
        for (int j = 0; j < 8; ++j) { const size_t m = (size_t)(grp * 64 + L.wave * 8 + j); hw8[j][0] = ((const GAS v4u*)(HB + m * D))[L.lane]; hw8[j][1] = ((const GAS v4u*)(HB + m * D))[L.lane + 64]; }
        PIN8(hw8[0][0], hw8[0][1], hw8[1][0], hw8[1][1], hw8[2][0], hw8[2][1], hw8[3][0], hw8[3][1]); PIN8(hw8[4][0], hw8[4][1], hw8[5][0], hw8[5][1], hw8[6][0], hw8[6][1], hw8[7][0], hw8[7][1]);
        float val[72];
#pragma unroll
        for (int j = 0; j < 8; ++j) {
#pragma unroll
            for (int e = 0; e < 9; ++e) val[9 * j + e] = 0.f;
#pragma unroll
            for (int jj = 0; jj < 2; ++jj)
#pragma unroll
                for (int q = 0; q < 8; ++q) { const unsigned wq = hw8[j][jj][q >> 1]; const float hx = __uint_as_float((q & 1) ? (wq & 0xffff0000u) : (wq << 16)); val[9 * j + 8] += hx * hx;
#pragma unroll
                    for (int e = 0; e < 8; ++e) val[9 * j + e] += hx * gr[jj][q][e]; } }
#pragma unroll
        for (int i = 0; i < 36; ++i) { const bool up = (L.lane & 32) != 0; const float send = up ? val[i] : val[i + 36], keep = up ? val[i + 36] : val[i]; val[i] = keep + __shfl_xor(send, 32); }
#pragma unroll
        for (int i = 0; i < 18; ++i) { const bool up = (L.lane & 16) != 0; const float send = up ? val[i] : val[i + 18], keep = up ? val[i + 18] : val[i]; val[i] = keep + __shfl_xor(send, 16); }
#pragma unroll
        for (int i = 0; i < 9; ++i) { const bool up = (L.lane & 8) != 0; const float send = up ? val[i] : val[i + 9], keep = up ? val[i + 9] : val[i]; val[i] = keep + __shfl_xor(send, 8); }
#pragma unroll
        for (int i = 0; i < 9; ++i) { val[i] += __shfl_xor(val[i], 4); val[i] += __shfl_xor(val[i], 2); val[i] += __shfl_xor(val[i], 1); }
        if ((L.lane & 7) == 0) { const int j = L.lane >> 3;
            const float rstd = rsqrtf(val[8] * (1.0f / 1024.0f) + EPS); float lg[8];
#pragma unroll
            for (int e = 0; e < 8; ++e) lg[e] = val[e] * rstd;
            int i1 = 0; float l1 = lg[0];
#pragma unroll
            for (int e = 1; e < 8; ++e) if (lg[e] > l1) { l1 = lg[e]; i1 = e; }
            int i2 = -1; float l2 = -3.0e38f;
#pragma unroll
            for (int e = 0; e < 8; ++e) if (e != i1 && lg[e] > l2) { l2 = lg[e]; i2 = e; }
            const float e2 = __expf(l2 - l1), g1 = 1.0f / (1.0f + e2), g2 = e2 * g1;
            const int sl = L.wave * 8 + j; RT[sl * 4 + 0] = __int_as_float(i1); RT[sl * 4 + 1] = __int_as_float(i2); RT[sl * 4 + 2] = g1; RT[sl * 4 + 3] = g2; RT[256 + sl] = rstd; }
        __syncthreads();
        if (L.wave == 0) { const int tk = grp * 64 + L.lane; const int e1 = __float_as_int(RT[L.lane * 4 + 0]), e2 = __float_as_int(RT[L.lane * 4 + 1]); const float g1 = RT[L.lane * 4 + 2], g2 = RT[L.lane * 4 + 3];
            const int row = tk; const unsigned long long lt = (1ull << L.lane) - 1ull; int p1 = 0, p2 = 0, off2 = 0; unsigned mine = 0u;
#pragma unroll
            for (int e = 0; e < 8; ++e) { const unsigned long long m1 = __ballot(e1 == e), m2 = __ballot(e2 == e); const int n1 = __popcll(m1), n2 = __popcll(m2);
                if (L.lane == e) mine = (unsigned)(n1 + n2); if (e1 == e) p1 = __popcll(m1 & lt); if (e2 == e) { p2 = __popcll(m2 & lt); off2 = n1; } }
            unsigned base = 0u; if (L.lane < 8 && mine > 0u) base = atomicAdd(CNT + L.lane, mine);
            p1 += (int)__shfl(base, e1); p2 += (int)__shfl(base, e2) + off2;
            LIST[(size_t)e1 * MOE_CAP + p1] = row; LIST[(size_t)e2 * MOE_CAP + p2] = row; { float* RSL = (float*)(F.ws + WS_RSL); const float rs = RT[256 + L.lane]; RSL[(size_t)e1 * MOE_CAP + p1] = rs; RSL[(size_t)e2 * MOE_CAP + p2] = rs; }
            POS[tk * 2] = (e1 << 20) | p1; POS[tk * 2 + 1] = (e2 << 20) | p2; GATE[tk * 2] = g1; GATE[tk * 2 + 1] = g2; }
        __syncthreads();
    }
}
__device__ __forceinline__ void p_final(Frame& F, float* out) {
    const Loc L = make_loc(F.wave_s);
    const int gw = L.vcu * NWAVES + L.wave, NGW = L.G * NWAVES; const bf16* HB = (const bf16*)(F.ws + WS_HB); const float* gf = F.in[27];
    const int* POS = (const int*)(F.ws + WS_POS); const float* GATE = (const float*)(F.ws + WS_GATE); const bf16* YS = (const bf16*)(F.ws + WS_YS); const unsigned* CNT = (const unsigned*)(F.ctl + CW_CNT);
    moe_table(F); const LAS int* tbl = (const LAS int*)(F.lds + MOETBL_OFF); const int Tm = tbl[9], SP = tbl[10]; const bf16* PART = (const bf16*)(F.ws + WS_PART);
    f32x4 gfr[4];
#pragma unroll
    for (int j = 0; j < 4; ++j) gfr[j] = ((const GAS f32x4*)gf)[L.lane + 64 * j];
    PIN4(gfr[0], gfr[1], gfr[2], gfr[3]);
    for (int r = gw; r < BATCH * SEQ; r += NGW) { const size_t m = (size_t)r;
        const int q1 = POS[r * 2], q2 = POS[r * 2 + 1]; const float g1 = GATE[r * 2], g2 = GATE[r * 2 + 1]; const int t1 = tbl[q1 >> 20], t2 = tbl[q2 >> 20];
        const size_t s1 = (size_t)t1 * 256 + (q1 & 0xfffff), s2 = (size_t)t2 * 256 + (q2 & 0xfffff);
        f32x4 v[4]; float s = 0.f; unsigned long long hh[4], ya[4], yb[4];
        const bool tl1 = (int)(s1 >> 8) >= Tm, tl2 = (int)(s2 >> 8) >= Tm;
#pragma unroll
        for (int j = 0; j < 4; ++j) { hh[j] = ((const GAS unsigned long long*)(HB + m * D))[L.lane + 64 * j];
            ya[j] = tl1 ? 0ull : ((const GAS unsigned long long*)(YS + s1 * D))[L.lane + 64 * j]; yb[j] = tl2 ? 0ull : ((const GAS unsigned long long*)(YS + s2 * D))[L.lane + 64 * j]; }
        PIN4(hh[0], hh[1], hh[2], hh[3]); PIN8(ya[0], ya[1], ya[2], ya[3], yb[0], yb[1], yb[2], yb[3]);
        float ta[4][4], tb2[4][4];
        if (tl1 || tl2) {
#pragma unroll
            for (int j = 0; j < 4; ++j)
#pragma unroll
                for (int q = 0; q < 4; ++q) { ta[j][q] = 0.f; tb2[j][q] = 0.f; }
            for (int ks0 = 0; ks0 < SP; ks0 += 7) {
                unsigned long long pa[7][4], pb[7][4];
#pragma unroll
                for (int kk = 0; kk < 7; ++kk)
#pragma unroll
                    for (int j = 0; j < 4; ++j) { const bool on = ks0 + kk < SP;
                        pa[kk][j] = (tl1 && on) ? *(const GAS unsigned long long*)(PART + ((size_t)((((int)(s1 >> 8) - Tm) * 4 + j) * SP + ks0 + kk)) * 65536 + (size_t)(s1 & 255) * 256 + 4 * L.lane) : 0ull;
                        pb[kk][j] = (tl2 && on) ? *(const GAS unsigned long long*)(PART + ((size_t)((((int)(s2 >> 8) - Tm) * 4 + j) * SP + ks0 + kk)) * 65536 + (size_t)(s2 & 255) * 256 + 4 * L.lane) : 0ull; }
#pragma unroll
                for (int kk = 0; kk < 7; ++kk) { PIN8(pa[kk][0], pa[kk][1], pa[kk][2], pa[kk][3], pb[kk][0], pb[kk][1], pb[kk][2], pb[kk][3]); }
#pragma unroll
                for (int kk = 0; kk < 7; ++kk)
#pragma unroll
                    for (int j = 0; j < 4; ++j)
#pragma unroll
                        for (int q = 0; q < 4; ++q) { ta[j][q] += bf2f((bf16)(pa[kk][j] >> (16 * q))); tb2[j][q] += bf2f((bf16)(pb[kk][j] >> (16 * q))); } } }
#pragma unroll
        for (int j = 0; j < 4; ++j) { const unsigned long long y1 = ya[j], y2 = yb[j];
#pragma unroll
            for (int q = 0; q < 4; ++q) v[j][q] = bf2f((bf16)(hh[j] >> (16 * q))) + g1 * (tl1 ? ta[j][q] : bf2f((bf16)(y1 >> (16 * q)))) + g2 * (tl2 ? tb2[j][q] : bf2f((bf16)(y2 >> (16 * q))));
            s += (v[j].x * v[j].x + v[j].y * v[j].y) + (v[j].z * v[j].z + v[j].w * v[j].w); }
        const float rstd = rsqrtf(wave_sum(s) * (1.0f / 1024.0f) + EPS);
#pragma unroll
        for (int j = 0; j < 4; ++j) ((GAS f32x4*)(out + (size_t)r * D))[L.lane + 64 * j] = v[j] * rstd * gfr[j];
        if (PROBE_TA >= 0 && r == 0 && L.lane == 0) { asm volatile("s_waitcnt vmcnt(0)" ::: "memory"); out[0] = PROBE_SCALE * (float)(__hip_atomic_load(F.ctl + CW_PROBE + (PROBE_TB >= 0 ? PROBE_TB : 0), RLX_AGENT) - __hip_atomic_load(F.ctl + CW_PROBE + (PROBE_TA >= 0 ? PROBE_TA : 0), RLX_AGENT)); }
    }
}

template <int KIND> __device__ __forceinline__ void meta_side(Frame& F, const bf16* A, int K, const bf16* Wt, int ntiles, bf16* OUT, int ldo) {
    const Loc L = make_loc(F.wave_s);
    if (L.bx < ntiles) {
        LAS float* red = (LAS float*)F.lds; LAS float* rs = red + 8 * 64 * 8;
        const int il = L.lane & 15, g = L.lane >> 4, w = L.wave;
        if (KIND != 1) { const bf16* HB = (const bf16*)(F.ws + WS_HB);
#pragma unroll
            for (int rr = 0; rr < 2; ++rr) { const int r = 2 * w + rr; const v4u x0 = ((const GAS v4u*)(HB + (size_t)(MROW0 + r) * D))[L.lane], x1 = ((const GAS v4u*)(HB + (size_t)(MROW0 + r) * D))[L.lane + 64]; float ss = 0.f;
#pragma unroll
                for (int q = 0; q < 4; ++q) { const float a = __uint_as_float(x0[q] << 16), bq = __uint_as_float(x0[q] & 0xffff0000u), c = __uint_as_float(x1[q] << 16), d = __uint_as_float(x1[q] & 0xffff0000u); ss += (a * a + bq * bq) + (c * c + d * d); }
                ss = wave_sum(ss); if (L.lane == 0) rs[r] = rsqrtf(ss * (1.0f / 1024.0f) + EPS); } }
        const int kw = K / 8, nks = kw / 32;
        const int n0 = KIND == 2 ? ((16 * L.bx) >> 7) * 256 + ((16 * L.bx) & 127) : 16 * L.bx;
        const bf16* ap = A + (size_t)(MROW0 + il) * K + w * kw + 8 * g; const bf16* bp = Wt + (size_t)(n0 + il) * K + w * kw + 8 * g;
        const f32x4 zero = {0.f, 0.f, 0.f, 0.f}; f32x4 a0 = zero, a1 = zero;
        for (int ks = 0; ks < nks; ++ks) { const bf16x8 Af = *(const bf16x8*)(ap + 32 * ks), B0 = *(const bf16x8*)(bp + 32 * ks); a0 = mfma16(Af, B0, a0);
            if (KIND == 2) { const bf16x8 B1 = *(const bf16x8*)(bp + (size_t)128 * K + 32 * ks); a1 = mfma16(Af, B1, a1); } }
        *(LAS f32x4*)(red + (w * 64 + L.lane) * 8) = a0; if (KIND == 2) *(LAS f32x4*)(red + (w * 64 + L.lane) * 8 + 4) = a1;
        __syncthreads();
        if (w == 0) { f32x4 s0 = zero, s1 = zero;
#pragma unroll
            for (int ww = 0; ww < 8; ++ww) { s0 = s0 + *(const LAS f32x4*)(red + (ww * 64 + L.lane) * 8); if (KIND == 2) s1 = s1 + *(const LAS f32x4*)(red + (ww * 64 + L.lane) * 8 + 4); }
#pragma unroll
            for (int r = 0; r < 4; ++r) { const int mr = 4 * g + r; bf16* o = OUT + (size_t)(MROW0 + mr) * ldo + 16 * L.bx + il;
                if (KIND == 0) *o = f2bf_(s0[r] * rs[mr]);
                else if (KIND == 1) *o = f2bf_(bf2f(*o) + s0[r]);
                else { const float av = s0[r] * rs[mr], bv = s1[r] * rs[mr]; *o = f2bf_(silu_f(av) * bv); } } }
        __syncthreads();
    }
}
struct Args { const float* in[28]; float* out; unsigned char* ws; int ph_lo, ph_hi, li, pad; };
__global__ void __launch_bounds__(NWAVES * 64, 2) __attribute__((amdgpu_waves_per_eu(2, 2))) mk_fwd(Args args) {
    extern __shared__ __attribute__((aligned(16))) unsigned char lds[];
    Frame F;
    F.lds = (LAS unsigned char*)lds; F.MISC = (volatile LAS unsigned*)(F.lds + MISC_OFF);
    F.ws = args.ws; F.ctl = (gu32*)(args.ws + WS_CTL); F.in = args.in; F.wave_s = __builtin_amdgcn_readfirstlane((int)threadIdx.x >> 6);
    for (int u = mk_tid(F.wave_s); u < (LDS_BYTES - LDSCTL_OFF) / 4; u += NWAVES * 64) ((LAS unsigned*)(F.lds + LDSCTL_OFF))[u] = 0u;
    __syncthreads();
    XcdBarrier bar; bar.bar = (unsigned*)(F.ctl + CW_BAR); bar.x = 0; bar.st = nullptr; bar.wv = F.wave_s;
    if (!MK_PER_PHASE) bar = xcd_barrier_post((unsigned*)(F.ctl + CW_BAR), F.MISC + 8, F.wave_s);
    STAMP(15);
    const int lo = args.ph_lo, hi = args.ph_hi;
#define IN(k) (lo <= (k) && (k) < hi)
#define SEAM(k) do { if (!MK_PER_PHASE && (k) + 1 < hi) xcd_barrier(bar); STAMP(16 + (k)); } while (0)
    unsigned char* ws = args.ws;
    float* SS = (float*)(ws + WS_SSP);
    if (IN(0)) for (int rep = 0; rep < REP(1); ++rep) { p0_prologue(F); SEAM(0); }
    for (int l = 0; l < 2; ++l) {
        { unsigned char* w_ = args.ws; asm volatile("" : "+s"(w_)); ws = w_; F.ws = w_; F.ctl = (gu32*)(w_ + WS_CTL); SS = (float*)(w_ + WS_SSP); }
        const int base = 1 + 30 * l;
        if (IN(base + 0)) for (int rep = 0; rep < REP(2); ++rep) {
            pg8::Gemm g{(const bf16*)(ws + WS_HB), (const bf16*)(ws + WS_WIN) + (size_t)l * NIN * D, MT, NIN, D, F.wave_s}; pg8::StaticOrder S; const Loc L = make_loc(F.wave_s); S.init(MT, NIN, L.G, L.bx);
            pg8::EpiProj E{(bf16*)(ws + WS_PROJ), NIN, SS + (size_t)(2 * l) * M * 16};
            pg8::gemm_phase<pg8::EpiProj, pg8::StaticOrder, true, true>(F.lds + RING_OFF, g, S, E);
            meta_side<0>(F, (const bf16*)(ws + WS_HB), D, (const bf16*)(ws + WS_WIN) + (size_t)l * NIN * D, NIN / 16, (bf16*)(ws + WS_PROJ), NIN);
            { const Loc L2 = make_loc(F.wave_s); if (L2.bx >= 192) conv_moe13(F, L2.bx - 192, 64, l == 0 ? 1408 : 3008, l == 0 ? 1984 : N_M13, L2.tid); }
            SEAM(base + 0);
        }
        if (IN(base + 1)) for (int rep = 0; rep < REP(3); ++rep) { p_ma(F, l, args.out); SEAM(base + 1); }
        if (IN(base + 2)) { p_mb(F, l, args.out); SEAM(base + 2); }
        if (IN(base + 3)) for (int rep = 0; rep < REP(4); ++rep) { p_mc(F, l, args.out); SEAM(base + 3); }
        if (IN(base + 6)) {
            pg8::Gemm g{(const bf16*)(ws + WS_MIXED), (const bf16*)(ws + WS_WOUT) + (size_t)l * D * D, MT, D, D, F.wave_s}; pg8::StaticOrder S; const Loc L = make_loc(F.wave_s); S.init(MT, D, L.G, L.bx);
            pg8::EpiResid E{(bf16*)(ws + WS_HB), SS + (size_t)(2 * l + 1) * M * 16, nullptr, 0, 1};
            pg8::gemm_phase<pg8::EpiResid, pg8::StaticOrder, true, true>(F.lds + RING_OFF, g, S, E);
            if (l == 0) meta_side<1>(F, (const bf16*)(ws + WS_MIXED), D, (const bf16*)(ws + WS_WOUT), D / 16, (bf16*)(ws + WS_HB), D);
            SEAM(base + 6);
        }
        if (l == 0) {
            if (IN(base + 8)) for (int rep = 0; rep < REP(5); ++rep) {
                pg8::Gemm g{(const bf16*)(ws + WS_HB), (const bf16*)(ws + WS_WF13), MT, 2 * DFF, D, F.wave_s}; pg8::StaticOrder S; const Loc L = make_loc(F.wave_s); S.init(MT, 2 * DFF, L.G, L.bx);
                pg8::EpiSwiglu E{(bf16*)(ws + WS_ACT), DFF, SS + (size_t)1 * M * 16};
                pg8::gemm_phase<pg8::EpiSwiglu, pg8::StaticOrder, true, true>(F.lds + RING_OFF, g, S, E);
                meta_side<2>(F, (const bf16*)(ws + WS_HB), D, (const bf16*)(ws + WS_WF13), DFF / 16, (bf16*)(ws + WS_ACT), DFF);
                { const Loc L2 = make_loc(F.wave_s); if (L2.bx >= 128) conv_moe13(F, L2.bx - 128, 128, 1984, 3008, L2.tid); }
                SEAM(base + 8);
            }
            if (IN(base + 9)) {
                pg8::Gemm g{(const bf16*)(ws + WS_ACT), (const bf16*)(ws + WS_WF2), MT, D, DFF, F.wave_s}; pg8::StaticOrder S; const Loc L = make_loc(F.wave_s); S.init(MT, D, L.G, L.bx);
                pg8::EpiResid E{(bf16*)(ws + WS_HB), SS + (size_t)2 * M * 16, nullptr, 0, 1};
                pg8::gemm_phase<pg8::EpiResid, pg8::StaticOrder, true, true>(F.lds + RING_OFF, g, S, E);
                meta_side<1>(F, (const bf16*)(ws + WS_ACT), DFF, (const bf16*)(ws + WS_WF2), D / 16, (bf16*)(ws + WS_HB), D);
                SEAM(base + 9);
            }
        } else {
            if (IN(base + 7)) { p_route(F); SEAM(base + 7); }
            if (IN(base + 10)) for (int rep = 0; rep < REP(6); ++rep) {
                pg8::Gemm g{(const bf16*)(ws + WS_HB), (const bf16*)(ws + WS_WM13), MOE_TMAX * 256, NEXP * 2 * DFE, D, F.wave_s}; const Loc L = make_loc(F.wave_s);
                moe_table(F); pg8::MoeOrder<true> S; S.init((const int*)(F.ctl + CW_CNT), (const int*)(ws + WS_LIST), MOE_CAP, 2 * DFE / 256, L.G, L.bx, (const LAS int*)(F.lds + MOETBL_OFF));
                pg8::EpiSwigluMoe E{(bf16*)(ws + WS_ACT), DFE, (const float*)(ws + WS_RSL), MOE_CAP, 2 * DFE / 256};
                pg8::gemm_phase<pg8::EpiSwigluMoe, pg8::MoeOrder<true>, true, true>(F.lds + RING_OFF, g, S, E);
                { const Loc L2 = make_loc(F.wave_s); const int rem = S.nwg % L2.G; if (rem == 0) conv_w2(F, L2.bx, L2.G, 792, 1792, L2.tid); else if (L2.bx >= rem) conv_w2(F, L2.bx - rem, L2.G - rem, 792, 1792, L2.tid); }
                SEAM(base + 10);
            }
            if (IN(base + 12)) for (int rep = 0; rep < REP(7); ++rep) {
                pg8::Gemm g{(const bf16*)(ws + WS_ACT), (const bf16*)(ws + WS_WM2A), MOE_TMAX * 256, NEXP * D, DFE, F.wave_s}; const Loc L = make_loc(F.wave_s);
                moe_table(F); pg8::MoeOrder<false> S; S.init((const int*)(F.ctl + CW_CNT), (const int*)(ws + WS_LIST), MOE_CAP, D / 256, L.G, L.bx, (const LAS int*)(F.lds + MOETBL_OFF)); S.hi_off = (long)WS_WM2B - (long)WS_WM2A - (long)4 * D * DFE * 2;
                S.nT = ((const LAS int*)(F.lds + MOETBL_OFF))[9]; S.nwg = S.nT * S.nNe;
                pg8::EpiYs E{(bf16*)(ws + WS_YS)};
                pg8::gemm_phase<pg8::EpiYs, pg8::MoeOrder<false>, true, true>(F.lds + RING_OFF, g, S, E);
                { pg8::Gemm g2{(const bf16*)(ws + WS_ACT), (const bf16*)(ws + WS_WM2A), MOE_TMAX * 256, NEXP * D, 0, F.wave_s, DFE}; const Loc L2 = make_loc(F.wave_s);
                  pg8::MoeTailOrder S2; S2.init((const LAS int*)(F.lds + MOETBL_OFF), L2.G, L2.bx, DFE); S2.hi_off = S.hi_off; g2.K = S2.kslice;
                  pg8::EpiPart E2{(bf16*)(ws + WS_PART), S2.S};
                  if (S2.nsub > 0) pg8::gemm_phase<pg8::EpiPart, pg8::MoeTailOrder, true, true>(F.lds + RING_OFF, g2, S2, E2); }
                SEAM(base + 12);
            }
        }
    }
    if (IN(NPH - 1)) for (int rep = 0; rep < REP(9); ++rep) p_final(F, args.out);
#undef IN
#undef SEAM
}

extern "C" void kernel_launch(void* const* d_in, const int* in_sizes, int n_in, void* d_out, int out_size, void* d_ws, size_t ws_size, hipStream_t stream) {
    static int grid = 0;
    if (grid == 0) {
        if (n_in != 28 || out_size != BATCH * SEQ * D || ws_size < WS_END) { fprintf(stderr, "kernel_launch: unexpected shapes: n_in %d out %d ws %zu (need %zu)\n", n_in, out_size, ws_size, (size_t)WS_END); grid = -1; return; }
        int dev = 0, cus = 0, per_cu = 0;
        if (hipGetDevice(&dev) != hipSuccess || hipDeviceGetAttribute(&cus, hipDeviceAttributeMultiprocessorCount, dev) != hipSuccess) { grid = -1; return; }
        if (hipFuncSetAttribute((const void*)mk_fwd, hipFuncAttributeMaxDynamicSharedMemorySize, LDS_BYTES) != hipSuccess) { fprintf(stderr, "kernel_launch: hipFuncSetAttribute failed\n"); grid = -1; return; }
        if (hipOccupancyMaxActiveBlocksPerMultiprocessor(&per_cu, (const void*)mk_fwd, NWAVES * 64, LDS_BYTES) != hipSuccess || per_cu < 1) { fprintf(stderr, "kernel_launch: occupancy query says %d\n", per_cu); }
        (void)hipGetLastError();
        grid = cus;
    }
    if (grid < 0) return;
    if (hipMemsetAsync((char*)d_ws + WS_CTL, 0, CTL_ZERO_BYTES, stream) != hipSuccess) return;
    Args a{};
    for (int i = 0; i < 28; ++i) a.in[i] = (const float*)d_in[i];
    a.out = (float*)d_out; a.ws = (unsigned char*)d_ws;
#if MK_PER_PHASE
    for (int k = 0; k < NPH; ++k) { if (!phase_exists(k)) continue; a.ph_lo = k; a.ph_hi = k + 1; a.li = 0; hipLaunchKernelGGL(mk_fwd, dim3(grid), dim3(NWAVES * 64), LDS_BYTES, stream, a); }
#else
    a.ph_lo = 0; a.ph_hi = NPH; a.li = 0;
    hipLaunchKernelGGL(mk_fwd, dim3(grid), dim3(NWAVES * 64), LDS_BYTES, stream, a);
#endif
}
```
